# Optimizing an MI355X kernel written in HIP

```python
import jax, jax.numpy as jnp
from jax import lax
import numpy as np

D_MODEL = 1024
BATCH = 16
SEQ = 2048
DEPTH = 2
DEC_BATCH = 128
DEC_SEQ = 8
PAST_LEN = 8192
PAGE_SIZE = 128

N_MIXERS = 2
N_MLA_LAYERS = (DEPTH + 1) // 2
N_GLA_LAYERS = DEPTH // 2
D_FF = 2816
FFN_RESID = 0.5
EPS = 1e-6

MLA_HEADS = 8
MLA_Q_LORA = 384
MLA_KV_LORA = 256
MLA_NOPE = 128
MLA_ROPE = 64
MLA_V = 128
MLA_SCALE = (MLA_NOPE + MLA_ROPE) ** -0.5
ROPE_THETA = 10000.0
Q_BLOCK = 128

GLA_HEADS = 4
GLA_DK = D_MODEL // 2 // GLA_HEADS
GLA_DV = D_MODEL // GLA_HEADS
GLA_GATE_RANK = 16
GLA_GATE_NORM = 16.0
GLA_CHUNK = 64

kernel_name = 'hybrid_mla_gla_macaron_step'


def rmsnorm(x, g):
    xf = x.astype(jnp.float32)
    y = xf * lax.rsqrt(jnp.mean(xf * xf, axis=-1, keepdims=True) + EPS)
    return (y * g.astype(jnp.float32)).astype(x.dtype)


def ffn_half(h, g_pre, g_post, w_in, w_out):
    a = rmsnorm(h, g_pre) @ w_in
    gate, up = jnp.split(a, 2, axis=-1)
    return h + FFN_RESID * rmsnorm((jax.nn.silu(gate) * up) @ w_out, g_post)


def rope(x, pos):
    half = MLA_ROPE // 2
    inv = ROPE_THETA ** (-jnp.arange(half, dtype=jnp.float32) / half)
    ang = pos.astype(jnp.float32)[:, None] * inv[None, :]
    cos = jnp.cos(ang)[None, :, None, :]
    sin = jnp.sin(ang)[None, :, None, :]
    xf = x.astype(jnp.float32)
    x1, x2 = xf[..., :half], xf[..., half:]
    return jnp.concatenate([x1 * cos - x2 * sin, x2 * cos + x1 * sin], axis=-1).astype(x.dtype)


def mla_project(x, pos, w_down, g_q, w_uq, g_kv):
    B, S, _ = x.shape
    d = x @ w_down
    c_q = rmsnorm(d[..., :MLA_Q_LORA], g_q)
    c_kv = rmsnorm(d[..., MLA_Q_LORA:MLA_Q_LORA + MLA_KV_LORA], g_kv)
    k_pe = rope(d[..., MLA_Q_LORA + MLA_KV_LORA:][:, :, None, :], pos)[:, :, 0, :]
    q = (c_q @ w_uq).reshape(B, S, MLA_HEADS, MLA_NOPE + MLA_ROPE)
    q_nope = q[..., :MLA_NOPE]
    q_pe = rope(q[..., MLA_NOPE:], pos)
    return q_nope, q_pe, c_kv, k_pe


def mla_prompt(x, w_down, g_q, w_uq, g_kv, w_uk, w_uv, w_o):
    B, S, _ = x.shape
    pos = jnp.arange(S)
    q_nope, q_pe, c_kv, k_pe = mla_project(x, pos, w_down, g_q, w_uq, g_kv)
    k_nope = jnp.einsum('bsr,rhd->bshd', c_kv, w_uk)
    v = jnp.einsum('bsr,rhd->bshd', c_kv, w_uv)
    n_blk = S // Q_BLOCK
    qn_b = q_nope.reshape(B, n_blk, Q_BLOCK, MLA_HEADS, MLA_NOPE).swapaxes(0, 1)
    qp_b = q_pe.reshape(B, n_blk, Q_BLOCK, MLA_HEADS, MLA_ROPE).swapaxes(0, 1)
    key_pos = jnp.arange(S)

    def block(args):
        qn, qp, i = args
        s = (jnp.einsum('bqhd,bkhd->bhqk', qn, k_nope)
             + jnp.einsum('bqhr,bkr->bhqk', qp, k_pe)).astype(jnp.float32) * MLA_SCALE
        q_pos = i * Q_BLOCK + jnp.arange(Q_BLOCK)
        s = jnp.where(key_pos[None, :] <= q_pos[:, None], s, -jnp.inf)
        p = jax.nn.softmax(s, axis=-1).astype(v.dtype)
        return jnp.einsum('bhqk,bkhd->bqhd', p, v)

    o = lax.map(block, (qn_b, qp_b, jnp.arange(n_blk)))
    o = o.swapaxes(0, 1).reshape(B, S, MLA_HEADS * MLA_V)
    return o @ w_o, c_kv, k_pe


def mla_sample(x, cache_ckv, cache_kpe, page_table, w_down, g_q, w_uq, g_kv, w_uk, w_uv, w_o):
    B, T, _ = x.shape
    pos = PAST_LEN + jnp.arange(T)
    q_nope, q_pe, c_kv, k_pe = mla_project(x, pos, w_down, g_q, w_uq, g_kv)
    past_ckv = cache_ckv[page_table].reshape(B, -1, MLA_KV_LORA).astype(c_kv.dtype)
    past_kpe = cache_kpe[page_table].reshape(B, -1, MLA_ROPE).astype(k_pe.dtype)
    P = past_ckv.shape[1]
    all_ckv = jnp.concatenate([past_ckv, c_kv], axis=1)
    all_kpe = jnp.concatenate([past_kpe, k_pe], axis=1)
    q_lat = jnp.einsum('bthd,rhd->bthr', q_nope, w_uk)
    s = (jnp.einsum('bthr,bkr->bhtk', q_lat, all_ckv)
         + jnp.einsum('bthd,bkd->bhtk', q_pe, all_kpe)).astype(jnp.float32) * MLA_SCALE
    key_idx = jnp.arange(P + T)
    q_idx = P + jnp.arange(T)
    s = jnp.where(key_idx[None, :] <= q_idx[:, None], s, -jnp.inf)
    p = jax.nn.softmax(s, axis=-1).astype(all_ckv.dtype)
    o_lat = jnp.einsum('bhtk,bkr->bthr', p, all_ckv)
    o = jnp.einsum('bthr,rhd->bthd', o_lat, w_uv).reshape(B, T, MLA_HEADS * MLA_V)
    return o @ w_o, c_kv, k_pe


def gla_project(x, w_in, w_gk1, w_gk2, b_gk):
    B, S, _ = x.shape
    hk, hv = GLA_HEADS * GLA_DK, GLA_HEADS * GLA_DV
    p = x @ w_in
    q, k, v, og = jnp.split(p, [hk, 2 * hk, 2 * hk + hv], axis=-1)
    q = q.reshape(B, S, GLA_HEADS, GLA_DK) * GLA_DK ** -0.5
    k = k.reshape(B, S, GLA_HEADS, GLA_DK)
    v = v.reshape(B, S, GLA_HEADS, GLA_DV)
    gk = jax.nn.log_sigmoid(((x @ w_gk1) @ w_gk2 + b_gk).astype(jnp.float32)) / GLA_GATE_NORM
    gk = gk.reshape(B, S, GLA_HEADS, GLA_DK)
    return q, k, v, gk, og


def gla_chunk(state, q, k, v, g):
    qf, kf, vf = q.astype(jnp.float32), k.astype(jnp.float32), v.astype(jnp.float32)
    G = jnp.cumsum(g, axis=1)
    C = q.shape[1]
    causal = jnp.tril(jnp.ones((C, C), dtype=bool))
    diff = G[:, :, None] - G[:, None, :]
    decay = jnp.exp(jnp.where(causal[None, :, :, None, None], diff, -jnp.inf))
    attn = jnp.sum(qf[:, :, None] * kf[:, None, :] * decay, axis=-1)
    o = (jnp.einsum('bthk,bhkv->bthv', qf * jnp.exp(G), state)
         + jnp.einsum('btsh,bshv->bthv', attn, vf))
    g_last = G[:, -1]
    new_state = (jnp.exp(g_last)[..., None] * state
                 + jnp.einsum('bshk,bshv->bhkv', kf * jnp.exp(g_last[:, None] - G), vf))
    return new_state, o


def gla_output(o, og, g_norm, w_o):
    B, S = o.shape[:2]
    og = og.reshape(B, S, GLA_HEADS, GLA_DV)
    o = rmsnorm(o.astype(og.dtype), g_norm) * jax.nn.silu(og)
    return o.reshape(B, S, GLA_HEADS * GLA_DV) @ w_o


def gla_prompt(x, w_in, w_gk1, w_gk2, b_gk, g_norm, w_o):
    B, S, _ = x.shape
    q, k, v, gk, og = gla_project(x, w_in, w_gk1, w_gk2, b_gk)
    n = S // GLA_CHUNK

    def to_chunks(a):
        return a.reshape(B, n, GLA_CHUNK, *a.shape[2:]).swapaxes(0, 1)

    s0 = jnp.zeros((B, GLA_HEADS, GLA_DK, GLA_DV), jnp.float32)

    def step(state, inp):
        return gla_chunk(state, *inp)

    s_fin, o = lax.scan(step, s0, (to_chunks(q), to_chunks(k), to_chunks(v), to_chunks(gk)))
    o = o.swapaxes(0, 1).reshape(B, S, GLA_HEADS, GLA_DV)
    return gla_output(o, og, g_norm, w_o), s_fin


def gla_sample(x, state, w_in, w_gk1, w_gk2, b_gk, g_norm, w_o):
    q, k, v, gk, og = gla_project(x, w_in, w_gk1, w_gk2, b_gk)
    s_new, o = gla_chunk(state.astype(jnp.float32), q, k, v, gk)
    return gla_output(o, og, g_norm, w_o), s_new


def setup_inputs(seed: int = 0) -> dict:
    key = jax.random.key(seed)
    ks = jax.random.split(key, 24)
    n_pages = PAST_LEN // PAGE_SIZE
    n_pool = (DEC_BATCH * n_pages * 5) // 4

    def w(k, shape, fan_in):
        return jax.random.normal(k, shape, jnp.float32) * fan_in ** -0.5

    def gain(k, shape):
        return 1.0 + 0.02 * jax.random.normal(k, shape, jnp.float32)

    return {
        'x_prompt': jax.random.normal(ks[0], (BATCH, SEQ, D_MODEL), jnp.float32),
        'x_sample': jax.random.normal(ks[1], (DEC_BATCH, DEC_SEQ, D_MODEL), jnp.float32),
        'cache_ckv': jax.random.normal(ks[2], (N_MLA_LAYERS, n_pool, PAGE_SIZE, MLA_KV_LORA), jnp.float32),
        'cache_kpe': jax.random.normal(ks[3], (N_MLA_LAYERS, n_pool, PAGE_SIZE, MLA_ROPE), jnp.float32),
        'state_gla': 0.5 * jax.random.normal(ks[4], (N_GLA_LAYERS, DEC_BATCH, GLA_HEADS, GLA_DK, GLA_DV), jnp.float32),
        'page_table': jax.random.permutation(ks[5], n_pool)[:DEC_BATCH * n_pages].reshape(DEC_BATCH, n_pages).astype(jnp.int32),
        'norm_g': gain(ks[6], (DEPTH, 6, D_MODEL)),
        'ffn_w_in': w(ks[7], (DEPTH, 2, D_MODEL, 2 * D_FF), D_MODEL),
        'ffn_w_out': w(ks[8], (DEPTH, 2, D_FF, D_MODEL), D_FF),
        'mla_w_down': w(ks[9], (N_MLA_LAYERS, D_MODEL, MLA_Q_LORA + MLA_KV_LORA + MLA_ROPE), D_MODEL),
        'mla_g_q': gain(ks[10], (N_MLA_LAYERS, MLA_Q_LORA)),
        'mla_w_uq': w(ks[11], (N_MLA_LAYERS, MLA_Q_LORA, MLA_HEADS * (MLA_NOPE + MLA_ROPE)), MLA_Q_LORA),
        'mla_g_kv': gain(ks[12], (N_MLA_LAYERS, MLA_KV_LORA)),
        'mla_w_uk': w(ks[13], (N_MLA_LAYERS, MLA_KV_LORA, MLA_HEADS, MLA_NOPE), MLA_KV_LORA),
        'mla_w_uv': w(ks[14], (N_MLA_LAYERS, MLA_KV_LORA, MLA_HEADS, MLA_V), MLA_KV_LORA),
        'mla_w_o': w(ks[15], (N_MLA_LAYERS, MLA_HEADS * MLA_V, D_MODEL), MLA_HEADS * MLA_V),
        'gla_w_in': w(ks[16], (N_GLA_LAYERS, D_MODEL, 2 * GLA_HEADS * GLA_DK + 2 * GLA_HEADS * GLA_DV), D_MODEL),
        'gla_w_gk1': w(ks[17], (N_GLA_LAYERS, D_MODEL, GLA_GATE_RANK), D_MODEL),
        'gla_w_gk2': w(ks[18], (N_GLA_LAYERS, GLA_GATE_RANK, GLA_HEADS * GLA_DK), GLA_GATE_RANK),
        'gla_b_gk': 0.1 * jax.random.normal(ks[19], (N_GLA_LAYERS, GLA_HEADS * GLA_DK), jnp.float32),
        'gla_g_norm': gain(ks[20], (N_GLA_LAYERS, GLA_DV)),
        'gla_w_o': w(ks[21], (N_GLA_LAYERS, GLA_HEADS * GLA_DV, D_MODEL), GLA_HEADS * GLA_DV),
    }


def reference(x_prompt, x_sample, cache_ckv, cache_kpe, state_gla, page_table,
              norm_g, ffn_w_in, ffn_w_out,
              mla_w_down, mla_g_q, mla_w_uq, mla_g_kv, mla_w_uk, mla_w_uv, mla_w_o,
              gla_w_in, gla_w_gk1, gla_w_gk2, gla_b_gk, gla_g_norm, gla_w_o):
    yp, ys = x_prompt, x_sample
    ckv_p, kpe_p, ckv_s, kpe_s, st_p, st_s = [], [], [], [], [], []
    for i in range(DEPTH):
        g = norm_g[i]
        yp = ffn_half(yp, g[0], g[1], ffn_w_in[i, 0], ffn_w_out[i, 0])
        ys = ffn_half(ys, g[0], g[1], ffn_w_in[i, 0], ffn_w_out[i, 0])
        j = i // N_MIXERS
        if i % N_MIXERS == 0:
            mla_w = (mla_w_down[j], mla_g_q[j], mla_w_uq[j], mla_g_kv[j], mla_w_uk[j], mla_w_uv[j], mla_w_o[j])
            mp, c_p, k_p = mla_prompt(rmsnorm(yp, g[2]), *mla_w)
            ms, c_s, k_s = mla_sample(rmsnorm(ys, g[2]), cache_ckv[j], cache_kpe[j], page_table, *mla_w)
            ckv_p.append(c_p)
            kpe_p.append(k_p)
            ckv_s.append(c_s)
            kpe_s.append(k_s)
        else:
            gla_w = (gla_w_in[j], gla_w_gk1[j], gla_w_gk2[j], gla_b_gk[j], gla_g_norm[j], gla_w_o[j])
            mp, s_p = gla_prompt(rmsnorm(yp, g[2]), *gla_w)
            ms, s_s = gla_sample(rmsnorm(ys, g[2]), state_gla[j], *gla_w)
            st_p.append(s_p)
            st_s.append(s_s)
        yp = yp + rmsnorm(mp, g[3])
        ys = ys + rmsnorm(ms, g[3])
        yp = ffn_half(yp, g[4], g[5], ffn_w_in[i, 1], ffn_w_out[i, 1])
        ys = ffn_half(ys, g[4], g[5], ffn_w_in[i, 1], ffn_w_out[i, 1])
    new_ckv_prompt = jnp.stack(ckv_p, axis=0)
    new_kpe_prompt = jnp.stack(kpe_p, axis=0)
    new_ckv_sample = jnp.stack(ckv_s, axis=0)
    new_kpe_sample = jnp.stack(kpe_s, axis=0)
    new_state_prompt = jnp.stack(st_p, axis=0)
    new_state_sample = jnp.stack(st_s, axis=0)
    return (yp, ys, new_ckv_prompt, new_kpe_prompt, new_ckv_sample, new_kpe_sample, new_state_prompt, new_state_sample)
```

```cpp
#include <hip/hip_runtime.h>
#include <cstdio>
#include <cstdint>


#define GAS __attribute__((address_space(1)))
#define LAS __attribute__((address_space(3)))
typedef unsigned short bf16_t;
typedef short bf16x8 __attribute__((ext_vector_type(8)));
typedef float f32x4 __attribute__((ext_vector_type(4)));
typedef float f32x2 __attribute__((ext_vector_type(2)));
typedef float f32x16 __attribute__((ext_vector_type(16)));
typedef unsigned u32x4 __attribute__((ext_vector_type(4)));
typedef unsigned u32x2 __attribute__((ext_vector_type(2)));

constexpr int DM = 1024, NB = 16, SEQ = 2048, DECB = 128, DECT = 8, PAST = 8192, PAGE = 128, NPAGES = PAST / PAGE;
constexpr int MP = NB * SEQ, MS = DECB * DECT, M = MP + MS;
constexpr int DFF = 2816;
constexpr int QL = 384, KVL = 256, NOPE = 128, ROPE = 64, VD = 128, NH = 8, QKD = NOPE + ROPE;
constexpr int DDOWN = QL + KVL + ROPE, DDOWN_P = 768;
constexpr int GH = 4, GDK = 128, GDV = 256, GRANK = 16, GIN = 2 * GH * GDK + 2 * GH * GDV, GIN_P = GIN + 256;
constexpr float EPS = 1e-6f;
constexpr float LOG2E = 1.4426950408889634f;
constexpr int NPOOL = (DECB * NPAGES * 5) / 4;

constexpr size_t OUT_Y = 0;
constexpr size_t OUT_CKV_P = (size_t)M * DM;
constexpr size_t OUT_KPE_P = OUT_CKV_P + (size_t)MP * KVL;
constexpr size_t OUT_CKV_S = OUT_KPE_P + (size_t)MP * ROPE;
constexpr size_t OUT_KPE_S = OUT_CKV_S + (size_t)MS * KVL;
constexpr size_t OUT_ST_P = OUT_KPE_S + (size_t)MS * ROPE;
constexpr size_t OUT_ST_S = OUT_ST_P + (size_t)NB * GH * GDK * GDV;
constexpr size_t OUT_END = OUT_ST_S + (size_t)DECB * GH * GDK * GDV;

constexpr size_t MiB = 1u << 20;
constexpr size_t al(size_t x) { return (x + 4095) & ~(size_t)4095; }
constexpr size_t WS_CTL = 0, CTL_ZERO_BYTES = 64 * 1024;
constexpr size_t WS_ROPE = 1 * MiB;
constexpr size_t WS_WIN = 2 * MiB;
constexpr size_t SZ_WIN1 = (size_t)2 * DFF * DM * 2;
constexpr size_t WS_WOUT = WS_WIN + 4 * SZ_WIN1;
constexpr size_t SZ_WOUT1 = (size_t)DM * DFF * 2;
constexpr size_t WS_WDOWN = WS_WOUT + 4 * SZ_WOUT1;
constexpr size_t WS_WUQ = WS_WDOWN + (size_t)DDOWN_P * DM * 2;
constexpr size_t WS_WUKT = WS_WUQ + (size_t)NH * QKD * QL * 2;
constexpr size_t WS_WUK = WS_WUKT + (size_t)NH * NOPE * KVL * 2;
constexpr size_t WS_WUVT = WS_WUK + (size_t)NH * NOPE * KVL * 2;
constexpr size_t WS_WOT = WS_WUVT + (size_t)(NH * VD + 128) * KVL * 2;
constexpr size_t WS_WGIN = WS_WOT + (size_t)DM * DM * 2;
constexpr size_t WS_WGO = WS_WGIN + (size_t)GIN_P * DM * 2;
constexpr size_t WS_ACT = al(WS_WGO + (size_t)DM * DM * 2);
constexpr size_t WS_XN = WS_ACT;
constexpr size_t WS_HM = al(WS_XN + (size_t)M * DM * 2);
constexpr size_t WS_T = al(WS_HM + (size_t)M * DFF * 2);
constexpr size_t WS_D = al(WS_T + (size_t)M * DM * 4);
constexpr size_t WS_CQ = al(WS_D + (size_t)M * DDOWN_P * 4);
constexpr size_t WS_CKV = al(WS_CQ + (size_t)M * QL * 2);
constexpr size_t WS_KPES = al(WS_CKV + (size_t)M * KVL * 2);
constexpr size_t WS_Q = al(WS_KPES + (size_t)MS * ROPE * 2);
constexpr size_t WS_KB = al(WS_Q + (size_t)M * NH * QKD * 2);
constexpr size_t WS_VT = al(WS_KB + (size_t)MP * NH * QKD * 2);
constexpr size_t WS_QLAT = al(WS_VT + (size_t)NH * VD * MP * 2);
constexpr size_t WS_O = al(WS_QLAT + (size_t)MS * NH * 320 * 2);
constexpr size_t WS_OPART = al(WS_O + (size_t)M * DM * 2);
constexpr size_t WS_OML = al(WS_OPART + (size_t)DECB * 2 * 64 * 256 * 4);
constexpr size_t WS_OLAT = al(WS_OML + (size_t)DECB * 2 * 64 * 2 * 4);
constexpr size_t WS_QKVG = al(WS_OLAT + (size_t)MS * NH * KVL * 2);
constexpr size_t WS_T16 = al(WS_QKVG + (size_t)M * GIN * 2);
constexpr size_t WS_GO = al(WS_T16 + (size_t)M * 16 * 4);
constexpr size_t WS_END = al(WS_GO + (size_t)M * DM * 4);

constexpr int RING_BYTES = 131072;
constexpr int LDSCTL_OFF = RING_BYTES, MISC_OFF = LDSCTL_OFF + 320;
constexpr int LDS_BYTES = 147456;
constexpr int NWAVES = 8;

#define LDS_WAIT() asm volatile("s_waitcnt lgkmcnt(0)" ::: "memory")
#define VM_WAIT() asm volatile("s_waitcnt vmcnt(0)" ::: "memory")
#define RLX_AGENT __ATOMIC_RELAXED, __HIP_MEMORY_SCOPE_AGENT

__device__ __forceinline__ unsigned cvt_pk_bf16(float lo, float hi) { unsigned r; asm volatile("v_cvt_pk_bf16_f32 %0, %1, %2" : "=v"(r) : "v"(lo), "v"(hi)); return r; }
__device__ __forceinline__ int lane_now() { int l; asm volatile("v_mbcnt_lo_u32_b32 %0, -1, 0\n\tv_mbcnt_hi_u32_b32 %0, -1, %0" : "=v"(l)); return l; }
__device__ __forceinline__ float bf2f(unsigned short b) { return __uint_as_float((unsigned)b << 16); }
__device__ __forceinline__ float wave_sum(float v) {
#pragma unroll
    for (int o = 1; o < 64; o <<= 1) v += __shfl_xor(v, o);
    return v;
}

namespace pg8 {
constexpr int BM = 256, BK = 64, HALF = 128, HTB = HALF * BK * 2, STAGE_BYTES = 8 * HTB, NXCD = 8, WGM = 8;
__host__ __device__ __forceinline__ int lds_byte(int r, int c) { const int st = (r >> 4) * 2 + (c >> 5), rr = r & 15, cc = c & 31, ob = rr * 64 + cc * 2; return st * 1024 + (ob ^ (((ob >> 9) & 1) << 5)); }
__host__ __device__ __forceinline__ void stage_rc(int b, int& R, int& C) { const int st = b / 1024, sb = b % 1024, swz = sb ^ (((sb >> 9) & 1) << 5); R = (st >> 1) * 16 + swz / 64; C = (st & 1) * 32 + (swz % 64) / 2; }
__host__ __device__ __forceinline__ int perm32(int rho) { const int n = rho >> 4, i = rho & 15; return 8 * (i >> 2) + 4 * n + (i & 3); }

struct Unit { int pm, pn, z; };
struct Gemm { const bf16_t* A; const bf16_t* Bt; int lda, ldb, K; long sAz, sBz; };

struct Order {
    int nM, nN, nZ, G, c;
    __device__ __forceinline__ bool next(int i, Unit& u) const {
        const long L = (long)i * G + c; const int per = nM * nN; if (L >= (long)per * nZ) return false;
        const int z = (int)(L / per); int wgid = (int)(L - (long)z * per);
        { const int q = per / NXCD, r = per % NXCD, xcd = wgid % NXCD, off = wgid / NXCD; wgid = (xcd < r ? xcd * (q + 1) : r * (q + 1) + (xcd - r) * q) + off; }
        const int nig = WGM * nN, gid = wgid / nig, fm = gid * WGM, gsz = (nM - fm) < WGM ? (nM - fm) : WGM;
        u.pm = fm + ((wgid % nig) % gsz); u.pn = (wgid % nig) / gsz; u.z = z; return true;
    }
};

template <class Epi, bool ALIGN_EPI>
__device__ __forceinline__ void gemm_phase(LAS unsigned char* lds, const int wid, const Gemm g, const Order& S, const Epi& E) {
    const int lane = lane_now(), tid = wid * 64 + lane;
    const int wr = wid >> 2, wc = wid & 3, fr = lane & 15, fq = lane >> 4;
    const int K = g.K, nt = K / BK;
    unsigned voffA, voffB;
    { int R, C; stage_rc(tid * 16, R, C); const int Rb = Epi::PERM ? ((R & ~31) + perm32(R & 31)) : R;
      voffA = (unsigned)(R * g.lda + C) * 2u; voffB = (unsigned)(Rb * g.ldb + C) * 2u; }
    const size_t qsA = (size_t)64 * g.lda * 2, qsB = (size_t)64 * g.ldb * 2;
    const size_t kstep = (size_t)(BK * 2);
    const size_t hsA = (size_t)HALF * g.lda * 2, hsB = (size_t)HALF * g.ldb * 2;
    const unsigned ldsw = (unsigned)wid * 1024u;
    const int aoff = lds_byte(wr * 64 + fr, fq * 8), boff = lds_byte(wc * 32 + fr, fq * 8);
#define PG8_SA(b, h) (((b) * 2 + (h)) * HTB)
#define PG8_SB(b, h) ((4 + (b) * 2 + (h)) * HTB)
#define PG8_STAGE(bufoff, gbase, voff) do { _Pragma("unroll") for (int _i = 0; _i < 2; ++_i) \
        __builtin_amdgcn_global_load_lds((const unsigned*)((const char*)(gbase) + _i * PG8_QS_##voff + (voff)), (LAS unsigned*)(lds + (bufoff) + ldsw + _i * 8192), 16, 0, 0); } while (0)
#define PG8_QS_voffA qsA
#define PG8_QS_voffB qsB
#define PG8_LDA(dst, b, h) do { _Pragma("unroll") for (int m = 0; m < 4; ++m) _Pragma("unroll") for (int k = 0; k < 2; ++k) dst[m][k] = *(const LAS bf16x8*)(lds + PG8_SA(b, h) + aoff + m * 2048 + k * 1024); } while (0)
#define PG8_LDB(dst, b, h) do { _Pragma("unroll") for (int n = 0; n < 2; ++n) _Pragma("unroll") for (int k = 0; k < 2; ++k) dst[n][k] = *(const LAS bf16x8*)(lds + PG8_SB(b, h) + boff + n * 2048 + k * 1024); } while (0)
#define PG8_MMA(ai, bj, At, Bt) do { __builtin_amdgcn_s_setprio(1); _Pragma("unroll") for (int m = 0; m < 4; ++m) _Pragma("unroll") for (int n = 0; n < 2; ++n) _Pragma("unroll") for (int k = 0; k < 2; ++k) \
        acc[ai][bj][m][n] = __builtin_amdgcn_mfma_f32_16x16x32_bf16(Bt[n][k], At[m][k], acc[ai][bj][m][n], 0, 0, 0); __builtin_amdgcn_s_setprio(0); } while (0)
#define PG8_WAIT_V(n) asm volatile("s_waitcnt vmcnt(" #n ")" ::: "memory")
#define PG8_WAIT_L(n) asm volatile("s_waitcnt lgkmcnt(" #n ")" ::: "memory")
#define PG8_BAR __builtin_amdgcn_s_barrier()
#define PG8_SCHED __builtin_amdgcn_sched_barrier(0)
#define PG8_APTR(u) ((const char*)g.A + ((size_t)(u).z * g.sAz + (size_t)(u).pm * BM * g.lda) * 2)
#define PG8_BPTR(u) ((const char*)g.Bt + ((size_t)(u).z * g.sBz + (size_t)(u).pn * BM * g.ldb) * 2)
    Unit cur, nxt; int ui = 0;
    if (!S.next(0, cur)) return;
    f32x4 acc[2][2][4][2];
#pragma unroll
    for (int a = 0; a < 2; ++a)
#pragma unroll
        for (int b = 0; b < 2; ++b)
#pragma unroll
            for (int m = 0; m < 4; ++m)
#pragma unroll
                for (int n = 0; n < 2; ++n) acc[a][b][m][n] = (f32x4){0.f, 0.f, 0.f, 0.f};
    bf16x8 At[4][2], B0[2][2], B1[2][2];
    const char* cA = PG8_APTR(cur); const char* cB = PG8_BPTR(cur);
    PG8_STAGE(PG8_SB(0, 0), cB, voffB); PG8_STAGE(PG8_SB(0, 1), cB + hsB, voffB); PG8_STAGE(PG8_SA(0, 0), cA, voffA); PG8_STAGE(PG8_SA(0, 1), cA + hsA, voffA);
    if (wr == 1) PG8_BAR;
    PG8_WAIT_V(2); PG8_BAR;
    PG8_STAGE(PG8_SB(1, 0), cB + kstep, voffB); PG8_STAGE(PG8_SA(1, 0), cA + kstep, voffA); PG8_STAGE(PG8_SB(1, 1), cB + hsB + kstep, voffB);
    PG8_WAIT_V(6); PG8_BAR;
    for (;;) {
        const bool has_next = S.next(ui + 1, nxt);
        const char* nA = has_next ? PG8_APTR(nxt) : cA; const char* nB = has_next ? PG8_BPTR(nxt) : cB;
#pragma unroll 1
        for (int t = 0; t < nt; t += 2) {
            const bool last = (t == nt - 2);
            const char* a1 = cA + (size_t)(t + 1) * kstep;
            const char* a2 = last ? nA : cA + (size_t)(t + 2) * kstep; const char* b2 = last ? nB : cB + (size_t)(t + 2) * kstep;
            const char* a3 = a2 + kstep; const char* b3 = b2 + kstep;
            PG8_LDB(B0, 0, 0); PG8_LDB(B1, 0, 1); PG8_SCHED; PG8_LDA(At, 0, 0); PG8_STAGE(PG8_SA(1, 1), a1 + hsA, voffA);
            PG8_WAIT_V(8); PG8_WAIT_L(0); PG8_BAR; PG8_MMA(0, 0, At, B0); PG8_MMA(0, 1, At, B1); PG8_BAR; PG8_SCHED;
            PG8_LDA(At, 0, 1); PG8_STAGE(PG8_SB(0, 0), b2, voffB); PG8_STAGE(PG8_SB(0, 1), b2 + hsB, voffB); PG8_STAGE(PG8_SA(0, 0), a2, voffA);
            PG8_WAIT_V(8); PG8_WAIT_L(0); PG8_BAR; PG8_MMA(1, 0, At, B0); PG8_MMA(1, 1, At, B1); PG8_BAR; PG8_SCHED;
            PG8_LDB(B0, 1, 0); PG8_LDB(B1, 1, 1); PG8_SCHED; PG8_LDA(At, 1, 0); PG8_STAGE(PG8_SA(0, 1), a2 + hsA, voffA);
            PG8_WAIT_V(8); PG8_WAIT_L(0); PG8_BAR; PG8_MMA(0, 0, At, B0); PG8_MMA(0, 1, At, B1); PG8_BAR; PG8_SCHED;
            PG8_LDA(At, 1, 1); PG8_STAGE(PG8_SB(1, 0), b3, voffB); PG8_STAGE(PG8_SB(1, 1), b3 + hsB, voffB); PG8_STAGE(PG8_SA(1, 0), a3, voffA);
            PG8_WAIT_V(8); PG8_WAIT_L(0); PG8_BAR; PG8_MMA(1, 0, At, B0); PG8_MMA(1, 1, At, B1); PG8_BAR; PG8_SCHED;
        }
        if constexpr (ALIGN_EPI) { if (wr == 0) PG8_BAR; }
        { int fr2 = fr, fq2 = fq; asm volatile("" : "+v"(fr2), "+v"(fq2)); E(acc, cur, wr, wc, fr2, fq2); }
        if (!has_next) break;
#pragma unroll
        for (int a = 0; a < 2; ++a)
#pragma unroll
            for (int b = 0; b < 2; ++b)
#pragma unroll
                for (int m = 0; m < 4; ++m)
#pragma unroll
                    for (int n = 0; n < 2; ++n) acc[a][b][m][n] = (f32x4){0.f, 0.f, 0.f, 0.f};
        cur = nxt; cA = nA; cB = nB; ++ui;
        if constexpr (ALIGN_EPI) { if (wr == 1) PG8_BAR; }
    }
    PG8_WAIT_V(0);
    if constexpr (!ALIGN_EPI) { if (wr == 0) PG8_BAR; }
    PG8_BAR;
#undef PG8_SA
#undef PG8_SB
#undef PG8_STAGE
#undef PG8_QS_voffA
#undef PG8_QS_voffB
#undef PG8_LDA
#undef PG8_LDB
#undef PG8_MMA
#undef PG8_WAIT_V
#undef PG8_WAIT_L
#undef PG8_BAR
#undef PG8_SCHED
#undef PG8_APTR
#undef PG8_BPTR
}

__device__ __forceinline__ float silu_f(float g) { return g * __builtin_amdgcn_rcpf(1.0f + __builtin_amdgcn_exp2f(-g * LOG2E)); }

struct EpiSwiGLU {
    static constexpr bool PERM = true;
    bf16_t* O; int ldc;
    __device__ __forceinline__ void operator()(const f32x4 (&acc)[2][2][4][2], const Unit& u, int wr, int wc, int fr, int fq) const {
        const int row0 = u.pm * BM + wr * 64 + fr, col0 = u.pn * HALF + wc * 32 + 8 * fq;
#pragma unroll
        for (int ai = 0; ai < 2; ++ai)
#pragma unroll
            for (int m = 0; m < 4; ++m) {
                bf16_t* rowp = O + (size_t)(row0 + ai * HALF + m * 16) * ldc + col0;
                const f32x4 g0 = acc[ai][0][m][0], g1 = acc[ai][0][m][1], u0 = acc[ai][1][m][0], u1 = acc[ai][1][m][1];
                u32x4 w;
                w.x = cvt_pk_bf16(silu_f(g0[0]) * u0[0], silu_f(g0[1]) * u0[1]); w.y = cvt_pk_bf16(silu_f(g0[2]) * u0[2], silu_f(g0[3]) * u0[3]);
                w.z = cvt_pk_bf16(silu_f(g1[0]) * u1[0], silu_f(g1[1]) * u1[1]); w.w = cvt_pk_bf16(silu_f(g1[2]) * u1[2], silu_f(g1[3]) * u1[3]);
                *(u32x4*)rowp = w;
            }
    }
};
struct EpiF32 {
    static constexpr bool PERM = false;
    float* O; int ldc;
    __device__ __forceinline__ void operator()(const f32x4 (&acc)[2][2][4][2], const Unit& u, int wr, int wc, int fr, int fq) const {
        const int row0 = u.pm * BM + wr * 64 + fr, col0 = u.pn * BM + wc * 32 + 4 * fq;
#pragma unroll
        for (int ai = 0; ai < 2; ++ai)
#pragma unroll
            for (int m = 0; m < 4; ++m) {
                float* rowp = O + (size_t)(row0 + ai * HALF + m * 16) * ldc + col0;
#pragma unroll
                for (int bj = 0; bj < 2; ++bj)
#pragma unroll
                    for (int n = 0; n < 2; ++n) *(f32x4*)(rowp + bj * HALF + n * 16) = acc[ai][bj][m][n];
            }
    }
};

template <int CMAP> struct EpiBf16 {
    static constexpr bool PERM = true;
    bf16_t* O; int ldc; long sOz; int ncol; float scale; int scale_cols;
    __device__ __forceinline__ void operator()(const f32x4 (&acc)[2][2][4][2], const Unit& u, int wr, int wc, int fr, int fq) const {
        const int row0 = u.pm * BM + wr * 64 + fr;
#pragma unroll
        for (int bj = 0; bj < 2; ++bj) {
            const int ct = bj * HALF + wc * 32 + 8 * fq; if (ct >= ncol) continue;
            const int c0 = u.pn * BM + ct; const int oc = CMAP == 1 ? (c0 >> 7) * 192 + (c0 & 127) : c0;
            const float sc = c0 < scale_cols ? scale : 1.f;
            bf16_t* base = O + (size_t)u.z * sOz + oc;
#pragma unroll
            for (int ai = 0; ai < 2; ++ai)
#pragma unroll
                for (int m = 0; m < 4; ++m) { const f32x4 v0 = acc[ai][bj][m][0] * sc, v1 = acc[ai][bj][m][1] * sc;
                    u32x4 w; w.x = cvt_pk_bf16(v0[0], v0[1]); w.y = cvt_pk_bf16(v0[2], v0[3]); w.z = cvt_pk_bf16(v1[0], v1[1]); w.w = cvt_pk_bf16(v1[2], v1[3]);
                    *(u32x4*)(base + (size_t)(row0 + ai * HALF + m * 16) * ldc) = w; }
        }
    }
};
struct EpiQ {
    static constexpr bool PERM = true;
    bf16_t* O; const float* rope_t; float scale;
    __device__ __forceinline__ void operator()(const f32x4 (&acc)[2][2][4][2], const Unit& u, int wr, int wc, int fr, int fq) const {
        const int row0 = u.pm * BM + wr * 64 + fr;
#pragma unroll
        for (int bj = 0; bj < 2; ++bj) {
            const int c0 = u.pn * BM + bj * HALF + wc * 32 + 8 * fq; const int h = c0 / 192, f0 = c0 - h * 192;
            if (f0 < 128) {
#pragma unroll
                for (int ai = 0; ai < 2; ++ai)
#pragma unroll
                    for (int m = 0; m < 4; ++m) { const f32x4 v0 = acc[ai][bj][m][0] * scale, v1 = acc[ai][bj][m][1] * scale;
                        u32x4 w; w.x = cvt_pk_bf16(v0[0], v0[1]); w.y = cvt_pk_bf16(v0[2], v0[3]); w.z = cvt_pk_bf16(v1[0], v1[1]); w.w = cvt_pk_bf16(v1[2], v1[3]);
                        *(u32x4*)(O + (size_t)(row0 + ai * HALF + m * 16) * 1536 + c0) = w; }
            } else {
                const int a4 = ((f0 - 128) >> 3) * 4;
#pragma unroll
                for (int ai = 0; ai < 2; ++ai)
#pragma unroll
                    for (int m = 0; m < 4; ++m) { const int r = row0 + ai * HALF + m * 16; const int pidx = r < MP ? (r & (SEQ - 1)) : SEQ + ((r - MP) & (DECT - 1));
                        const f32x4 cs0 = *(const f32x4*)(rope_t + (size_t)(pidx * 32 + a4) * 2), cs1 = *(const f32x4*)(rope_t + (size_t)(pidx * 32 + a4) * 2 + 4);
                        const f32x4 x1 = acc[ai][bj][m][0] * scale, x2 = acc[ai][bj][m][1] * scale;
                        const float y10 = x1[0] * cs0[0] - x2[0] * cs0[1], y11 = x1[1] * cs0[2] - x2[1] * cs0[3], y12 = x1[2] * cs1[0] - x2[2] * cs1[1], y13 = x1[3] * cs1[2] - x2[3] * cs1[3];
                        const float y20 = x2[0] * cs0[0] + x1[0] * cs0[1], y21 = x2[1] * cs0[2] + x1[1] * cs0[3], y22 = x2[2] * cs1[0] + x1[2] * cs1[1], y23 = x2[3] * cs1[2] + x1[3] * cs1[3];
                        bf16_t* rowp = O + (size_t)r * 1536 + h * 192 + 128 + a4;
                        u32x2 w1, w2; w1.x = cvt_pk_bf16(y10, y11); w1.y = cvt_pk_bf16(y12, y13); w2.x = cvt_pk_bf16(y20, y21); w2.y = cvt_pk_bf16(y22, y23);
                        *(u32x2*)rowp = w1; *(u32x2*)(rowp + 32) = w2; asm volatile("" ::: "memory"); }
            }
        }
    }
};

struct EpiGla {
    static constexpr bool PERM = true;
    bf16_t* O; float* T16; float qscale;
    __device__ __forceinline__ void operator()(const f32x4 (&acc)[2][2][4][2], const Unit& u, int wr, int wc, int fr, int fq) const {
        const int row0 = u.pm * BM + wr * 64 + fr;
        if (u.pn < 12) {
#pragma unroll
            for (int bj = 0; bj < 2; ++bj) {
                const int c0 = u.pn * BM + bj * HALF + wc * 32 + 8 * fq; const float sc = c0 < 512 ? qscale : 1.f;
#pragma unroll
                for (int ai = 0; ai < 2; ++ai)
#pragma unroll
                    for (int m = 0; m < 4; ++m) { const f32x4 v0 = acc[ai][bj][m][0] * sc, v1 = acc[ai][bj][m][1] * sc;
                        u32x4 w; w.x = cvt_pk_bf16(v0[0], v0[1]); w.y = cvt_pk_bf16(v0[2], v0[3]); w.z = cvt_pk_bf16(v1[0], v1[1]); w.w = cvt_pk_bf16(v1[2], v1[3]);
                        *(u32x4*)(O + (size_t)(row0 + ai * HALF + m * 16) * GIN + c0) = w; }
            }
        } else if (wc == 0 && fq < 2) {
#pragma unroll
            for (int ai = 0; ai < 2; ++ai)
#pragma unroll
                for (int m = 0; m < 4; ++m) { float* tp = T16 + (size_t)(row0 + ai * HALF + m * 16) * 16 + 8 * fq;
                    *(f32x4*)tp = acc[ai][0][m][0]; *(f32x4*)(tp + 4) = acc[ai][0][m][1]; }
        }
    }
};
}

#define XB_TMO      128
#define XB_XCNT(j)  (256  + 64 * (j))
#define XB_XSUB(j)  (1280 + 64 * (j))
#define XB_XGEN(j)  (2304 + 64 * (j))
#define XB_TOP      3328
#define XB_TOPGEN   3392
#define XCD_BAR_WORDS 3456
#define XB_SPIN_CAP (1u << 18)

__device__ __forceinline__ unsigned xb_ld(unsigned* p)              { return __hip_atomic_load(p, __ATOMIC_RELAXED, __HIP_MEMORY_SCOPE_AGENT); }
__device__ __forceinline__ unsigned xb_add(unsigned* p, unsigned v) { return __hip_atomic_fetch_add(p, v, __ATOMIC_RELAXED, __HIP_MEMORY_SCOPE_AGENT); }
__device__ __forceinline__ unsigned xb_xcc_id() { return (unsigned)__builtin_amdgcn_s_getreg((3 << 11) | 20) & 0xFu; }
#define XB_SPIN(cond, bar) do { unsigned _sp = 0; while (cond) { __builtin_amdgcn_s_sleep(1); \
    if ((++_sp & 255u) == 0u) { if (xb_ld(&(bar)[XB_TMO])) break; if (_sp > XB_SPIN_CAP) { atomicAdd(&(bar)[XB_TMO], 1u); break; } } } } while (0)

struct XcdBarrier { unsigned* bar; unsigned x; volatile LAS unsigned* st; };

__device__ __forceinline__ XcdBarrier xcd_barrier_post(unsigned* bar, volatile LAS unsigned* st, bool t0) {
    XcdBarrier b; b.bar = bar; b.x = xb_xcc_id(); b.st = st;
    if (t0) (void)xb_add(&bar[XB_XCNT(b.x)], 1u);
    return b;
}
__device__ __forceinline__ void xcd_barrier_complete(unsigned* bar, unsigned x, unsigned& nloc, unsigned& nx) {
    const unsigned G = gridDim.x * gridDim.y * gridDim.z;
    unsigned sum, cnt, mine, sp = 0u;
    for (;;) {
        sum = 0u; cnt = 0u; mine = 0u;
#pragma unroll
        for (unsigned j = 0; j < 16; ++j) { const unsigned c = xb_ld(&bar[XB_XCNT(j)]); sum += c; cnt += (c > 0u) ? 1u : 0u; mine = (j == x) ? c : mine; }
        if (sum == G) break;
        __builtin_amdgcn_s_sleep(1);
        if ((++sp & 255u) == 0u) { if (xb_ld(&bar[XB_TMO])) break; if (sp > XB_SPIN_CAP) { atomicAdd(&bar[XB_TMO], 1u); break; } }
    }
    nloc = mine > 0u ? mine : 1u; nx = cnt > 0u ? cnt : 1u;
}
__device__ __forceinline__ void xcd_barrier(const XcdBarrier& b, bool t0) {
    asm volatile("s_waitcnt vmcnt(0)" ::: "memory");
    __syncthreads();
    if (t0) {
        unsigned* bar = b.bar;
        __builtin_amdgcn_s_waitcnt(0);
        unsigned nloc = b.st[0], nx = b.st[1];
        if (nloc == 0u) { xcd_barrier_complete(bar, b.x, nloc, nx); b.st[0] = nloc; b.st[1] = nx; }
        const unsigned old = xb_add(&bar[XB_XSUB(b.x)], 1u);
        const unsigned gen = old / nloc;
        if (old + 1u == (gen + 1u) * nloc) {
            __builtin_amdgcn_fence(__ATOMIC_RELEASE, "agent");
            asm volatile("s_waitcnt vmcnt(0)" ::: "memory");
            const unsigned og = xb_add(&bar[XB_TOP], 1u);
            const unsigned tg = og / nx;
            if (og + 1u == (tg + 1u) * nx) xb_add(&bar[XB_TOPGEN], 1u);
            else XB_SPIN(xb_ld(&bar[XB_TOPGEN]) == tg, bar);
            __builtin_amdgcn_fence(__ATOMIC_ACQUIRE, "agent");
            xb_add(&bar[XB_XGEN(b.x)], 1u);
            asm volatile("s_waitcnt vmcnt(0)" ::: "memory");
        } else {
            XB_SPIN(xb_ld(&bar[XB_XGEN(b.x)]) == gen, bar);
            __builtin_amdgcn_fence(__ATOMIC_ACQUIRE, "agent");
            asm volatile("s_waitcnt vmcnt(0)" ::: "memory");
        }
    }
    __syncthreads();
}

struct Args { const void* in[22]; float* out; unsigned char* ws; int ph_lo, ph_hi; };

struct Frame {
    LAS unsigned char* lds;
    int tid, lane, wave, vcu, G;
    const float* const* dummy;
};

__device__ __forceinline__ void transpose_item(const float* W, int N, int k0, int n0, bf16_t* WT, int KT, int drow0, int interleave, LAS float* scr, int lane) {
#pragma unroll 8
    for (int i = 0; i < 32; ++i) { const int kk = 2 * i + (lane >> 5); scr[kk * 33 + (lane & 31)] = W[(size_t)(k0 + kk) * N + n0 + (lane & 31)]; }
    LDS_WAIT(); asm volatile("" ::: "memory");
    const int c = lane & 7;
#pragma unroll
    for (int j = 0; j < 4; ++j) { const int n = (lane >> 3) + 8 * j; const LAS float* s = scr + (8 * c) * 33 + n;
        u32x4 o; o.x = cvt_pk_bf16(s[0 * 33], s[1 * 33]); o.y = cvt_pk_bf16(s[2 * 33], s[3 * 33]); o.z = cvt_pk_bf16(s[4 * 33], s[5 * 33]); o.w = cvt_pk_bf16(s[6 * 33], s[7 * 33]);
        const int drow = interleave ? (drow0 + 8 * (n >> 2) + (n & 3)) : (drow0 + n);
        *(u32x4*)(WT + (size_t)drow * KT + k0 + 8 * c) = o; }
    LDS_WAIT(); asm volatile("" ::: "memory");
}

struct Row16 { f32x4 v[4]; };
__device__ __forceinline__ Row16 ld_row(const float* p, int lane) { Row16 r; const f32x4* q = (const f32x4*)p + lane;
#pragma unroll
    for (int j = 0; j < 4; ++j) r.v[j] = q[64 * j]; return r; }
__device__ __forceinline__ float row_ss(const Row16& r) { float s = 0.f;
#pragma unroll
    for (int j = 0; j < 4; ++j) s += (r.v[j][0] * r.v[j][0] + r.v[j][1] * r.v[j][1]) + (r.v[j][2] * r.v[j][2] + r.v[j][3] * r.v[j][3]); return wave_sum(s); }
__device__ __forceinline__ void st_row_bf16(bf16_t* p, const Row16& r, int lane) { u32x2* q = (u32x2*)p + lane;
#pragma unroll
    for (int j = 0; j < 4; ++j) { u32x2 w; w.x = cvt_pk_bf16(r.v[j][0], r.v[j][1]); w.y = cvt_pk_bf16(r.v[j][2], r.v[j][3]); q[64 * j] = w; } }
__device__ __forceinline__ void st_row_f32(float* p, const Row16& r, int lane) { f32x4* q = (f32x4*)p + lane;
#pragma unroll
    for (int j = 0; j < 4; ++j) q[64 * j] = r.v[j]; }

template <bool HAS_T, bool HAS_PRE, bool SRC_X>
__device__ __forceinline__ void thin_phase(int gw, int NGW, const float* xp, const float* xs, const float* hin, const float* T, float* hout, bf16_t* XN, const float* gpost, const float* gpre, float scale) {
    const int lane = lane_now();
    Row16 gp, gq;
    if (HAS_T) gp = ld_row(gpost, lane);
    if (HAS_PRE) gq = ld_row(gpre, lane);
    for (int r = gw; r < M; r += NGW) {
        const float* src; if constexpr (SRC_X) src = (r < MP ? xp + (size_t)r * DM : xs + (size_t)(r - MP) * DM); else src = hin + (size_t)r * DM;
        Row16 h = ld_row(src, lane);
        if (HAS_T) {
            Row16 t = ld_row(T + (size_t)r * DM, lane);
            const float rs = scale * __builtin_amdgcn_rsqf(row_ss(t) * (1.0f / DM) + EPS);
#pragma unroll
            for (int j = 0; j < 4; ++j) h.v[j] = h.v[j] + (t.v[j] * rs) * gp.v[j];
            st_row_f32(hout + (size_t)r * DM, h, lane);
        }
        if (HAS_PRE) {
            const float rs = __builtin_amdgcn_rsqf(row_ss(h) * (1.0f / DM) + EPS);
#pragma unroll
            for (int j = 0; j < 4; ++j) h.v[j] = (h.v[j] * rs) * gq.v[j];
            st_row_bf16(XN + (size_t)r * DM, h, lane);
        }
    }
}

__device__ __forceinline__ int rope_pos_index(int r) { return r < MP ? (r & (SEQ - 1)) : SEQ + ((r - MP) & (DECT - 1)); }


typedef short s16x4 __attribute__((ext_vector_type(4)));
__device__ __forceinline__ int swap23(int x) { return (x & ~12) | ((x & 4) << 1) | ((x & 8) >> 1); }
__device__ __forceinline__ float half_max(float v) { auto rr = __builtin_amdgcn_permlane32_swap(__float_as_uint(v), __float_as_uint(v), false, false); return fmaxf(__uint_as_float(rr[0]), __uint_as_float(rr[1])); }
__device__ __forceinline__ float half_sum(float v) { auto rr = __builtin_amdgcn_permlane32_swap(__float_as_uint(v), __float_as_uint(v), false, false); return __uint_as_float(rr[0]) + __uint_as_float(rr[1]); }
__device__ __forceinline__ bf16x8 pack8(const f32x16& p, int o) {
    u32x4 w; w.x = cvt_pk_bf16(p[o + 0], p[o + 1]); w.y = cvt_pk_bf16(p[o + 2], p[o + 3]); w.z = cvt_pk_bf16(p[o + 4], p[o + 5]); w.w = cvt_pk_bf16(p[o + 6], p[o + 7]);
    return __builtin_bit_cast(bf16x8, w);
}
template <int NO>
__device__ __forceinline__ void softmax_step(f32x16& p0, f32x16& p1, float& m, float& lh, f32x16 (&o)[NO], bf16x8 (&pf)[4]) {
    float pm = fmaxf(p0[0], p1[0]);
#pragma unroll
    for (int r = 1; r < 16; ++r) pm = fmaxf(pm, fmaxf(p0[r], p1[r]));
    pm = half_max(pm);
    const float mn = fmaxf(m, pm), alpha = __builtin_amdgcn_exp2f(m - mn); m = mn;
    float rs = 0.f;
#pragma unroll
    for (int r = 0; r < 16; ++r) { p0[r] = __builtin_amdgcn_exp2f(p0[r] - mn); p1[r] = __builtin_amdgcn_exp2f(p1[r] - mn); rs += p0[r] + p1[r]; }
    lh = lh * alpha + rs;
    if (!__all(alpha == 1.0f)) {
#pragma unroll
        for (int d = 0; d < NO; ++d) o[d] = o[d] * alpha;
    }
    pf[0] = pack8(p0, 0); pf[1] = pack8(p0, 8); pf[2] = pack8(p1, 0); pf[3] = pack8(p1, 8);
}

namespace pat {
constexpr int KROW = 400, VROW = 144, KTILE = 64 * KROW, VTILE = 128 * VROW;
__device__ __forceinline__ void unit(LAS unsigned char* lds, const int wave, const bf16_t* Q, const bf16_t* KB, const bf16_t* VT, bf16_t* O, int b, int h, int qb) {
    const int lane = lane_now(), tid = wave * 64 + lane, ql = lane & 31, hh = lane >> 5;
    const int q0 = b * SEQ + qb * 256 + 32 * wave;
    bf16x8 qf[12];
    { const bf16_t* qp = Q + (size_t)(q0 + ql) * (NH * QKD) + h * QKD + hh * 8;
#pragma unroll
      for (int ks = 0; ks < 12; ++ks) qf[ks] = *(const bf16x8*)(qp + ks * 16); }
    f32x16 o[4];
#pragma unroll
    for (int d = 0; d < 4; ++d)
#pragma unroll
        for (int r = 0; r < 16; ++r) o[d][r] = 0.f;
    float m = -1e30f, lh = 0.f;
    const int ntiles = 4 * (qb + 1);
    int krow[3], kcc[3]; unsigned koff[3];
#pragma unroll
    for (int i = 0; i < 3; ++i) { const int c = tid + 512 * i; krow[i] = c / 24; kcc[i] = c % 24; koff[i] = (unsigned)(krow[i] * KROW + kcc[i] * 16); }
    const bf16_t* kg = KB + (size_t)(b * SEQ) * (NH * QKD) + h * QKD;
    const bf16_t* vg = VT + (size_t)(h * VD) * MP + b * SEQ;
    const int vrow0 = tid >> 3, vcc = tid & 7;
    u32x4 kst[3], vst[2];
#define PAT_LOAD(j) do { _Pragma("unroll") for (int i = 0; i < 3; ++i) kst[i] = *(const u32x4*)(kg + (size_t)((j) * 64 + krow[i]) * (NH * QKD) + kcc[i] * 8); \
        _Pragma("unroll") for (int i = 0; i < 2; ++i) vst[i] = *(const u32x4*)(vg + (size_t)(vrow0 + 64 * i) * MP + (j) * 64 + vcc * 8); } while (0)
#define PAT_STORE(buf) do { _Pragma("unroll") for (int i = 0; i < 3; ++i) *(LAS u32x4*)(lds + (buf) * KTILE + koff[i]) = kst[i]; \
        _Pragma("unroll") for (int i = 0; i < 2; ++i) *(LAS u32x4*)(lds + 2 * KTILE + (buf) * VTILE + (vrow0 + 64 * i) * VROW + vcc * 16) = vst[i]; } while (0)
    PAT_LOAD(0); PAT_STORE(0);
    __syncthreads();
    const int kr = swap23(ql);
    for (int j = 0; j < ntiles; ++j) {
        const int buf = j & 1;
        if (j + 1 < ntiles) PAT_LOAD(j + 1);
        const int jd = j - 4 * qb;
        if (jd <= (wave >> 1)) {
            f32x16 p0, p1;
#pragma unroll
            for (int r = 0; r < 16; ++r) { p0[r] = 0.f; p1[r] = 0.f; }
            const LAS unsigned char* kb0 = lds + buf * KTILE + kr * KROW + hh * 16;
#pragma unroll
            for (int ks = 0; ks < 12; ++ks) {
                const bf16x8 a0 = *(const LAS bf16x8*)(kb0 + ks * 32), a1 = *(const LAS bf16x8*)(kb0 + 32 * KROW + ks * 32);
                p0 = __builtin_amdgcn_mfma_f32_32x32x16_bf16(a0, qf[ks], p0, 0, 0, 0);
                p1 = __builtin_amdgcn_mfma_f32_32x32x16_bf16(a1, qf[ks], p1, 0, 0, 0);
            }
            if (jd >= 0) {
                const int qrel = 32 * wave + ql - 64 * jd - 8 * hh;
#pragma unroll
                for (int r = 0; r < 16; ++r) { const int kk = 16 * (r >> 3) + (r & 7);
                    if (kk > qrel) p0[r] = -__builtin_inff();
                    if (kk + 32 > qrel) p1[r] = -__builtin_inff(); }
            }
            bf16x8 pf[4];
            softmax_step<4>(p0, p1, m, lh, o, pf);
            const LAS unsigned char* vb0 = lds + 2 * KTILE + buf * VTILE + ql * VROW + hh * 16;
#pragma unroll
            for (int d = 0; d < 4; ++d)
#pragma unroll
                for (int ss = 0; ss < 4; ++ss) {
                    const bf16x8 a = *(const LAS bf16x8*)(vb0 + d * 32 * VROW + ss * 32);
                    o[d] = __builtin_amdgcn_mfma_f32_32x32x16_bf16(a, pf[ss], o[d], 0, 0, 0);
                }
        }
        if (j + 1 < ntiles) PAT_STORE(buf ^ 1);
        __syncthreads();
    }
#undef PAT_LOAD
#undef PAT_STORE
    const float inv = 1.0f / half_sum(lh);
    bf16_t* op = O + (size_t)(q0 + ql) * DM + h * VD + 4 * hh;
#pragma unroll
    for (int d = 0; d < 4; ++d)
#pragma unroll
        for (int g = 0; g < 4; ++g) { u32x2 w; w.x = cvt_pk_bf16(o[d][4 * g] * inv, o[d][4 * g + 1] * inv); w.y = cvt_pk_bf16(o[d][4 * g + 2] * inv, o[d][4 * g + 3] * inv);
            *(u32x2*)(op + 32 * d + 8 * g) = w; }
}
}

namespace sat {
constexpr int KROW = 656, KTILE = 64 * KROW;
__device__ __forceinline__ bf16x8 tr_frag(const LAS unsigned char* p) {
    typedef short v4i16_t __attribute__((ext_vector_type(4)));
    const s16x4 a = __builtin_bit_cast(s16x4, __builtin_amdgcn_ds_read_tr16_b64_v4i16((LAS v4i16_t*)p));
    const s16x4 b = __builtin_bit_cast(s16x4, __builtin_amdgcn_ds_read_tr16_b64_v4i16((LAS v4i16_t*)(p + 4 * KROW)));
    bf16x8 r; r[0] = a[0]; r[1] = a[1]; r[2] = a[2]; r[3] = a[3]; r[4] = b[0]; r[5] = b[1]; r[6] = b[2]; r[7] = b[3]; return r;
}
__device__ __forceinline__ void unit(LAS unsigned char* lds, const int wave, const bf16_t* QLAT, const float* cache_ckv, const float* cache_kpe, const int* page_table, const bf16_t* CKVS  , const bf16_t* KPES,
                                     float* OPART, float* OML, int b, int split) {
    const int lane = lane_now(), tid = wave * 64 + lane, ql = lane & 31, hh = lane >> 5;
    const int qblk = wave & 1, dvp = wave >> 1;
    bf16x8 qf[20];
    { const bf16_t* qp = QLAT + (size_t)(b * 64 + 32 * qblk + ql) * 320 + hh * 8;
#pragma unroll
      for (int ks = 0; ks < 20; ++ks) qf[ks] = *(const bf16x8*)(qp + ks * 16); }
    f32x16 o[2];
#pragma unroll
    for (int d = 0; d < 2; ++d)
#pragma unroll
        for (int r = 0; r < 16; ++r) o[d][r] = 0.f;
    float m = -1e30f, lh = 0.f;
    const int npg = NPAGES / 2, ntiles = 2 * npg + (split == 1 ? 1 : 0);
    const int* pt = page_table + b * NPAGES + split * npg;
    const int crow0 = tid >> 6, ccol = tid & 63;
    const int prow0 = tid >> 4, pcol = tid & 15;
    f32x4 cst[8], pst[2];
#define SAT_LOAD(j) do { const int pg = pt[(j) >> 1]; const size_t r0 = (size_t)pg * PAGE + ((j) & 1) * 64; \
        _Pragma("unroll") for (int i = 0; i < 8; ++i) cst[i] = __builtin_nontemporal_load((const f32x4*)(cache_ckv + (r0 + crow0 + 8 * i) * KVL) + ccol); \
        _Pragma("unroll") for (int i = 0; i < 2; ++i) pst[i] = __builtin_nontemporal_load((const f32x4*)(cache_kpe + (r0 + prow0 + 32 * i) * ROPE) + pcol); } while (0)
#define SAT_STORE(buf) do { _Pragma("unroll") for (int i = 0; i < 8; ++i) { u32x2 w; w.x = cvt_pk_bf16(cst[i][0], cst[i][1]); w.y = cvt_pk_bf16(cst[i][2], cst[i][3]); \
            *(LAS u32x2*)(lds + (buf) * KTILE + (crow0 + 8 * i) * KROW + ccol * 8) = w; } \
        _Pragma("unroll") for (int i = 0; i < 2; ++i) { u32x2 w; w.x = cvt_pk_bf16(pst[i][0], pst[i][1]); w.y = cvt_pk_bf16(pst[i][2], pst[i][3]); \
            *(LAS u32x2*)(lds + (buf) * KTILE + (prow0 + 32 * i) * KROW + 512 + pcol * 8) = w; } } while (0)
#define SAT_NEW(buf) do { _Pragma("unroll") for (int i = 0; i < 5; ++i) { const int c = tid + 512 * i, row = c / 40, cc = c % 40; u32x4 v = (u32x4){0u, 0u, 0u, 0u}; \
            if (row < DECT) v = cc < 32 ? *(const u32x4*)(CKVS + (size_t)(b * DECT + row) * KVL + cc * 8) : *(const u32x4*)(KPES + (size_t)(b * DECT + row) * ROPE + (cc - 32) * 8); \
            *(LAS u32x4*)(lds + (buf) * KTILE + row * KROW + cc * 16) = v; } } while (0)
    SAT_LOAD(0); SAT_STORE(0);
    __syncthreads();
    const int kr = swap23(ql);
    const int g16 = lane >> 4, i16 = lane & 15;
    const int troff = (8 * (g16 >> 1) + (i16 >> 2)) * KROW + (16 * (g16 & 1) + 4 * (i16 & 3)) * 2;
    for (int j = 0; j < ntiles; ++j) {
        const int buf = j & 1;
        const bool nxt_page = (j + 1 < 2 * npg), nxt_new = (j + 1 == 2 * npg) && (split == 1);
        if (nxt_page) SAT_LOAD(j + 1);
        f32x16 p0, p1;
#pragma unroll
        for (int r = 0; r < 16; ++r) { p0[r] = 0.f; p1[r] = 0.f; }
        const LAS unsigned char* kb0 = lds + buf * KTILE + kr * KROW + hh * 16;
#pragma unroll
        for (int ks = 0; ks < 20; ++ks) {
            const bf16x8 a0 = *(const LAS bf16x8*)(kb0 + ks * 32), a1 = *(const LAS bf16x8*)(kb0 + 32 * KROW + ks * 32);
            p0 = __builtin_amdgcn_mfma_f32_32x32x16_bf16(a0, qf[ks], p0, 0, 0, 0);
            p1 = __builtin_amdgcn_mfma_f32_32x32x16_bf16(a1, qf[ks], p1, 0, 0, 0);
        }
        if (j == 2 * npg) {
            const int tq = (32 * qblk + ql) >> 3;
#pragma unroll
            for (int r = 0; r < 16; ++r) { const int kk = 16 * (r >> 3) + 8 * hh + (r & 7);
                if (kk > tq) p0[r] = -__builtin_inff();
                p1[r] = -__builtin_inff(); }
        }
        bf16x8 pf[4];
        softmax_step<2>(p0, p1, m, lh, o, pf);
        const LAS unsigned char* vb0 = lds + buf * KTILE + troff + (2 * dvp) * 64;
#pragma unroll
        for (int d = 0; d < 2; ++d)
#pragma unroll
            for (int ss = 0; ss < 4; ++ss) {
                const bf16x8 a = tr_frag(vb0 + d * 64 + ss * 16 * KROW);
                o[d] = __builtin_amdgcn_mfma_f32_32x32x16_bf16(a, pf[ss], o[d], 0, 0, 0);
            }
        if (nxt_page) SAT_STORE(buf ^ 1);
        if (nxt_new) SAT_NEW(buf ^ 1);
        __syncthreads();
    }
#undef SAT_LOAD
#undef SAT_STORE
#undef SAT_NEW
    const float lt = half_sum(lh);
    const int q = 32 * qblk + ql;
    float* op = OPART + ((size_t)(b * 2 + split) * 64 + q) * KVL + 64 * dvp + 4 * hh;
#pragma unroll
    for (int d = 0; d < 2; ++d)
#pragma unroll
        for (int g = 0; g < 4; ++g) *(f32x4*)(op + 32 * d + 8 * g) = (f32x4){o[d][4 * g], o[d][4 * g + 1], o[d][4 * g + 2], o[d][4 * g + 3]};
    if (dvp == 0 && hh == 0) *(f32x2*)(OML + ((size_t)(b * 2 + split) * 64 + q) * 2) = (f32x2){m, lt};
}
}


namespace gla {
constexpr int QROW = 272, KTROW = 144, VROW = 528;
constexpr int OFF_T16 = 0, OFF_TOT = 4096, OFF_DK = 6144, OFF_QT = 8192, OFF_KT = OFF_QT + 64 * QROW, OFF_KH = OFF_KT + 64 * QROW, OFF_V = OFF_KH + 128 * KTROW, OFF_AT = OFF_V + 64 * VROW;
static_assert(OFF_AT + 6144 <= RING_BYTES, "gla LDS");
__device__ __forceinline__ bf16x8 tr_frag(const LAS unsigned char* p) {
    typedef short v4i16_t __attribute__((ext_vector_type(4)));
    const s16x4 a = __builtin_bit_cast(s16x4, __builtin_amdgcn_ds_read_tr16_b64_v4i16((LAS v4i16_t*)p));
    const s16x4 b = __builtin_bit_cast(s16x4, __builtin_amdgcn_ds_read_tr16_b64_v4i16((LAS v4i16_t*)(p + 4 * VROW)));
    bf16x8 r; r[0] = a[0]; r[1] = a[1]; r[2] = a[2]; r[3] = a[3]; r[4] = b[0]; r[5] = b[1]; r[6] = b[2]; r[7] = b[3]; return r;
}
__device__ __forceinline__ void chain(LAS unsigned char* lds, const int wave, const bf16_t* QKVG, const float* T16, const float* w_gk2, const float* b_gk, int h, int row0, int ntok,
                                      const float* state_in, float* state_out, float* GO) {
    const int lane = lane_now(), tid = wave * 64 + lane, ql = lane & 31, hh = lane >> 5;
    const int kk = tid & 127, tq = tid >> 7;
    f32x16 S[4];
#pragma unroll
    for (int kb = 0; kb < 4; ++kb)
#pragma unroll
        for (int r = 0; r < 16; ++r) S[kb][r] = state_in ? state_in[(size_t)(32 * kb + 16 * (r >> 3) + 8 * hh + (r & 7)) * GDV + 32 * wave + ql] : 0.f;
    const int nchunk = (ntok + 63) >> 6;
    const bf16_t* qg = QKVG + (size_t)row0 * GIN + h * GDK + kk;
    const bf16_t* vg = QKVG + (size_t)row0 * GIN + 2 * GH * GDK + h * GDV;
    const int vrow0 = tid >> 5, vcc = tid & 31;
    unsigned short qraw[16], kraw[16]; u32x4 vst[4]; f32x4 t16st;
#define GLA_LOAD_QK(c) do { _Pragma("unroll") for (int i = 0; i < 16; ++i) { const int t = (c) * 64 + tq * 16 + i; const bool ok = t < ntok; \
        qraw[i] = ok ? qg[(size_t)t * GIN] : (unsigned short)0; kraw[i] = ok ? qg[(size_t)t * GIN + GH * GDK] : (unsigned short)0; } } while (0)
#define GLA_LOAD_V(c) do { _Pragma("unroll") for (int i = 0; i < 4; ++i) { const int t = (c) * 64 + vrow0 + 16 * i; \
        vst[i] = t < ntok ? *(const u32x4*)(vg + (size_t)t * GIN + vcc * 8) : (u32x4){0u, 0u, 0u, 0u}; } \
        { const int t = (c) * 64 + (tid >> 2); t16st = (tid < 256 && t < ntok) ? *(const f32x4*)(T16 + (size_t)(row0 + t) * 16 + (tid & 3) * 4) : (f32x4){0.f, 0.f, 0.f, 0.f}; } } while (0)
    GLA_LOAD_QK(0); GLA_LOAD_V(0);
    const int g16 = lane >> 4, i16 = lane & 15;
    const int troff = (8 * (g16 >> 1) + (i16 >> 2)) * VROW + (32 * wave + 16 * (g16 & 1) + 4 * (i16 & 3)) * 2;
    const int kr = swap23(ql);
    for (int c = 0; c < nchunk; ++c) {
        __syncthreads();
#pragma unroll
        for (int i = 0; i < 4; ++i) *(LAS u32x4*)(lds + OFF_V + (vrow0 + 16 * i) * VROW + vcc * 16) = vst[i];
        if (tid < 256) *(LAS f32x4*)(lds + OFF_T16 + tid * 16) = t16st;
        __syncthreads();
        if (c + 1 < nchunk) GLA_LOAD_V(c + 1);
        float Gl[16];
        { int kkx = kk; asm volatile("" : "+v"(kkx));
          float w2[16];
#pragma unroll
          for (int j = 0; j < 16; ++j) w2[j] = w_gk2[j * (GH * GDK) + h * GDK + kkx];
          const float bias = b_gk[h * GDK + kkx];
          float run = 0.f;
#pragma unroll
          for (int i = 0; i < 16; ++i) { const int t = tq * 16 + i; const LAS f32x4* tp = (const LAS f32x4*)(lds + OFF_T16 + t * 64);
              const f32x4 a0 = tp[0], a1 = tp[1], a2 = tp[2], a3 = tp[3];
              float z = bias;
              z += a0[0] * w2[0] + a0[1] * w2[1] + a0[2] * w2[2] + a0[3] * w2[3];
              z += a1[0] * w2[4] + a1[1] * w2[5] + a1[2] * w2[6] + a1[3] * w2[7];
              z += a2[0] * w2[8] + a2[1] * w2[9] + a2[2] * w2[10] + a2[3] * w2[11];
              z += a3[0] * w2[12] + a3[1] * w2[13] + a3[2] * w2[14] + a3[3] * w2[15];
              const float ls = fminf(z, 0.f) - 0.6931471805599453f * __builtin_amdgcn_logf(1.0f + __builtin_amdgcn_exp2f(-fabsf(z) * LOG2E));
              const float gk = (c * 64 + t < ntok) ? ls * (1.0f / 16.0f) : 0.f;
              run += gk; Gl[i] = run; }
          *(LAS float*)(lds + OFF_TOT + (tq * 128 + kk) * 4) = run; }
        __syncthreads();
        float prefix = 0.f, total = 0.f;
#pragma unroll
        for (int q = 0; q < 4; ++q) { const float v = *(const LAS float*)(lds + OFF_TOT + (q * 128 + kk) * 4); total += v; if (q < tq) prefix += v; }
        { unsigned kh[8];
#pragma unroll
          for (int i = 0; i < 16; i += 2) {
              const float G0 = (Gl[i] + prefix) * LOG2E, G1 = (Gl[i + 1] + prefix) * LOG2E, TL = total * LOG2E;
              const float q0 = bf2f(qraw[i]), q1 = bf2f(qraw[i + 1]), k0 = bf2f(kraw[i]), k1 = bf2f(kraw[i + 1]);
              const unsigned qq = cvt_pk_bf16(q0 * __builtin_amdgcn_exp2f(G0), q1 * __builtin_amdgcn_exp2f(G1));
              const unsigned kt = cvt_pk_bf16(k0 * __builtin_amdgcn_exp2f(-G0), k1 * __builtin_amdgcn_exp2f(-G1));
              kh[i >> 1] = cvt_pk_bf16(k0 * __builtin_amdgcn_exp2f(TL - G0), k1 * __builtin_amdgcn_exp2f(TL - G1));
              const int t = tq * 16 + i;
              *(LAS unsigned short*)(lds + OFF_QT + t * QROW + kk * 2) = (unsigned short)(qq & 0xffffu); *(LAS unsigned short*)(lds + OFF_QT + (t + 1) * QROW + kk * 2) = (unsigned short)(qq >> 16);
              *(LAS unsigned short*)(lds + OFF_KT + t * QROW + kk * 2) = (unsigned short)(kt & 0xffffu); *(LAS unsigned short*)(lds + OFF_KT + (t + 1) * QROW + kk * 2) = (unsigned short)(kt >> 16);
          }
          *(LAS u32x4*)(lds + OFF_KH + kk * KTROW + tq * 32) = (u32x4){kh[0], kh[1], kh[2], kh[3]};
          *(LAS u32x4*)(lds + OFF_KH + kk * KTROW + tq * 32 + 16) = (u32x4){kh[4], kh[5], kh[6], kh[7]};
          if (tq == 0) *(LAS float*)(lds + OFF_DK + kk * 4) = __builtin_amdgcn_exp2f(total * LOG2E); }
        if (c + 1 < nchunk) GLA_LOAD_QK(c + 1);
        __syncthreads();
        if (wave < 3) {
            const int sb = wave >> 1, tb = (wave + 1) >> 1;
            f32x16 x;
#pragma unroll
            for (int r = 0; r < 16; ++r) x[r] = 0.f;
            const LAS unsigned char* ap = lds + OFF_KT + (32 * sb + kr) * QROW + hh * 16;
            const LAS unsigned char* bp = lds + OFF_QT + (32 * tb + ql) * QROW + hh * 16;
#pragma unroll
            for (int ks = 0; ks < 8; ++ks) x = __builtin_amdgcn_mfma_f32_32x32x16_bf16(*(const LAS bf16x8*)(ap + ks * 32), *(const LAS bf16x8*)(bp + ks * 32), x, 0, 0, 0);
            if (sb == tb) {
#pragma unroll
                for (int r = 0; r < 16; ++r) { const int sr = 16 * (r >> 3) + 8 * hh + (r & 7); if (sr > ql) x[r] = 0.f; }
            }
            *(LAS bf16x8*)(lds + OFF_AT + (wave * 2 + 0) * 1024 + lane * 16) = pack8(x, 0);
            *(LAS bf16x8*)(lds + OFF_AT + (wave * 2 + 1) * 1024 + lane * 16) = pack8(x, 8);
        }
        f32x16 o[2];
#pragma unroll
        for (int tb = 0; tb < 2; ++tb)
#pragma unroll
            for (int r = 0; r < 16; ++r) o[tb][r] = 0.f;
#pragma unroll
        for (int kb = 0; kb < 4; ++kb)
#pragma unroll
            for (int ks = 0; ks < 2; ++ks) {
                const bf16x8 sf = pack8(S[kb], 8 * ks);
#pragma unroll
                for (int tb = 0; tb < 2; ++tb) {
                    const bf16x8 a = *(const LAS bf16x8*)(lds + OFF_QT + (32 * tb + ql) * QROW + (32 * kb + 16 * ks + 8 * hh) * 2);
                    o[tb] = __builtin_amdgcn_mfma_f32_32x32x16_bf16(a, sf, o[tb], 0, 0, 0);
                }
            }
        __syncthreads();
        bf16x8 vf[4];
#pragma unroll
        for (int ss = 0; ss < 4; ++ss) vf[ss] = tr_frag(lds + OFF_V + troff + ss * 16 * VROW);
        { const LAS unsigned char* at = lds + OFF_AT + lane * 16;
          o[0] = __builtin_amdgcn_mfma_f32_32x32x16_bf16(*(const LAS bf16x8*)(at + 0 * 1024), vf[0], o[0], 0, 0, 0);
          o[0] = __builtin_amdgcn_mfma_f32_32x32x16_bf16(*(const LAS bf16x8*)(at + 1 * 1024), vf[1], o[0], 0, 0, 0);
          o[1] = __builtin_amdgcn_mfma_f32_32x32x16_bf16(*(const LAS bf16x8*)(at + 2 * 1024), vf[0], o[1], 0, 0, 0);
          o[1] = __builtin_amdgcn_mfma_f32_32x32x16_bf16(*(const LAS bf16x8*)(at + 3 * 1024), vf[1], o[1], 0, 0, 0);
          o[1] = __builtin_amdgcn_mfma_f32_32x32x16_bf16(*(const LAS bf16x8*)(at + 4 * 1024), vf[2], o[1], 0, 0, 0);
          o[1] = __builtin_amdgcn_mfma_f32_32x32x16_bf16(*(const LAS bf16x8*)(at + 5 * 1024), vf[3], o[1], 0, 0, 0); }
#pragma unroll
        for (int kb = 0; kb < 4; ++kb) {
#pragma unroll
            for (int g = 0; g < 2; ++g) { const LAS f32x4* dp = (const LAS f32x4*)(lds + OFF_DK + (32 * kb + 16 * g + 8 * hh) * 4); const f32x4 d0 = dp[0], d1 = dp[1];
                S[kb][8 * g + 0] *= d0[0]; S[kb][8 * g + 1] *= d0[1]; S[kb][8 * g + 2] *= d0[2]; S[kb][8 * g + 3] *= d0[3];
                S[kb][8 * g + 4] *= d1[0]; S[kb][8 * g + 5] *= d1[1]; S[kb][8 * g + 6] *= d1[2]; S[kb][8 * g + 7] *= d1[3]; }
            const LAS unsigned char* ap = lds + OFF_KH + (32 * kb + kr) * KTROW + hh * 16;
#pragma unroll
            for (int ss = 0; ss < 4; ++ss) S[kb] = __builtin_amdgcn_mfma_f32_32x32x16_bf16(*(const LAS bf16x8*)(ap + ss * 32), vf[ss], S[kb], 0, 0, 0);
        }
        { int qlx = ql, hhx = hh; asm volatile("" : "+v"(qlx), "+v"(hhx));
          float* gp = GO + (size_t)(row0 + c * 64) * DM + h * GDV + 32 * wave + qlx;
#pragma unroll
          for (int tb = 0; tb < 2; ++tb)
#pragma unroll
              for (int r = 0; r < 16; ++r) { const int t = 32 * tb + (r & 3) + 8 * (r >> 2) + 4 * hhx; if (c * 64 + t < ntok) gp[(size_t)t * DM] = o[tb][r]; } }
    }
#undef GLA_LOAD_QK
#undef GLA_LOAD_V
    { int qlx = ql, hhx = hh; asm volatile("" : "+v"(qlx), "+v"(hhx));
#pragma unroll
    for (int kb = 0; kb < 4; ++kb)
#pragma unroll
        for (int r = 0; r < 16; ++r) state_out[(size_t)(32 * kb + 16 * (r >> 3) + 8 * hhx + (r & 7)) * GDV + 32 * wave + qlx] = S[kb][r]; }
    __syncthreads();
}
}

__global__ void __launch_bounds__(NWAVES * 64, 2) mk_fwd(Args args) {
    extern __shared__ __attribute__((aligned(16))) unsigned char lds_raw[];
    LAS unsigned char* lds = (LAS unsigned char*)lds_raw;
    volatile LAS unsigned* MISC = (volatile LAS unsigned*)(lds + MISC_OFF);
    const int wave = __builtin_amdgcn_readfirstlane(threadIdx.x >> 6);
    const int G = gridDim.x; const int bx = blockIdx.x; const int vcu = (G % 8 == 0) ? (bx % 8) * (G / 8) + bx / 8 : bx;
    const int gw = vcu * NWAVES + wave, NGW = G * NWAVES;
    unsigned char* ws = args.ws;
    unsigned* ctl = (unsigned*)(ws + WS_CTL);
    for (int u = wave * 64 + lane_now(); u < (LDS_BYTES - LDSCTL_OFF) / 4; u += NWAVES * 64) ((LAS unsigned*)(lds + LDSCTL_OFF))[u] = 0u;
    __syncthreads();
    XcdBarrier bar = xcd_barrier_post(ctl + 1024, MISC + 8, wave == 0 && lane_now() == 0);
#define GRID_BAR() xcd_barrier(bar, wave == 0 && lane_now() == 0)

    const float* x_prompt = (const float*)args.in[0]; const float* x_sample = (const float*)args.in[1];
    const float* cache_ckv = (const float*)args.in[2]; const float* cache_kpe = (const float*)args.in[3];
    const float* state_gla = (const float*)args.in[4]; const int* page_table = (const int*)args.in[5];
    const float* norm_g = (const float*)args.in[6]; const float* ffn_w_in = (const float*)args.in[7]; const float* ffn_w_out = (const float*)args.in[8];
    const float* mla_w_down = (const float*)args.in[9]; const float* mla_g_q = (const float*)args.in[10]; const float* mla_w_uq = (const float*)args.in[11];
    const float* mla_g_kv = (const float*)args.in[12]; const float* mla_w_uk = (const float*)args.in[13]; const float* mla_w_uv = (const float*)args.in[14];
    const float* mla_w_o = (const float*)args.in[15]; const float* gla_w_in = (const float*)args.in[16]; const float* gla_w_gk1 = (const float*)args.in[17];
    const float* gla_w_gk2 = (const float*)args.in[18]; const float* gla_b_gk = (const float*)args.in[19]; const float* gla_g_norm = (const float*)args.in[20];
    const float* gla_w_o = (const float*)args.in[21];
    float* out = args.out;
    float* ROPE_T = (float*)(ws + WS_ROPE);
    bf16_t* WIN = (bf16_t*)(ws + WS_WIN); bf16_t* WOUT = (bf16_t*)(ws + WS_WOUT); bf16_t* WDOWN = (bf16_t*)(ws + WS_WDOWN); bf16_t* WUQ = (bf16_t*)(ws + WS_WUQ);
    bf16_t* WUKT = (bf16_t*)(ws + WS_WUKT); bf16_t* WUK = (bf16_t*)(ws + WS_WUK); bf16_t* WUVT = (bf16_t*)(ws + WS_WUVT); bf16_t* WOT = (bf16_t*)(ws + WS_WOT);
    bf16_t* WGIN = (bf16_t*)(ws + WS_WGIN); bf16_t* WGO = (bf16_t*)(ws + WS_WGO);
    bf16_t* XN = (bf16_t*)(ws + WS_XN); bf16_t* HM = (bf16_t*)(ws + WS_HM); float* T = (float*)(ws + WS_T); float* D = (float*)(ws + WS_D);
    bf16_t* CQ = (bf16_t*)(ws + WS_CQ); bf16_t* CKV = (bf16_t*)(ws + WS_CKV); bf16_t* KPES = (bf16_t*)(ws + WS_KPES);
    bf16_t* KB = (bf16_t*)(ws + WS_KB);
    float* Y = out + OUT_Y;

    {
        const int lane = lane_now(), tid = wave * 64 + lane; (void)tid;
        LAS float* scr = (LAS float*)(lds + wave * 16384);
        constexpr int I_WIN = (DM / 64) * (2 * DFF / 32);
        constexpr int I_WOUT = (DFF / 64) * (DM / 32);
        constexpr int I_DOWN = (DM / 64) * (DDOWN / 32);
        constexpr int I_UQ = (QL / 64) * (NH * QKD / 32);
        constexpr int I_UK = (KVL / 64) * (NH * NOPE / 32);
        constexpr int I_UV = I_UK;
        constexpr int I_O = (DM / 64) * (DM / 32);
        constexpr int I_GIN = (DM / 64) * (GIN / 32);
        constexpr int I_GO = I_O;
        constexpr int NITEMS = 4 * I_WIN + 4 * I_WOUT + I_DOWN + I_UQ + I_UK + I_UV + I_O + I_GIN + I_GO;
        for (int it = gw; it < NITEMS; it += NGW) {
            int r = it;
            if (r < 4 * I_WIN) { const int mi = r / I_WIN; r -= mi * I_WIN; const int nblk = 2 * DFF / 32, kb = r / nblk, nb = r % nblk, n0 = nb * 32;
                const int drow0 = n0 < DFF ? 256 * (n0 / 128) + (n0 % 128) : 256 * ((n0 - DFF) / 128) + 128 + ((n0 - DFF) % 128);
                transpose_item(ffn_w_in + (size_t)mi * DM * 2 * DFF, 2 * DFF, kb * 64, n0, WIN + (size_t)mi * 2 * DFF * DM, DM, drow0, 0, scr, lane); continue; } r -= 4 * I_WIN;
            if (r < 4 * I_WOUT) { const int mi = r / I_WOUT; r -= mi * I_WOUT; const int nblk = DM / 32, kb = r / nblk, nb = r % nblk;
                transpose_item(ffn_w_out + (size_t)mi * DFF * DM, DM, kb * 64, nb * 32, WOUT + (size_t)mi * DM * DFF, DFF, nb * 32, 0, scr, lane); continue; } r -= 4 * I_WOUT;
            if (r < I_DOWN) { const int nblk = DDOWN / 32, kb = r / nblk, nb = r % nblk;
                transpose_item(mla_w_down, DDOWN, kb * 64, nb * 32, WDOWN, DM, nb * 32, 0, scr, lane); continue; } r -= I_DOWN;
            if (r < I_UQ) { const int nblk = NH * QKD / 32, kb = r / nblk, nb = r % nblk, n0 = nb * 32, h = n0 / QKD, f = n0 % QKD;
                if (f < NOPE) transpose_item(mla_w_uq, NH * QKD, kb * 64, n0, WUQ, QL, n0, 0, scr, lane);
                else transpose_item(mla_w_uq, NH * QKD, kb * 64, n0, WUQ, QL, h * QKD + NOPE + (f == NOPE ? 0 : 4), 1, scr, lane);
                continue; } r -= I_UQ;
            if (r < I_UK) { const int nblk = NH * NOPE / 32, kb = r / nblk, nb = r % nblk;
                transpose_item(mla_w_uk, NH * NOPE, kb * 64, nb * 32, WUKT, KVL, nb * 32, 0, scr, lane); continue; } r -= I_UK;
            if (r < I_UV) { const int nblk = NH * VD / 32, kb = r / nblk, nb = r % nblk;
                transpose_item(mla_w_uv, NH * VD, kb * 64, nb * 32, WUVT, KVL, nb * 32, 0, scr, lane); continue; } r -= I_UV;
            if (r < I_O) { const int nblk = DM / 32, kb = r / nblk, nb = r % nblk;
                transpose_item(mla_w_o, DM, kb * 64, nb * 32, WOT, DM, nb * 32, 0, scr, lane); continue; } r -= I_O;
            if (r < I_GIN) { const int nblk = GIN / 32, kb = r / nblk, nb = r % nblk;
                transpose_item(gla_w_in, GIN, kb * 64, nb * 32, WGIN, DM, nb * 32, 0, scr, lane); continue; } r -= I_GIN;
            { const int nblk = DM / 32, kb = r / nblk, nb = r % nblk;
                transpose_item(gla_w_o, DM, kb * 64, nb * 32, WGO, DM, nb * 32, 0, scr, lane); }
        }
        const int gt = vcu * (NWAVES * 64) + tid, NGT = G * NWAVES * 64;
        for (int i = gt; i < KVL * NH * NOPE / 2; i += NGT) { const f32x2 v = ((const f32x2*)mla_w_uk)[i]; ((unsigned*)WUK)[i] = cvt_pk_bf16(v[0], v[1]); }
        for (int i = gt; i < (DDOWN_P - DDOWN) * DM / 2; i += NGT) ((unsigned*)(WDOWN + (size_t)DDOWN * DM))[i] = 0u;
        for (int i = gt; i < 128 * KVL / 2; i += NGT) ((unsigned*)(WUVT + (size_t)NH * VD * KVL))[i] = 0u;
        for (int i = gt; i < (GIN_P - GIN) * DM / 2; i += NGT) { const int row = (2 * i) / DM, k = (2 * i) % DM;
            unsigned w = 0u; if (row < GRANK) w = cvt_pk_bf16(gla_w_gk1[(size_t)k * GRANK + row], gla_w_gk1[(size_t)(k + 1) * GRANK + row]);
            ((unsigned*)(WGIN + (size_t)GIN * DM))[i] = w; }
        for (int i = gt; i < (SEQ + DECT) * 32; i += NGT) { const int p = i >> 5, fi = i & 31; const float pos = (float)(p < SEQ ? p : PAST + (p - SEQ));
            const float inv = (float)exp2(-(double)fi * (13.287712379549449 / 32.0));
            const float ang = pos * inv; double t = (double)ang * 0.15915494309189535; t -= rint(t); const float tf = (float)t;
            ((f32x2*)ROPE_T)[i] = (f32x2){__builtin_amdgcn_cosf(tf), __builtin_amdgcn_sinf(tf)}; }
        thin_phase<false, true, true>(gw, NGW, x_prompt, x_sample, nullptr, nullptr, nullptr, XN, nullptr, norm_g + 0 * DM, 1.f);
        GRID_BAR();
    }
    bf16_t* QKVG = (bf16_t*)(ws + WS_QKVG); float* T16 = (float*)(ws + WS_T16); float* GO = (float*)(ws + WS_GO);
#define FFN_GEMMS(slot) do { \
        { pg8::Gemm g{XN, WIN + (size_t)(slot) * 2 * DFF * DM, DM, DM, DM, 0, 0}; pg8::Order S{M / 256, 2 * DFF / 256, 1, G, bx}; \
          pg8::EpiSwiGLU E{HM, DFF}; \
          pg8::gemm_phase<pg8::EpiSwiGLU, true>(lds, wave, g, S, E); \
          GRID_BAR(); } \
        { pg8::Gemm g{HM, WOUT + (size_t)(slot) * DM * DFF, DFF, DFF, DFF, 0, 0}; pg8::Order S{M / 256, DM / 256, 1, G, bx}; \
          pg8::EpiF32 E{T, DM}; \
          pg8::gemm_phase<pg8::EpiF32, true>(lds, wave, g, S, E); \
          GRID_BAR(); } } while (0)
    { const float* ng = norm_g;
    FFN_GEMMS(0);
    thin_phase<true, true, true>(gw, NGW, x_prompt, x_sample, nullptr, T, Y, XN, ng + 1 * DM, ng + 2 * DM, 0.5f); GRID_BAR();
        {
            pg8::Gemm g{XN, WDOWN, DM, DM, DM, 0, 0}; pg8::Order S{M / 256, DDOWN_P / 256, 1, G, bx};
            pg8::EpiF32 E{D, DDOWN_P};
            pg8::gemm_phase<pg8::EpiF32, true>(lds, wave, g, S, E);
            GRID_BAR();
        }
        {
            const int lane = lane_now(), tid = wave * 64 + lane; (void)tid;
            f32x2 gq[3]; f32x4 gkv;
    #pragma unroll
            for (int j = 0; j < 3; ++j) gq[j] = *(const f32x2*)(mla_g_q + 2 * lane + 128 * j);
            gkv = *(const f32x4*)(mla_g_kv + 4 * lane);
            for (int r = gw; r < M; r += NGW) {
                const float* d = D + (size_t)r * DDOWN_P;
                f32x2 q[3];
    #pragma unroll
                for (int j = 0; j < 3; ++j) q[j] = *(const f32x2*)(d + 2 * lane + 128 * j);
                const f32x4 kv = *(const f32x4*)(d + QL + 4 * lane);
                const float pe = d[QL + KVL + lane];
                float sq = 0.f;
    #pragma unroll
                for (int j = 0; j < 3; ++j) sq += q[j][0] * q[j][0] + q[j][1] * q[j][1];
                sq = wave_sum(sq);
                const float skv = wave_sum((kv[0] * kv[0] + kv[1] * kv[1]) + (kv[2] * kv[2] + kv[3] * kv[3]));
                const float rq = __builtin_amdgcn_rsqf(sq * (1.0f / QL) + EPS), rkv = __builtin_amdgcn_rsqf(skv * (1.0f / KVL) + EPS);
    #pragma unroll
                for (int j = 0; j < 3; ++j) *(unsigned*)(CQ + (size_t)r * QL + 2 * lane + 128 * j) = cvt_pk_bf16(q[j][0] * rq * gq[j][0], q[j][1] * rq * gq[j][1]);
                const f32x4 ckv = (kv * rkv) * gkv;
                float* ockv = r < MP ? out + OUT_CKV_P + (size_t)r * KVL : out + OUT_CKV_S + (size_t)(r - MP) * KVL;
                *(f32x4*)(ockv + 4 * lane) = ckv;
                u32x2 w; w.x = cvt_pk_bf16(ckv[0], ckv[1]); w.y = cvt_pk_bf16(ckv[2], ckv[3]);
                *(u32x2*)(CKV + (size_t)r * KVL + 4 * lane) = w;
                const float other = __shfl_xor(pe, 32);
                const f32x2 cs = ((const f32x2*)ROPE_T)[rope_pos_index(r) * 32 + (lane & 31)];
                const float ro = lane < 32 ? pe * cs[0] - other * cs[1] : pe * cs[0] + other * cs[1];
                float* okpe = r < MP ? out + OUT_KPE_P + (size_t)r * ROPE : out + OUT_KPE_S + (size_t)(r - MP) * ROPE;
                okpe[lane] = ro;
                const unsigned short rb = (unsigned short)(cvt_pk_bf16(ro, 0.f) & 0xffffu);
                if (r < MP) {
    #pragma unroll
                    for (int h = 0; h < NH; ++h) KB[(size_t)r * (NH * QKD) + h * QKD + NOPE + lane] = rb;
                } else KPES[(size_t)(r - MP) * ROPE + lane] = rb;
            }
            GRID_BAR();
        }

        bf16_t* Qb = (bf16_t*)(ws + WS_Q); bf16_t* VT = (bf16_t*)(ws + WS_VT); bf16_t* QLAT = (bf16_t*)(ws + WS_QLAT); bf16_t* Ob = (bf16_t*)(ws + WS_O);
        float* OPART = (float*)(ws + WS_OPART); float* OML = (float*)(ws + WS_OML); bf16_t* OLAT = (bf16_t*)(ws + WS_OLAT);
        const float QSCALE = 0.07216878364870322f * LOG2E;
        {
            pg8::Gemm g{CQ, WUQ, QL, QL, QL, 0, 0}; pg8::Order S{M / 256, NH * QKD / 256, 1, G, bx};
            pg8::EpiQ E{Qb, ROPE_T, QSCALE};
            pg8::gemm_phase<pg8::EpiQ, true>(lds, wave, g, S, E);
            GRID_BAR();
        }
        {
            { pg8::Gemm g{CKV, WUKT, KVL, KVL, KVL, 0, 0}; pg8::Order S{MP / 256, NH * NOPE / 256, 1, G, bx};
              pg8::EpiBf16<1> E{KB, NH * QKD, 0, 256, 1.f, 0};
              pg8::gemm_phase<pg8::EpiBf16<1>, true>(lds, wave, g, S, E); }
            { pg8::Gemm g{WUVT, CKV, KVL, KVL, KVL, 0, 0}; pg8::Order S{NH * VD / 256, MP / 256, 1, G, bx};
              pg8::EpiBf16<0> E{VT, MP, 0, 256, 1.f, 0};
              pg8::gemm_phase<pg8::EpiBf16<0>, true>(lds, wave, g, S, E); }
            { pg8::Gemm g{Qb + (size_t)MP * NH * QKD, WUK, NH * QKD, NH * NOPE, NOPE, QKD, NOPE}; pg8::Order S{MS / 256, 1, NH, G, bx};
              pg8::EpiBf16<0> E{QLAT, NH * 320, 320, 256, 1.f, 0};
              pg8::gemm_phase<pg8::EpiBf16<0>, true>(lds, wave, g, S, E); }
            const int lane = lane_now(), tid = wave * 64 + lane; (void)tid;
            for (int i = vcu * (NWAVES * 64) + tid; i < MS * NH * 8; i += G * NWAVES * 64) { const int c = i & 7, th = i >> 3;
                *(u32x4*)(QLAT + (size_t)th * 320 + 256 + c * 8) = *(const u32x4*)(Qb + (size_t)(MP + (th >> 3)) * (NH * QKD) + (th & 7) * QKD + NOPE + c * 8); }
            GRID_BAR();
        }

        {
            for (int p = vcu; p < NB * NH * 4; p += G) { const int bh = p >> 2, x = p & 3;
                pat::unit(lds, wave, Qb, KB, VT, Ob, bh >> 3, bh & 7, 7 - x);
                pat::unit(lds, wave, Qb, KB, VT, Ob, bh >> 3, bh & 7, x); }
            for (int u = bx; u < DECB * 2; u += G)
                sat::unit(lds, wave, QLAT, cache_ckv, cache_kpe, page_table, CKV + (size_t)MP * KVL, KPES, OPART, OML, u >> 1, u & 1);
            GRID_BAR();
        }
        {
            const int lane = lane_now(), tid = wave * 64 + lane; (void)tid;
            for (int r = gw; r < DECB * 64; r += NGW) { const int b = r >> 6, q = r & 63;
                const f32x2 ml0 = *(const f32x2*)(OML + ((size_t)(b * 2) * 64 + q) * 2), ml1 = *(const f32x2*)(OML + ((size_t)(b * 2 + 1) * 64 + q) * 2);
                const float mm = fmaxf(ml0[0], ml1[0]), w0 = __builtin_amdgcn_exp2f(ml0[0] - mm), w1 = __builtin_amdgcn_exp2f(ml1[0] - mm), inv = 1.0f / (ml0[1] * w0 + ml1[1] * w1);
                const f32x4 a = *(const f32x4*)(OPART + ((size_t)(b * 2) * 64 + q) * KVL + 4 * lane), c = *(const f32x4*)(OPART + ((size_t)(b * 2 + 1) * 64 + q) * KVL + 4 * lane);
                const f32x4 v = (a * w0 + c * w1) * inv;
                u32x2 w; w.x = cvt_pk_bf16(v[0], v[1]); w.y = cvt_pk_bf16(v[2], v[3]);
                *(u32x2*)(OLAT + (size_t)r * KVL + 4 * lane) = w; }
            GRID_BAR();
        }
        {
            pg8::Gemm g{OLAT, WUVT, NH * KVL, KVL, KVL, KVL, (long)VD * KVL}; pg8::Order S{MS / 256, 1, NH, G, bx};
            pg8::EpiBf16<0> E{Ob + (size_t)MP * DM, DM, VD, 128, 1.f, 0};
            pg8::gemm_phase<pg8::EpiBf16<0>, true>(lds, wave, g, S, E);
            GRID_BAR();
        }
        {
            pg8::Gemm g{Ob, WOT, DM, DM, DM, 0, 0}; pg8::Order S{M / 256, DM / 256, 1, G, bx};
            pg8::EpiF32 E{T, DM};
            pg8::gemm_phase<pg8::EpiF32, true>(lds, wave, g, S, E);
            GRID_BAR();
        }
        {
            thin_phase<true, true, false>(gw, NGW, nullptr, nullptr, Y, T, Y, XN, norm_g + 3 * DM, norm_g + 4 * DM, 1.0f);
            GRID_BAR();
        }


    FFN_GEMMS(1);
    thin_phase<true, true, false>(gw, NGW, nullptr, nullptr, Y, T, Y, XN, ng + 5 * DM, norm_g + 6 * DM, 0.5f); GRID_BAR();
    }
    { const float* ng = norm_g + 6 * DM;
    FFN_GEMMS(2);
    thin_phase<true, true, false>(gw, NGW, nullptr, nullptr, Y, T, Y, XN, ng + 1 * DM, ng + 2 * DM, 0.5f); GRID_BAR();
            { pg8::Gemm g{XN, WGIN, DM, DM, DM, 0, 0}; pg8::Order S{M / 256, GIN_P / 256, 1, G, bx};
              pg8::EpiGla E{QKVG, T16, 0.08838834764831845f};
              pg8::gemm_phase<pg8::EpiGla, true>(lds, wave, g, S, E);
              GRID_BAR(); }
            { if (bx < NB * GH) { const int b = bx >> 2, h = bx & 3;
                  gla::chain(lds, wave, QKVG, T16, gla_w_gk2, gla_b_gk, h, b * SEQ, SEQ, nullptr, out + OUT_ST_P + (size_t)bx * GDK * GDV, GO);
              } else if (G > NB * GH) {
                  for (int u = bx - NB * GH; u < DECB * GH; u += G - NB * GH) { const int b = u >> 2, h = u & 3;
                      gla::chain(lds, wave, QKVG, T16, gla_w_gk2, gla_b_gk, h, MP + b * DECT, DECT, state_gla + (size_t)u * GDK * GDV, out + OUT_ST_S + (size_t)u * GDK * GDV, GO); }
              }
              GRID_BAR(); }
            { const int lane = lane_now(), tid = wave * 64 + lane; (void)tid; const f32x4 gn = *(const f32x4*)(gla_g_norm + 4 * lane);
              for (int r = gw; r < M; r += NGW) {
                  Row16 o = ld_row(GO + (size_t)r * DM, lane);
                  const u32x2* gp = (const u32x2*)(QKVG + (size_t)r * GIN + 2 * GH * GDK + GH * GDV) + lane;
#pragma unroll
                  for (int j = 0; j < 4; ++j) { const u32x2 gw2 = gp[64 * j];
                      const float ss = wave_sum((o.v[j][0] * o.v[j][0] + o.v[j][1] * o.v[j][1]) + (o.v[j][2] * o.v[j][2] + o.v[j][3] * o.v[j][3]));
                      const float rs = __builtin_amdgcn_rsqf(ss * (1.0f / GDV) + EPS);
                      const float g0 = __uint_as_float(gw2.x << 16), g1 = __uint_as_float(gw2.x & 0xffff0000u), g2 = __uint_as_float(gw2.y << 16), g3 = __uint_as_float(gw2.y & 0xffff0000u);
                      o.v[j][0] = o.v[j][0] * rs * gn[0] * pg8::silu_f(g0); o.v[j][1] = o.v[j][1] * rs * gn[1] * pg8::silu_f(g1);
                      o.v[j][2] = o.v[j][2] * rs * gn[2] * pg8::silu_f(g2); o.v[j][3] = o.v[j][3] * rs * gn[3] * pg8::silu_f(g3); }
                  st_row_bf16(XN + (size_t)r * DM, o, lane); }
              GRID_BAR(); }
            { pg8::Gemm g{XN, WGO, DM, DM, DM, 0, 0}; pg8::Order S{M / 256, DM / 256, 1, G, bx};
              pg8::EpiF32 E{T, DM};
              pg8::gemm_phase<pg8::EpiF32, true>(lds, wave, g, S, E);
              GRID_BAR(); }
            { thin_phase<true, true, false>(gw, NGW, nullptr, nullptr, Y, T, Y, XN, ng + 3 * DM, ng + 4 * DM, 1.0f);
              GRID_BAR(); }

    FFN_GEMMS(3);
    thin_phase<true, false, false>(gw, NGW, nullptr, nullptr, Y, T, Y, XN, ng + 5 * DM, nullptr, 0.5f);
    }
#ifdef DBG_SCALE_MASK
    GRID_BAR();
    {
        const int lane = lane_now(), tid = wave * 64 + lane; (void)tid;
        const size_t offs[9] = {OUT_Y, OUT_Y + (size_t)MP * DM, OUT_CKV_P, OUT_KPE_P, OUT_CKV_S, OUT_KPE_S, OUT_ST_P, OUT_ST_S, OUT_END};
        for (int o = 0; o < 8; ++o) if ((DBG_SCALE_MASK >> o) & 1)
            for (size_t i = offs[o] / 4 + (size_t)vcu * (NWAVES * 64) + tid; i < offs[o + 1] / 4; i += (size_t)G * NWAVES * 64) ((f32x4*)out)[i] = ((f32x4*)out)[i] * 3.0f;
    }
#endif
#undef GRID_BAR
}

extern "C" void kernel_launch(void* const* d_in, const int* in_sizes, int n_in, void* d_out, int out_size, void* d_ws, size_t ws_size, hipStream_t stream) {
    static int grid = 0;
    if (grid == 0) {
        if (n_in != 22 || (size_t)out_size != OUT_END || ws_size < WS_END) { fprintf(stderr, "kernel_launch: unexpected shapes: n_in %d out %d ws %zu (need %zu)\n", n_in, out_size, ws_size, (size_t)WS_END); grid = -1; return; }
        int dev = 0, cus = 0, per_cu = 0;
        if (hipGetDevice(&dev) != hipSuccess || hipDeviceGetAttribute(&cus, hipDeviceAttributeMultiprocessorCount, dev) != hipSuccess) { grid = -1; return; }
        if (hipFuncSetAttribute((const void*)mk_fwd, hipFuncAttributeMaxDynamicSharedMemorySize, LDS_BYTES) != hipSuccess) { fprintf(stderr, "kernel_launch: hipFuncSetAttribute failed\n"); grid = -1; return; }
        if (hipOccupancyMaxActiveBlocksPerMultiprocessor(&per_cu, (const void*)mk_fwd, NWAVES * 64, LDS_BYTES) != hipSuccess || per_cu < 1) { fprintf(stderr, "kernel_launch: occupancy query says %d\n", per_cu); }
        (void)hipGetLastError();
        grid = cus;
    }
    if (grid < 0) return;
    if (hipMemsetAsync((char*)d_ws + WS_CTL, 0, CTL_ZERO_BYTES, stream) != hipSuccess) return;
    Args a{};
    for (int i = 0; i < 22; ++i) a.in[i] = d_in[i];
    a.out = (float*)d_out; a.ws = (unsigned char*)d_ws; a.ph_lo = 0; a.ph_hi = 100;
    hipLaunchKernelGGL(mk_fwd, dim3(grid), dim3(NWAVES * 64), LDS_BYTES, stream, a);
}
```

```cpp
#include <hip/hip_runtime.h>
#include <cstdio>
#include <cstdint>


#define GAS __attribute__((address_space(1)))
#define LAS __attribute__((address_space(3)))
typedef unsigned short bf16_t;
typedef short bf16x8 __attribute__((ext_vector_type(8)));
typedef float f32x4 __attribute__((ext_vector_type(4)));
typedef float f32x2 __attribute__((ext_vector_type(2)));
typedef float f32x16 __attribute__((ext_vector_type(16)));
typedef unsigned u32x4 __attribute__((ext_vector_type(4)));
typedef unsigned u32x2 __attribute__((ext_vector_type(2)));

constexpr int DM = 1024, NB = 16, SEQ = 2048, DECB = 128, DECT = 8, PAST = 8192, PAGE = 128, NPAGES = PAST / PAGE;
constexpr int MP = NB * SEQ, MS = DECB * DECT, M = MP + MS;
constexpr int DFF = 2816;
constexpr int QL = 384, KVL = 256, NOPE = 128, ROPE = 64, VD = 128, NH = 8, QKD = NOPE + ROPE;
constexpr int DDOWN = QL + KVL + ROPE, DDOWN_P = 768;
constexpr int GH = 4, GDK = 128, GDV = 256, GRANK = 16, GIN = 2 * GH * GDK + 2 * GH * GDV, GIN_P = GIN + 256;
constexpr float EPS = 1e-6f;
constexpr float LOG2E = 1.4426950408889634f;
constexpr int NPOOL = (DECB * NPAGES * 5) / 4;

constexpr size_t OUT_Y = 0;
constexpr size_t OUT_CKV_P = (size_t)M * DM;
constexpr size_t OUT_KPE_P = OUT_CKV_P + (size_t)MP * KVL;
constexpr size_t OUT_CKV_S = OUT_KPE_P + (size_t)MP * ROPE;
constexpr size_t OUT_KPE_S = OUT_CKV_S + (size_t)MS * KVL;
constexpr size_t OUT_ST_P = OUT_KPE_S + (size_t)MS * ROPE;
constexpr size_t OUT_ST_S = OUT_ST_P + (size_t)NB * GH * GDK * GDV;
constexpr size_t OUT_END = OUT_ST_S + (size_t)DECB * GH * GDK * GDV;

constexpr size_t MiB = 1u << 20;
constexpr size_t al(size_t x) { return (x + 4095) & ~(size_t)4095; }
constexpr size_t WS_CTL = 0, CTL_ZERO_BYTES = 64 * 1024;
constexpr size_t WS_ROPE = 1 * MiB;
constexpr size_t WS_WIN = 2 * MiB;
constexpr size_t SZ_WIN1 = (size_t)2 * DFF * DM * 2;
constexpr size_t WS_WOUT = WS_WIN + 4 * SZ_WIN1;
constexpr size_t SZ_WOUT1 = (size_t)DM * DFF * 2;
constexpr size_t WS_WDOWN = WS_WOUT + 4 * SZ_WOUT1;
constexpr size_t WS_WUQ = WS_WDOWN + (size_t)DDOWN_P * DM * 2;
constexpr size_t WS_WUKT = WS_WUQ + (size_t)NH * QKD * QL * 2;
constexpr size_t WS_WUK = WS_WUKT + (size_t)NH * NOPE * KVL * 2;
constexpr size_t WS_WUVT = WS_WUK + (size_t)NH * NOPE * KVL * 2;
constexpr size_t WS_WOT = WS_WUVT + (size_t)(NH * VD + 128) * KVL * 2;
constexpr size_t WS_WGIN = WS_WOT + (size_t)DM * DM * 2;
constexpr size_t WS_WGO = WS_WGIN + (size_t)GIN_P * DM * 2;
constexpr size_t WS_ACT = al(WS_WGO + (size_t)DM * DM * 2);
constexpr size_t WS_XN = WS_ACT;
constexpr size_t WS_HM = al(WS_XN + (size_t)M * DM * 2);
constexpr size_t WS_T = al(WS_HM + (size_t)M * DFF * 2);
constexpr size_t WS_D = al(WS_T + (size_t)M * DM * 4);
constexpr size_t WS_CQ = al(WS_D + (size_t)M * DDOWN_P * 4);
constexpr size_t WS_CKV = al(WS_CQ + (size_t)M * QL * 2);
constexpr size_t WS_KPES = al(WS_CKV + (size_t)M * KVL * 2);
constexpr size_t WS_Q = al(WS_KPES + (size_t)MS * ROPE * 2);
constexpr size_t WS_KB = al(WS_Q + (size_t)M * NH * QKD * 2);
constexpr size_t WS_KPEP = al(WS_KB + (size_t)MP * NH * NOPE * 2);
constexpr size_t WS_VT = al(WS_KPEP + (size_t)MP * ROPE * 2);
constexpr size_t WS_QLAT = al(WS_VT + (size_t)NH * VD * MP * 2);
constexpr size_t WS_O = al(WS_QLAT + (size_t)MS * NH * 320 * 2);
constexpr size_t WS_OPART = al(WS_O + (size_t)M * DM * 2);
constexpr size_t WS_OML = al(WS_OPART + (size_t)DECB * 2 * 64 * 256 * 4);
constexpr size_t WS_OLAT = al(WS_OML + (size_t)DECB * 2 * 64 * 2 * 4);
constexpr size_t WS_QKVG = al(WS_OLAT + (size_t)MS * NH * KVL * 2);
constexpr size_t WS_T16 = al(WS_QKVG + (size_t)M * GIN * 2);
constexpr size_t WS_GO = al(WS_T16 + (size_t)M * 16 * 4);
constexpr size_t WS_H = al(WS_GO + (size_t)M * DM * 4);
constexpr size_t WS_TP = al(WS_H + (size_t)M * DM * 2);
constexpr size_t WS_GQT = al(WS_TP + (size_t)11 * MS * DM * 4);
constexpr size_t WS_GKH = al(WS_GQT + (size_t)M * GH * GDK * 2);
constexpr size_t WS_GAT = al(WS_GKH + (size_t)(M / 64) * GH * 128 * 64 * 2);
constexpr size_t WS_GDK = al(WS_GAT + (size_t)(M / 64) * GH * 3072 * 2);
constexpr size_t WS_END = al(WS_GDK + (size_t)(M / 64) * GH * 1024 * 4);

constexpr int RING_BYTES = 131072;
constexpr int LDSCTL_OFF = RING_BYTES, MISC_OFF = LDSCTL_OFF + 320;
constexpr int LDS_BYTES = 147456;
constexpr int NWAVES = 8;

#define LDS_WAIT() asm volatile("s_waitcnt lgkmcnt(0)" ::: "memory")
#define VM_WAIT() asm volatile("s_waitcnt vmcnt(0)" ::: "memory")
#define RLX_AGENT __ATOMIC_RELAXED, __HIP_MEMORY_SCOPE_AGENT

typedef __bf16 bf16x2_t __attribute__((ext_vector_type(2)));
__device__ __forceinline__ unsigned cvt_pk_bf16(float lo, float hi) { const f32x2 v = {lo, hi}; const bf16x2_t b = __builtin_convertvector(v, bf16x2_t); return __builtin_bit_cast(unsigned, b); }
__device__ __forceinline__ int lane_now() { int l; asm volatile("v_mbcnt_lo_u32_b32 %0, -1, 0\n\tv_mbcnt_hi_u32_b32 %0, -1, %0" : "=v"(l)); return l; }
__device__ __forceinline__ float bf2f(unsigned short b) { return __uint_as_float((unsigned)b << 16); }
template <int CTRL> __device__ __forceinline__ float dpp_mov(float v) { return __builtin_bit_cast(float, __builtin_amdgcn_update_dpp(0, __builtin_bit_cast(int, v), CTRL, 0xF, 0xF, true)); }
__device__ __forceinline__ float wave_sum(float v) {
    v += dpp_mov<0xB1>(v);
    v += dpp_mov<0x4E>(v);
    v += dpp_mov<0x141>(v);
    v += dpp_mov<0x140>(v);
    const int iv = __builtin_bit_cast(int, v);
    const float a = __builtin_bit_cast(float, __builtin_amdgcn_readlane(iv, 0)), b = __builtin_bit_cast(float, __builtin_amdgcn_readlane(iv, 16));
    const float c = __builtin_bit_cast(float, __builtin_amdgcn_readlane(iv, 32)), d = __builtin_bit_cast(float, __builtin_amdgcn_readlane(iv, 48));
    return (a + b) + (c + d);
}

namespace pg8 {
constexpr int BM = 256, BK = 64, HALF = 128, HTB = HALF * BK * 2, STAGE_BYTES = 8 * HTB, NXCD = 8, WGM = 8;
__host__ __device__ __forceinline__ int lds_byte(int r, int c) { const int st = (r >> 4) * 2 + (c >> 5), rr = r & 15, cc = c & 31, ob = rr * 64 + cc * 2; return st * 1024 + (ob ^ (((ob >> 9) & 1) << 5)); }
__host__ __device__ __forceinline__ void stage_rc(int b, int& R, int& C) { const int st = b / 1024, sb = b % 1024, swz = sb ^ (((sb >> 9) & 1) << 5); R = (st >> 1) * 16 + swz / 64; C = (st & 1) * 32 + (swz % 64) / 2; }
__host__ __device__ __forceinline__ int perm32(int rho) { const int n = rho >> 4, i = rho & 15; return 8 * (i >> 2) + 4 * n + (i & 3); }

struct Unit { int pm, pn, z; };
struct Gemm { const bf16_t* A; const bf16_t* Bt; int lda, ldb, K; long sAz, sBz; };

struct Order {
    int nM, nN, nZ, G, c;
    __device__ __forceinline__ bool next(int i, Unit& u) const {
        const long L = (long)i * G + c; const int per = nM * nN; if (L >= (long)per * nZ) return false;
        const int z = (int)(L / per); int wgid = (int)(L - (long)z * per);
        { const int q = per / NXCD, r = per % NXCD, xcd = wgid % NXCD, off = wgid / NXCD; wgid = (xcd < r ? xcd * (q + 1) : r * (q + 1) + (xcd - r) * q) + off; }
        const int nig = WGM * nN, gid = wgid / nig, fm = gid * WGM, gsz = (nM - fm) < WGM ? (nM - fm) : WGM;
        u.pm = fm + ((wgid % nig) % gsz); u.pn = (wgid % nig) / gsz; u.z = z; return true;
    }
};

struct OrderOff {
    Order o; int m0;
    __device__ __forceinline__ bool next(int i, Unit& u) const { const bool ok = o.next(i, u); u.pm += m0; return ok; }
};

template <class Epi, bool ALIGN_EPI, class Ord = Order>
__device__ __forceinline__ void gemm_phase(LAS unsigned char* lds, const int wid, const Gemm g, const Ord& S, const Epi& E) {
    const int lane = lane_now(), tid = wid * 64 + lane;
    const int wr = wid >> 2, wc = wid & 3, fr = lane & 15, fq = lane >> 4;
    const int K = g.K, nt = K / BK;
    unsigned voffA, voffB;
    { int R, C; stage_rc(tid * 16, R, C); const int Rb = Epi::PERM ? ((R & ~31) + perm32(R & 31)) : R;
      voffA = (unsigned)(R * g.lda + C) * 2u; voffB = (unsigned)(Rb * g.ldb + C) * 2u; }
    const size_t qsA = (size_t)64 * g.lda * 2, qsB = (size_t)64 * g.ldb * 2;
    const size_t kstep = (size_t)(BK * 2);
    const size_t hsA = (size_t)HALF * g.lda * 2, hsB = (size_t)HALF * g.ldb * 2;
    const unsigned ldsw = (unsigned)wid * 1024u;
    const int aoff = lds_byte(wr * 64 + fr, fq * 8), boff = lds_byte(wc * 32 + fr, fq * 8);
#define PG8_SA(b, h) (((b) * 2 + (h)) * HTB)
#define PG8_SB(b, h) ((4 + (b) * 2 + (h)) * HTB)
#define PG8_STAGE(bufoff, gbase, voff) do { _Pragma("unroll") for (int _i = 0; _i < 2; ++_i) \
        __builtin_amdgcn_global_load_lds((const unsigned*)((const char*)(gbase) + _i * PG8_QS_##voff + (voff)), (LAS unsigned*)(lds + (bufoff) + ldsw + _i * 8192), 16, 0, 0); } while (0)
#define PG8_QS_voffA qsA
#define PG8_QS_voffB qsB
#define PG8_LDA(dst, b, h) do { _Pragma("unroll") for (int m = 0; m < 4; ++m) _Pragma("unroll") for (int k = 0; k < 2; ++k) dst[m][k] = *(const LAS bf16x8*)(lds + PG8_SA(b, h) + aoff + m * 2048 + k * 1024); } while (0)
#define PG8_LDB(dst, b, h) do { _Pragma("unroll") for (int n = 0; n < 2; ++n) _Pragma("unroll") for (int k = 0; k < 2; ++k) dst[n][k] = *(const LAS bf16x8*)(lds + PG8_SB(b, h) + boff + n * 2048 + k * 1024); } while (0)
#define PG8_MMA(ai, bj, At, Bt) do { __builtin_amdgcn_s_setprio(1); _Pragma("unroll") for (int m = 0; m < 4; ++m) _Pragma("unroll") for (int n = 0; n < 2; ++n) _Pragma("unroll") for (int k = 0; k < 2; ++k) \
        acc[ai][bj][m][n] = __builtin_amdgcn_mfma_f32_16x16x32_bf16(Bt[n][k], At[m][k], acc[ai][bj][m][n], 0, 0, 0); __builtin_amdgcn_s_setprio(0); } while (0)
#define PG8_WAIT_V(n) asm volatile("s_waitcnt vmcnt(" #n ")" ::: "memory")
#define PG8_WAIT_L(n) asm volatile("s_waitcnt lgkmcnt(" #n ")" ::: "memory")
#define PG8_BAR __builtin_amdgcn_s_barrier()
#define PG8_SCHED __builtin_amdgcn_sched_barrier(0)
#define PG8_APTR(u) ((const char*)g.A + ((size_t)(u).z * g.sAz + (size_t)(u).pm * BM * g.lda) * 2)
#define PG8_BPTR(u) ((const char*)g.Bt + ((size_t)(u).z * g.sBz + (size_t)(u).pn * BM * g.ldb) * 2)
    Unit cur, nxt; int ui = 0;
    if (!S.next(0, cur)) return;
    f32x4 acc[2][2][4][2];
#pragma unroll
    for (int a = 0; a < 2; ++a)
#pragma unroll
        for (int b = 0; b < 2; ++b)
#pragma unroll
            for (int m = 0; m < 4; ++m)
#pragma unroll
                for (int n = 0; n < 2; ++n) acc[a][b][m][n] = (f32x4){0.f, 0.f, 0.f, 0.f};
    bf16x8 At[4][2], B0[2][2], B1[2][2];
    const char* cA = PG8_APTR(cur); const char* cB = PG8_BPTR(cur);
    PG8_STAGE(PG8_SB(0, 0), cB, voffB); PG8_STAGE(PG8_SB(0, 1), cB + hsB, voffB); PG8_STAGE(PG8_SA(0, 0), cA, voffA); PG8_STAGE(PG8_SA(0, 1), cA + hsA, voffA);
    if (wr == 1) PG8_BAR;
    PG8_WAIT_V(2); PG8_BAR;
    PG8_STAGE(PG8_SB(1, 0), cB + kstep, voffB); PG8_STAGE(PG8_SA(1, 0), cA + kstep, voffA); PG8_STAGE(PG8_SB(1, 1), cB + hsB + kstep, voffB);
    PG8_WAIT_V(6); PG8_BAR;
    for (;;) {
        const bool has_next = S.next(ui + 1, nxt);
        const char* nA = has_next ? PG8_APTR(nxt) : cA; const char* nB = has_next ? PG8_BPTR(nxt) : cB;
#pragma unroll 1
        for (int t = 0; t < nt; t += 2) {
            const bool last = (t == nt - 2);
            const char* a1 = cA + (size_t)(t + 1) * kstep;
            const char* a2 = last ? nA : cA + (size_t)(t + 2) * kstep; const char* b2 = last ? nB : cB + (size_t)(t + 2) * kstep;
            const char* a3 = a2 + kstep; const char* b3 = b2 + kstep;
            PG8_LDB(B0, 0, 0); PG8_LDB(B1, 0, 1); PG8_SCHED; PG8_LDA(At, 0, 0); PG8_STAGE(PG8_SA(1, 1), a1 + hsA, voffA);
            PG8_WAIT_V(8); PG8_WAIT_L(0); PG8_BAR; PG8_MMA(0, 0, At, B0); PG8_MMA(0, 1, At, B1); PG8_BAR; PG8_SCHED;
            PG8_LDA(At, 0, 1); PG8_STAGE(PG8_SB(0, 0), b2, voffB); PG8_STAGE(PG8_SB(0, 1), b2 + hsB, voffB); PG8_STAGE(PG8_SA(0, 0), a2, voffA);
            PG8_WAIT_V(8); PG8_WAIT_L(0); PG8_BAR; PG8_MMA(1, 0, At, B0); PG8_MMA(1, 1, At, B1); PG8_BAR; PG8_SCHED;
            PG8_LDB(B0, 1, 0); PG8_LDB(B1, 1, 1); PG8_SCHED; PG8_LDA(At, 1, 0); PG8_STAGE(PG8_SA(0, 1), a2 + hsA, voffA);
            PG8_WAIT_V(8); PG8_WAIT_L(0); PG8_BAR; PG8_MMA(0, 0, At, B0); PG8_MMA(0, 1, At, B1); PG8_BAR; PG8_SCHED;
            PG8_LDA(At, 1, 1); PG8_STAGE(PG8_SB(1, 0), b3, voffB); PG8_STAGE(PG8_SB(1, 1), b3 + hsB, voffB); PG8_STAGE(PG8_SA(1, 0), a3, voffA);
            PG8_WAIT_V(8); PG8_WAIT_L(0); PG8_BAR; PG8_MMA(1, 0, At, B0); PG8_MMA(1, 1, At, B1); PG8_BAR; PG8_SCHED;
        }
        if constexpr (ALIGN_EPI) { if (wr == 0) PG8_BAR; }
        { int fr2 = fr, fq2 = fq; asm volatile("" : "+v"(fr2), "+v"(fq2)); E(acc, cur, wr, wc, fr2, fq2); }
        if (!has_next) break;
#pragma unroll
        for (int a = 0; a < 2; ++a)
#pragma unroll
            for (int b = 0; b < 2; ++b)
#pragma unroll
                for (int m = 0; m < 4; ++m)
#pragma unroll
                    for (int n = 0; n < 2; ++n) acc[a][b][m][n] = (f32x4){0.f, 0.f, 0.f, 0.f};
        cur = nxt; cA = nA; cB = nB; ++ui;
        if constexpr (ALIGN_EPI) { if (wr == 1) PG8_BAR; }
    }
    PG8_WAIT_V(0);
    if constexpr (!ALIGN_EPI) { if (wr == 0) PG8_BAR; }
    PG8_BAR;
#undef PG8_SA
#undef PG8_SB
#undef PG8_STAGE
#undef PG8_QS_voffA
#undef PG8_QS_voffB
#undef PG8_LDA
#undef PG8_LDB
#undef PG8_MMA
#undef PG8_WAIT_V
#undef PG8_WAIT_L
#undef PG8_BAR
#undef PG8_SCHED
#undef PG8_APTR
#undef PG8_BPTR
}

__device__ __forceinline__ float silu_f(float g) { return g * __builtin_amdgcn_rcpf(1.0f + __builtin_amdgcn_exp2f(-g * LOG2E)); }

struct EpiSwiGLU {
    static constexpr bool PERM = true;
    bf16_t* O; int ldc;
    __device__ __forceinline__ void operator()(const f32x4 (&acc)[2][2][4][2], const Unit& u, int wr, int wc, int fr, int fq) const {
        const int row0 = u.pm * BM + wr * 64 + fr, col0 = u.pn * HALF + wc * 32 + 8 * fq;
#pragma unroll
        for (int ai = 0; ai < 2; ++ai)
#pragma unroll
            for (int m = 0; m < 4; ++m) {
                bf16_t* rowp = O + (size_t)(row0 + ai * HALF + m * 16) * ldc + col0;
                const f32x4 g0 = acc[ai][0][m][0], g1 = acc[ai][0][m][1], u0 = acc[ai][1][m][0], u1 = acc[ai][1][m][1];
                u32x4 w;
                w.x = cvt_pk_bf16(silu_f(g0[0]) * u0[0], silu_f(g0[1]) * u0[1]); w.y = cvt_pk_bf16(silu_f(g0[2]) * u0[2], silu_f(g0[3]) * u0[3]);
                w.z = cvt_pk_bf16(silu_f(g1[0]) * u1[0], silu_f(g1[1]) * u1[1]); w.w = cvt_pk_bf16(silu_f(g1[2]) * u1[2], silu_f(g1[3]) * u1[3]);
                *(u32x4*)rowp = w;
            }
    }
};
struct EpiF32 {
    static constexpr bool PERM = false;
    float* O; int ldc; long sOz;
    __device__ __forceinline__ void operator()(const f32x4 (&acc)[2][2][4][2], const Unit& u, int wr, int wc, int fr, int fq) const {
        const int row0 = u.pm * BM + wr * 64 + fr, col0 = u.pn * BM + wc * 32 + 4 * fq;
#pragma unroll
        for (int ai = 0; ai < 2; ++ai)
#pragma unroll
            for (int m = 0; m < 4; ++m) {
                float* rowp = O + (size_t)u.z * sOz + (size_t)(row0 + ai * HALF + m * 16) * ldc + col0;
#pragma unroll
                for (int bj = 0; bj < 2; ++bj)
#pragma unroll
                    for (int n = 0; n < 2; ++n) *(f32x4*)(rowp + bj * HALF + n * 16) = acc[ai][bj][m][n];
            }
    }
};

template <int CMAP> struct EpiBf16 {
    static constexpr bool PERM = true;
    bf16_t* O; int ldc; long sOz; int ncol; float scale; int scale_cols;
    __device__ __forceinline__ void operator()(const f32x4 (&acc)[2][2][4][2], const Unit& u, int wr, int wc, int fr, int fq) const {
        const int row0 = u.pm * BM + wr * 64 + fr;
#pragma unroll
        for (int bj = 0; bj < 2; ++bj) {
            const int ct = bj * HALF + wc * 32 + 8 * fq; if (ct >= ncol) continue;
            const int c0 = u.pn * BM + ct; const int oc = CMAP == 1 ? (c0 >> 7) * 192 + (c0 & 127) : c0;
            const float sc = c0 < scale_cols ? scale : 1.f;
            bf16_t* base = O + (size_t)u.z * sOz + oc;
#pragma unroll
            for (int ai = 0; ai < 2; ++ai)
#pragma unroll
                for (int m = 0; m < 4; ++m) { const f32x4 v0 = acc[ai][bj][m][0] * sc, v1 = acc[ai][bj][m][1] * sc;
                    u32x4 w; w.x = cvt_pk_bf16(v0[0], v0[1]); w.y = cvt_pk_bf16(v0[2], v0[3]); w.z = cvt_pk_bf16(v1[0], v1[1]); w.w = cvt_pk_bf16(v1[2], v1[3]);
                    *(u32x4*)(base + (size_t)(row0 + ai * HALF + m * 16) * ldc) = w; }
        }
    }
};
struct EpiQ {
    static constexpr bool PERM = true;
    bf16_t* O; const float* rope_t; float scale;
    __device__ __forceinline__ void operator()(const f32x4 (&acc)[2][2][4][2], const Unit& u, int wr, int wc, int fr, int fq) const {
        const int row0 = u.pm * BM + wr * 64 + fr;
#pragma unroll
        for (int bj = 0; bj < 2; ++bj) {
            const int c0 = u.pn * BM + bj * HALF + wc * 32 + 8 * fq; const int h = c0 / 192, f0 = c0 - h * 192;
            if (f0 < 128) {
#pragma unroll
                for (int ai = 0; ai < 2; ++ai)
#pragma unroll
                    for (int m = 0; m < 4; ++m) { const f32x4 v0 = acc[ai][bj][m][0] * scale, v1 = acc[ai][bj][m][1] * scale;
                        u32x4 w; w.x = cvt_pk_bf16(v0[0], v0[1]); w.y = cvt_pk_bf16(v0[2], v0[3]); w.z = cvt_pk_bf16(v1[0], v1[1]); w.w = cvt_pk_bf16(v1[2], v1[3]);
                        *(u32x4*)(O + (size_t)(row0 + ai * HALF + m * 16) * 1536 + c0) = w; }
            } else {
                const int a4 = ((f0 - 128) >> 3) * 4;
#pragma unroll
                for (int ai = 0; ai < 2; ++ai)
#pragma unroll
                    for (int m = 0; m < 4; ++m) { const int r = row0 + ai * HALF + m * 16; const int pidx = r < MP ? (r & (SEQ - 1)) : SEQ + ((r - MP) & (DECT - 1));
                        const f32x4 cs0 = *(const f32x4*)(rope_t + (size_t)(pidx * 32 + a4) * 2), cs1 = *(const f32x4*)(rope_t + (size_t)(pidx * 32 + a4) * 2 + 4);
                        const f32x4 x1 = acc[ai][bj][m][0] * scale, x2 = acc[ai][bj][m][1] * scale;
                        const float y10 = x1[0] * cs0[0] - x2[0] * cs0[1], y11 = x1[1] * cs0[2] - x2[1] * cs0[3], y12 = x1[2] * cs1[0] - x2[2] * cs1[1], y13 = x1[3] * cs1[2] - x2[3] * cs1[3];
                        const float y20 = x2[0] * cs0[0] + x1[0] * cs0[1], y21 = x2[1] * cs0[2] + x1[1] * cs0[3], y22 = x2[2] * cs1[0] + x1[2] * cs1[1], y23 = x2[3] * cs1[2] + x1[3] * cs1[3];
                        bf16_t* rowp = O + (size_t)r * 1536 + h * 192 + 128 + a4;
                        u32x2 w1, w2; w1.x = cvt_pk_bf16(y10, y11); w1.y = cvt_pk_bf16(y12, y13); w2.x = cvt_pk_bf16(y20, y21); w2.y = cvt_pk_bf16(y22, y23);
                        *(u32x2*)rowp = w1; *(u32x2*)(rowp + 32) = w2; asm volatile("" ::: "memory"); }
            }
        }
    }
};

struct EpiGla {
    static constexpr bool PERM = true;
    bf16_t* O; float* T16; float qscale;
    __device__ __forceinline__ void operator()(const f32x4 (&acc)[2][2][4][2], const Unit& u, int wr, int wc, int fr, int fq) const {
        const int row0 = u.pm * BM + wr * 64 + fr;
        if (u.pn < 12) {
#pragma unroll
            for (int bj = 0; bj < 2; ++bj) {
                const int c0 = u.pn * BM + bj * HALF + wc * 32 + 8 * fq; const float sc = c0 < 512 ? qscale : 1.f;
#pragma unroll
                for (int ai = 0; ai < 2; ++ai)
#pragma unroll
                    for (int m = 0; m < 4; ++m) { const f32x4 v0 = acc[ai][bj][m][0] * sc, v1 = acc[ai][bj][m][1] * sc;
                        u32x4 w; w.x = cvt_pk_bf16(v0[0], v0[1]); w.y = cvt_pk_bf16(v0[2], v0[3]); w.z = cvt_pk_bf16(v1[0], v1[1]); w.w = cvt_pk_bf16(v1[2], v1[3]);
                        *(u32x4*)(O + (size_t)(row0 + ai * HALF + m * 16) * GIN + c0) = w; }
            }
        } else if (wc == 0 && fq < 2) {
#pragma unroll
            for (int ai = 0; ai < 2; ++ai)
#pragma unroll
                for (int m = 0; m < 4; ++m) { float* tp = T16 + (size_t)(row0 + ai * HALF + m * 16) * 16 + 8 * fq;
                    *(f32x4*)tp = acc[ai][0][m][0]; *(f32x4*)(tp + 4) = acc[ai][0][m][1]; }
        }
    }
};
}

#define XB_TMO      128
#define XB_XCNT(j)  (256  + 64 * (j))
#define XB_XSUB(j)  (1280 + 64 * (j))
#define XB_XGEN(j)  (2304 + 64 * (j))
#define XB_TOP      3328
#define XB_TOPGEN   3392
#define XCD_BAR_WORDS 3456
#define XB_SPIN_CAP (1u << 18)

__device__ __forceinline__ unsigned xb_ld(unsigned* p)              { return __hip_atomic_load(p, __ATOMIC_RELAXED, __HIP_MEMORY_SCOPE_AGENT); }
__device__ __forceinline__ unsigned xb_add(unsigned* p, unsigned v) { return __hip_atomic_fetch_add(p, v, __ATOMIC_RELAXED, __HIP_MEMORY_SCOPE_AGENT); }
__device__ __forceinline__ unsigned xb_xcc_id() { return (unsigned)__builtin_amdgcn_s_getreg((3 << 11) | 20) & 0xFu; }
#define XB_SPIN(cond, bar) do { unsigned _sp = 0; while (cond) { __builtin_amdgcn_s_sleep(1); \
    if ((++_sp & 255u) == 0u) { if (xb_ld(&(bar)[XB_TMO])) break; if (_sp > XB_SPIN_CAP) { atomicAdd(&(bar)[XB_TMO], 1u); break; } } } } while (0)

struct XcdBarrier { unsigned* bar; unsigned x; volatile LAS unsigned* st; };

__device__ __forceinline__ XcdBarrier xcd_barrier_post(unsigned* bar, volatile LAS unsigned* st, bool t0) {
    XcdBarrier b; b.bar = bar; b.x = xb_xcc_id(); b.st = st;
    if (t0) (void)xb_add(&bar[XB_XCNT(b.x)], 1u);
    return b;
}
__device__ __forceinline__ void xcd_barrier_complete(unsigned* bar, unsigned x, unsigned& nloc, unsigned& nx) {
    const unsigned G = gridDim.x * gridDim.y * gridDim.z;
    unsigned sum, cnt, mine, sp = 0u;
    for (;;) {
        sum = 0u; cnt = 0u; mine = 0u;
#pragma unroll
        for (unsigned j = 0; j < 16; ++j) { const unsigned c = xb_ld(&bar[XB_XCNT(j)]); sum += c; cnt += (c > 0u) ? 1u : 0u; mine = (j == x) ? c : mine; }
        if (sum == G) break;
        __builtin_amdgcn_s_sleep(1);
        if ((++sp & 255u) == 0u) { if (xb_ld(&bar[XB_TMO])) break; if (sp > XB_SPIN_CAP) { atomicAdd(&bar[XB_TMO], 1u); break; } }
    }
    nloc = mine > 0u ? mine : 1u; nx = cnt > 0u ? cnt : 1u;
}
__device__ __forceinline__ void xcd_barrier(const XcdBarrier& b, bool t0) {
    asm volatile("s_waitcnt vmcnt(0)" ::: "memory");
    __syncthreads();
    if (t0) {
        unsigned* bar = b.bar;
        __builtin_amdgcn_s_waitcnt(0);
        unsigned nloc = b.st[0], nx = b.st[1];
        if (nloc == 0u) { xcd_barrier_complete(bar, b.x, nloc, nx); b.st[0] = nloc; b.st[1] = nx; }
        const unsigned old = xb_add(&bar[XB_XSUB(b.x)], 1u);
        const unsigned gen = old / nloc;
        if (old + 1u == (gen + 1u) * nloc) {
            __builtin_amdgcn_fence(__ATOMIC_RELEASE, "agent");
            asm volatile("s_waitcnt vmcnt(0)" ::: "memory");
            const unsigned og = xb_add(&bar[XB_TOP], 1u);
            const unsigned tg = og / nx;
            if (og + 1u == (tg + 1u) * nx) xb_add(&bar[XB_TOPGEN], 1u);
            else XB_SPIN(xb_ld(&bar[XB_TOPGEN]) == tg, bar);
            __builtin_amdgcn_fence(__ATOMIC_ACQUIRE, "agent");
            xb_add(&bar[XB_XGEN(b.x)], 1u);
            asm volatile("s_waitcnt vmcnt(0)" ::: "memory");
        } else {
            XB_SPIN(xb_ld(&bar[XB_XGEN(b.x)]) == gen, bar);
            __builtin_amdgcn_fence(__ATOMIC_ACQUIRE, "agent");
            asm volatile("s_waitcnt vmcnt(0)" ::: "memory");
        }
    }
    __syncthreads();
}

struct Args { const void* in[22]; float* out; unsigned char* ws; int ph_lo, ph_hi; };

struct Frame {
    LAS unsigned char* lds;
    int tid, lane, wave, vcu, G;
    const float* const* dummy;
};

__device__ __forceinline__ void transpose_item(const float* W, int N, int k0, int n0, bf16_t* WT, int KT, int drow0, int interleave, LAS float* scr, int lane) {
    f32x4 v[8];
    const float* src = W + (size_t)(k0 + (lane >> 3)) * N + n0 + 4 * (lane & 7);
#pragma unroll
    for (int i = 0; i < 8; ++i) v[i] = *(const f32x4*)(src + (size_t)(8 * i) * N);
#pragma unroll
    for (int i = 0; i < 8; ++i) { LAS float* d = scr + (8 * i + (lane >> 3)) * 33 + 4 * (lane & 7); d[0] = v[i][0]; d[1] = v[i][1]; d[2] = v[i][2]; d[3] = v[i][3]; }
    LDS_WAIT(); asm volatile("" ::: "memory");
    const int c = lane & 7;
#pragma unroll
    for (int j = 0; j < 4; ++j) { const int n = (lane >> 3) + 8 * j; const LAS float* s = scr + (8 * c) * 33 + n;
        u32x4 o; o.x = cvt_pk_bf16(s[0 * 33], s[1 * 33]); o.y = cvt_pk_bf16(s[2 * 33], s[3 * 33]); o.z = cvt_pk_bf16(s[4 * 33], s[5 * 33]); o.w = cvt_pk_bf16(s[6 * 33], s[7 * 33]);
        const int drow = interleave ? (drow0 + 8 * (n >> 2) + (n & 3)) : (drow0 + n);
        *(u32x4*)(WT + (size_t)drow * KT + k0 + 8 * c) = o; }
    LDS_WAIT(); asm volatile("" ::: "memory");
}

struct ConvPtrs { const float *w_in, *w_out, *w_down, *w_uq, *w_uk, *w_uv, *w_o, *g_in, *g_o; bf16_t *WIN, *WOUT, *WDOWN, *WUQ, *WUKT, *WUVT, *WOT, *WGIN, *WGO; };
constexpr int I_WIN = (DM / 64) * (2 * DFF / 32);
constexpr int I_WOUT = (DFF / 64) * (DM / 32);
constexpr int I_DOWN = (DM / 64) * (DDOWN / 32);
constexpr int I_UQ = (QL / 64) * (NH * QKD / 32);
constexpr int I_UK = (KVL / 64) * (NH * NOPE / 32);
constexpr int I_UV = I_UK;
constexpr int I_O = (DM / 64) * (DM / 32);
constexpr int I_GIN = (DM / 64) * (GIN / 32);
constexpr int I_GO = I_O;
template <int SEG> __device__ __forceinline__ void conv_segment(const ConvPtrs& P, int widx, int nw, LAS float* scr, int lane) {
    constexpr int mi = SEG;
    constexpr int NIT = I_WIN + I_WOUT + (SEG == 1 ? I_DOWN + I_UQ + I_UK + I_UV + I_O : SEG == 2 ? I_GIN + I_GO : 0);
    for (int it = widx; it < NIT; it += nw) {
        int r = it;
        if (r < I_WIN) { const int nblk = 2 * DFF / 32, kb = r / nblk, nb = r % nblk, n0 = nb * 32;
            const int drow0 = n0 < DFF ? 256 * (n0 / 128) + (n0 % 128) : 256 * ((n0 - DFF) / 128) + 128 + ((n0 - DFF) % 128);
            transpose_item(P.w_in + (size_t)mi * DM * 2 * DFF, 2 * DFF, kb * 64, n0, P.WIN + (size_t)mi * 2 * DFF * DM, DM, drow0, 0, scr, lane); continue; } r -= I_WIN;
        if (r < I_WOUT) { const int nblk = DM / 32, kb = r / nblk, nb = r % nblk;
            transpose_item(P.w_out + (size_t)mi * DFF * DM, DM, kb * 64, nb * 32, P.WOUT + (size_t)mi * DM * DFF, DFF, nb * 32, 0, scr, lane); continue; } r -= I_WOUT;
        if constexpr (SEG == 1) {
            if (r < I_DOWN) { const int nblk = DDOWN / 32, kb = r / nblk, nb = r % nblk;
                transpose_item(P.w_down, DDOWN, kb * 64, nb * 32, P.WDOWN, DM, nb * 32, 0, scr, lane); continue; } r -= I_DOWN;
            if (r < I_UQ) { const int nblk = NH * QKD / 32, kb = r / nblk, nb = r % nblk, n0 = nb * 32, h = n0 / QKD, f = n0 % QKD;
                if (f < NOPE) transpose_item(P.w_uq, NH * QKD, kb * 64, n0, P.WUQ, QL, n0, 0, scr, lane);
                else transpose_item(P.w_uq, NH * QKD, kb * 64, n0, P.WUQ, QL, h * QKD + NOPE + (f == NOPE ? 0 : 4), 1, scr, lane);
                continue; } r -= I_UQ;
            if (r < I_UK) { const int nblk = NH * NOPE / 32, kb = r / nblk, nb = r % nblk;
                transpose_item(P.w_uk, NH * NOPE, kb * 64, nb * 32, P.WUKT, KVL, nb * 32, 0, scr, lane); continue; } r -= I_UK;
            if (r < I_UV) { const int nblk = NH * VD / 32, kb = r / nblk, nb = r % nblk;
                transpose_item(P.w_uv, NH * VD, kb * 64, nb * 32, P.WUVT, KVL, nb * 32, 0, scr, lane); continue; } r -= I_UV;
            { const int nblk = DM / 32, kb = r / nblk, nb = r % nblk;
                transpose_item(P.w_o, DM, kb * 64, nb * 32, P.WOT, DM, nb * 32, 0, scr, lane); }
        }
        if constexpr (SEG == 2) {
            if (r < I_GIN) { const int nblk = GIN / 32, kb = r / nblk, nb = r % nblk;
                transpose_item(P.g_in, GIN, kb * 64, nb * 32, P.WGIN, DM, nb * 32, 0, scr, lane); continue; } r -= I_GIN;
            { const int nblk = DM / 32, kb = r / nblk, nb = r % nblk;
                transpose_item(P.g_o, DM, kb * 64, nb * 32, P.WGO, DM, nb * 32, 0, scr, lane); }
        }
    }
}

struct Row16 { f32x4 v[4]; };
__device__ __forceinline__ Row16 ld_row(const float* p, int lane) { Row16 r; const f32x4* q = (const f32x4*)p + lane;
#pragma unroll
    for (int j = 0; j < 4; ++j) r.v[j] = q[64 * j]; return r; }
__device__ __forceinline__ Row16 ld_row_bf16(const bf16_t* p, int lane) { Row16 r; const u32x2* q = (const u32x2*)p + lane;
#pragma unroll
    for (int j = 0; j < 4; ++j) { const u32x2 w = q[64 * j]; r.v[j][0] = __uint_as_float(w.x << 16); r.v[j][1] = __uint_as_float(w.x & 0xffff0000u); r.v[j][2] = __uint_as_float(w.y << 16); r.v[j][3] = __uint_as_float(w.y & 0xffff0000u); } return r; }
__device__ __forceinline__ float row_ss(const Row16& r) { float s = 0.f;
#pragma unroll
    for (int j = 0; j < 4; ++j) s += (r.v[j][0] * r.v[j][0] + r.v[j][1] * r.v[j][1]) + (r.v[j][2] * r.v[j][2] + r.v[j][3] * r.v[j][3]); return wave_sum(s); }
__device__ __forceinline__ void st_row_bf16(bf16_t* p, const Row16& r, int lane) { u32x2* q = (u32x2*)p + lane;
#pragma unroll
    for (int j = 0; j < 4; ++j) { u32x2 w; w.x = cvt_pk_bf16(r.v[j][0], r.v[j][1]); w.y = cvt_pk_bf16(r.v[j][2], r.v[j][3]); q[64 * j] = w; } }
__device__ __forceinline__ void st_row_f32(float* p, const Row16& r, int lane) { f32x4* q = (f32x4*)p + lane;
#pragma unroll
    for (int j = 0; j < 4; ++j) q[64 * j] = r.v[j]; }

template <bool HAS_T, bool HAS_PRE, bool SRC_X, bool FINAL>
__device__ __forceinline__ void thin_phase(int gw, int NGW, const float* xp, const float* xs, const bf16_t* T, const float* TP, int nsplit, bf16_t* H, float* Yout, bf16_t* XN, const float* gpost, const float* gpre, float scale) {
    const int lane = lane_now();
    Row16 gp, gq;
    if (HAS_T) gp = ld_row(gpost, lane);
    if (HAS_PRE) gq = ld_row(gpre, lane);
    for (int r = gw; r < M; r += NGW) {
        Row16 h;
        if constexpr (SRC_X) h = ld_row(r < MP ? xp + (size_t)r * DM : xs + (size_t)(r - MP) * DM, lane); else h = ld_row_bf16(H + (size_t)r * DM, lane);
        if (HAS_T) {
            Row16 t;
            if (r < MP) t = ld_row_bf16(T + (size_t)r * DM, lane);
            else { t = ld_row(TP + (size_t)(r - MP) * DM, lane);
                for (int z = 1; z < nsplit; ++z) { const Row16 u = ld_row(TP + ((size_t)z * MS + (r - MP)) * DM, lane);
#pragma unroll
                    for (int j = 0; j < 4; ++j) t.v[j] = t.v[j] + u.v[j]; } }
            const float rs = scale * __builtin_amdgcn_rsqf(row_ss(t) * (1.0f / DM) + EPS);
#pragma unroll
            for (int j = 0; j < 4; ++j) h.v[j] = h.v[j] + (t.v[j] * rs) * gp.v[j];
            if constexpr (FINAL) st_row_f32(Yout + (size_t)r * DM, h, lane); else st_row_bf16(H + (size_t)r * DM, h, lane);
        }
        if (HAS_PRE) {
            const float rs = __builtin_amdgcn_rsqf(row_ss(h) * (1.0f / DM) + EPS);
#pragma unroll
            for (int j = 0; j < 4; ++j) h.v[j] = (h.v[j] * rs) * gq.v[j];
            st_row_bf16(XN + (size_t)r * DM, h, lane);
        }
    }
}

__device__ __forceinline__ int rope_pos_index(int r) { return r < MP ? (r & (SEQ - 1)) : SEQ + ((r - MP) & (DECT - 1)); }


typedef short s16x4 __attribute__((ext_vector_type(4)));
__device__ __forceinline__ int swap23(int x) { return (x & ~12) | ((x & 4) << 1) | ((x & 8) >> 1); }
__device__ __forceinline__ float half_max(float v) { auto rr = __builtin_amdgcn_permlane32_swap(__float_as_uint(v), __float_as_uint(v), false, false); return fmaxf(__uint_as_float(rr[0]), __uint_as_float(rr[1])); }
__device__ __forceinline__ float half_sum(float v) { auto rr = __builtin_amdgcn_permlane32_swap(__float_as_uint(v), __float_as_uint(v), false, false); return __uint_as_float(rr[0]) + __uint_as_float(rr[1]); }
__device__ __forceinline__ bf16x8 pack8(const f32x16& p, int o) {
    u32x4 w; w.x = cvt_pk_bf16(p[o + 0], p[o + 1]); w.y = cvt_pk_bf16(p[o + 2], p[o + 3]); w.z = cvt_pk_bf16(p[o + 4], p[o + 5]); w.w = cvt_pk_bf16(p[o + 6], p[o + 7]);
    return __builtin_bit_cast(bf16x8, w);
}
template <int NO>
__device__ __forceinline__ void softmax_step(f32x16& p0, f32x16& p1, float& m, float& lh, f32x16 (&o)[NO], bf16x8 (&pf)[4]) {
    float pm = fmaxf(p0[0], p1[0]);
#pragma unroll
    for (int r = 1; r < 16; ++r) pm = fmaxf(pm, fmaxf(p0[r], p1[r]));
    pm = half_max(pm);
    const float mn = fmaxf(m, pm), alpha = __builtin_amdgcn_exp2f(m - mn); m = mn;
    float rs = 0.f;
#pragma unroll
    for (int r = 0; r < 16; ++r) { p0[r] = __builtin_amdgcn_exp2f(p0[r] - mn); p1[r] = __builtin_amdgcn_exp2f(p1[r] - mn); rs += p0[r] + p1[r]; }
    lh = lh * alpha + rs;
    if (!__all(alpha == 1.0f)) {
#pragma unroll
        for (int d = 0; d < NO; ++d) o[d] = o[d] * alpha;
    }
    pf[0] = pack8(p0, 0); pf[1] = pack8(p0, 8); pf[2] = pack8(p1, 0); pf[3] = pack8(p1, 8);
}

template <int NO>
__device__ __forceinline__ void softmax_step1(f32x16& p0, float& m, float& lh, f32x16 (&o)[NO], bf16x8 (&pf)[2]) {
    float pm = p0[0];
#pragma unroll
    for (int r = 1; r < 16; ++r) pm = fmaxf(pm, p0[r]);
    pm = half_max(pm);
    const float mn = fmaxf(m, pm), alpha = __builtin_amdgcn_exp2f(m - mn); m = mn;
    float rs = 0.f;
#pragma unroll
    for (int r = 0; r < 16; ++r) { p0[r] = __builtin_amdgcn_exp2f(p0[r] - mn); rs += p0[r]; }
    lh = lh * alpha + rs;
    if (!__all(alpha == 1.0f)) {
#pragma unroll
        for (int d = 0; d < NO; ++d) o[d] = o[d] * alpha;
    }
    pf[0] = pack8(p0, 0); pf[1] = pack8(p0, 8);
}

namespace pat {
constexpr int KROW = 400, VROW = 144, KTILE = 64 * KROW, VTILE = 128 * VROW;
__device__ __forceinline__ void unit(LAS unsigned char* lds, const int wave, const bf16_t* Q, const bf16_t* KB, const bf16_t* KPE, const bf16_t* VT, bf16_t* O, int b, int h, int qb) {
    const int lane = lane_now(), tid = wave * 64 + lane, ql = lane & 31, hh = lane >> 5;
    const int q0 = b * SEQ + qb * 256 + 32 * wave;
    bf16x8 qf[12];
    { const bf16_t* qp = Q + (size_t)(q0 + ql) * (NH * QKD) + h * QKD + hh * 8;
#pragma unroll
      for (int ks = 0; ks < 12; ++ks) qf[ks] = *(const bf16x8*)(qp + ks * 16); }
    f32x16 o[4];
#pragma unroll
    for (int d = 0; d < 4; ++d)
#pragma unroll
        for (int r = 0; r < 16; ++r) o[d][r] = 0.f;
    float m = -1e30f, lh = 0.f;
    const int ntiles = 4 * (qb + 1);
    int krow[3], kcc[3]; unsigned koff[3];
#pragma unroll
    for (int i = 0; i < 3; ++i) { const int c = tid + 512 * i; krow[i] = c / 24; kcc[i] = c % 24; koff[i] = (unsigned)(krow[i] * KROW + kcc[i] * 16); }
    const bf16_t* kg = KB + (size_t)(b * SEQ) * (NH * NOPE) + h * NOPE;
    const bf16_t* kpg = KPE + (size_t)(b * SEQ) * ROPE;
    const bf16_t* vg = VT + (size_t)(h * VD) * MP + b * SEQ;
    const int vrow0 = tid >> 3, vcc = tid & 7;
    u32x4 kst[3], vst[2];
#define PAT_LOAD(j) do { _Pragma("unroll") for (int i = 0; i < 3; ++i) kst[i] = kcc[i] < 16 ? *(const u32x4*)(kg + (size_t)((j) * 64 + krow[i]) * (NH * NOPE) + kcc[i] * 8) : *(const u32x4*)(kpg + (size_t)((j) * 64 + krow[i]) * ROPE + (kcc[i] - 16) * 8); \
        _Pragma("unroll") for (int i = 0; i < 2; ++i) vst[i] = *(const u32x4*)(vg + (size_t)(vrow0 + 64 * i) * MP + (j) * 64 + vcc * 8); } while (0)
#define PAT_STORE(buf) do { _Pragma("unroll") for (int i = 0; i < 3; ++i) *(LAS u32x4*)(lds + (buf) * KTILE + koff[i]) = kst[i]; \
        _Pragma("unroll") for (int i = 0; i < 2; ++i) *(LAS u32x4*)(lds + 2 * KTILE + (buf) * VTILE + (vrow0 + 64 * i) * VROW + vcc * 16) = vst[i]; } while (0)
    PAT_LOAD(0); PAT_STORE(0);
    __syncthreads();
    const int kr = swap23(ql);
    for (int j = 0; j < ntiles; ++j) {
        const int buf = j & 1;
        if (j + 1 < ntiles) PAT_LOAD(j + 1);
        const int jd = j - 4 * qb;
        if (jd <= (wave >> 1)) {
            f32x16 p0, p1;
#pragma unroll
            for (int r = 0; r < 16; ++r) { p0[r] = 0.f; p1[r] = 0.f; }
            const LAS unsigned char* kb0 = lds + buf * KTILE + kr * KROW + hh * 16;
            __builtin_amdgcn_s_setprio(1);
#pragma unroll
            for (int ks = 0; ks < 12; ++ks) {
                const bf16x8 a0 = *(const LAS bf16x8*)(kb0 + ks * 32), a1 = *(const LAS bf16x8*)(kb0 + 32 * KROW + ks * 32);
                p0 = __builtin_amdgcn_mfma_f32_32x32x16_bf16(a0, qf[ks], p0, 0, 0, 0);
                p1 = __builtin_amdgcn_mfma_f32_32x32x16_bf16(a1, qf[ks], p1, 0, 0, 0);
            }
            __builtin_amdgcn_s_setprio(0);
            if (jd >= 0) {
                const int qrel = 32 * wave + ql - 64 * jd - 8 * hh;
#pragma unroll
                for (int r = 0; r < 16; ++r) { const int kk = 16 * (r >> 3) + (r & 7);
                    if (kk > qrel) p0[r] = -__builtin_inff();
                    if (kk + 32 > qrel) p1[r] = -__builtin_inff(); }
            }
            bf16x8 pf[4];
            softmax_step<4>(p0, p1, m, lh, o, pf);
            const LAS unsigned char* vb0 = lds + 2 * KTILE + buf * VTILE + ql * VROW + hh * 16;
#pragma unroll
            for (int d = 0; d < 4; ++d)
#pragma unroll
                for (int ss = 0; ss < 4; ++ss) {
                    const bf16x8 a = *(const LAS bf16x8*)(vb0 + d * 32 * VROW + ss * 32);
                    o[d] = __builtin_amdgcn_mfma_f32_32x32x16_bf16(a, pf[ss], o[d], 0, 0, 0);
                }
        }
        if (j + 1 < ntiles) PAT_STORE(buf ^ 1);
        __syncthreads();
    }
#undef PAT_LOAD
#undef PAT_STORE
    const float inv = 1.0f / half_sum(lh);
    bf16_t* op = O + (size_t)(q0 + ql) * DM + h * VD + 4 * hh;
#pragma unroll
    for (int d = 0; d < 4; ++d)
#pragma unroll
        for (int g = 0; g < 4; ++g) { u32x2 w; w.x = cvt_pk_bf16(o[d][4 * g] * inv, o[d][4 * g + 1] * inv); w.y = cvt_pk_bf16(o[d][4 * g + 2] * inv, o[d][4 * g + 3] * inv);
            *(u32x2*)(op + 32 * d + 8 * g) = w; }
}
}

namespace sat {
constexpr int KROW = 656, KTILE = 64 * KROW;
__device__ __forceinline__ bf16x8 tr_frag(const LAS unsigned char* p) {
    typedef short v4i16_t __attribute__((ext_vector_type(4)));
    const s16x4 a = __builtin_bit_cast(s16x4, __builtin_amdgcn_ds_read_tr16_b64_v4i16((LAS v4i16_t*)p));
    const s16x4 b = __builtin_bit_cast(s16x4, __builtin_amdgcn_ds_read_tr16_b64_v4i16((LAS v4i16_t*)(p + 4 * KROW)));
    bf16x8 r; r[0] = a[0]; r[1] = a[1]; r[2] = a[2]; r[3] = a[3]; r[4] = b[0]; r[5] = b[1]; r[6] = b[2]; r[7] = b[3]; return r;
}
__device__ __forceinline__ void unit(LAS unsigned char* lds, const int wave, const bf16_t* QLAT, const float* cache_ckv, const float* cache_kpe, const int* page_table, const bf16_t* CKVS  , const bf16_t* KPES,
                                     float* OPART, float* OML, int b, int split) {
    const int lane = lane_now(), tid = wave * 64 + lane, ql = lane & 31, hh = lane >> 5;
    const int qblk = wave & 1, kb = (wave >> 1) & 1, dvh = wave >> 2;
#pragma unroll
    for (int i = 0; i < 5; ++i) { const int c = tid + 512 * i, row = c / 40, cc = c % 40;
        *(LAS u32x4*)(lds + 2 * KTILE + row * KROW + cc * 16) = *(const u32x4*)(QLAT + (size_t)(b * 64 + row) * 320 + cc * 8); }
    f32x16 o[4];
#pragma unroll
    for (int d = 0; d < 4; ++d)
#pragma unroll
        for (int r = 0; r < 16; ++r) o[d][r] = 0.f;
    float m = -1e30f, lh = 0.f;
    const int npg = NPAGES / 2, ntiles = 2 * npg + (split == 1 ? 1 : 0);
    const int* pt = page_table + b * NPAGES + split * npg;
    const int crow0 = tid >> 6, ccol = tid & 63;
    const int prow0 = tid >> 4, pcol = tid & 15;
    f32x4 cst[8], pst[2];
#define SAT_LOAD(j) do { const int pg = pt[(j) >> 1]; const size_t r0 = (size_t)pg * PAGE + ((j) & 1) * 64; \
        _Pragma("unroll") for (int i = 0; i < 8; ++i) cst[i] = __builtin_nontemporal_load((const f32x4*)(cache_ckv + (r0 + crow0 + 8 * i) * KVL) + ccol); \
        _Pragma("unroll") for (int i = 0; i < 2; ++i) pst[i] = __builtin_nontemporal_load((const f32x4*)(cache_kpe + (r0 + prow0 + 32 * i) * ROPE) + pcol); } while (0)
#define SAT_STORE(buf) do { _Pragma("unroll") for (int i = 0; i < 8; ++i) { u32x2 w; w.x = cvt_pk_bf16(cst[i][0], cst[i][1]); w.y = cvt_pk_bf16(cst[i][2], cst[i][3]); \
            *(LAS u32x2*)(lds + (buf) * KTILE + (crow0 + 8 * i) * KROW + ccol * 8) = w; } \
        _Pragma("unroll") for (int i = 0; i < 2; ++i) { u32x2 w; w.x = cvt_pk_bf16(pst[i][0], pst[i][1]); w.y = cvt_pk_bf16(pst[i][2], pst[i][3]); \
            *(LAS u32x2*)(lds + (buf) * KTILE + (prow0 + 32 * i) * KROW + 512 + pcol * 8) = w; } } while (0)
#define SAT_NEW(buf) do { _Pragma("unroll") for (int i = 0; i < 5; ++i) { const int c = tid + 512 * i, row = c / 40, cc = c % 40; u32x4 v = (u32x4){0u, 0u, 0u, 0u}; \
            if (row < DECT) v = cc < 32 ? *(const u32x4*)(CKVS + (size_t)(b * DECT + row) * KVL + cc * 8) : *(const u32x4*)(KPES + (size_t)(b * DECT + row) * ROPE + (cc - 32) * 8); \
            *(LAS u32x4*)(lds + (buf) * KTILE + row * KROW + cc * 16) = v; } } while (0)
    SAT_LOAD(0); SAT_STORE(0);
    __syncthreads();
    const int kr = 32 * kb + swap23(ql);
    const int g16 = lane >> 4, i16 = lane & 15;
    const int troff = (32 * kb + 8 * (g16 >> 1) + (i16 >> 2)) * KROW + (128 * dvh + 16 * (g16 & 1) + 4 * (i16 & 3)) * 2;
    for (int j = 0; j < ntiles; ++j) {
        const int buf = j & 1;
        const bool nxt_page = (j + 1 < 2 * npg), nxt_new = (j + 1 == 2 * npg) && (split == 1);
        if (nxt_page) SAT_LOAD(j + 1);
        f32x16 p0;
#pragma unroll
        for (int r = 0; r < 16; ++r) p0[r] = 0.f;
        const LAS unsigned char* kb0 = lds + buf * KTILE + kr * KROW + hh * 16;
        const LAS unsigned char* qb0 = lds + 2 * KTILE + (32 * qblk + ql) * KROW + hh * 16;
        __builtin_amdgcn_s_setprio(1);
#pragma unroll
        for (int ks = 0; ks < 20; ++ks) p0 = __builtin_amdgcn_mfma_f32_32x32x16_bf16(*(const LAS bf16x8*)(kb0 + ks * 32), *(const LAS bf16x8*)(qb0 + ks * 32), p0, 0, 0, 0);
        __builtin_amdgcn_s_setprio(0);
        if (j == 2 * npg) {
            const int tq = (32 * qblk + ql) >> 3;
#pragma unroll
            for (int r = 0; r < 16; ++r) { const int kk = 32 * kb + 16 * (r >> 3) + 8 * hh + (r & 7); if (kk > tq) p0[r] = -__builtin_inff(); }
        }
        bf16x8 pf[2];
        softmax_step1<4>(p0, m, lh, o, pf);
        const LAS unsigned char* vb0 = lds + buf * KTILE + troff;
#pragma unroll
        for (int d = 0; d < 4; ++d)
#pragma unroll
            for (int ss = 0; ss < 2; ++ss) {
                const bf16x8 a = tr_frag(vb0 + d * 64 + ss * 16 * KROW);
                o[d] = __builtin_amdgcn_mfma_f32_32x32x16_bf16(a, pf[ss], o[d], 0, 0, 0);
            }
        if (nxt_page) SAT_STORE(buf ^ 1);
        if (nxt_new) SAT_NEW(buf ^ 1);
        __syncthreads();
    }
#undef SAT_LOAD
#undef SAT_STORE
#undef SAT_NEW
    float lt = half_sum(lh);
    const int pair = dvh * 2 + qblk;
    LAS float* xb = (LAS float*)(lds + pair * 17408);
    if (kb == 1) {
#pragma unroll
        for (int d = 0; d < 4; ++d)
#pragma unroll
            for (int r = 0; r < 16; ++r) xb[(d * 16 + r) * 64 + lane] = o[d][r];
        xb[64 * 64 + lane] = m; xb[65 * 64 + lane] = lt;
    }
    __syncthreads();
    if (kb == 0) {
        const float m1 = xb[64 * 64 + lane], l1 = xb[65 * 64 + lane];
        const float mm = fmaxf(m, m1), w0 = __builtin_amdgcn_exp2f(m - mm), w1 = __builtin_amdgcn_exp2f(m1 - mm);
#pragma unroll
        for (int d = 0; d < 4; ++d)
#pragma unroll
            for (int r = 0; r < 16; ++r) o[d][r] = o[d][r] * w0 + xb[(d * 16 + r) * 64 + lane] * w1;
        lt = lt * w0 + l1 * w1;
        const int q = 32 * qblk + ql;
        float* op = OPART + ((size_t)(b * 2 + split) * 64 + q) * KVL + 128 * dvh + 4 * hh;
#pragma unroll
        for (int d = 0; d < 4; ++d)
#pragma unroll
            for (int g = 0; g < 4; ++g) *(f32x4*)(op + 32 * d + 8 * g) = (f32x4){o[d][4 * g], o[d][4 * g + 1], o[d][4 * g + 2], o[d][4 * g + 3]};
        if (dvh == 0 && hh == 0) *(f32x2*)(OML + ((size_t)(b * 2 + split) * 64 + q) * 2) = (f32x2){mm, lt};
    }
    __syncthreads();
}
}


#define LDS_RD128(dst, addr, off) asm volatile("ds_read_b128 %0, %1 offset:%2" : "=v"(dst) : "v"(addr), "n"(off))
#define LDS_WAIT4(f, N) asm volatile("s_waitcnt lgkmcnt(" #N ")" : "+v"(f[0]), "+v"(f[1]), "+v"(f[2]), "+v"(f[3]))
namespace gla {
constexpr int QROW = 272, KTROW = 144, VROW = 528;
constexpr int P_T16 = 0, P_TOT = 4096, P_QT = 8192, P_KT = P_QT + 64 * QROW;
constexpr int C_DK = 0, C_QT = 1024, C_KH = C_QT + 64 * QROW, C_V = C_KH + 128 * KTROW, C_AT = C_V + 64 * VROW, C_O = C_AT + 6144;
static_assert(C_O + 64 * 8 * 64 <= RING_BYTES, "gla chain LDS");
static_assert(C_AT + 6144 <= RING_BYTES, "gla LDS");
__device__ __forceinline__ bf16x8 tr_frag(const LAS unsigned char* p) {
    typedef short v4i16_t __attribute__((ext_vector_type(4)));
    const s16x4 a = __builtin_bit_cast(s16x4, __builtin_amdgcn_ds_read_tr16_b64_v4i16((LAS v4i16_t*)p));
    const s16x4 b = __builtin_bit_cast(s16x4, __builtin_amdgcn_ds_read_tr16_b64_v4i16((LAS v4i16_t*)(p + 4 * VROW)));
    bf16x8 r; r[0] = a[0]; r[1] = a[1]; r[2] = a[2]; r[3] = a[3]; r[4] = b[0]; r[5] = b[1]; r[6] = b[2]; r[7] = b[3]; return r;
}
template <int SEG>
__device__ __forceinline__ void prep(LAS unsigned char* lds, const int wave, const bf16_t* QKVG, const float* T16, const float* w_gk2, const float* b_gk, int chunk, int h,
                                     bf16_t* QTg, bf16_t* KHg, bf16_t* ATg, float* DKg) {
    const int lane = lane_now(), tid = wave * 64 + lane, ql = lane & 31, hh = lane >> 5;
    const int kk = tid & 127, tq = tid >> 7, cu = chunk * 4 + h, row0 = chunk * 64;
    float w2[16];
#pragma unroll
    for (int j = 0; j < 16; ++j) w2[j] = w_gk2[j * (GH * GDK) + h * GDK + kk];
    const float bias = b_gk[h * GDK + kk];
    unsigned short qraw[16], kraw[16];
    { const bf16_t* qg = QKVG + (size_t)(row0 + tq * 16) * GIN + h * GDK + kk;
#pragma unroll
      for (int i = 0; i < 16; ++i) { qraw[i] = qg[(size_t)i * GIN]; kraw[i] = qg[(size_t)i * GIN + GH * GDK]; } }
    __syncthreads();
    if (tid < 256) *(LAS f32x4*)(lds + P_T16 + tid * 16) = *(const f32x4*)(T16 + (size_t)row0 * 16 + tid * 4);
    __syncthreads();
    float Gl[16];
    { float run = 0.f;
#pragma unroll
      for (int i = 0; i < 16; ++i) { const int t = tq * 16 + i; const LAS f32x4* tp = (const LAS f32x4*)(lds + P_T16 + t * 64);
          const f32x4 a0 = tp[0], a1 = tp[1], a2 = tp[2], a3 = tp[3];
          float z = bias;
          z += a0[0] * w2[0] + a0[1] * w2[1] + a0[2] * w2[2] + a0[3] * w2[3];
          z += a1[0] * w2[4] + a1[1] * w2[5] + a1[2] * w2[6] + a1[3] * w2[7];
          z += a2[0] * w2[8] + a2[1] * w2[9] + a2[2] * w2[10] + a2[3] * w2[11];
          z += a3[0] * w2[12] + a3[1] * w2[13] + a3[2] * w2[14] + a3[3] * w2[15];
          const float ls = fminf(z, 0.f) - 0.6931471805599453f * __builtin_amdgcn_logf(1.0f + __builtin_amdgcn_exp2f(-fabsf(z) * LOG2E));
          if (SEG == 8 && i == 8) run = 0.f;
          run += ls * (1.0f / 16.0f); Gl[i] = run; }
      if (SEG == 64) *(LAS float*)(lds + P_TOT + (tq * 128 + kk) * 4) = run; }
    float prefix = 0.f, total = 0.f;
    if (SEG == 64) {
        __syncthreads();
#pragma unroll
        for (int q = 0; q < 4; ++q) { const float v = *(const LAS float*)(lds + P_TOT + (q * 128 + kk) * 4); total += v; if (q < tq) prefix += v; }
    }
    { unsigned kh[8];
#pragma unroll
      for (int i = 0; i < 16; i += 2) {
          const float G0 = (Gl[i] + prefix) * LOG2E, G1 = (Gl[i + 1] + prefix) * LOG2E;
          const float TL = (SEG == 64 ? total : Gl[i | 7]) * LOG2E;
          const float q0 = bf2f(qraw[i]), q1 = bf2f(qraw[i + 1]), k0 = bf2f(kraw[i]), k1 = bf2f(kraw[i + 1]);
          const unsigned qq = cvt_pk_bf16(q0 * __builtin_amdgcn_exp2f(G0), q1 * __builtin_amdgcn_exp2f(G1));
          const unsigned kt = cvt_pk_bf16(k0 * __builtin_amdgcn_exp2f(-G0), k1 * __builtin_amdgcn_exp2f(-G1));
          kh[i >> 1] = cvt_pk_bf16(k0 * __builtin_amdgcn_exp2f(TL - G0), k1 * __builtin_amdgcn_exp2f(TL - G1));
          const int t = tq * 16 + i;
          *(LAS unsigned short*)(lds + P_QT + t * QROW + kk * 2) = (unsigned short)(qq & 0xffffu); *(LAS unsigned short*)(lds + P_QT + (t + 1) * QROW + kk * 2) = (unsigned short)(qq >> 16);
          *(LAS unsigned short*)(lds + P_KT + t * QROW + kk * 2) = (unsigned short)(kt & 0xffffu); *(LAS unsigned short*)(lds + P_KT + (t + 1) * QROW + kk * 2) = (unsigned short)(kt >> 16);
      }
      bf16_t* khp = KHg + ((size_t)cu * 128 + kk) * 64 + tq * 16;
      *(u32x4*)khp = (u32x4){kh[0], kh[1], kh[2], kh[3]}; *(u32x4*)(khp + 8) = (u32x4){kh[4], kh[5], kh[6], kh[7]};
      if (SEG == 64) { if (tq == 0) DKg[(size_t)cu * 1024 + kk] = __builtin_amdgcn_exp2f(total * LOG2E); }
      else { DKg[(size_t)cu * 1024 + (tq * 2) * 128 + kk] = __builtin_amdgcn_exp2f(Gl[7] * LOG2E); DKg[(size_t)cu * 1024 + (tq * 2 + 1) * 128 + kk] = __builtin_amdgcn_exp2f(Gl[15] * LOG2E); } }
    __syncthreads();
    if (wave < 3) {
        const int sb = wave >> 1, tb = (wave + 1) >> 1, kr = swap23(ql);
        f32x16 x;
#pragma unroll
        for (int r = 0; r < 16; ++r) x[r] = 0.f;
        const LAS unsigned char* ap = lds + P_KT + (32 * sb + kr) * QROW + hh * 16;
        const LAS unsigned char* bp = lds + P_QT + (32 * tb + ql) * QROW + hh * 16;
#pragma unroll
        for (int ks = 0; ks < 8; ++ks) x = __builtin_amdgcn_mfma_f32_32x32x16_bf16(*(const LAS bf16x8*)(ap + ks * 32), *(const LAS bf16x8*)(bp + ks * 32), x, 0, 0, 0);
        const int tt = 32 * tb + ql;
#pragma unroll
        for (int r = 0; r < 16; ++r) { const int sr = 32 * sb + 16 * (r >> 3) + 8 * hh + (r & 7); if (sr > tt || (SEG == 8 && (sr >> 3) != (tt >> 3))) x[r] = 0.f; }
        bf16_t* atp = ATg + (size_t)cu * 3072 + (wave * 2) * 512 + lane * 8;
        *(bf16x8*)atp = pack8(x, 0); *(bf16x8*)(atp + 512) = pack8(x, 8);
    }
#pragma unroll
    for (int i = 0; i < 2; ++i) { const int c = tid + 512 * i, row = c >> 4, cc = c & 15;
        *(u32x4*)(QTg + (size_t)(row0 + row) * (GH * GDK) + h * GDK + cc * 8) = *(const LAS u32x4*)(lds + P_QT + row * QROW + cc * 16); }
}

template <int NWV>
__device__ __forceinline__ void chain(LAS unsigned char* lds, const int wave, const bf16_t* QTg, const bf16_t* KHg, const bf16_t* ATg, const float* DKg, const bf16_t* QKVG, int h, int chunk0, int nchunk,
                                      int srow, int nrow, int sseg, int dseg, int dvbase, const float* state_in, float* state_out, bf16_t* GO) {
    constexpr int VPR = NWV * 4  , VST = NWV / 2  , VRS = 512 / VPR  ;
    const bool active = wave < NWV;
    const int lane = lane_now(), tid = wave * 64 + lane, ql = lane & 31, hh = lane >> 5;
    f32x16 S[4];
#pragma unroll
    for (int kb = 0; kb < 4; ++kb)
#pragma unroll
        for (int r = 0; r < 16; ++r) S[kb][r] = (state_in && active) ? state_in[(size_t)(32 * kb + 16 * (r >> 3) + 8 * hh + (r & 7)) * GDV + dvbase + 32 * wave + ql] : 0.f;
    const int qrow = tid >> 4, qcc = tid & 15;
    const int krow = tid >> 3, kcc = tid & 7;
    const int vrow0 = tid / VPR, vcc = tid % VPR;
    u32x4 qst[2], kst[2], vst[VST], ast, dst;
#define GLC_LOAD(c) do { const int ch = chunk0 + (c); const size_t cu = (size_t)ch * 4 + h; \
        _Pragma("unroll") for (int i = 0; i < 2; ++i) qst[i] = *(const u32x4*)(QTg + (size_t)(ch * 64 + qrow + 32 * i) * (GH * GDK) + h * GDK + qcc * 8); \
        _Pragma("unroll") for (int i = 0; i < 2; ++i) kst[i] = (sseg < 0 || kcc == sseg) ? *(const u32x4*)(KHg + (cu * 128 + krow + 64 * i) * 64 + kcc * 8) : (u32x4){0u, 0u, 0u, 0u}; \
        _Pragma("unroll") for (int i = 0; i < VST; ++i) { const int r = vrow0 + VRS * i; \
            vst[i] = (r >= srow && r < srow + nrow) ? *(const u32x4*)(QKVG + (size_t)(ch * 64 + r) * GIN + 2 * GH * GDK + h * GDV + dvbase + vcc * 8) : (u32x4){0u, 0u, 0u, 0u}; } \
        if (tid < 384) ast = *(const u32x4*)(ATg + cu * 3072 + tid * 8); \
        if (tid < 32) dst = *(const u32x4*)(DKg + cu * 1024 + dseg * 128 + tid * 4); } while (0)
    GLC_LOAD(0);
    const int g16 = lane >> 4, i16 = lane & 15;
    const int troff = (8 * (g16 >> 1) + (i16 >> 2)) * VROW + (32 * wave + 16 * (g16 & 1) + 4 * (i16 & 3)) * 2;
    const int kr = swap23(ql);
#define GLC_LDS_BAR() do { asm volatile("s_waitcnt lgkmcnt(0)" ::: "memory"); __builtin_amdgcn_s_barrier(); asm volatile("" ::: "memory"); } while (0)
#define GLC_FLUSH(cprev) do { if constexpr (NWV != 8) { int tl_ = tid; asm volatile("" : "+v"(tl_)); _Pragma("unroll") for (int i_ = 0; i_ < NWV / 2; ++i_) { const int c_ = tl_ + 512 * i_, row_ = c_ / (NWV * 4), cc_ = c_ % (NWV * 4); \
            *(u32x4*)(GO + (size_t)((chunk0 + (cprev)) * 64 + row_) * DM + h * GDV + dvbase + cc_ * 8) = *(const LAS u32x4*)(lds + C_O + row_ * (NWV * 64) + cc_ * 16); } } } while (0)
    for (int c = 0; c < nchunk; ++c) {
        GLC_LDS_BAR();
        if (c > 0) GLC_FLUSH(c - 1);
#pragma unroll
        for (int i = 0; i < 2; ++i) *(LAS u32x4*)(lds + C_QT + (qrow + 32 * i) * QROW + qcc * 16) = qst[i];
#pragma unroll
        for (int i = 0; i < 2; ++i) *(LAS u32x4*)(lds + C_KH + (krow + 64 * i) * KTROW + kcc * 16) = kst[i];
#pragma unroll
        for (int i = 0; i < VST; ++i) *(LAS u32x4*)(lds + C_V + (vrow0 + VRS * i) * VROW + vcc * 16) = vst[i];
        if (tid < 384) *(LAS u32x4*)(lds + C_AT + tid * 16) = ast;
        if (tid < 32) *(LAS u32x4*)(lds + C_DK + tid * 16) = dst;
        GLC_LDS_BAR();
        if (c + 1 < nchunk) GLC_LOAD(c + 1);
        if (active) {
        f32x16 o[2];
#pragma unroll
        for (int tb = 0; tb < 2; ++tb)
#pragma unroll
            for (int r = 0; r < 16; ++r) o[tb][r] = 0.f;
        const unsigned qa = (unsigned)(size_t)(lds + C_QT + ql * QROW + hh * 16), ka = (unsigned)(size_t)(lds + C_KH + kr * KTROW + hh * 16), ata = (unsigned)(size_t)(lds + C_AT + lane * 16);
        bf16x8 fa[4], fb[4];
#define GLC_QLD(f, kb) do { LDS_RD128(f[0], qa, (kb) * 64); LDS_RD128(f[1], qa, 32 * QROW + (kb) * 64); LDS_RD128(f[2], qa, (kb) * 64 + 32); LDS_RD128(f[3], qa, 32 * QROW + (kb) * 64 + 32); } while (0)
#define GLC_QMM(f, kb) do { const bf16x8 s0 = pack8(S[kb], 0), s1 = pack8(S[kb], 8); \
            o[0] = __builtin_amdgcn_mfma_f32_32x32x16_bf16(f[0], s0, o[0], 0, 0, 0); o[1] = __builtin_amdgcn_mfma_f32_32x32x16_bf16(f[1], s0, o[1], 0, 0, 0); \
            o[0] = __builtin_amdgcn_mfma_f32_32x32x16_bf16(f[2], s1, o[0], 0, 0, 0); o[1] = __builtin_amdgcn_mfma_f32_32x32x16_bf16(f[3], s1, o[1], 0, 0, 0); } while (0)
        GLC_QLD(fa, 0); GLC_QLD(fb, 1);
        LDS_WAIT4(fa, 4); GLC_QMM(fa, 0); GLC_QLD(fa, 2);
        LDS_WAIT4(fb, 4); GLC_QMM(fb, 1); GLC_QLD(fb, 3);
        LDS_WAIT4(fa, 4); GLC_QMM(fa, 2);
        LDS_RD128(fa[0], ata, 0 * 1024); LDS_RD128(fa[1], ata, 1 * 1024); LDS_RD128(fa[2], ata, 2 * 1024); LDS_RD128(fa[3], ata, 3 * 1024);
        LDS_WAIT4(fb, 4); GLC_QMM(fb, 3);
        LDS_RD128(fb[0], ata, 4 * 1024); LDS_RD128(fb[1], ata, 5 * 1024); LDS_RD128(fb[2], ka, 0); LDS_RD128(fb[3], ka, 32);
        bf16x8 vf[4];
#pragma unroll
        for (int ss = 0; ss < 4; ++ss) vf[ss] = tr_frag(lds + C_V + troff + ss * 16 * VROW);
        LDS_WAIT4(fa, 0); LDS_WAIT4(fb, 0);
        o[0] = __builtin_amdgcn_mfma_f32_32x32x16_bf16(fa[0], vf[0], o[0], 0, 0, 0);
        o[0] = __builtin_amdgcn_mfma_f32_32x32x16_bf16(fa[1], vf[1], o[0], 0, 0, 0);
        o[1] = __builtin_amdgcn_mfma_f32_32x32x16_bf16(fa[2], vf[0], o[1], 0, 0, 0);
        o[1] = __builtin_amdgcn_mfma_f32_32x32x16_bf16(fa[3], vf[1], o[1], 0, 0, 0);
        o[1] = __builtin_amdgcn_mfma_f32_32x32x16_bf16(fb[0], vf[2], o[1], 0, 0, 0);
        o[1] = __builtin_amdgcn_mfma_f32_32x32x16_bf16(fb[1], vf[3], o[1], 0, 0, 0);
#define GLC_KLD(f, kb) do { LDS_RD128(f[0], ka, (kb) * 32 * KTROW); LDS_RD128(f[1], ka, (kb) * 32 * KTROW + 32); LDS_RD128(f[2], ka, (kb) * 32 * KTROW + 64); LDS_RD128(f[3], ka, (kb) * 32 * KTROW + 96); } while (0)
#define GLC_SCALE(kb) do { _Pragma("unroll") for (int g = 0; g < 2; ++g) { const LAS f32x4* dp = (const LAS f32x4*)(lds + C_DK + (32 * (kb) + 16 * g + 8 * hh) * 4); const f32x4 d0 = dp[0], d1 = dp[1]; \
            S[kb][8 * g + 0] *= d0[0]; S[kb][8 * g + 1] *= d0[1]; S[kb][8 * g + 2] *= d0[2]; S[kb][8 * g + 3] *= d0[3]; \
            S[kb][8 * g + 4] *= d1[0]; S[kb][8 * g + 5] *= d1[1]; S[kb][8 * g + 6] *= d1[2]; S[kb][8 * g + 7] *= d1[3]; } } while (0)
#define GLC_KMM(f, kb) do { S[kb] = __builtin_amdgcn_mfma_f32_32x32x16_bf16(f[0], vf[0], S[kb], 0, 0, 0); S[kb] = __builtin_amdgcn_mfma_f32_32x32x16_bf16(f[1], vf[1], S[kb], 0, 0, 0); \
            S[kb] = __builtin_amdgcn_mfma_f32_32x32x16_bf16(f[2], vf[2], S[kb], 0, 0, 0); S[kb] = __builtin_amdgcn_mfma_f32_32x32x16_bf16(f[3], vf[3], S[kb], 0, 0, 0); } while (0)
        GLC_KLD(fa, 1);
        LDS_RD128(fb[0], ka, 64); LDS_RD128(fb[1], ka, 96);
        GLC_SCALE(0);
        LDS_WAIT4(fb, 0);
        S[0] = __builtin_amdgcn_mfma_f32_32x32x16_bf16(fb[2], vf[0], S[0], 0, 0, 0); S[0] = __builtin_amdgcn_mfma_f32_32x32x16_bf16(fb[3], vf[1], S[0], 0, 0, 0);
        S[0] = __builtin_amdgcn_mfma_f32_32x32x16_bf16(fb[0], vf[2], S[0], 0, 0, 0); S[0] = __builtin_amdgcn_mfma_f32_32x32x16_bf16(fb[1], vf[3], S[0], 0, 0, 0);
        GLC_KLD(fb, 2); GLC_SCALE(1);
        LDS_WAIT4(fa, 4); GLC_KMM(fa, 1); GLC_KLD(fa, 3); GLC_SCALE(2);
        LDS_WAIT4(fb, 4); GLC_KMM(fb, 2); GLC_SCALE(3);
        LDS_WAIT4(fa, 0); GLC_KMM(fa, 3);
#undef GLC_QLD
#undef GLC_QMM
#undef GLC_KLD
#undef GLC_SCALE
#undef GLC_KMM
        if constexpr (NWV != 8) {
            int qlx = ql, hhx = hh; asm volatile("" : "+v"(qlx), "+v"(hhx));
            LAS unsigned short* op_ = (LAS unsigned short*)(lds + C_O) + (4 * hhx) * (NWV * 32) + 32 * wave + qlx;
#pragma unroll
            for (int tb = 0; tb < 2; ++tb)
#pragma unroll
                for (int r = 0; r < 16; r += 2) { const unsigned w_ = cvt_pk_bf16(o[tb][r], o[tb][r + 1]);
                    const int t0_ = 32 * tb + (r & 3) + 8 * (r >> 2);
                    op_[t0_ * (NWV * 32)] = (unsigned short)(w_ & 0xffffu); op_[(t0_ + 1) * (NWV * 32)] = (unsigned short)(w_ >> 16); }
        } else {
          int qlx = ql, hhx = hh; asm volatile("" : "+v"(qlx), "+v"(hhx));
          bf16_t* gp = GO + (size_t)((chunk0 + c) * 64) * DM + h * GDV + dvbase + 32 * wave + qlx;
#pragma unroll
          for (int tb = 0; tb < 2; ++tb)
#pragma unroll
              for (int r = 0; r < 16; ++r) { const int t = 32 * tb + (r & 3) + 8 * (r >> 2) + 4 * hhx; if (t >= srow && t < srow + nrow) gp[(size_t)t * DM] = (bf16_t)(cvt_pk_bf16(o[tb][r], 0.f) & 0xffffu); } }
        }
    }
    if constexpr (NWV != 8) { GLC_LDS_BAR(); GLC_FLUSH(nchunk - 1); }
#undef GLC_FLUSH
#undef GLC_LOAD
#undef GLC_LDS_BAR
    if (active) { int qlx = ql, hhx = hh; asm volatile("" : "+v"(qlx), "+v"(hhx));
#pragma unroll
    for (int kb = 0; kb < 4; ++kb)
#pragma unroll
        for (int r = 0; r < 16; ++r) state_out[(size_t)(32 * kb + 16 * (r >> 3) + 8 * hhx + (r & 7)) * GDV + dvbase + 32 * wave + qlx] = S[kb][r]; }
    __syncthreads();
}
}

__global__ void __launch_bounds__(NWAVES * 64, 2) mk_fwd(Args args) {
    extern __shared__ __attribute__((aligned(16))) unsigned char lds_raw[];
    LAS unsigned char* lds = (LAS unsigned char*)lds_raw;
    volatile LAS unsigned* MISC = (volatile LAS unsigned*)(lds + MISC_OFF);
    const int wave = __builtin_amdgcn_readfirstlane(threadIdx.x >> 6);
    const int G = gridDim.x; const int bx = blockIdx.x; const int vcu = (G % 8 == 0) ? (bx % 8) * (G / 8) + bx / 8 : bx;
    const int gw = vcu * NWAVES + wave, NGW = G * NWAVES;
    unsigned char* ws = args.ws;
    unsigned* ctl = (unsigned*)(ws + WS_CTL);
    for (int u = wave * 64 + lane_now(); u < (LDS_BYTES - LDSCTL_OFF) / 4; u += NWAVES * 64) ((LAS unsigned*)(lds + LDSCTL_OFF))[u] = 0u;
    __syncthreads();
    XcdBarrier bar = xcd_barrier_post(ctl + 1024, MISC + 8, wave == 0 && lane_now() == 0);
#ifdef PROBE_A0
    unsigned long long* tsb = (unsigned long long*)(ws + WS_CTL + 32768);
    int n_ts = 0;
#define STAMP() do { if (bx == 0 && wave == 0 && lane_now() == 0) tsb[n_ts] = __builtin_amdgcn_s_memrealtime(); ++n_ts; } while (0)
#define GRID_BAR() do { xcd_barrier(bar, wave == 0 && lane_now() == 0); STAMP(); } while (0)
    STAMP();
#else
#define STAMP() do {} while (0)
#define GRID_BAR() xcd_barrier(bar, wave == 0 && lane_now() == 0)
#endif

    const float* x_prompt = (const float*)args.in[0]; const float* x_sample = (const float*)args.in[1];
    const float* cache_ckv = (const float*)args.in[2]; const float* cache_kpe = (const float*)args.in[3];
    const float* state_gla = (const float*)args.in[4]; const int* page_table = (const int*)args.in[5];
    const float* norm_g = (const float*)args.in[6]; const float* ffn_w_in = (const float*)args.in[7]; const float* ffn_w_out = (const float*)args.in[8];
    const float* mla_w_down = (const float*)args.in[9]; const float* mla_g_q = (const float*)args.in[10]; const float* mla_w_uq = (const float*)args.in[11];
    const float* mla_g_kv = (const float*)args.in[12]; const float* mla_w_uk = (const float*)args.in[13]; const float* mla_w_uv = (const float*)args.in[14];
    const float* mla_w_o = (const float*)args.in[15]; const float* gla_w_in = (const float*)args.in[16]; const float* gla_w_gk1 = (const float*)args.in[17];
    const float* gla_w_gk2 = (const float*)args.in[18]; const float* gla_b_gk = (const float*)args.in[19]; const float* gla_g_norm = (const float*)args.in[20];
    const float* gla_w_o = (const float*)args.in[21];
    float* out = args.out;
    float* ROPE_T = (float*)(ws + WS_ROPE);
    bf16_t* WIN = (bf16_t*)(ws + WS_WIN); bf16_t* WOUT = (bf16_t*)(ws + WS_WOUT); bf16_t* WDOWN = (bf16_t*)(ws + WS_WDOWN); bf16_t* WUQ = (bf16_t*)(ws + WS_WUQ);
    bf16_t* WUKT = (bf16_t*)(ws + WS_WUKT); bf16_t* WUK = (bf16_t*)(ws + WS_WUK); bf16_t* WUVT = (bf16_t*)(ws + WS_WUVT); bf16_t* WOT = (bf16_t*)(ws + WS_WOT);
    bf16_t* WGIN = (bf16_t*)(ws + WS_WGIN); bf16_t* WGO = (bf16_t*)(ws + WS_WGO);
    bf16_t* XN = (bf16_t*)(ws + WS_XN); bf16_t* HM = (bf16_t*)(ws + WS_HM); bf16_t* T = (bf16_t*)(ws + WS_T); bf16_t* H = (bf16_t*)(ws + WS_H); float* TP = (float*)(ws + WS_TP); bf16_t* D = (bf16_t*)(ws + WS_D);
    bf16_t* CQ = (bf16_t*)(ws + WS_CQ); bf16_t* CKV = (bf16_t*)(ws + WS_CKV); bf16_t* KPES = (bf16_t*)(ws + WS_KPES);
    bf16_t* KB = (bf16_t*)(ws + WS_KB); bf16_t* KPEP = (bf16_t*)(ws + WS_KPEP);
    float* Y = out + OUT_Y;
    const ConvPtrs cp{ffn_w_in, ffn_w_out, mla_w_down, mla_w_uq, mla_w_uk, mla_w_uv, mla_w_o, gla_w_in, gla_w_o, WIN, WOUT, WDOWN, WUQ, WUKT, WUVT, WOT, WGIN, WGO};

    {
        const int lane = lane_now(), tid = wave * 64 + lane; (void)tid;
        LAS float* scr = (LAS float*)(lds + wave * 16384);
        conv_segment<0>(cp, gw, NGW, scr, lane);
        const int gt = vcu * (NWAVES * 64) + tid, NGT = G * NWAVES * 64;
        for (int i = gt; i < KVL * NH * NOPE / 2; i += NGT) { const f32x2 v = ((const f32x2*)mla_w_uk)[i]; ((unsigned*)WUK)[i] = cvt_pk_bf16(v[0], v[1]); }
        for (int i = gt; i < (DDOWN_P - DDOWN) * DM / 2; i += NGT) ((unsigned*)(WDOWN + (size_t)DDOWN * DM))[i] = 0u;
        for (int i = gt; i < 128 * KVL / 2; i += NGT) ((unsigned*)(WUVT + (size_t)NH * VD * KVL))[i] = 0u;
        for (int i = gt; i < (GIN_P - GIN) * DM / 2; i += NGT) { const int row = (2 * i) / DM, k = (2 * i) % DM;
            unsigned w = 0u; if (row < GRANK) w = cvt_pk_bf16(gla_w_gk1[(size_t)k * GRANK + row], gla_w_gk1[(size_t)(k + 1) * GRANK + row]);
            ((unsigned*)(WGIN + (size_t)GIN * DM))[i] = w; }
        for (int i = gt; i < (SEQ + DECT) * 32; i += NGT) { const int p = i >> 5, fi = i & 31; const float pos = (float)(p < SEQ ? p : PAST + (p - SEQ));
            const float inv = (float)exp2(-(double)fi * (13.287712379549449 / 32.0));
            const float ang = pos * inv; double t = (double)ang * 0.15915494309189535; t -= rint(t); const float tf = (float)t;
            ((f32x2*)ROPE_T)[i] = (f32x2){__builtin_amdgcn_cosf(tf), __builtin_amdgcn_sinf(tf)}; }
        thin_phase<false, true, true, false>(gw, NGW, x_prompt, x_sample, nullptr, nullptr, 0, nullptr, nullptr, XN, nullptr, norm_g + 0 * DM, 1.f);
        GRID_BAR();
    }
    bf16_t* QKVG = (bf16_t*)(ws + WS_QKVG); float* T16 = (float*)(ws + WS_T16); bf16_t* GO = (bf16_t*)(ws + WS_GO);
    const int CONV_TAIL0 = ((M / 256) * (2 * DFF / 256)) % G;
#define FFN_GEMMS(slot) do { \
        { pg8::Gemm g{XN, WIN + (size_t)(slot) * 2 * DFF * DM, DM, DM, DM, 0, 0}; pg8::Order S{M / 256, 2 * DFF / 256, 1, G, bx}; \
          pg8::EpiSwiGLU E{HM, DFF}; \
          pg8::gemm_phase<pg8::EpiSwiGLU, true>(lds, wave, g, S, E); \
          if ((slot) < 3 && bx >= CONV_TAIL0) conv_segment<((slot) < 3 ? (slot) + 1 : 3)>(cp, (bx - CONV_TAIL0) * NWAVES + wave, (G - CONV_TAIL0) * NWAVES, (LAS float*)(lds + wave * 16384), lane_now()); \
          GRID_BAR(); } \
        { pg8::Gemm g{HM, WOUT + (size_t)(slot) * DM * DFF, DFF, DFF, DFF, 0, 0}; pg8::Order S{MP / 256, DM / 256, 1, G, bx};     \
          pg8::EpiBf16<0> E{T, DM, 0, 256, 1.f, 0}; \
          pg8::gemm_phase<pg8::EpiBf16<0>, true>(lds, wave, g, S, E); } \
        { pg8::Gemm g{HM + (size_t)MP * DFF, WOUT + (size_t)(slot) * DM * DFF, DFF, DFF, 256, 256, 256};     \
          pg8::EpiF32 E{TP, DM, (long)MS * DM};                                                                \
          unsigned* dctr = ctl + 16 + 64 * (6 + (slot)); \
          for (;;) { \
              if (wave == 0 && lane_now() == 0) MISC[12] = xb_add(dctr, 1u); \
              __syncthreads(); const int du = (int)MISC[12]; __syncthreads(); \
              if (du >= (MS / 256) * (DM / 256) * 11) break; \
              pg8::Order S{MS / 256, DM / 256, 11, 1 << 20, du}; \
              pg8::gemm_phase<pg8::EpiF32, true>(lds, wave, g, S, E); } \
          GRID_BAR(); } } while (0)
    { const float* ng = norm_g;
    FFN_GEMMS(0);
    thin_phase<true, true, true, false>(gw, NGW, x_prompt, x_sample, T, TP, 11, H, nullptr, XN, ng + 1 * DM, ng + 2 * DM, 0.5f); GRID_BAR();
        {
            pg8::Gemm g{XN, WDOWN, DM, DM, DM, 0, 0}; pg8::Order S{M / 256, DDOWN_P / 256, 1, G, bx};
            pg8::EpiBf16<0> E{D, DDOWN_P, 0, 256, 1.f, 0};
            pg8::gemm_phase<pg8::EpiBf16<0>, true>(lds, wave, g, S, E);
            GRID_BAR();
        }
        {
            const int lane = lane_now(), tid = wave * 64 + lane; (void)tid;
            f32x2 gq[3]; f32x4 gkv;
    #pragma unroll
            for (int j = 0; j < 3; ++j) gq[j] = *(const f32x2*)(mla_g_q + 2 * lane + 128 * j);
            gkv = *(const f32x4*)(mla_g_kv + 4 * lane);
            for (int r = gw; r < M; r += NGW) {
                const bf16_t* d = D + (size_t)r * DDOWN_P;
                f32x2 q[3];
    #pragma unroll
                for (int j = 0; j < 3; ++j) { const unsigned w = *(const unsigned*)(d + 2 * lane + 128 * j); q[j] = (f32x2){__uint_as_float(w << 16), __uint_as_float(w & 0xffff0000u)}; }
                const u32x2 kw = *(const u32x2*)(d + QL + 4 * lane);
                const f32x4 kv = (f32x4){__uint_as_float(kw.x << 16), __uint_as_float(kw.x & 0xffff0000u), __uint_as_float(kw.y << 16), __uint_as_float(kw.y & 0xffff0000u)};
                const float pe = bf2f(d[QL + KVL + lane]);
                float sq = 0.f;
    #pragma unroll
                for (int j = 0; j < 3; ++j) sq += q[j][0] * q[j][0] + q[j][1] * q[j][1];
                sq = wave_sum(sq);
                const float skv = wave_sum((kv[0] * kv[0] + kv[1] * kv[1]) + (kv[2] * kv[2] + kv[3] * kv[3]));
                const float rq = __builtin_amdgcn_rsqf(sq * (1.0f / QL) + EPS), rkv = __builtin_amdgcn_rsqf(skv * (1.0f / KVL) + EPS);
    #pragma unroll
                for (int j = 0; j < 3; ++j) *(unsigned*)(CQ + (size_t)r * QL + 2 * lane + 128 * j) = cvt_pk_bf16(q[j][0] * rq * gq[j][0], q[j][1] * rq * gq[j][1]);
                const f32x4 ckv = (kv * rkv) * gkv;
                float* ockv = r < MP ? out + OUT_CKV_P + (size_t)r * KVL : out + OUT_CKV_S + (size_t)(r - MP) * KVL;
                *(f32x4*)(ockv + 4 * lane) = ckv;
                u32x2 w; w.x = cvt_pk_bf16(ckv[0], ckv[1]); w.y = cvt_pk_bf16(ckv[2], ckv[3]);
                *(u32x2*)(CKV + (size_t)r * KVL + 4 * lane) = w;
                const float other = __shfl_xor(pe, 32);
                const f32x2 cs = ((const f32x2*)ROPE_T)[rope_pos_index(r) * 32 + (lane & 31)];
                const float ro = lane < 32 ? pe * cs[0] - other * cs[1] : pe * cs[0] + other * cs[1];
                float* okpe = r < MP ? out + OUT_KPE_P + (size_t)r * ROPE : out + OUT_KPE_S + (size_t)(r - MP) * ROPE;
                okpe[lane] = ro;
                const unsigned short rb = (unsigned short)(cvt_pk_bf16(ro, 0.f) & 0xffffu);
                if (r < MP) KPEP[(size_t)r * ROPE + lane] = rb; else KPES[(size_t)(r - MP) * ROPE + lane] = rb;
            }
            GRID_BAR();
        }

        bf16_t* Qb = (bf16_t*)(ws + WS_Q); bf16_t* VT = (bf16_t*)(ws + WS_VT); bf16_t* QLAT = (bf16_t*)(ws + WS_QLAT); bf16_t* Ob = (bf16_t*)(ws + WS_O);
        float* OPART = (float*)(ws + WS_OPART); float* OML = (float*)(ws + WS_OML); bf16_t* OLAT = (bf16_t*)(ws + WS_OLAT);
        const float QSCALE = 0.07216878364870322f * LOG2E;
        {
            pg8::Gemm g{CQ, WUQ, QL, QL, QL, 0, 0}; pg8::Order S{MP / 256, NH * QKD / 256, 1, G, bx};
            pg8::EpiQ E{Qb, ROPE_T, QSCALE};
            pg8::gemm_phase<pg8::EpiQ, true>(lds, wave, g, S, E);
            GRID_BAR();
        }
        {
            const int NQU = (MS / 256) * (NH * QKD / 256), NQP = NQU < G / 2 ? NQU : G / 2, NQC = 32 < G - NQP ? 32 : G - NQP;
            unsigned* qctr = ctl + 16 + 64 * 4;
            if (bx < NQP) {
                pg8::Gemm g{CQ, WUQ, QL, QL, QL, 0, 0}; pg8::OrderOff S{{MS / 256, NH * QKD / 256, 1, NQP, bx}, MP / 256};
                pg8::EpiQ E{Qb, ROPE_T, QSCALE};
                pg8::gemm_phase<pg8::EpiQ, true, pg8::OrderOff>(lds, wave, g, S, E);
                if (wave == 0 && lane_now() == 0) { __builtin_amdgcn_fence(__ATOMIC_RELEASE, "agent"); asm volatile("s_waitcnt vmcnt(0)" ::: "memory"); (void)xb_add(qctr, 1u); }
            }
            { pg8::Gemm g{CKV, WUKT, KVL, KVL, KVL, 0, 0}; pg8::Order S{MP / 256, NH * NOPE / 256, 1, G, bx};
              pg8::EpiBf16<0> E{KB, NH * NOPE, 0, 256, 1.f, 0};
              pg8::gemm_phase<pg8::EpiBf16<0>, true>(lds, wave, g, S, E); }
            { pg8::Gemm g{WUVT, CKV, KVL, KVL, KVL, 0, 0}; pg8::Order S{NH * VD / 256, MP / 256, 1, G, bx};
              pg8::EpiBf16<0> E{VT, MP, 0, 256, 1.f, 0};
              pg8::gemm_phase<pg8::EpiBf16<0>, true>(lds, wave, g, S, E); }
            if (bx >= G - NQC) {
                if (wave == 0 && lane_now() == 0) { XB_SPIN(xb_ld(qctr) < (unsigned)NQP, ctl + 1024); __builtin_amdgcn_fence(__ATOMIC_ACQUIRE, "agent"); asm volatile("s_waitcnt vmcnt(0)" ::: "memory"); }
                __syncthreads();
                { pg8::Gemm g{Qb + (size_t)MP * NH * QKD, WUK, NH * QKD, NH * NOPE, NOPE, QKD, NOPE}; pg8::Order S{MS / 256, 1, NH, NQC, bx - (G - NQC)};
                  pg8::EpiBf16<0> E{QLAT, NH * 320, 320, 256, 1.f, 0};
                  pg8::gemm_phase<pg8::EpiBf16<0>, true>(lds, wave, g, S, E); }
                const int lane = lane_now(), tid = wave * 64 + lane;
                for (int i = (bx - (G - NQC)) * (NWAVES * 64) + tid; i < MS * NH * 8; i += NQC * NWAVES * 64) { const int c = i & 7, th = i >> 3;
                    *(u32x4*)(QLAT + (size_t)th * 320 + 256 + c * 8) = *(const u32x4*)(Qb + (size_t)(MP + (th >> 3)) * (NH * QKD) + (th & 7) * QKD + NOPE + c * 8); }
            }
            GRID_BAR();
        }

        {
            for (int p = vcu; p < NB * NH * 4; p += G) { const int bh = p >> 2, x = p & 3;
                pat::unit(lds, wave, Qb, KB, KPEP, VT, Ob, bh >> 3, bh & 7, 7 - x);
                pat::unit(lds, wave, Qb, KB, KPEP, VT, Ob, bh >> 3, bh & 7, x); }
            STAMP();
            for (int u = bx; u < DECB * 2; u += G)
                sat::unit(lds, wave, QLAT, cache_ckv, cache_kpe, page_table, CKV + (size_t)MP * KVL, KPES, OPART, OML, u >> 1, u & 1);
            GRID_BAR();
        }
        {
            const int lane = lane_now(), tid = wave * 64 + lane; (void)tid;
            for (int r = gw; r < DECB * 64; r += NGW) { const int b = r >> 6, q = r & 63;
                const f32x2 ml0 = *(const f32x2*)(OML + ((size_t)(b * 2) * 64 + q) * 2), ml1 = *(const f32x2*)(OML + ((size_t)(b * 2 + 1) * 64 + q) * 2);
                const float mm = fmaxf(ml0[0], ml1[0]), w0 = __builtin_amdgcn_exp2f(ml0[0] - mm), w1 = __builtin_amdgcn_exp2f(ml1[0] - mm), inv = 1.0f / (ml0[1] * w0 + ml1[1] * w1);
                const f32x4 a = *(const f32x4*)(OPART + ((size_t)(b * 2) * 64 + q) * KVL + 4 * lane), c = *(const f32x4*)(OPART + ((size_t)(b * 2 + 1) * 64 + q) * KVL + 4 * lane);
                const f32x4 v = (a * w0 + c * w1) * inv;
                u32x2 w; w.x = cvt_pk_bf16(v[0], v[1]); w.y = cvt_pk_bf16(v[2], v[3]);
                *(u32x2*)(OLAT + (size_t)r * KVL + 4 * lane) = w; }
            GRID_BAR();
        }
        {
            pg8::Gemm g{OLAT, WUVT, NH * KVL, KVL, KVL, KVL, (long)VD * KVL}; pg8::Order S{MS / 256, 1, NH, G, bx};
            pg8::EpiBf16<0> E{Ob + (size_t)MP * DM, DM, VD, 128, 1.f, 0};
            pg8::gemm_phase<pg8::EpiBf16<0>, true>(lds, wave, g, S, E);
            GRID_BAR();
        }
        {
            { pg8::Gemm g{Ob, WOT, DM, DM, DM, 0, 0}; pg8::Order S{MP / 256, DM / 256, 1, G, bx};
              pg8::EpiBf16<0> E{T, DM, 0, 256, 1.f, 0};
              pg8::gemm_phase<pg8::EpiBf16<0>, true>(lds, wave, g, S, E); }
            { pg8::Gemm g{Ob + (size_t)MP * DM, WOT, DM, DM, 256, 256, 256}; pg8::Order S{MS / 256, DM / 256, 4, G, bx};
              pg8::EpiF32 E{TP, DM, (long)MS * DM};
              pg8::gemm_phase<pg8::EpiF32, true>(lds, wave, g, S, E); }
            GRID_BAR();
        }
        {
            thin_phase<true, true, false, false>(gw, NGW, nullptr, nullptr, T, TP, 4, H, nullptr, XN, norm_g + 3 * DM, norm_g + 4 * DM, 1.0f);
            GRID_BAR();
        }


    FFN_GEMMS(1);
    thin_phase<true, true, false, false>(gw, NGW, nullptr, nullptr, T, TP, 11, H, nullptr, XN, ng + 5 * DM, norm_g + 6 * DM, 0.5f); GRID_BAR();
    }
    { const float* ng = norm_g + 6 * DM;
    FFN_GEMMS(2);
    thin_phase<true, true, false, false>(gw, NGW, nullptr, nullptr, T, TP, 11, H, nullptr, XN, ng + 1 * DM, ng + 2 * DM, 0.5f); GRID_BAR();
            { pg8::Gemm g{XN, WGIN, DM, DM, DM, 0, 0}; pg8::Order S{M / 256, GIN_P / 256, 1, G, bx};
              pg8::EpiGla E{QKVG, T16, 0.08838834764831845f};
              pg8::gemm_phase<pg8::EpiGla, true>(lds, wave, g, S, E);
              GRID_BAR(); }
            bf16_t* GQT = (bf16_t*)(ws + WS_GQT); bf16_t* GKH = (bf16_t*)(ws + WS_GKH); bf16_t* GAT = (bf16_t*)(ws + WS_GAT); float* GDK_ = (float*)(ws + WS_GDK);
            { for (int u = bx; u < (M / 64) * GH; u += G) { const int chunk = u >> 2, h = u & 3;
                  if (chunk < MP / 64) gla::prep<64>(lds, wave, QKVG, T16, gla_w_gk2, gla_b_gk, chunk, h, GQT, GKH, GAT, GDK_);
                  else gla::prep<8>(lds, wave, QKVG, T16, gla_w_gk2, gla_b_gk, chunk, h, GQT, GKH, GAT, GDK_); }
              GRID_BAR(); }
            { const int NPB = (G >= 2 * NB * GH * 2) ? NB * GH * 2 : 0;
              if (NPB == 0 || vcu < NPB) {
                  for (int u = vcu; u < NB * GH * 2; u += (NPB ? NPB : G)) { const int bh = u >> 1, q = u & 1, b = bh >> 2, h = bh & 3;
                      gla::chain<4>(lds, wave, GQT, GKH, GAT, GDK_, QKVG, h, b * (SEQ / 64), SEQ / 64, 0, 64, -1, 0, 128 * q, nullptr, out + OUT_ST_P + (size_t)bh * GDK * GDV, GO); } }
              if (NPB == 0 || vcu >= NPB) {
                  for (int u = (NPB ? vcu - NPB : vcu); u < DECB * GH; u += (NPB ? G - NPB : G)) { const int b = u >> 2, h = u & 3;
                      gla::chain<8>(lds, wave, GQT, GKH, GAT, GDK_, QKVG, h, MP / 64 + (b >> 3), 1, 8 * (b & 7), 8, b & 7, b & 7, 0, state_gla + (size_t)u * GDK * GDV, out + OUT_ST_S + (size_t)u * GDK * GDV, GO); } }
              GRID_BAR(); }
            { const int lane = lane_now(), tid = wave * 64 + lane; (void)tid; const f32x4 gn = *(const f32x4*)(gla_g_norm + 4 * lane);
              for (int r = gw; r < M; r += NGW) {
                  Row16 o = ld_row_bf16(GO + (size_t)r * DM, lane);
                  const u32x2* gp = (const u32x2*)(QKVG + (size_t)r * GIN + 2 * GH * GDK + GH * GDV) + lane;
#pragma unroll
                  for (int j = 0; j < 4; ++j) { const u32x2 gw2 = gp[64 * j];
                      const float ss = wave_sum((o.v[j][0] * o.v[j][0] + o.v[j][1] * o.v[j][1]) + (o.v[j][2] * o.v[j][2] + o.v[j][3] * o.v[j][3]));
                      const float rs = __builtin_amdgcn_rsqf(ss * (1.0f / GDV) + EPS);
                      const float g0 = __uint_as_float(gw2.x << 16), g1 = __uint_as_float(gw2.x & 0xffff0000u), g2 = __uint_as_float(gw2.y << 16), g3 = __uint_as_float(gw2.y & 0xffff0000u);
                      o.v[j][0] = o.v[j][0] * rs * gn[0] * pg8::silu_f(g0); o.v[j][1] = o.v[j][1] * rs * gn[1] * pg8::silu_f(g1);
                      o.v[j][2] = o.v[j][2] * rs * gn[2] * pg8::silu_f(g2); o.v[j][3] = o.v[j][3] * rs * gn[3] * pg8::silu_f(g3); }
                  st_row_bf16(XN + (size_t)r * DM, o, lane); }
              GRID_BAR(); }
            { { pg8::Gemm g{XN, WGO, DM, DM, DM, 0, 0}; pg8::Order S{MP / 256, DM / 256, 1, G, bx};
                pg8::EpiBf16<0> E{T, DM, 0, 256, 1.f, 0};
                pg8::gemm_phase<pg8::EpiBf16<0>, true>(lds, wave, g, S, E); }
              { pg8::Gemm g{XN + (size_t)MP * DM, WGO, DM, DM, 256, 256, 256}; pg8::Order S{MS / 256, DM / 256, 4, G, bx};
                pg8::EpiF32 E{TP, DM, (long)MS * DM};
                pg8::gemm_phase<pg8::EpiF32, true>(lds, wave, g, S, E); }
              GRID_BAR(); }
            { thin_phase<true, true, false, false>(gw, NGW, nullptr, nullptr, T, TP, 4, H, nullptr, XN, ng + 3 * DM, ng + 4 * DM, 1.0f);
              GRID_BAR(); }

    FFN_GEMMS(3);
    thin_phase<true, false, false, true>(gw, NGW, nullptr, nullptr, T, TP, 11, H, Y, XN, ng + 5 * DM, nullptr, 0.5f);
    }
#ifdef PROBE_A0
    GRID_BAR();
    {
        const int lane = lane_now(), tid = wave * 64 + lane;
        const float ta = (float)(tsb[PROBE_A1] - tsb[PROBE_A0]) * 0.01f, tb = (float)(tsb[PROBE_B1] - tsb[PROBE_B0]) * 0.01f;
        if (bx == 0 && tid == 0) out[0] += ta * 0.1f;
        const float f = 1.0f + tb * (1.0f / PROBE_BDIV);
        for (int i = bx * (NWAVES * 64) + tid; i < MS * ROPE; i += G * NWAVES * 64) out[OUT_KPE_S + i] *= f;
    }
#endif
#ifdef DBG_SCALE_MASK
    GRID_BAR();
    {
        const int lane = lane_now(), tid = wave * 64 + lane; (void)tid;
        const size_t offs[9] = {OUT_Y, OUT_Y + (size_t)MP * DM, OUT_CKV_P, OUT_KPE_P, OUT_CKV_S, OUT_KPE_S, OUT_ST_P, OUT_ST_S, OUT_END};
        for (int o = 0; o < 8; ++o) if ((DBG_SCALE_MASK >> o) & 1)
            for (size_t i = offs[o] / 4 + (size_t)vcu * (NWAVES * 64) + tid; i < offs[o + 1] / 4; i += (size_t)G * NWAVES * 64) ((f32x4*)out)[i] = ((f32x4*)out)[i] * 3.0f;
    }
#endif
#undef GRID_BAR
}

extern "C" void kernel_launch(void* const* d_in, const int* in_sizes, int n_in, void* d_out, int out_size, void* d_ws, size_t ws_size, hipStream_t stream) {
    static int grid = 0;
    if (grid == 0) {
        if (n_in != 22 || (size_t)out_size != OUT_END || ws_size < WS_END) { fprintf(stderr, "kernel_launch: unexpected shapes: n_in %d out %d ws %zu (need %zu)\n", n_in, out_size, ws_size, (size_t)WS_END); grid = -1; return; }
        int dev = 0, cus = 0, per_cu = 0;
        if (hipGetDevice(&dev) != hipSuccess || hipDeviceGetAttribute(&cus, hipDeviceAttributeMultiprocessorCount, dev) != hipSuccess) { grid = -1; return; }
        if (hipFuncSetAttribute((const void*)mk_fwd, hipFuncAttributeMaxDynamicSharedMemorySize, LDS_BYTES) != hipSuccess) { fprintf(stderr, "kernel_launch: hipFuncSetAttribute failed\n"); grid = -1; return; }
        if (hipOccupancyMaxActiveBlocksPerMultiprocessor(&per_cu, (const void*)mk_fwd, NWAVES * 64, LDS_BYTES) != hipSuccess || per_cu < 1) { fprintf(stderr, "kernel_launch: occupancy query says %d\n", per_cu); }
        (void)hipGetLastError();
        grid = cus;
    }
    if (grid < 0) return;
    if (hipMemsetAsync((char*)d_ws + WS_CTL, 0, CTL_ZERO_BYTES, stream) != hipSuccess) return;
    Args a{};
    for (int i = 0; i < 22; ++i) a.in[i] = d_in[i];
    a.out = (float*)d_out; a.ws = (unsigned char*)d_ws; a.ph_lo = 0; a.ph_hi = 100;
    hipLaunchKernelGGL(mk_fwd, dim3(grid), dim3(NWAVES * 64), LDS_BYTES, stream, a);
}
```

```cpp
#include <hip/hip_runtime.h>
#include <cstdio>
#include <cstdint>


#define GAS __attribute__((address_space(1)))
#define LAS __attribute__((address_space(3)))
typedef unsigned short bf16_t;
typedef short bf16x8 __attribute__((ext_vector_type(8)));
typedef float f32x4 __attribute__((ext_vector_type(4)));
typedef float f32x2 __attribute__((ext_vector_type(2)));
typedef float f32x16 __attribute__((ext_vector_type(16)));
typedef unsigned u32x4 __attribute__((ext_vector_type(4)));
typedef unsigned u32x2 __attribute__((ext_vector_type(2)));

constexpr int DM = 1024, NB = 16, SEQ = 2048, DECB = 128, DECT = 8, PAST = 8192, PAGE = 128, NPAGES = PAST / PAGE;
constexpr int MP = NB * SEQ, MS = DECB * DECT, M = MP + MS;
constexpr int DFF = 2816;
constexpr int QL = 384, KVL = 256, NOPE = 128, ROPE = 64, VD = 128, NH = 8, QKD = NOPE + ROPE;
constexpr int DDOWN = QL + KVL + ROPE, DDOWN_P = 768;
constexpr int GH = 4, GDK = 128, GDV = 256, GRANK = 16, GIN = 2 * GH * GDK + 2 * GH * GDV, GIN_P = GIN + 256;
constexpr float EPS = 1e-6f;
constexpr float LOG2E = 1.4426950408889634f;
constexpr int NPOOL = (DECB * NPAGES * 5) / 4;

constexpr size_t OUT_Y = 0;
constexpr size_t OUT_CKV_P = (size_t)M * DM;
constexpr size_t OUT_KPE_P = OUT_CKV_P + (size_t)MP * KVL;
constexpr size_t OUT_CKV_S = OUT_KPE_P + (size_t)MP * ROPE;
constexpr size_t OUT_KPE_S = OUT_CKV_S + (size_t)MS * KVL;
constexpr size_t OUT_ST_P = OUT_KPE_S + (size_t)MS * ROPE;
constexpr size_t OUT_ST_S = OUT_ST_P + (size_t)NB * GH * GDK * GDV;
constexpr size_t OUT_END = OUT_ST_S + (size_t)DECB * GH * GDK * GDV;

constexpr size_t MiB = 1u << 20;
constexpr size_t al(size_t x) { return (x + 4095) & ~(size_t)4095; }
constexpr size_t WS_CTL = 0, CTL_ZERO_BYTES = 64 * 1024;
constexpr size_t WS_ROPE = 1 * MiB;
constexpr size_t WS_WIN = 2 * MiB;
constexpr size_t SZ_WIN1 = (size_t)2 * DFF * DM * 2;
constexpr size_t WS_WOUT = WS_WIN + 4 * SZ_WIN1;
constexpr size_t SZ_WOUT1 = (size_t)DM * DFF * 2;
constexpr size_t WS_WDOWN = WS_WOUT + 4 * SZ_WOUT1;
constexpr size_t WS_WUQ = WS_WDOWN + (size_t)DDOWN_P * DM * 2;
constexpr size_t WS_WUKT = WS_WUQ + (size_t)NH * QKD * QL * 2;
constexpr size_t WS_WUK = WS_WUKT + (size_t)NH * NOPE * KVL * 2;
constexpr size_t WS_WUVT = WS_WUK + (size_t)NH * NOPE * KVL * 2;
constexpr size_t WS_WOT = WS_WUVT + (size_t)(NH * VD + 128) * KVL * 2;
constexpr size_t WS_WGIN = WS_WOT + (size_t)DM * DM * 2;
constexpr size_t WS_WGO = WS_WGIN + (size_t)GIN_P * DM * 2;
constexpr size_t WS_ACT = al(WS_WGO + (size_t)DM * DM * 2);
constexpr size_t WS_XN = WS_ACT;
constexpr size_t WS_HM = al(WS_XN + (size_t)M * DM * 2);
constexpr size_t WS_T = al(WS_HM + (size_t)M * DFF * 2);
constexpr size_t WS_D = al(WS_T + (size_t)M * DM * 4);
constexpr size_t WS_CQ = al(WS_D + (size_t)M * DDOWN_P * 4);
constexpr size_t WS_CKV = al(WS_CQ + (size_t)M * QL * 2);
constexpr size_t WS_KPES = al(WS_CKV + (size_t)M * KVL * 2);
constexpr size_t WS_Q = al(WS_KPES + (size_t)MS * ROPE * 2);
constexpr size_t WS_KB = al(WS_Q + (size_t)M * NH * QKD * 2);
constexpr size_t WS_KPEP = al(WS_KB + (size_t)MP * NH * NOPE * 2);
constexpr size_t WS_VT = al(WS_KPEP + (size_t)MP * ROPE * 2);
constexpr size_t WS_QLAT = al(WS_VT + (size_t)NH * VD * MP * 2);
constexpr size_t WS_O = al(WS_QLAT + (size_t)MS * NH * 320 * 2);
constexpr size_t WS_OPART = al(WS_O + (size_t)M * DM * 2);
constexpr size_t WS_OML = al(WS_OPART + (size_t)DECB * 2 * 64 * 256 * 4);
constexpr size_t WS_OLAT = al(WS_OML + (size_t)DECB * 2 * 64 * 2 * 4);
constexpr size_t WS_QKVG = al(WS_OLAT + (size_t)MS * NH * KVL * 2);
constexpr size_t WS_T16 = al(WS_QKVG + (size_t)M * GIN * 2);
constexpr size_t WS_GO = al(WS_T16 + (size_t)M * 16 * 4);
constexpr size_t WS_H = al(WS_GO + (size_t)M * DM * 4);
constexpr size_t WS_TP = al(WS_H + (size_t)M * DM * 2);
constexpr size_t WS_GQT = al(WS_TP + (size_t)11 * MS * DM * 4);
constexpr size_t WS_GKH = al(WS_GQT + (size_t)M * GH * GDK * 2);
constexpr size_t WS_GAT = al(WS_GKH + (size_t)(M / 64) * GH * 128 * 64 * 2);
constexpr size_t WS_GDK = al(WS_GAT + (size_t)(M / 64) * GH * 3072 * 2);
constexpr size_t WS_END = al(WS_GDK + (size_t)(M / 64) * GH * 1024 * 4);

constexpr int RING_BYTES = 131072;
constexpr int LDSCTL_OFF = RING_BYTES, MISC_OFF = LDSCTL_OFF + 320;
constexpr int LDS_BYTES = 147456;
constexpr int NWAVES = 8;

#define LDS_WAIT() asm volatile("s_waitcnt lgkmcnt(0)" ::: "memory")
#define VM_WAIT() asm volatile("s_waitcnt vmcnt(0)" ::: "memory")
#define RLX_AGENT __ATOMIC_RELAXED, __HIP_MEMORY_SCOPE_AGENT

typedef __bf16 bf16x2_t __attribute__((ext_vector_type(2)));
__device__ __forceinline__ unsigned cvt_pk_bf16(float lo, float hi) { const f32x2 v = {lo, hi}; const bf16x2_t b = __builtin_convertvector(v, bf16x2_t); return __builtin_bit_cast(unsigned, b); }
__device__ __forceinline__ int lane_now() { int l; asm volatile("v_mbcnt_lo_u32_b32 %0, -1, 0\n\tv_mbcnt_hi_u32_b32 %0, -1, %0" : "=v"(l)); return l; }
__device__ __forceinline__ float bf2f(unsigned short b) { return __uint_as_float((unsigned)b << 16); }
template <int CTRL> __device__ __forceinline__ float dpp_mov(float v) { return __builtin_bit_cast(float, __builtin_amdgcn_update_dpp(0, __builtin_bit_cast(int, v), CTRL, 0xF, 0xF, true)); }
__device__ __forceinline__ float wave_sum(float v) {
    v += dpp_mov<0xB1>(v);
    v += dpp_mov<0x4E>(v);
    v += dpp_mov<0x141>(v);
    v += dpp_mov<0x140>(v);
    const int iv = __builtin_bit_cast(int, v);
    const float a = __builtin_bit_cast(float, __builtin_amdgcn_readlane(iv, 0)), b = __builtin_bit_cast(float, __builtin_amdgcn_readlane(iv, 16));
    const float c = __builtin_bit_cast(float, __builtin_amdgcn_readlane(iv, 32)), d = __builtin_bit_cast(float, __builtin_amdgcn_readlane(iv, 48));
    return (a + b) + (c + d);
}

namespace pg8 {
constexpr int BM = 256, BK = 64, HALF = 128, HTB = HALF * BK * 2, STAGE_BYTES = 8 * HTB, NXCD = 8, WGM = 8;
__host__ __device__ __forceinline__ int lds_byte(int r, int c) { const int st = (r >> 4) * 2 + (c >> 5), rr = r & 15, cc = c & 31, ob = rr * 64 + cc * 2; return st * 1024 + (ob ^ (((ob >> 9) & 1) << 5)); }
__host__ __device__ __forceinline__ void stage_rc(int b, int& R, int& C) { const int st = b / 1024, sb = b % 1024, swz = sb ^ (((sb >> 9) & 1) << 5); R = (st >> 1) * 16 + swz / 64; C = (st & 1) * 32 + (swz % 64) / 2; }
__host__ __device__ __forceinline__ int perm32(int rho) { const int n = rho >> 4, i = rho & 15; return 8 * (i >> 2) + 4 * n + (i & 3); }

struct Unit { int pm, pn, z; };
struct Gemm { const bf16_t* A; const bf16_t* Bt; int lda, ldb, K; long sAz, sBz; };

struct Order {
    int nM, nN, nZ, G, c;
    __device__ __forceinline__ bool next(int i, Unit& u) const {
        const long L = (long)i * G + c; const int per = nM * nN; if (L >= (long)per * nZ) return false;
        const int z = (int)(L / per); int wgid = (int)(L - (long)z * per);
        { const int q = per / NXCD, r = per % NXCD, xcd = wgid % NXCD, off = wgid / NXCD; wgid = (xcd < r ? xcd * (q + 1) : r * (q + 1) + (xcd - r) * q) + off; }
        const int nig = WGM * nN, gid = wgid / nig, fm = gid * WGM, gsz = (nM - fm) < WGM ? (nM - fm) : WGM;
        u.pm = fm + ((wgid % nig) % gsz); u.pn = (wgid % nig) / gsz; u.z = z; return true;
    }
};

struct OrderOff {
    Order o; int m0;
    __device__ __forceinline__ bool next(int i, Unit& u) const { const bool ok = o.next(i, u); u.pm += m0; return ok; }
};

template <class Epi, bool ALIGN_EPI, class Ord = Order>
__device__ __forceinline__ void gemm_phase(LAS unsigned char* lds, const int wid, const Gemm g, const Ord& S, const Epi& E) {
    const int lane = lane_now(), tid = wid * 64 + lane;
    const int wr = wid >> 2, wc = wid & 3, fr = lane & 15, fq = lane >> 4;
    const int K = g.K, nt = K / BK;
    unsigned voffA, voffB;
    { int R, C; stage_rc(tid * 16, R, C); const int Rb = Epi::PERM ? ((R & ~31) + perm32(R & 31)) : R;
      voffA = (unsigned)(R * g.lda + C) * 2u; voffB = (unsigned)(Rb * g.ldb + C) * 2u; }
    const size_t qsA = (size_t)64 * g.lda * 2, qsB = (size_t)64 * g.ldb * 2;
    const size_t kstep = (size_t)(BK * 2);
    const size_t hsA = (size_t)HALF * g.lda * 2, hsB = (size_t)HALF * g.ldb * 2;
    const unsigned ldsw = (unsigned)wid * 1024u;
    const int aoff = lds_byte(wr * 64 + fr, fq * 8), boff = lds_byte(wc * 32 + fr, fq * 8);
#define PG8_SA(b, h) (((b) * 2 + (h)) * HTB)
#define PG8_SB(b, h) ((4 + (b) * 2 + (h)) * HTB)
#define PG8_STAGE(bufoff, gbase, voff) do { _Pragma("unroll") for (int _i = 0; _i < 2; ++_i) \
        __builtin_amdgcn_global_load_lds((const unsigned*)((const char*)(gbase) + _i * PG8_QS_##voff + (voff)), (LAS unsigned*)(lds + (bufoff) + ldsw + _i * 8192), 16, 0, 0); } while (0)
#define PG8_QS_voffA qsA
#define PG8_QS_voffB qsB
#define PG8_LDA(dst, b, h) do { _Pragma("unroll") for (int m = 0; m < 4; ++m) _Pragma("unroll") for (int k = 0; k < 2; ++k) dst[m][k] = *(const LAS bf16x8*)(lds + PG8_SA(b, h) + aoff + m * 2048 + k * 1024); } while (0)
#define PG8_LDB(dst, b, h) do { _Pragma("unroll") for (int n = 0; n < 2; ++n) _Pragma("unroll") for (int k = 0; k < 2; ++k) dst[n][k] = *(const LAS bf16x8*)(lds + PG8_SB(b, h) + boff + n * 2048 + k * 1024); } while (0)
#define PG8_MMA(ai, bj, At, Bt) do { __builtin_amdgcn_s_setprio(1); _Pragma("unroll") for (int m = 0; m < 4; ++m) _Pragma("unroll") for (int n = 0; n < 2; ++n) _Pragma("unroll") for (int k = 0; k < 2; ++k) \
        acc[ai][bj][m][n] = __builtin_amdgcn_mfma_f32_16x16x32_bf16(Bt[n][k], At[m][k], acc[ai][bj][m][n], 0, 0, 0); __builtin_amdgcn_s_setprio(0); } while (0)
#define PG8_WAIT_V(n) asm volatile("s_waitcnt vmcnt(" #n ")" ::: "memory")
#define PG8_WAIT_L(n) asm volatile("s_waitcnt lgkmcnt(" #n ")" ::: "memory")
#define PG8_BAR __builtin_amdgcn_s_barrier()
#define PG8_SCHED __builtin_amdgcn_sched_barrier(0)
#define PG8_APTR(u) ((const char*)g.A + ((size_t)(u).z * g.sAz + (size_t)(u).pm * BM * g.lda) * 2)
#define PG8_BPTR(u) ((const char*)g.Bt + ((size_t)(u).z * g.sBz + (size_t)(u).pn * BM * g.ldb) * 2)
    Unit cur, nxt; int ui = 0;
    if (!S.next(0, cur)) return;
    f32x4 acc[2][2][4][2];
#pragma unroll
    for (int a = 0; a < 2; ++a)
#pragma unroll
        for (int b = 0; b < 2; ++b)
#pragma unroll
            for (int m = 0; m < 4; ++m)
#pragma unroll
                for (int n = 0; n < 2; ++n) acc[a][b][m][n] = (f32x4){0.f, 0.f, 0.f, 0.f};
    bf16x8 At[4][2], B0[2][2], B1[2][2];
    const char* cA = PG8_APTR(cur); const char* cB = PG8_BPTR(cur);
    PG8_STAGE(PG8_SB(0, 0), cB, voffB); PG8_STAGE(PG8_SB(0, 1), cB + hsB, voffB); PG8_STAGE(PG8_SA(0, 0), cA, voffA); PG8_STAGE(PG8_SA(0, 1), cA + hsA, voffA);
    if (wr == 1) PG8_BAR;
    PG8_WAIT_V(2); PG8_BAR;
    PG8_STAGE(PG8_SB(1, 0), cB + kstep, voffB); PG8_STAGE(PG8_SA(1, 0), cA + kstep, voffA); PG8_STAGE(PG8_SB(1, 1), cB + hsB + kstep, voffB);
    PG8_WAIT_V(6); PG8_BAR;
    for (;;) {
        const bool has_next = S.next(ui + 1, nxt);
        const char* nA = has_next ? PG8_APTR(nxt) : cA; const char* nB = has_next ? PG8_BPTR(nxt) : cB;
#pragma unroll 1
        for (int t = 0; t < nt; t += 2) {
            const bool last = (t == nt - 2);
            const char* a1 = cA + (size_t)(t + 1) * kstep;
            const char* a2 = last ? nA : cA + (size_t)(t + 2) * kstep; const char* b2 = last ? nB : cB + (size_t)(t + 2) * kstep;
            const char* a3 = a2 + kstep; const char* b3 = b2 + kstep;
            PG8_LDB(B0, 0, 0); PG8_LDB(B1, 0, 1); PG8_SCHED; PG8_LDA(At, 0, 0); PG8_STAGE(PG8_SA(1, 1), a1 + hsA, voffA);
            PG8_WAIT_V(8); PG8_WAIT_L(0); PG8_BAR; PG8_MMA(0, 0, At, B0); PG8_MMA(0, 1, At, B1); PG8_BAR; PG8_SCHED;
            PG8_LDA(At, 0, 1); PG8_STAGE(PG8_SB(0, 0), b2, voffB); PG8_STAGE(PG8_SB(0, 1), b2 + hsB, voffB); PG8_STAGE(PG8_SA(0, 0), a2, voffA);
            PG8_WAIT_V(8); PG8_WAIT_L(0); PG8_BAR; PG8_MMA(1, 0, At, B0); PG8_MMA(1, 1, At, B1); PG8_BAR; PG8_SCHED;
            PG8_LDB(B0, 1, 0); PG8_LDB(B1, 1, 1); PG8_SCHED; PG8_LDA(At, 1, 0); PG8_STAGE(PG8_SA(0, 1), a2 + hsA, voffA);
            PG8_WAIT_V(8); PG8_WAIT_L(0); PG8_BAR; PG8_MMA(0, 0, At, B0); PG8_MMA(0, 1, At, B1); PG8_BAR; PG8_SCHED;
            PG8_LDA(At, 1, 1); PG8_STAGE(PG8_SB(1, 0), b3, voffB); PG8_STAGE(PG8_SB(1, 1), b3 + hsB, voffB); PG8_STAGE(PG8_SA(1, 0), a3, voffA);
            PG8_WAIT_V(8); PG8_WAIT_L(0); PG8_BAR; PG8_MMA(1, 0, At, B0); PG8_MMA(1, 1, At, B1); PG8_BAR; PG8_SCHED;
        }
        if constexpr (ALIGN_EPI) { if (wr == 0) PG8_BAR; }
        { int fr2 = fr, fq2 = fq; asm volatile("" : "+v"(fr2), "+v"(fq2)); E(acc, cur, wr, wc, fr2, fq2); }
        if (!has_next) break;
#pragma unroll
        for (int a = 0; a < 2; ++a)
#pragma unroll
            for (int b = 0; b < 2; ++b)
#pragma unroll
                for (int m = 0; m < 4; ++m)
#pragma unroll
                    for (int n = 0; n < 2; ++n) acc[a][b][m][n] = (f32x4){0.f, 0.f, 0.f, 0.f};
        cur = nxt; cA = nA; cB = nB; ++ui;
        if constexpr (ALIGN_EPI) { if (wr == 1) PG8_BAR; }
    }
    PG8_WAIT_V(0);
    if constexpr (!ALIGN_EPI) { if (wr == 0) PG8_BAR; }
    PG8_BAR;
#undef PG8_SA
#undef PG8_SB
#undef PG8_STAGE
#undef PG8_QS_voffA
#undef PG8_QS_voffB
#undef PG8_LDA
#undef PG8_LDB
#undef PG8_MMA
#undef PG8_WAIT_V
#undef PG8_WAIT_L
#undef PG8_BAR
#undef PG8_SCHED
#undef PG8_APTR
#undef PG8_BPTR
}

__device__ __forceinline__ float silu_f(float g) { return g * __builtin_amdgcn_rcpf(1.0f + __builtin_amdgcn_exp2f(-g * LOG2E)); }

struct EpiSwiGLU {
    static constexpr bool PERM = true;
    bf16_t* O; int ldc;
    __device__ __forceinline__ void operator()(const f32x4 (&acc)[2][2][4][2], const Unit& u, int wr, int wc, int fr, int fq) const {
        const int row0 = u.pm * BM + wr * 64 + fr, col0 = u.pn * HALF + wc * 32 + 8 * fq;
#pragma unroll
        for (int ai = 0; ai < 2; ++ai)
#pragma unroll
            for (int m = 0; m < 4; ++m) {
                bf16_t* rowp = O + (size_t)(row0 + ai * HALF + m * 16) * ldc + col0;
                const f32x4 g0 = acc[ai][0][m][0], g1 = acc[ai][0][m][1], u0 = acc[ai][1][m][0], u1 = acc[ai][1][m][1];
                u32x4 w;
                w.x = cvt_pk_bf16(silu_f(g0[0]) * u0[0], silu_f(g0[1]) * u0[1]); w.y = cvt_pk_bf16(silu_f(g0[2]) * u0[2], silu_f(g0[3]) * u0[3]);
                w.z = cvt_pk_bf16(silu_f(g1[0]) * u1[0], silu_f(g1[1]) * u1[1]); w.w = cvt_pk_bf16(silu_f(g1[2]) * u1[2], silu_f(g1[3]) * u1[3]);
                *(u32x4*)rowp = w;
            }
    }
};
struct EpiF32 {
    static constexpr bool PERM = false;
    float* O; int ldc; long sOz;
    __device__ __forceinline__ void operator()(const f32x4 (&acc)[2][2][4][2], const Unit& u, int wr, int wc, int fr, int fq) const {
        const int row0 = u.pm * BM + wr * 64 + fr, col0 = u.pn * BM + wc * 32 + 4 * fq;
#pragma unroll
        for (int ai = 0; ai < 2; ++ai)
#pragma unroll
            for (int m = 0; m < 4; ++m) {
                float* rowp = O + (size_t)u.z * sOz + (size_t)(row0 + ai * HALF + m * 16) * ldc + col0;
#pragma unroll
                for (int bj = 0; bj < 2; ++bj)
#pragma unroll
                    for (int n = 0; n < 2; ++n) *(f32x4*)(rowp + bj * HALF + n * 16) = acc[ai][bj][m][n];
            }
    }
};

template <int CMAP> struct EpiBf16 {
    static constexpr bool PERM = true;
    bf16_t* O; int ldc; long sOz; int ncol; float scale; int scale_cols;
    __device__ __forceinline__ void operator()(const f32x4 (&acc)[2][2][4][2], const Unit& u, int wr, int wc, int fr, int fq) const {
        const int row0 = u.pm * BM + wr * 64 + fr;
#pragma unroll
        for (int bj = 0; bj < 2; ++bj) {
            const int ct = bj * HALF + wc * 32 + 8 * fq; if (ct >= ncol) continue;
            const int c0 = u.pn * BM + ct; const int oc = CMAP == 1 ? (c0 >> 7) * 192 + (c0 & 127) : c0;
            const float sc = c0 < scale_cols ? scale : 1.f;
            bf16_t* base = O + (size_t)u.z * sOz + oc;
#pragma unroll
            for (int ai = 0; ai < 2; ++ai)
#pragma unroll
                for (int m = 0; m < 4; ++m) { const f32x4 v0 = acc[ai][bj][m][0] * sc, v1 = acc[ai][bj][m][1] * sc;
                    u32x4 w; w.x = cvt_pk_bf16(v0[0], v0[1]); w.y = cvt_pk_bf16(v0[2], v0[3]); w.z = cvt_pk_bf16(v1[0], v1[1]); w.w = cvt_pk_bf16(v1[2], v1[3]);
                    *(u32x4*)(base + (size_t)(row0 + ai * HALF + m * 16) * ldc) = w; }
        }
    }
};
struct EpiQ {
    static constexpr bool PERM = true;
    bf16_t* O; const float* rope_t; float scale;
    __device__ __forceinline__ void operator()(const f32x4 (&acc)[2][2][4][2], const Unit& u, int wr, int wc, int fr, int fq) const {
        const int row0 = u.pm * BM + wr * 64 + fr;
#pragma unroll
        for (int bj = 0; bj < 2; ++bj) {
            const int c0 = u.pn * BM + bj * HALF + wc * 32 + 8 * fq; const int h = c0 / 192, f0 = c0 - h * 192;
            if (f0 < 128) {
#pragma unroll
                for (int ai = 0; ai < 2; ++ai)
#pragma unroll
                    for (int m = 0; m < 4; ++m) { const f32x4 v0 = acc[ai][bj][m][0] * scale, v1 = acc[ai][bj][m][1] * scale;
                        u32x4 w; w.x = cvt_pk_bf16(v0[0], v0[1]); w.y = cvt_pk_bf16(v0[2], v0[3]); w.z = cvt_pk_bf16(v1[0], v1[1]); w.w = cvt_pk_bf16(v1[2], v1[3]);
                        *(u32x4*)(O + (size_t)(row0 + ai * HALF + m * 16) * 1536 + c0) = w; }
            } else {
                const int a4 = ((f0 - 128) >> 3) * 4;
#pragma unroll
                for (int ai = 0; ai < 2; ++ai)
#pragma unroll
                    for (int m = 0; m < 4; ++m) { const int r = row0 + ai * HALF + m * 16; const int pidx = r < MP ? (r & (SEQ - 1)) : SEQ + ((r - MP) & (DECT - 1));
                        const f32x4 cs0 = *(const f32x4*)(rope_t + (size_t)(pidx * 32 + a4) * 2), cs1 = *(const f32x4*)(rope_t + (size_t)(pidx * 32 + a4) * 2 + 4);
                        const f32x4 x1 = acc[ai][bj][m][0] * scale, x2 = acc[ai][bj][m][1] * scale;
                        const float y10 = x1[0] * cs0[0] - x2[0] * cs0[1], y11 = x1[1] * cs0[2] - x2[1] * cs0[3], y12 = x1[2] * cs1[0] - x2[2] * cs1[1], y13 = x1[3] * cs1[2] - x2[3] * cs1[3];
                        const float y20 = x2[0] * cs0[0] + x1[0] * cs0[1], y21 = x2[1] * cs0[2] + x1[1] * cs0[3], y22 = x2[2] * cs1[0] + x1[2] * cs1[1], y23 = x2[3] * cs1[2] + x1[3] * cs1[3];
                        bf16_t* rowp = O + (size_t)r * 1536 + h * 192 + 128 + a4;
                        u32x2 w1, w2; w1.x = cvt_pk_bf16(y10, y11); w1.y = cvt_pk_bf16(y12, y13); w2.x = cvt_pk_bf16(y20, y21); w2.y = cvt_pk_bf16(y22, y23);
                        *(u32x2*)rowp = w1; *(u32x2*)(rowp + 32) = w2; asm volatile("" ::: "memory"); }
            }
        }
    }
};

struct EpiGla {
    static constexpr bool PERM = true;
    bf16_t* O; float* T16; float qscale;
    __device__ __forceinline__ void operator()(const f32x4 (&acc)[2][2][4][2], const Unit& u, int wr, int wc, int fr, int fq) const {
        const int row0 = u.pm * BM + wr * 64 + fr;
        if (u.pn < 12) {
#pragma unroll
            for (int bj = 0; bj < 2; ++bj) {
                const int c0 = u.pn * BM + bj * HALF + wc * 32 + 8 * fq; const float sc = c0 < 512 ? qscale : 1.f;
#pragma unroll
                for (int ai = 0; ai < 2; ++ai)
#pragma unroll
                    for (int m = 0; m < 4; ++m) { const f32x4 v0 = acc[ai][bj][m][0] * sc, v1 = acc[ai][bj][m][1] * sc;
                        u32x4 w; w.x = cvt_pk_bf16(v0[0], v0[1]); w.y = cvt_pk_bf16(v0[2], v0[3]); w.z = cvt_pk_bf16(v1[0], v1[1]); w.w = cvt_pk_bf16(v1[2], v1[3]);
                        *(u32x4*)(O + (size_t)(row0 + ai * HALF + m * 16) * GIN + c0) = w; }
            }
        } else if (wc == 0 && fq < 2) {
#pragma unroll
            for (int ai = 0; ai < 2; ++ai)
#pragma unroll
                for (int m = 0; m < 4; ++m) { float* tp = T16 + (size_t)(row0 + ai * HALF + m * 16) * 16 + 8 * fq;
                    *(f32x4*)tp = acc[ai][0][m][0]; *(f32x4*)(tp + 4) = acc[ai][0][m][1]; }
        }
    }
};
}

#define XB_TMO      128
#define XB_XCNT(j)  (256  + 64 * (j))
#define XB_XSUB(j)  (1280 + 64 * (j))
#define XB_XGEN(j)  (2304 + 64 * (j))
#define XB_TOP      3328
#define XB_TOPGEN   3392
#define XCD_BAR_WORDS 3456
#define XB_SPIN_CAP (1u << 18)

__device__ __forceinline__ unsigned xb_ld(unsigned* p)              { return __hip_atomic_load(p, __ATOMIC_RELAXED, __HIP_MEMORY_SCOPE_AGENT); }
__device__ __forceinline__ unsigned xb_add(unsigned* p, unsigned v) { return __hip_atomic_fetch_add(p, v, __ATOMIC_RELAXED, __HIP_MEMORY_SCOPE_AGENT); }
__device__ __forceinline__ unsigned xb_xcc_id() { return (unsigned)__builtin_amdgcn_s_getreg((3 << 11) | 20) & 0xFu; }
#define XB_SPIN(cond, bar) do { unsigned _sp = 0; while (cond) { __builtin_amdgcn_s_sleep(1); \
    if ((++_sp & 255u) == 0u) { if (xb_ld(&(bar)[XB_TMO])) break; if (_sp > XB_SPIN_CAP) { atomicAdd(&(bar)[XB_TMO], 1u); break; } } } } while (0)

struct XcdBarrier { unsigned* bar; unsigned x; volatile LAS unsigned* st; };

__device__ __forceinline__ XcdBarrier xcd_barrier_post(unsigned* bar, volatile LAS unsigned* st, bool t0) {
    XcdBarrier b; b.bar = bar; b.x = xb_xcc_id(); b.st = st;
    if (t0) (void)xb_add(&bar[XB_XCNT(b.x)], 1u);
    return b;
}
__device__ __forceinline__ void xcd_barrier_complete(unsigned* bar, unsigned x, unsigned& nloc, unsigned& nx) {
    const unsigned G = gridDim.x * gridDim.y * gridDim.z;
    unsigned sum, cnt, mine, sp = 0u;
    for (;;) {
        sum = 0u; cnt = 0u; mine = 0u;
#pragma unroll
        for (unsigned j = 0; j < 16; ++j) { const unsigned c = xb_ld(&bar[XB_XCNT(j)]); sum += c; cnt += (c > 0u) ? 1u : 0u; mine = (j == x) ? c : mine; }
        if (sum == G) break;
        __builtin_amdgcn_s_sleep(1);
        if ((++sp & 255u) == 0u) { if (xb_ld(&bar[XB_TMO])) break; if (sp > XB_SPIN_CAP) { atomicAdd(&bar[XB_TMO], 1u); break; } }
    }
    nloc = mine > 0u ? mine : 1u; nx = cnt > 0u ? cnt : 1u;
}
__device__ __forceinline__ void xcd_barrier(const XcdBarrier& b, bool t0) {
    asm volatile("s_waitcnt vmcnt(0)" ::: "memory");
    __syncthreads();
    if (t0) {
        unsigned* bar = b.bar;
        __builtin_amdgcn_s_waitcnt(0);
        unsigned nloc = b.st[0], nx = b.st[1];
        if (nloc == 0u) { xcd_barrier_complete(bar, b.x, nloc, nx); b.st[0] = nloc; b.st[1] = nx; }
        const unsigned old = xb_add(&bar[XB_XSUB(b.x)], 1u);
        const unsigned gen = old / nloc;
        if (old + 1u == (gen + 1u) * nloc) {
            __builtin_amdgcn_fence(__ATOMIC_RELEASE, "agent");
            asm volatile("s_waitcnt vmcnt(0)" ::: "memory");
            const unsigned og = xb_add(&bar[XB_TOP], 1u);
            const unsigned tg = og / nx;
            if (og + 1u == (tg + 1u) * nx) xb_add(&bar[XB_TOPGEN], 1u);
            else XB_SPIN(xb_ld(&bar[XB_TOPGEN]) == tg, bar);
            __builtin_amdgcn_fence(__ATOMIC_ACQUIRE, "agent");
            xb_add(&bar[XB_XGEN(b.x)], 1u);
            asm volatile("s_waitcnt vmcnt(0)" ::: "memory");
        } else {
            XB_SPIN(xb_ld(&bar[XB_XGEN(b.x)]) == gen, bar);
            __builtin_amdgcn_fence(__ATOMIC_ACQUIRE, "agent");
            asm volatile("s_waitcnt vmcnt(0)" ::: "memory");
        }
    }
    __syncthreads();
}

struct Args { const void* in[22]; float* out; unsigned char* ws; int ph_lo, ph_hi; };

struct Frame {
    LAS unsigned char* lds;
    int tid, lane, wave, vcu, G;
    const float* const* dummy;
};

__device__ __forceinline__ void transpose_item(const float* W, int N, int k0, int n0, bf16_t* WT, int KT, int drow0, int interleave, LAS float* scr, int lane) {
    f32x4 v[8];
    const float* src = W + (size_t)(k0 + (lane >> 3)) * N + n0 + 4 * (lane & 7);
#pragma unroll
    for (int i = 0; i < 8; ++i) v[i] = *(const f32x4*)(src + (size_t)(8 * i) * N);
#pragma unroll
    for (int i = 0; i < 8; ++i) { LAS float* d = scr + (8 * i + (lane >> 3)) * 33 + 4 * (lane & 7); d[0] = v[i][0]; d[1] = v[i][1]; d[2] = v[i][2]; d[3] = v[i][3]; }
    LDS_WAIT(); asm volatile("" ::: "memory");
    const int c = lane & 7;
#pragma unroll
    for (int j = 0; j < 4; ++j) { const int n = (lane >> 3) + 8 * j; const LAS float* s = scr + (8 * c) * 33 + n;
        u32x4 o; o.x = cvt_pk_bf16(s[0 * 33], s[1 * 33]); o.y = cvt_pk_bf16(s[2 * 33], s[3 * 33]); o.z = cvt_pk_bf16(s[4 * 33], s[5 * 33]); o.w = cvt_pk_bf16(s[6 * 33], s[7 * 33]);
        const int drow = interleave ? (drow0 + 8 * (n >> 2) + (n & 3)) : (drow0 + n);
        *(u32x4*)(WT + (size_t)drow * KT + k0 + 8 * c) = o; }
    LDS_WAIT(); asm volatile("" ::: "memory");
}

struct ConvPtrs { const float *w_in, *w_out, *w_down, *w_uq, *w_uk, *w_uv, *w_o, *g_in, *g_o; bf16_t *WIN, *WOUT, *WDOWN, *WUQ, *WUKT, *WUVT, *WOT, *WGIN, *WGO; };
constexpr int I_WIN = (DM / 64) * (2 * DFF / 32);
constexpr int I_WOUT = (DFF / 64) * (DM / 32);
constexpr int I_DOWN = (DM / 64) * (DDOWN / 32);
constexpr int I_UQ = (QL / 64) * (NH * QKD / 32);
constexpr int I_UK = (KVL / 64) * (NH * NOPE / 32);
constexpr int I_UV = I_UK;
constexpr int I_O = (DM / 64) * (DM / 32);
constexpr int I_GIN = (DM / 64) * (GIN / 32);
constexpr int I_GO = I_O;
template <int SEG> __device__ __forceinline__ void conv_segment(const ConvPtrs& P, int widx, int nw, LAS float* scr, int lane) {
    constexpr int mi = SEG;
    constexpr int NIT = I_WIN + I_WOUT + (SEG == 1 ? I_DOWN + I_UQ + I_UK + I_UV + I_O : SEG == 2 ? I_GIN + I_GO : 0);
    for (int it = widx; it < NIT; it += nw) {
        int r = it;
        if (r < I_WIN) { const int nblk = 2 * DFF / 32, kb = r / nblk, nb = r % nblk, n0 = nb * 32;
            const int drow0 = n0 < DFF ? 256 * (n0 / 128) + (n0 % 128) : 256 * ((n0 - DFF) / 128) + 128 + ((n0 - DFF) % 128);
            transpose_item(P.w_in + (size_t)mi * DM * 2 * DFF, 2 * DFF, kb * 64, n0, P.WIN + (size_t)mi * 2 * DFF * DM, DM, drow0, 0, scr, lane); continue; } r -= I_WIN;
        if (r < I_WOUT) { const int nblk = DM / 32, kb = r / nblk, nb = r % nblk;
            transpose_item(P.w_out + (size_t)mi * DFF * DM, DM, kb * 64, nb * 32, P.WOUT + (size_t)mi * DM * DFF, DFF, nb * 32, 0, scr, lane); continue; } r -= I_WOUT;
        if constexpr (SEG == 1) {
            if (r < I_DOWN) { const int nblk = DDOWN / 32, kb = r / nblk, nb = r % nblk;
                transpose_item(P.w_down, DDOWN, kb * 64, nb * 32, P.WDOWN, DM, nb * 32, 0, scr, lane); continue; } r -= I_DOWN;
            if (r < I_UQ) { const int nblk = NH * QKD / 32, kb = r / nblk, nb = r % nblk, n0 = nb * 32, h = n0 / QKD, f = n0 % QKD;
                if (f < NOPE) transpose_item(P.w_uq, NH * QKD, kb * 64, n0, P.WUQ, QL, n0, 0, scr, lane);
                else transpose_item(P.w_uq, NH * QKD, kb * 64, n0, P.WUQ, QL, h * QKD + NOPE + (f == NOPE ? 0 : 4), 1, scr, lane);
                continue; } r -= I_UQ;
            if (r < I_UK) { const int nblk = NH * NOPE / 32, kb = r / nblk, nb = r % nblk;
                transpose_item(P.w_uk, NH * NOPE, kb * 64, nb * 32, P.WUKT, KVL, nb * 32, 0, scr, lane); continue; } r -= I_UK;
            if (r < I_UV) { const int nblk = NH * VD / 32, kb = r / nblk, nb = r % nblk;
                transpose_item(P.w_uv, NH * VD, kb * 64, nb * 32, P.WUVT, KVL, nb * 32, 0, scr, lane); continue; } r -= I_UV;
            { const int nblk = DM / 32, kb = r / nblk, nb = r % nblk;
                transpose_item(P.w_o, DM, kb * 64, nb * 32, P.WOT, DM, nb * 32, 0, scr, lane); }
        }
        if constexpr (SEG == 2) {
            if (r < I_GIN) { const int nblk = GIN / 32, kb = r / nblk, nb = r % nblk;
                transpose_item(P.g_in, GIN, kb * 64, nb * 32, P.WGIN, DM, nb * 32, 0, scr, lane); continue; } r -= I_GIN;
            { const int nblk = DM / 32, kb = r / nblk, nb = r % nblk;
                transpose_item(P.g_o, DM, kb * 64, nb * 32, P.WGO, DM, nb * 32, 0, scr, lane); }
        }
    }
}

struct Row16 { f32x4 v[4]; };
__device__ __forceinline__ Row16 ld_row(const float* p, int lane) { Row16 r; const f32x4* q = (const f32x4*)p + lane;
#pragma unroll
    for (int j = 0; j < 4; ++j) r.v[j] = q[64 * j]; return r; }
__device__ __forceinline__ Row16 ld_row_bf16(const bf16_t* p, int lane) { Row16 r; const u32x2* q = (const u32x2*)p + lane;
#pragma unroll
    for (int j = 0; j < 4; ++j) { const u32x2 w = q[64 * j]; r.v[j][0] = __uint_as_float(w.x << 16); r.v[j][1] = __uint_as_float(w.x & 0xffff0000u); r.v[j][2] = __uint_as_float(w.y << 16); r.v[j][3] = __uint_as_float(w.y & 0xffff0000u); } return r; }
__device__ __forceinline__ float row_ss(const Row16& r) { float s = 0.f;
#pragma unroll
    for (int j = 0; j < 4; ++j) s += (r.v[j][0] * r.v[j][0] + r.v[j][1] * r.v[j][1]) + (r.v[j][2] * r.v[j][2] + r.v[j][3] * r.v[j][3]); return wave_sum(s); }
__device__ __forceinline__ void st_row_bf16(bf16_t* p, const Row16& r, int lane) { u32x2* q = (u32x2*)p + lane;
#pragma unroll
    for (int j = 0; j < 4; ++j) { u32x2 w; w.x = cvt_pk_bf16(r.v[j][0], r.v[j][1]); w.y = cvt_pk_bf16(r.v[j][2], r.v[j][3]); q[64 * j] = w; } }
__device__ __forceinline__ void st_row_f32(float* p, const Row16& r, int lane) { f32x4* q = (f32x4*)p + lane;
#pragma unroll
    for (int j = 0; j < 4; ++j) q[64 * j] = r.v[j]; }

template <bool HAS_T, bool HAS_PRE, bool SRC_X, bool FINAL>
__device__ __forceinline__ void thin_phase(int gw, int NGW, const float* xp, const float* xs, const bf16_t* T, const float* TP, int nsplit, bf16_t* H, float* Yout, bf16_t* XN, const float* gpost, const float* gpre, float scale) {
    const int lane = lane_now();
    Row16 gp, gq;
    if (HAS_T) gp = ld_row(gpost, lane);
    if (HAS_PRE) gq = ld_row(gpre, lane);
    for (int r = gw; r < M; r += NGW) {
        Row16 h;
        if constexpr (SRC_X) h = ld_row(r < MP ? xp + (size_t)r * DM : xs + (size_t)(r - MP) * DM, lane); else h = ld_row_bf16(H + (size_t)r * DM, lane);
        if (HAS_T) {
            Row16 t;
            if (r < MP) t = ld_row_bf16(T + (size_t)r * DM, lane);
            else { t = ld_row(TP + (size_t)(r - MP) * DM, lane);
                for (int z = 1; z < nsplit; ++z) { const Row16 u = ld_row(TP + ((size_t)z * MS + (r - MP)) * DM, lane);
#pragma unroll
                    for (int j = 0; j < 4; ++j) t.v[j] = t.v[j] + u.v[j]; } }
            const float rs = scale * __builtin_amdgcn_rsqf(row_ss(t) * (1.0f / DM) + EPS);
#pragma unroll
            for (int j = 0; j < 4; ++j) h.v[j] = h.v[j] + (t.v[j] * rs) * gp.v[j];
            if constexpr (FINAL) st_row_f32(Yout + (size_t)r * DM, h, lane); else st_row_bf16(H + (size_t)r * DM, h, lane);
        }
        if (HAS_PRE) {
            const float rs = __builtin_amdgcn_rsqf(row_ss(h) * (1.0f / DM) + EPS);
#pragma unroll
            for (int j = 0; j < 4; ++j) h.v[j] = (h.v[j] * rs) * gq.v[j];
            st_row_bf16(XN + (size_t)r * DM, h, lane);
        }
    }
}

__device__ __forceinline__ int rope_pos_index(int r) { return r < MP ? (r & (SEQ - 1)) : SEQ + ((r - MP) & (DECT - 1)); }


typedef short s16x4 __attribute__((ext_vector_type(4)));
__device__ __forceinline__ int swap23(int x) { return (x & ~12) | ((x & 4) << 1) | ((x & 8) >> 1); }
__device__ __forceinline__ float half_max(float v) { auto rr = __builtin_amdgcn_permlane32_swap(__float_as_uint(v), __float_as_uint(v), false, false); return fmaxf(__uint_as_float(rr[0]), __uint_as_float(rr[1])); }
__device__ __forceinline__ float half_sum(float v) { auto rr = __builtin_amdgcn_permlane32_swap(__float_as_uint(v), __float_as_uint(v), false, false); return __uint_as_float(rr[0]) + __uint_as_float(rr[1]); }
__device__ __forceinline__ bf16x8 pack8(const f32x16& p, int o) {
    u32x4 w; w.x = cvt_pk_bf16(p[o + 0], p[o + 1]); w.y = cvt_pk_bf16(p[o + 2], p[o + 3]); w.z = cvt_pk_bf16(p[o + 4], p[o + 5]); w.w = cvt_pk_bf16(p[o + 6], p[o + 7]);
    return __builtin_bit_cast(bf16x8, w);
}
template <int NO>
__device__ __forceinline__ void softmax_step(f32x16& p0, f32x16& p1, float& m, float& lh, f32x16 (&o)[NO], bf16x8 (&pf)[4]) {
    float pm = fmaxf(p0[0], p1[0]);
#pragma unroll
    for (int r = 1; r < 16; ++r) pm = fmaxf(pm, fmaxf(p0[r], p1[r]));
    pm = half_max(pm);
    const float mn = fmaxf(m, pm), alpha = __builtin_amdgcn_exp2f(m - mn); m = mn;
    float rs = 0.f;
#pragma unroll
    for (int r = 0; r < 16; ++r) { p0[r] = __builtin_amdgcn_exp2f(p0[r] - mn); p1[r] = __builtin_amdgcn_exp2f(p1[r] - mn); rs += p0[r] + p1[r]; }
    lh = lh * alpha + rs;
    if (!__all(alpha == 1.0f)) {
#pragma unroll
        for (int d = 0; d < NO; ++d) o[d] = o[d] * alpha;
    }
    pf[0] = pack8(p0, 0); pf[1] = pack8(p0, 8); pf[2] = pack8(p1, 0); pf[3] = pack8(p1, 8);
}

template <int NO>
__device__ __forceinline__ void softmax_step1(f32x16& p0, float& m, float& lh, f32x16 (&o)[NO], bf16x8 (&pf)[2]) {
    float pm = p0[0];
#pragma unroll
    for (int r = 1; r < 16; ++r) pm = fmaxf(pm, p0[r]);
    pm = half_max(pm);
    const float mn = fmaxf(m, pm), alpha = __builtin_amdgcn_exp2f(m - mn); m = mn;
    float rs = 0.f;
#pragma unroll
    for (int r = 0; r < 16; ++r) { p0[r] = __builtin_amdgcn_exp2f(p0[r] - mn); rs += p0[r]; }
    lh = lh * alpha + rs;
    if (!__all(alpha == 1.0f)) {
#pragma unroll
        for (int d = 0; d < NO; ++d) o[d] = o[d] * alpha;
    }
    pf[0] = pack8(p0, 0); pf[1] = pack8(p0, 8);
}

namespace pat {
constexpr int KROW = 400, VROW = 144, KTILE = 64 * KROW, VTILE = 128 * VROW, VBASE = 3 * KTILE;
static_assert(VBASE + 2 * VTILE <= RING_BYTES, "pat LDS");
__device__ __forceinline__ void softmax1_nb(f32x16& p0, float& m, float& lh, f32x16 (&o)[4], bf16x8 (&pf)[2]) {
    float pm = p0[0];
#pragma unroll
    for (int r = 1; r < 16; ++r) pm = fmaxf(pm, p0[r]);
    pm = half_max(pm);
    const float mn = fmaxf(m, pm), alpha = __builtin_amdgcn_exp2f(m - mn); m = mn;
    float rs = 0.f;
#pragma unroll
    for (int r = 0; r < 16; ++r) { p0[r] = __builtin_amdgcn_exp2f(p0[r] - mn); rs += p0[r]; }
    lh = lh * alpha + rs;
    pf[0] = pack8(p0, 0); pf[1] = pack8(p0, 8);
    if (!__all(alpha == 1.0f)) {
#pragma unroll
        for (int d = 0; d < 4; ++d) o[d] = o[d] * alpha;
    }
}
__device__ __forceinline__ void unit(LAS unsigned char* lds, const int wave, const bf16_t* Q, const bf16_t* KB, const bf16_t* KPE, const bf16_t* VT, bf16_t* O, int b, int h, int qb) {
    const int q0 = b * SEQ + qb * 256 + 32 * wave;
    asm volatile("" : "+s"(Q), "+s"(O));
    bf16x8 qf[12];
    unsigned kaddr, vaddr;
    { const int lane = lane_now(), ql = lane & 31, hh = lane >> 5; kaddr = (unsigned)(swap23(ql) * KROW + hh * 16); vaddr = (unsigned)(ql * VROW + hh * 16);
      const bf16_t* qp = Q + (size_t)(q0 + ql) * (NH * QKD) + h * QKD + hh * 8;
#pragma unroll
      for (int ks = 0; ks < 12; ++ks) qf[ks] = *(const bf16x8*)(qp + ks * 16); }
    f32x16 o[4];
#pragma unroll
    for (int d = 0; d < 4; ++d)
#pragma unroll
        for (int r = 0; r < 16; ++r) o[d][r] = 0.f;
    float m = -1e30f, lh = 0.f;
    const int ntiles = 4 * (qb + 1);
    const bf16_t* kg = KB + (size_t)(b * SEQ) * (NH * NOPE) + h * NOPE;
    const bf16_t* kpg = KPE + (size_t)(b * SEQ) * ROPE;
    const bf16_t* vg = VT + (size_t)(h * VD) * MP + b * SEQ;
    unsigned kgo[4], vgo[3]; bool kpe_[4];
    const int tid = wave * 64 + lane_now();
#pragma unroll
    for (int i = 0; i < 4; ++i) { const int c = tid + 512 * i, row = c / 25, cc = c % 25; kpe_[i] = cc >= 16 && cc < 24;
        kgo[i] = kpe_[i] ? (unsigned)(row * (ROPE * 2) + (cc - 16) * 16) : (unsigned)(row * (NH * NOPE * 2) + (cc < 16 ? cc : 0) * 16); }
#pragma unroll
    for (int i = 0; i < 3; ++i) { const int c = tid + 512 * i, row = c / 9, cc = c % 9; vgo[i] = (unsigned)row * (unsigned)(MP * 2) + (unsigned)((cc < 8 ? cc : 0) * 16); }
#define PAT_DMAK(j, koff) do { const char* kb_ = (const char*)kg + (size_t)(j) * (64 * NH * NOPE * 2); const char* kp_ = (const char*)kpg + (size_t)(j) * (64 * ROPE * 2); \
        _Pragma("unroll") for (int i = 0; i < 4; ++i) if (i < 3 || wave == 0) { unsigned o_ = kgo[i]; asm volatile("" : "+v"(o_));     \
            __builtin_amdgcn_global_load_lds((const unsigned*)((kpe_[i] ? kp_ : kb_) + o_), (LAS unsigned*)(lds + (koff) + (wave * 64 + 512 * i) * 16), 16, 0, 0); } } while (0)
#define PAT_DMAV(j, voff) do { const char* vb_ = (const char*)vg + (size_t)(j) * 128; \
        _Pragma("unroll") for (int i = 0; i < 3; ++i) if (i < 2 || wave < 2) { unsigned o_ = vgo[i]; asm volatile("" : "+v"(o_)); \
            __builtin_amdgcn_global_load_lds((const unsigned*)(vb_ + o_), (LAS unsigned*)(lds + VBASE + (voff) + (wave * 64 + 512 * i) * 16), 16, 0, 0); } } while (0)
#define PAT_QK1(P, khoff) do { const LAS unsigned char* kb0_ = lds + (khoff) + kaddr; \
        _Pragma("unroll") for (int r = 0; r < 16; ++r) P[r] = 0.f; \
        _Pragma("unroll") for (int ks = 0; ks < 12; ++ks) P = __builtin_amdgcn_mfma_f32_32x32x16_bf16(*(const LAS bf16x8*)(kb0_ + ks * 32), qf[ks], P, 0, 0, 0); } while (0)
#define PAT_PV1(vhoff) do { const LAS unsigned char* vb0_ = lds + VBASE + (vhoff) + vaddr; \
        _Pragma("unroll") for (int ss = 0; ss < 2; ++ss) _Pragma("unroll") for (int d = 0; d < 4; ++d) \
            o[d] = __builtin_amdgcn_mfma_f32_32x32x16_bf16(*(const LAS bf16x8*)(vb0_ + d * 32 * VROW + ss * 32), pf[ss], o[d], 0, 0, 0); } while (0)
#define PAT_HSTEP(C, N, hh_, khoff, vhoff, hasn) do { \
        const int hd_ = (hh_) - 8 * qb;                      \
        const bool attc_ = hd_ <= wave, attn_ = (hasn) && (hd_ + 1 <= wave); \
        if (hd_ == wave) {                                   \
            const int ln_ = lane_now(), qrel_ = (ln_ & 31) - 8 * (ln_ >> 5); \
            _Pragma("unroll") for (int r = 0; r < 16; ++r) { const int kk = 16 * (r >> 3) + (r & 7); if (kk > qrel_) C[r] = -__builtin_inff(); } } \
        if (attn_) { bf16x8 pf[2]; \
            __builtin_amdgcn_s_setprio(1); \
            PAT_QK1(N, khoff); \
            softmax1_nb(C, m, lh, o, pf); \
            PAT_PV1(vhoff); \
            __builtin_amdgcn_s_setprio(0); } \
        else if (attc_) { bf16x8 pf[2]; \
            softmax1_nb(C, m, lh, o, pf); \
            __builtin_amdgcn_s_setprio(1); PAT_PV1(vhoff); __builtin_amdgcn_s_setprio(0); } } while (0)
    int k0 = 0, k1 = KTILE, k2 = 2 * KTILE, v0 = 0, v1 = VTILE;
    PAT_DMAK(0, k0); PAT_DMAV(0, v0); PAT_DMAK(1, k1);
    __syncthreads();
    f32x16 pa, pb;
    PAT_QK1(pa, k0);
#pragma unroll 1
    for (int j = 0; j < ntiles; ++j) {
        if (j + 2 < ntiles) PAT_DMAK(j + 2, k2);
        if (j + 1 < ntiles) PAT_DMAV(j + 1, v1);
        PAT_HSTEP(pa, pb, 2 * j, k0 + 32 * KROW, v0, true);
        PAT_HSTEP(pb, pa, 2 * j + 1, k1, v0 + 64, j + 1 < ntiles);
        __syncthreads();
        { const int t = k0; k0 = k1; k1 = k2; k2 = t; } { const int t = v0; v0 = v1; v1 = t; }
    }
#undef PAT_DMAK
#undef PAT_DMAV
#undef PAT_QK1
#undef PAT_PV1
#undef PAT_HSTEP
    const float inv = 1.0f / half_sum(lh);
    const int lane2 = lane_now();
    bf16_t* op = O + (size_t)(q0 + (lane2 & 31)) * DM + h * VD + 4 * (lane2 >> 5);
#pragma unroll
    for (int d = 0; d < 4; ++d)
#pragma unroll
        for (int g = 0; g < 4; ++g) { u32x2 w; w.x = cvt_pk_bf16(o[d][4 * g] * inv, o[d][4 * g + 1] * inv); w.y = cvt_pk_bf16(o[d][4 * g + 2] * inv, o[d][4 * g + 3] * inv);
            *(u32x2*)(op + 32 * d + 8 * g) = w; }
}
}

namespace sat {
constexpr int KROW = 656, KTILE = 64 * KROW;
__device__ __forceinline__ bf16x8 tr_frag(const LAS unsigned char* p) {
    typedef short v4i16_t __attribute__((ext_vector_type(4)));
    const s16x4 a = __builtin_bit_cast(s16x4, __builtin_amdgcn_ds_read_tr16_b64_v4i16((LAS v4i16_t*)p));
    const s16x4 b = __builtin_bit_cast(s16x4, __builtin_amdgcn_ds_read_tr16_b64_v4i16((LAS v4i16_t*)(p + 4 * KROW)));
    bf16x8 r; r[0] = a[0]; r[1] = a[1]; r[2] = a[2]; r[3] = a[3]; r[4] = b[0]; r[5] = b[1]; r[6] = b[2]; r[7] = b[3]; return r;
}
__device__ __forceinline__ void unit(LAS unsigned char* lds, const int wave, const bf16_t* QLAT, const float* cache_ckv, const float* cache_kpe, const int* page_table, const bf16_t* CKVS  , const bf16_t* KPES,
                                     float* OPART, float* OML, int b, int split) {
    const int lane = lane_now(), tid = wave * 64 + lane, ql = lane & 31, hh = lane >> 5;
    const int qblk = wave & 1, kb = (wave >> 1) & 1, dvh = wave >> 2;
#pragma unroll
    for (int i = 0; i < 5; ++i) { const int c = tid + 512 * i, row = c / 40, cc = c % 40;
        *(LAS u32x4*)(lds + 2 * KTILE + row * KROW + cc * 16) = *(const u32x4*)(QLAT + (size_t)(b * 64 + row) * 320 + cc * 8); }
    f32x16 o[4];
#pragma unroll
    for (int d = 0; d < 4; ++d)
#pragma unroll
        for (int r = 0; r < 16; ++r) o[d][r] = 0.f;
    float m = -1e30f, lh = 0.f;
    const int npg = NPAGES / 2, ntiles = 2 * npg + (split == 1 ? 1 : 0);
    const int* pt = page_table + b * NPAGES + split * npg;
    const int crow0 = tid >> 6, ccol = tid & 63;
    const int prow0 = tid >> 4, pcol = tid & 15;
    f32x4 cst[8], pst[2];
#define SAT_LOAD(j) do { const int pg = pt[(j) >> 1]; const size_t r0 = (size_t)pg * PAGE + ((j) & 1) * 64; \
        _Pragma("unroll") for (int i = 0; i < 8; ++i) cst[i] = __builtin_nontemporal_load((const f32x4*)(cache_ckv + (r0 + crow0 + 8 * i) * KVL) + ccol); \
        _Pragma("unroll") for (int i = 0; i < 2; ++i) pst[i] = __builtin_nontemporal_load((const f32x4*)(cache_kpe + (r0 + prow0 + 32 * i) * ROPE) + pcol); } while (0)
#define SAT_STORE(buf) do { _Pragma("unroll") for (int i = 0; i < 8; ++i) { u32x2 w; w.x = cvt_pk_bf16(cst[i][0], cst[i][1]); w.y = cvt_pk_bf16(cst[i][2], cst[i][3]); \
            *(LAS u32x2*)(lds + (buf) * KTILE + (crow0 + 8 * i) * KROW + ccol * 8) = w; } \
        _Pragma("unroll") for (int i = 0; i < 2; ++i) { u32x2 w; w.x = cvt_pk_bf16(pst[i][0], pst[i][1]); w.y = cvt_pk_bf16(pst[i][2], pst[i][3]); \
            *(LAS u32x2*)(lds + (buf) * KTILE + (prow0 + 32 * i) * KROW + 512 + pcol * 8) = w; } } while (0)
#define SAT_NEW(buf) do { _Pragma("unroll") for (int i = 0; i < 5; ++i) { const int c = tid + 512 * i, row = c / 40, cc = c % 40; u32x4 v = (u32x4){0u, 0u, 0u, 0u}; \
            if (row < DECT) v = cc < 32 ? *(const u32x4*)(CKVS + (size_t)(b * DECT + row) * KVL + cc * 8) : *(const u32x4*)(KPES + (size_t)(b * DECT + row) * ROPE + (cc - 32) * 8); \
            *(LAS u32x4*)(lds + (buf) * KTILE + row * KROW + cc * 16) = v; } } while (0)
    SAT_LOAD(0); SAT_STORE(0);
    __syncthreads();
    const int kr = 32 * kb + swap23(ql);
    const int g16 = lane >> 4, i16 = lane & 15;
    const int troff = (32 * kb + 8 * (g16 >> 1) + (i16 >> 2)) * KROW + (128 * dvh + 16 * (g16 & 1) + 4 * (i16 & 3)) * 2;
    for (int j = 0; j < ntiles; ++j) {
        const int buf = j & 1;
        const bool nxt_page = (j + 1 < 2 * npg), nxt_new = (j + 1 == 2 * npg) && (split == 1);
        if (nxt_page) SAT_LOAD(j + 1);
        f32x16 p0;
#pragma unroll
        for (int r = 0; r < 16; ++r) p0[r] = 0.f;
        const LAS unsigned char* kb0 = lds + buf * KTILE + kr * KROW + hh * 16;
        const LAS unsigned char* qb0 = lds + 2 * KTILE + (32 * qblk + ql) * KROW + hh * 16;
        __builtin_amdgcn_s_setprio(1);
#pragma unroll
        for (int ks = 0; ks < 20; ++ks) p0 = __builtin_amdgcn_mfma_f32_32x32x16_bf16(*(const LAS bf16x8*)(kb0 + ks * 32), *(const LAS bf16x8*)(qb0 + ks * 32), p0, 0, 0, 0);
        __builtin_amdgcn_s_setprio(0);
        if (j == 2 * npg) {
            const int tq = (32 * qblk + ql) >> 3;
#pragma unroll
            for (int r = 0; r < 16; ++r) { const int kk = 32 * kb + 16 * (r >> 3) + 8 * hh + (r & 7); if (kk > tq) p0[r] = -__builtin_inff(); }
        }
        bf16x8 pf[2];
        softmax_step1<4>(p0, m, lh, o, pf);
        const LAS unsigned char* vb0 = lds + buf * KTILE + troff;
#pragma unroll
        for (int d = 0; d < 4; ++d)
#pragma unroll
            for (int ss = 0; ss < 2; ++ss) {
                const bf16x8 a = tr_frag(vb0 + d * 64 + ss * 16 * KROW);
                o[d] = __builtin_amdgcn_mfma_f32_32x32x16_bf16(a, pf[ss], o[d], 0, 0, 0);
            }
        if (nxt_page) SAT_STORE(buf ^ 1);
        if (nxt_new) SAT_NEW(buf ^ 1);
        __syncthreads();
    }
#undef SAT_LOAD
#undef SAT_STORE
#undef SAT_NEW
    float lt = half_sum(lh);
    const int pair = dvh * 2 + qblk;
    LAS float* xb = (LAS float*)(lds + pair * 17408);
    if (kb == 1) {
#pragma unroll
        for (int d = 0; d < 4; ++d)
#pragma unroll
            for (int r = 0; r < 16; ++r) xb[(d * 16 + r) * 64 + lane] = o[d][r];
        xb[64 * 64 + lane] = m; xb[65 * 64 + lane] = lt;
    }
    __syncthreads();
    if (kb == 0) {
        const float m1 = xb[64 * 64 + lane], l1 = xb[65 * 64 + lane];
        const float mm = fmaxf(m, m1), w0 = __builtin_amdgcn_exp2f(m - mm), w1 = __builtin_amdgcn_exp2f(m1 - mm);
#pragma unroll
        for (int d = 0; d < 4; ++d)
#pragma unroll
            for (int r = 0; r < 16; ++r) o[d][r] = o[d][r] * w0 + xb[(d * 16 + r) * 64 + lane] * w1;
        lt = lt * w0 + l1 * w1;
        const int q = 32 * qblk + ql;
        float* op = OPART + ((size_t)(b * 2 + split) * 64 + q) * KVL + 128 * dvh + 4 * hh;
#pragma unroll
        for (int d = 0; d < 4; ++d)
#pragma unroll
            for (int g = 0; g < 4; ++g) *(f32x4*)(op + 32 * d + 8 * g) = (f32x4){o[d][4 * g], o[d][4 * g + 1], o[d][4 * g + 2], o[d][4 * g + 3]};
        if (dvh == 0 && hh == 0) *(f32x2*)(OML + ((size_t)(b * 2 + split) * 64 + q) * 2) = (f32x2){mm, lt};
    }
    __syncthreads();
}
}


#define LDS_RD128(dst, addr, off) asm volatile("ds_read_b128 %0, %1 offset:%2" : "=v"(dst) : "v"(addr), "n"(off))
#define LDS_WAIT4(f, N) asm volatile("s_waitcnt lgkmcnt(" #N ")" : "+v"(f[0]), "+v"(f[1]), "+v"(f[2]), "+v"(f[3]))
namespace gla {
constexpr int QROW = 272, KTROW = 144, VROW = 528;
constexpr int P_T16 = 0, P_TOT = 4096, P_QT = 8192, P_KT = P_QT + 64 * QROW;
constexpr int C_DK = 0, C_QT = 1024, C_KH = C_QT + 64 * QROW, C_V = C_KH + 128 * KTROW, C_AT = C_V + 64 * VROW, C_O = C_AT + 6144;
static_assert(C_O + 64 * 8 * 64 <= RING_BYTES, "gla chain LDS");
static_assert(C_AT + 6144 <= RING_BYTES, "gla LDS");
__device__ __forceinline__ bf16x8 tr_frag(const LAS unsigned char* p) {
    typedef short v4i16_t __attribute__((ext_vector_type(4)));
    const s16x4 a = __builtin_bit_cast(s16x4, __builtin_amdgcn_ds_read_tr16_b64_v4i16((LAS v4i16_t*)p));
    const s16x4 b = __builtin_bit_cast(s16x4, __builtin_amdgcn_ds_read_tr16_b64_v4i16((LAS v4i16_t*)(p + 4 * VROW)));
    bf16x8 r; r[0] = a[0]; r[1] = a[1]; r[2] = a[2]; r[3] = a[3]; r[4] = b[0]; r[5] = b[1]; r[6] = b[2]; r[7] = b[3]; return r;
}
template <int SEG>
__device__ __forceinline__ void prep(LAS unsigned char* lds, const int wave, const bf16_t* QKVG, const float* T16, const float* w_gk2, const float* b_gk, int chunk, int h,
                                     bf16_t* QTg, bf16_t* KHg, bf16_t* ATg, float* DKg) {
    const int lane = lane_now(), tid = wave * 64 + lane, ql = lane & 31, hh = lane >> 5;
    const int kk = tid & 127, tq = tid >> 7, cu = chunk * 4 + h, row0 = chunk * 64;
    float w2[16];
#pragma unroll
    for (int j = 0; j < 16; ++j) w2[j] = w_gk2[j * (GH * GDK) + h * GDK + kk];
    const float bias = b_gk[h * GDK + kk];
    unsigned short qraw[16], kraw[16];
    { const bf16_t* qg = QKVG + (size_t)(row0 + tq * 16) * GIN + h * GDK + kk;
#pragma unroll
      for (int i = 0; i < 16; ++i) { qraw[i] = qg[(size_t)i * GIN]; kraw[i] = qg[(size_t)i * GIN + GH * GDK]; } }
    __syncthreads();
    if (tid < 256) *(LAS f32x4*)(lds + P_T16 + tid * 16) = *(const f32x4*)(T16 + (size_t)row0 * 16 + tid * 4);
    __syncthreads();
    float Gl[16];
    { float run = 0.f;
#pragma unroll
      for (int i = 0; i < 16; ++i) { const int t = tq * 16 + i; const LAS f32x4* tp = (const LAS f32x4*)(lds + P_T16 + t * 64);
          const f32x4 a0 = tp[0], a1 = tp[1], a2 = tp[2], a3 = tp[3];
          float z = bias;
          z += a0[0] * w2[0] + a0[1] * w2[1] + a0[2] * w2[2] + a0[3] * w2[3];
          z += a1[0] * w2[4] + a1[1] * w2[5] + a1[2] * w2[6] + a1[3] * w2[7];
          z += a2[0] * w2[8] + a2[1] * w2[9] + a2[2] * w2[10] + a2[3] * w2[11];
          z += a3[0] * w2[12] + a3[1] * w2[13] + a3[2] * w2[14] + a3[3] * w2[15];
          const float ls = fminf(z, 0.f) - 0.6931471805599453f * __builtin_amdgcn_logf(1.0f + __builtin_amdgcn_exp2f(-fabsf(z) * LOG2E));
          if (SEG == 8 && i == 8) run = 0.f;
          run += ls * (1.0f / 16.0f); Gl[i] = run; }
      if (SEG == 64) *(LAS float*)(lds + P_TOT + (tq * 128 + kk) * 4) = run; }
    float prefix = 0.f, total = 0.f;
    if (SEG == 64) {
        __syncthreads();
#pragma unroll
        for (int q = 0; q < 4; ++q) { const float v = *(const LAS float*)(lds + P_TOT + (q * 128 + kk) * 4); total += v; if (q < tq) prefix += v; }
    }
    { unsigned kh[8];
#pragma unroll
      for (int i = 0; i < 16; i += 2) {
          const float G0 = (Gl[i] + prefix) * LOG2E, G1 = (Gl[i + 1] + prefix) * LOG2E;
          const float TL = (SEG == 64 ? total : Gl[i | 7]) * LOG2E;
          const float q0 = bf2f(qraw[i]), q1 = bf2f(qraw[i + 1]), k0 = bf2f(kraw[i]), k1 = bf2f(kraw[i + 1]);
          const unsigned qq = cvt_pk_bf16(q0 * __builtin_amdgcn_exp2f(G0), q1 * __builtin_amdgcn_exp2f(G1));
          const unsigned kt = cvt_pk_bf16(k0 * __builtin_amdgcn_exp2f(-G0), k1 * __builtin_amdgcn_exp2f(-G1));
          kh[i >> 1] = cvt_pk_bf16(k0 * __builtin_amdgcn_exp2f(TL - G0), k1 * __builtin_amdgcn_exp2f(TL - G1));
          const int t = tq * 16 + i;
          *(LAS unsigned short*)(lds + P_QT + t * QROW + kk * 2) = (unsigned short)(qq & 0xffffu); *(LAS unsigned short*)(lds + P_QT + (t + 1) * QROW + kk * 2) = (unsigned short)(qq >> 16);
          *(LAS unsigned short*)(lds + P_KT + t * QROW + kk * 2) = (unsigned short)(kt & 0xffffu); *(LAS unsigned short*)(lds + P_KT + (t + 1) * QROW + kk * 2) = (unsigned short)(kt >> 16);
      }
      bf16_t* khp = KHg + ((size_t)cu * 128 + kk) * 64 + tq * 16;
      *(u32x4*)khp = (u32x4){kh[0], kh[1], kh[2], kh[3]}; *(u32x4*)(khp + 8) = (u32x4){kh[4], kh[5], kh[6], kh[7]};
      if (SEG == 64) { if (tq == 0) DKg[(size_t)cu * 1024 + kk] = __builtin_amdgcn_exp2f(total * LOG2E); }
      else { DKg[(size_t)cu * 1024 + (tq * 2) * 128 + kk] = __builtin_amdgcn_exp2f(Gl[7] * LOG2E); DKg[(size_t)cu * 1024 + (tq * 2 + 1) * 128 + kk] = __builtin_amdgcn_exp2f(Gl[15] * LOG2E); } }
    __syncthreads();
    if (wave < 3) {
        const int sb = wave >> 1, tb = (wave + 1) >> 1, kr = swap23(ql);
        f32x16 x;
#pragma unroll
        for (int r = 0; r < 16; ++r) x[r] = 0.f;
        const LAS unsigned char* ap = lds + P_KT + (32 * sb + kr) * QROW + hh * 16;
        const LAS unsigned char* bp = lds + P_QT + (32 * tb + ql) * QROW + hh * 16;
#pragma unroll
        for (int ks = 0; ks < 8; ++ks) x = __builtin_amdgcn_mfma_f32_32x32x16_bf16(*(const LAS bf16x8*)(ap + ks * 32), *(const LAS bf16x8*)(bp + ks * 32), x, 0, 0, 0);
        const int tt = 32 * tb + ql;
#pragma unroll
        for (int r = 0; r < 16; ++r) { const int sr = 32 * sb + 16 * (r >> 3) + 8 * hh + (r & 7); if (sr > tt || (SEG == 8 && (sr >> 3) != (tt >> 3))) x[r] = 0.f; }
        bf16_t* atp = ATg + (size_t)cu * 3072 + (wave * 2) * 512 + lane * 8;
        *(bf16x8*)atp = pack8(x, 0); *(bf16x8*)(atp + 512) = pack8(x, 8);
    }
#pragma unroll
    for (int i = 0; i < 2; ++i) { const int c = tid + 512 * i, row = c >> 4, cc = c & 15;
        *(u32x4*)(QTg + (size_t)(row0 + row) * (GH * GDK) + h * GDK + cc * 8) = *(const LAS u32x4*)(lds + P_QT + row * QROW + cc * 16); }
}

template <int NWV>
__device__ __forceinline__ void chain(LAS unsigned char* lds, const int wave, const bf16_t* QTg, const bf16_t* KHg, const bf16_t* ATg, const float* DKg, const bf16_t* QKVG, int h, int chunk0, int nchunk,
                                      int srow, int nrow, int sseg, int dseg, int dvbase, const float* state_in, float* state_out, bf16_t* GO) {
    constexpr int VPR = NWV * 4  , VST = NWV / 2  , VRS = 512 / VPR  ;
    const bool active = wave < NWV;
    const int lane = lane_now(), tid = wave * 64 + lane, ql = lane & 31, hh = lane >> 5;
    f32x16 S[4];
#pragma unroll
    for (int kb = 0; kb < 4; ++kb)
#pragma unroll
        for (int r = 0; r < 16; ++r) S[kb][r] = (state_in && active) ? state_in[(size_t)(32 * kb + 16 * (r >> 3) + 8 * hh + (r & 7)) * GDV + dvbase + 32 * wave + ql] : 0.f;
    const int qrow = tid >> 4, qcc = tid & 15;
    const int krow = tid >> 3, kcc = tid & 7;
    const int vrow0 = tid / VPR, vcc = tid % VPR;
    u32x4 qst[2], kst[2], vst[VST], ast, dst;
#define GLC_LOAD(c) do { const int ch = chunk0 + (c); const size_t cu = (size_t)ch * 4 + h; \
        _Pragma("unroll") for (int i = 0; i < 2; ++i) qst[i] = *(const u32x4*)(QTg + (size_t)(ch * 64 + qrow + 32 * i) * (GH * GDK) + h * GDK + qcc * 8); \
        _Pragma("unroll") for (int i = 0; i < 2; ++i) kst[i] = (sseg < 0 || kcc == sseg) ? *(const u32x4*)(KHg + (cu * 128 + krow + 64 * i) * 64 + kcc * 8) : (u32x4){0u, 0u, 0u, 0u}; \
        _Pragma("unroll") for (int i = 0; i < VST; ++i) { const int r = vrow0 + VRS * i; \
            vst[i] = (r >= srow && r < srow + nrow) ? *(const u32x4*)(QKVG + (size_t)(ch * 64 + r) * GIN + 2 * GH * GDK + h * GDV + dvbase + vcc * 8) : (u32x4){0u, 0u, 0u, 0u}; } \
        if (tid < 384) ast = *(const u32x4*)(ATg + cu * 3072 + tid * 8); \
        if (tid < 32) dst = *(const u32x4*)(DKg + cu * 1024 + dseg * 128 + tid * 4); } while (0)
    GLC_LOAD(0);
    const int g16 = lane >> 4, i16 = lane & 15;
    const int troff = (8 * (g16 >> 1) + (i16 >> 2)) * VROW + (32 * wave + 16 * (g16 & 1) + 4 * (i16 & 3)) * 2;
    const int kr = swap23(ql);
#define GLC_LDS_BAR() do { asm volatile("s_waitcnt lgkmcnt(0)" ::: "memory"); __builtin_amdgcn_s_barrier(); asm volatile("" ::: "memory"); } while (0)
#define GLC_FLUSH(cprev) do { if constexpr (NWV != 8) { int tl_ = tid; asm volatile("" : "+v"(tl_)); _Pragma("unroll") for (int i_ = 0; i_ < NWV / 2; ++i_) { const int c_ = tl_ + 512 * i_, row_ = c_ / (NWV * 4), cc_ = c_ % (NWV * 4); \
            *(u32x4*)(GO + (size_t)((chunk0 + (cprev)) * 64 + row_) * DM + h * GDV + dvbase + cc_ * 8) = *(const LAS u32x4*)(lds + C_O + row_ * (NWV * 64) + cc_ * 16); } } } while (0)
    for (int c = 0; c < nchunk; ++c) {
        GLC_LDS_BAR();
        if (c > 0) GLC_FLUSH(c - 1);
#pragma unroll
        for (int i = 0; i < 2; ++i) *(LAS u32x4*)(lds + C_QT + (qrow + 32 * i) * QROW + qcc * 16) = qst[i];
#pragma unroll
        for (int i = 0; i < 2; ++i) *(LAS u32x4*)(lds + C_KH + (krow + 64 * i) * KTROW + kcc * 16) = kst[i];
#pragma unroll
        for (int i = 0; i < VST; ++i) *(LAS u32x4*)(lds + C_V + (vrow0 + VRS * i) * VROW + vcc * 16) = vst[i];
        if (tid < 384) *(LAS u32x4*)(lds + C_AT + tid * 16) = ast;
        if (tid < 32) *(LAS u32x4*)(lds + C_DK + tid * 16) = dst;
        GLC_LDS_BAR();
        if (c + 1 < nchunk) GLC_LOAD(c + 1);
        if (active) {
        f32x16 o[2];
#pragma unroll
        for (int tb = 0; tb < 2; ++tb)
#pragma unroll
            for (int r = 0; r < 16; ++r) o[tb][r] = 0.f;
        const unsigned qa = (unsigned)(size_t)(lds + C_QT + ql * QROW + hh * 16), ka = (unsigned)(size_t)(lds + C_KH + kr * KTROW + hh * 16), ata = (unsigned)(size_t)(lds + C_AT + lane * 16);
        bf16x8 fa[4], fb[4];
#define GLC_QLD(f, kb) do { LDS_RD128(f[0], qa, (kb) * 64); LDS_RD128(f[1], qa, 32 * QROW + (kb) * 64); LDS_RD128(f[2], qa, (kb) * 64 + 32); LDS_RD128(f[3], qa, 32 * QROW + (kb) * 64 + 32); } while (0)
#define GLC_QMM(f, kb) do { const bf16x8 s0 = pack8(S[kb], 0), s1 = pack8(S[kb], 8); \
            o[0] = __builtin_amdgcn_mfma_f32_32x32x16_bf16(f[0], s0, o[0], 0, 0, 0); o[1] = __builtin_amdgcn_mfma_f32_32x32x16_bf16(f[1], s0, o[1], 0, 0, 0); \
            o[0] = __builtin_amdgcn_mfma_f32_32x32x16_bf16(f[2], s1, o[0], 0, 0, 0); o[1] = __builtin_amdgcn_mfma_f32_32x32x16_bf16(f[3], s1, o[1], 0, 0, 0); } while (0)
        GLC_QLD(fa, 0); GLC_QLD(fb, 1);
        LDS_WAIT4(fa, 4); GLC_QMM(fa, 0); GLC_QLD(fa, 2);
        LDS_WAIT4(fb, 4); GLC_QMM(fb, 1); GLC_QLD(fb, 3);
        LDS_WAIT4(fa, 4); GLC_QMM(fa, 2);
        LDS_RD128(fa[0], ata, 0 * 1024); LDS_RD128(fa[1], ata, 1 * 1024); LDS_RD128(fa[2], ata, 2 * 1024); LDS_RD128(fa[3], ata, 3 * 1024);
        LDS_WAIT4(fb, 4); GLC_QMM(fb, 3);
        LDS_RD128(fb[0], ata, 4 * 1024); LDS_RD128(fb[1], ata, 5 * 1024); LDS_RD128(fb[2], ka, 0); LDS_RD128(fb[3], ka, 32);
        bf16x8 vf[4];
#pragma unroll
        for (int ss = 0; ss < 4; ++ss) vf[ss] = tr_frag(lds + C_V + troff + ss * 16 * VROW);
        LDS_WAIT4(fa, 0); LDS_WAIT4(fb, 0);
        o[0] = __builtin_amdgcn_mfma_f32_32x32x16_bf16(fa[0], vf[0], o[0], 0, 0, 0);
        o[0] = __builtin_amdgcn_mfma_f32_32x32x16_bf16(fa[1], vf[1], o[0], 0, 0, 0);
        o[1] = __builtin_amdgcn_mfma_f32_32x32x16_bf16(fa[2], vf[0], o[1], 0, 0, 0);
        o[1] = __builtin_amdgcn_mfma_f32_32x32x16_bf16(fa[3], vf[1], o[1], 0, 0, 0);
        o[1] = __builtin_amdgcn_mfma_f32_32x32x16_bf16(fb[0], vf[2], o[1], 0, 0, 0);
        o[1] = __builtin_amdgcn_mfma_f32_32x32x16_bf16(fb[1], vf[3], o[1], 0, 0, 0);
#define GLC_KLD(f, kb) do { LDS_RD128(f[0], ka, (kb) * 32 * KTROW); LDS_RD128(f[1], ka, (kb) * 32 * KTROW + 32); LDS_RD128(f[2], ka, (kb) * 32 * KTROW + 64); LDS_RD128(f[3], ka, (kb) * 32 * KTROW + 96); } while (0)
#define GLC_SCALE(kb) do { _Pragma("unroll") for (int g = 0; g < 2; ++g) { const LAS f32x4* dp = (const LAS f32x4*)(lds + C_DK + (32 * (kb) + 16 * g + 8 * hh) * 4); const f32x4 d0 = dp[0], d1 = dp[1]; \
            S[kb][8 * g + 0] *= d0[0]; S[kb][8 * g + 1] *= d0[1]; S[kb][8 * g + 2] *= d0[2]; S[kb][8 * g + 3] *= d0[3]; \
            S[kb][8 * g + 4] *= d1[0]; S[kb][8 * g + 5] *= d1[1]; S[kb][8 * g + 6] *= d1[2]; S[kb][8 * g + 7] *= d1[3]; } } while (0)
#define GLC_KMM(f, kb) do { S[kb] = __builtin_amdgcn_mfma_f32_32x32x16_bf16(f[0], vf[0], S[kb], 0, 0, 0); S[kb] = __builtin_amdgcn_mfma_f32_32x32x16_bf16(f[1], vf[1], S[kb], 0, 0, 0); \
            S[kb] = __builtin_amdgcn_mfma_f32_32x32x16_bf16(f[2], vf[2], S[kb], 0, 0, 0); S[kb] = __builtin_amdgcn_mfma_f32_32x32x16_bf16(f[3], vf[3], S[kb], 0, 0, 0); } while (0)
        GLC_KLD(fa, 1);
        LDS_RD128(fb[0], ka, 64); LDS_RD128(fb[1], ka, 96);
        GLC_SCALE(0);
        LDS_WAIT4(fb, 0);
        S[0] = __builtin_amdgcn_mfma_f32_32x32x16_bf16(fb[2], vf[0], S[0], 0, 0, 0); S[0] = __builtin_amdgcn_mfma_f32_32x32x16_bf16(fb[3], vf[1], S[0], 0, 0, 0);
        S[0] = __builtin_amdgcn_mfma_f32_32x32x16_bf16(fb[0], vf[2], S[0], 0, 0, 0); S[0] = __builtin_amdgcn_mfma_f32_32x32x16_bf16(fb[1], vf[3], S[0], 0, 0, 0);
        GLC_KLD(fb, 2); GLC_SCALE(1);
        LDS_WAIT4(fa, 4); GLC_KMM(fa, 1); GLC_KLD(fa, 3); GLC_SCALE(2);
        LDS_WAIT4(fb, 4); GLC_KMM(fb, 2); GLC_SCALE(3);
        LDS_WAIT4(fa, 0); GLC_KMM(fa, 3);
#undef GLC_QLD
#undef GLC_QMM
#undef GLC_KLD
#undef GLC_SCALE
#undef GLC_KMM
        if constexpr (NWV != 8) {
            int qlx = ql, hhx = hh; asm volatile("" : "+v"(qlx), "+v"(hhx));
            LAS unsigned short* op_ = (LAS unsigned short*)(lds + C_O) + (4 * hhx) * (NWV * 32) + 32 * wave + qlx;
#pragma unroll
            for (int tb = 0; tb < 2; ++tb)
#pragma unroll
                for (int r = 0; r < 16; r += 2) { const unsigned w_ = cvt_pk_bf16(o[tb][r], o[tb][r + 1]);
                    const int t0_ = 32 * tb + (r & 3) + 8 * (r >> 2);
                    op_[t0_ * (NWV * 32)] = (unsigned short)(w_ & 0xffffu); op_[(t0_ + 1) * (NWV * 32)] = (unsigned short)(w_ >> 16); }
        } else {
          int qlx = ql, hhx = hh; asm volatile("" : "+v"(qlx), "+v"(hhx));
          bf16_t* gp = GO + (size_t)((chunk0 + c) * 64) * DM + h * GDV + dvbase + 32 * wave + qlx;
#pragma unroll
          for (int tb = 0; tb < 2; ++tb)
#pragma unroll
              for (int r = 0; r < 16; ++r) { const int t = 32 * tb + (r & 3) + 8 * (r >> 2) + 4 * hhx; if (t >= srow && t < srow + nrow) gp[(size_t)t * DM] = (bf16_t)(cvt_pk_bf16(o[tb][r], 0.f) & 0xffffu); } }
        }
    }
    if constexpr (NWV != 8) { GLC_LDS_BAR(); GLC_FLUSH(nchunk - 1); }
#undef GLC_FLUSH
#undef GLC_LOAD
#undef GLC_LDS_BAR
    if (active) { int qlx = ql, hhx = hh; asm volatile("" : "+v"(qlx), "+v"(hhx));
#pragma unroll
    for (int kb = 0; kb < 4; ++kb)
#pragma unroll
        for (int r = 0; r < 16; ++r) state_out[(size_t)(32 * kb + 16 * (r >> 3) + 8 * hhx + (r & 7)) * GDV + dvbase + 32 * wave + qlx] = S[kb][r]; }
    __syncthreads();
}
}

__global__ void __launch_bounds__(NWAVES * 64, 2) mk_fwd(Args args) {
    extern __shared__ __attribute__((aligned(16))) unsigned char lds_raw[];
    LAS unsigned char* lds = (LAS unsigned char*)lds_raw;
    volatile LAS unsigned* MISC = (volatile LAS unsigned*)(lds + MISC_OFF);
    const int wave = __builtin_amdgcn_readfirstlane(threadIdx.x >> 6);
    const int G = gridDim.x; const int bx = blockIdx.x; const int vcu = (G % 8 == 0) ? (bx % 8) * (G / 8) + bx / 8 : bx;
    const int gw = vcu * NWAVES + wave, NGW = G * NWAVES;
    unsigned char* ws = args.ws;
    unsigned* ctl = (unsigned*)(ws + WS_CTL);
    for (int u = wave * 64 + lane_now(); u < (LDS_BYTES - LDSCTL_OFF) / 4; u += NWAVES * 64) ((LAS unsigned*)(lds + LDSCTL_OFF))[u] = 0u;
    __syncthreads();
    XcdBarrier bar = xcd_barrier_post(ctl + 1024, MISC + 8, wave == 0 && lane_now() == 0);
#ifdef PROBE_A0
    unsigned long long* tsb = (unsigned long long*)(ws + WS_CTL + 32768);
    int n_ts = 0;
#define STAMP() do { if (bx == 0 && wave == 0 && lane_now() == 0) tsb[n_ts] = __builtin_amdgcn_s_memrealtime(); ++n_ts; } while (0)
#define GRID_BAR() do { xcd_barrier(bar, wave == 0 && lane_now() == 0); STAMP(); } while (0)
    STAMP();
#else
#define STAMP() do {} while (0)
#define GRID_BAR() xcd_barrier(bar, wave == 0 && lane_now() == 0)
#endif

    const float* x_prompt = (const float*)args.in[0]; const float* x_sample = (const float*)args.in[1];
    const float* cache_ckv = (const float*)args.in[2]; const float* cache_kpe = (const float*)args.in[3];
    const float* state_gla = (const float*)args.in[4]; const int* page_table = (const int*)args.in[5];
    const float* norm_g = (const float*)args.in[6]; const float* ffn_w_in = (const float*)args.in[7]; const float* ffn_w_out = (const float*)args.in[8];
    const float* mla_w_down = (const float*)args.in[9]; const float* mla_g_q = (const float*)args.in[10]; const float* mla_w_uq = (const float*)args.in[11];
    const float* mla_g_kv = (const float*)args.in[12]; const float* mla_w_uk = (const float*)args.in[13]; const float* mla_w_uv = (const float*)args.in[14];
    const float* mla_w_o = (const float*)args.in[15]; const float* gla_w_in = (const float*)args.in[16]; const float* gla_w_gk1 = (const float*)args.in[17];
    const float* gla_w_gk2 = (const float*)args.in[18]; const float* gla_b_gk = (const float*)args.in[19]; const float* gla_g_norm = (const float*)args.in[20];
    const float* gla_w_o = (const float*)args.in[21];
    float* out = args.out;
    float* ROPE_T = (float*)(ws + WS_ROPE);
    bf16_t* WIN = (bf16_t*)(ws + WS_WIN); bf16_t* WOUT = (bf16_t*)(ws + WS_WOUT); bf16_t* WDOWN = (bf16_t*)(ws + WS_WDOWN); bf16_t* WUQ = (bf16_t*)(ws + WS_WUQ);
    bf16_t* WUKT = (bf16_t*)(ws + WS_WUKT); bf16_t* WUK = (bf16_t*)(ws + WS_WUK); bf16_t* WUVT = (bf16_t*)(ws + WS_WUVT); bf16_t* WOT = (bf16_t*)(ws + WS_WOT);
    bf16_t* WGIN = (bf16_t*)(ws + WS_WGIN); bf16_t* WGO = (bf16_t*)(ws + WS_WGO);
    bf16_t* XN = (bf16_t*)(ws + WS_XN); bf16_t* HM = (bf16_t*)(ws + WS_HM); bf16_t* T = (bf16_t*)(ws + WS_T); bf16_t* H = (bf16_t*)(ws + WS_H); float* TP = (float*)(ws + WS_TP); bf16_t* D = (bf16_t*)(ws + WS_D);
    bf16_t* CQ = (bf16_t*)(ws + WS_CQ); bf16_t* CKV = (bf16_t*)(ws + WS_CKV); bf16_t* KPES = (bf16_t*)(ws + WS_KPES);
    bf16_t* KB = (bf16_t*)(ws + WS_KB); bf16_t* KPEP = (bf16_t*)(ws + WS_KPEP);
    float* Y = out + OUT_Y;
    const ConvPtrs cp{ffn_w_in, ffn_w_out, mla_w_down, mla_w_uq, mla_w_uk, mla_w_uv, mla_w_o, gla_w_in, gla_w_o, WIN, WOUT, WDOWN, WUQ, WUKT, WUVT, WOT, WGIN, WGO};

    {
        const int lane = lane_now(), tid = wave * 64 + lane; (void)tid;
        LAS float* scr = (LAS float*)(lds + wave * 16384);
        conv_segment<0>(cp, gw, NGW, scr, lane);
        const int gt = vcu * (NWAVES * 64) + tid, NGT = G * NWAVES * 64;
        for (int i = gt; i < KVL * NH * NOPE / 2; i += NGT) { const f32x2 v = ((const f32x2*)mla_w_uk)[i]; ((unsigned*)WUK)[i] = cvt_pk_bf16(v[0], v[1]); }
        for (int i = gt; i < (DDOWN_P - DDOWN) * DM / 2; i += NGT) ((unsigned*)(WDOWN + (size_t)DDOWN * DM))[i] = 0u;
        for (int i = gt; i < 128 * KVL / 2; i += NGT) ((unsigned*)(WUVT + (size_t)NH * VD * KVL))[i] = 0u;
        for (int i = gt; i < (GIN_P - GIN) * DM / 2; i += NGT) { const int row = (2 * i) / DM, k = (2 * i) % DM;
            unsigned w = 0u; if (row < GRANK) w = cvt_pk_bf16(gla_w_gk1[(size_t)k * GRANK + row], gla_w_gk1[(size_t)(k + 1) * GRANK + row]);
            ((unsigned*)(WGIN + (size_t)GIN * DM))[i] = w; }
        for (int i = gt; i < (SEQ + DECT) * 32; i += NGT) { const int p = i >> 5, fi = i & 31; const float pos = (float)(p < SEQ ? p : PAST + (p - SEQ));
            const float inv = (float)exp2(-(double)fi * (13.287712379549449 / 32.0));
            const float ang = pos * inv; double t = (double)ang * 0.15915494309189535; t -= rint(t); const float tf = (float)t;
            ((f32x2*)ROPE_T)[i] = (f32x2){__builtin_amdgcn_cosf(tf), __builtin_amdgcn_sinf(tf)}; }
        thin_phase<false, true, true, false>(gw, NGW, x_prompt, x_sample, nullptr, nullptr, 0, nullptr, nullptr, XN, nullptr, norm_g + 0 * DM, 1.f);
        GRID_BAR();
    }
    bf16_t* QKVG = (bf16_t*)(ws + WS_QKVG); float* T16 = (float*)(ws + WS_T16); bf16_t* GO = (bf16_t*)(ws + WS_GO);
    const int CONV_TAIL0 = ((M / 256) * (2 * DFF / 256)) % G;
#define FFN_GEMMS(slot) do { \
        { pg8::Gemm g{XN, WIN + (size_t)(slot) * 2 * DFF * DM, DM, DM, DM, 0, 0}; pg8::Order S{M / 256, 2 * DFF / 256, 1, G, bx}; \
          pg8::EpiSwiGLU E{HM, DFF}; \
          pg8::gemm_phase<pg8::EpiSwiGLU, true>(lds, wave, g, S, E); \
          if ((slot) < 3 && bx >= CONV_TAIL0) conv_segment<((slot) < 3 ? (slot) + 1 : 3)>(cp, (bx - CONV_TAIL0) * NWAVES + wave, (G - CONV_TAIL0) * NWAVES, (LAS float*)(lds + wave * 16384), lane_now()); \
          GRID_BAR(); } \
        { pg8::Gemm g{HM, WOUT + (size_t)(slot) * DM * DFF, DFF, DFF, DFF, 0, 0}; pg8::Order S{MP / 256, DM / 256, 1, G, bx};     \
          pg8::EpiBf16<0> E{T, DM, 0, 256, 1.f, 0}; \
          pg8::gemm_phase<pg8::EpiBf16<0>, true>(lds, wave, g, S, E); } \
        { pg8::Gemm g{HM + (size_t)MP * DFF, WOUT + (size_t)(slot) * DM * DFF, DFF, DFF, 256, 256, 256}; pg8::Order S{MS / 256, DM / 256, 11, G, bx};     \
          pg8::EpiF32 E{TP, DM, (long)MS * DM}; \
          pg8::gemm_phase<pg8::EpiF32, true>(lds, wave, g, S, E); \
          GRID_BAR(); } } while (0)
    { const float* ng = norm_g;
    FFN_GEMMS(0);
    thin_phase<true, true, true, false>(gw, NGW, x_prompt, x_sample, T, TP, 11, H, nullptr, XN, ng + 1 * DM, ng + 2 * DM, 0.5f); GRID_BAR();
        {
            pg8::Gemm g{XN, WDOWN, DM, DM, DM, 0, 0}; pg8::Order S{M / 256, DDOWN_P / 256, 1, G, bx};
            pg8::EpiBf16<0> E{D, DDOWN_P, 0, 256, 1.f, 0};
            pg8::gemm_phase<pg8::EpiBf16<0>, true>(lds, wave, g, S, E);
            GRID_BAR();
        }
        {
            const int lane = lane_now(), tid = wave * 64 + lane; (void)tid;
            f32x2 gq[3]; f32x4 gkv;
    #pragma unroll
            for (int j = 0; j < 3; ++j) gq[j] = *(const f32x2*)(mla_g_q + 2 * lane + 128 * j);
            gkv = *(const f32x4*)(mla_g_kv + 4 * lane);
            for (int r = gw; r < M; r += NGW) {
                const bf16_t* d = D + (size_t)r * DDOWN_P;
                f32x2 q[3];
    #pragma unroll
                for (int j = 0; j < 3; ++j) { const unsigned w = *(const unsigned*)(d + 2 * lane + 128 * j); q[j] = (f32x2){__uint_as_float(w << 16), __uint_as_float(w & 0xffff0000u)}; }
                const u32x2 kw = *(const u32x2*)(d + QL + 4 * lane);
                const f32x4 kv = (f32x4){__uint_as_float(kw.x << 16), __uint_as_float(kw.x & 0xffff0000u), __uint_as_float(kw.y << 16), __uint_as_float(kw.y & 0xffff0000u)};
                const float pe = bf2f(d[QL + KVL + lane]);
                float sq = 0.f;
    #pragma unroll
                for (int j = 0; j < 3; ++j) sq += q[j][0] * q[j][0] + q[j][1] * q[j][1];
                sq = wave_sum(sq);
                const float skv = wave_sum((kv[0] * kv[0] + kv[1] * kv[1]) + (kv[2] * kv[2] + kv[3] * kv[3]));
                const float rq = __builtin_amdgcn_rsqf(sq * (1.0f / QL) + EPS), rkv = __builtin_amdgcn_rsqf(skv * (1.0f / KVL) + EPS);
    #pragma unroll
                for (int j = 0; j < 3; ++j) *(unsigned*)(CQ + (size_t)r * QL + 2 * lane + 128 * j) = cvt_pk_bf16(q[j][0] * rq * gq[j][0], q[j][1] * rq * gq[j][1]);
                const f32x4 ckv = (kv * rkv) * gkv;
                float* ockv = r < MP ? out + OUT_CKV_P + (size_t)r * KVL : out + OUT_CKV_S + (size_t)(r - MP) * KVL;
                *(f32x4*)(ockv + 4 * lane) = ckv;
                u32x2 w; w.x = cvt_pk_bf16(ckv[0], ckv[1]); w.y = cvt_pk_bf16(ckv[2], ckv[3]);
                *(u32x2*)(CKV + (size_t)r * KVL + 4 * lane) = w;
                const float other = __shfl_xor(pe, 32);
                const f32x2 cs = ((const f32x2*)ROPE_T)[rope_pos_index(r) * 32 + (lane & 31)];
                const float ro = lane < 32 ? pe * cs[0] - other * cs[1] : pe * cs[0] + other * cs[1];
                float* okpe = r < MP ? out + OUT_KPE_P + (size_t)r * ROPE : out + OUT_KPE_S + (size_t)(r - MP) * ROPE;
                okpe[lane] = ro;
                const unsigned short rb = (unsigned short)(cvt_pk_bf16(ro, 0.f) & 0xffffu);
                if (r < MP) KPEP[(size_t)r * ROPE + lane] = rb; else KPES[(size_t)(r - MP) * ROPE + lane] = rb;
            }
            GRID_BAR();
        }

        bf16_t* Qb = (bf16_t*)(ws + WS_Q); bf16_t* VT = (bf16_t*)(ws + WS_VT); bf16_t* QLAT = (bf16_t*)(ws + WS_QLAT); bf16_t* Ob = (bf16_t*)(ws + WS_O);
        float* OPART = (float*)(ws + WS_OPART); float* OML = (float*)(ws + WS_OML); bf16_t* OLAT = (bf16_t*)(ws + WS_OLAT);
        const float QSCALE = 0.07216878364870322f * LOG2E;
        {
            pg8::Gemm g{CQ, WUQ, QL, QL, QL, 0, 0}; pg8::Order S{MP / 256, NH * QKD / 256, 1, G, bx};
            pg8::EpiQ E{Qb, ROPE_T, QSCALE};
            pg8::gemm_phase<pg8::EpiQ, true>(lds, wave, g, S, E);
            GRID_BAR();
        }
        {
            const int NQU = (MS / 256) * (NH * QKD / 256), NQP = NQU < G / 2 ? NQU : G / 2, NQC = 32 < G - NQP ? 32 : G - NQP;
            unsigned* qctr = ctl + 16 + 64 * 4;
            if (bx < NQP) {
                pg8::Gemm g{CQ, WUQ, QL, QL, QL, 0, 0}; pg8::OrderOff S{{MS / 256, NH * QKD / 256, 1, NQP, bx}, MP / 256};
                pg8::EpiQ E{Qb, ROPE_T, QSCALE};
                pg8::gemm_phase<pg8::EpiQ, true, pg8::OrderOff>(lds, wave, g, S, E);
                if (wave == 0 && lane_now() == 0) { __builtin_amdgcn_fence(__ATOMIC_RELEASE, "agent"); asm volatile("s_waitcnt vmcnt(0)" ::: "memory"); (void)xb_add(qctr, 1u); }
            }
            { pg8::Gemm g{CKV, WUKT, KVL, KVL, KVL, 0, 0}; pg8::Order S{MP / 256, NH * NOPE / 256, 1, G, bx};
              pg8::EpiBf16<0> E{KB, NH * NOPE, 0, 256, 1.f, 0};
              pg8::gemm_phase<pg8::EpiBf16<0>, true>(lds, wave, g, S, E); }
            { pg8::Gemm g{WUVT, CKV, KVL, KVL, KVL, 0, 0}; pg8::Order S{NH * VD / 256, MP / 256, 1, G, bx};
              pg8::EpiBf16<0> E{VT, MP, 0, 256, 1.f, 0};
              pg8::gemm_phase<pg8::EpiBf16<0>, true>(lds, wave, g, S, E); }
            if (bx >= G - NQC) {
                if (wave == 0 && lane_now() == 0) { XB_SPIN(xb_ld(qctr) < (unsigned)NQP, ctl + 1024); __builtin_amdgcn_fence(__ATOMIC_ACQUIRE, "agent"); asm volatile("s_waitcnt vmcnt(0)" ::: "memory"); }
                __syncthreads();
                { pg8::Gemm g{Qb + (size_t)MP * NH * QKD, WUK, NH * QKD, NH * NOPE, NOPE, QKD, NOPE}; pg8::Order S{MS / 256, 1, NH, NQC, bx - (G - NQC)};
                  pg8::EpiBf16<0> E{QLAT, NH * 320, 320, 256, 1.f, 0};
                  pg8::gemm_phase<pg8::EpiBf16<0>, true>(lds, wave, g, S, E); }
                const int lane = lane_now(), tid = wave * 64 + lane;
                for (int i = (bx - (G - NQC)) * (NWAVES * 64) + tid; i < MS * NH * 8; i += NQC * NWAVES * 64) { const int c = i & 7, th = i >> 3;
                    *(u32x4*)(QLAT + (size_t)th * 320 + 256 + c * 8) = *(const u32x4*)(Qb + (size_t)(MP + (th >> 3)) * (NH * QKD) + (th & 7) * QKD + NOPE + c * 8); }
            }
            GRID_BAR();
        }

        {
            for (int p = vcu; p < NB * NH * 4; p += G) { const int bh = p >> 2, x = p & 3;
                pat::unit(lds, wave, Qb, KB, KPEP, VT, Ob, bh >> 3, bh & 7, 7 - x);
                pat::unit(lds, wave, Qb, KB, KPEP, VT, Ob, bh >> 3, bh & 7, x); }
            STAMP();
            for (int u = bx; u < DECB * 2; u += G)
                sat::unit(lds, wave, QLAT, cache_ckv, cache_kpe, page_table, CKV + (size_t)MP * KVL, KPES, OPART, OML, u >> 1, u & 1);
            GRID_BAR();
        }
        {
            const int lane = lane_now(), tid = wave * 64 + lane; (void)tid;
            for (int r = gw; r < DECB * 64; r += NGW) { const int b = r >> 6, q = r & 63;
                const f32x2 ml0 = *(const f32x2*)(OML + ((size_t)(b * 2) * 64 + q) * 2), ml1 = *(const f32x2*)(OML + ((size_t)(b * 2 + 1) * 64 + q) * 2);
                const float mm = fmaxf(ml0[0], ml1[0]), w0 = __builtin_amdgcn_exp2f(ml0[0] - mm), w1 = __builtin_amdgcn_exp2f(ml1[0] - mm), inv = 1.0f / (ml0[1] * w0 + ml1[1] * w1);
                const f32x4 a = *(const f32x4*)(OPART + ((size_t)(b * 2) * 64 + q) * KVL + 4 * lane), c = *(const f32x4*)(OPART + ((size_t)(b * 2 + 1) * 64 + q) * KVL + 4 * lane);
                const f32x4 v = (a * w0 + c * w1) * inv;
                u32x2 w; w.x = cvt_pk_bf16(v[0], v[1]); w.y = cvt_pk_bf16(v[2], v[3]);
                *(u32x2*)(OLAT + (size_t)r * KVL + 4 * lane) = w; }
            GRID_BAR();
        }
        {
            pg8::Gemm g{OLAT, WUVT, NH * KVL, KVL, KVL, KVL, (long)VD * KVL}; pg8::Order S{MS / 256, 1, NH, G, bx};
            pg8::EpiBf16<0> E{Ob + (size_t)MP * DM, DM, VD, 128, 1.f, 0};
            pg8::gemm_phase<pg8::EpiBf16<0>, true>(lds, wave, g, S, E);
            GRID_BAR();
        }
        {
            { pg8::Gemm g{Ob, WOT, DM, DM, DM, 0, 0}; pg8::Order S{MP / 256, DM / 256, 1, G, bx};
              pg8::EpiBf16<0> E{T, DM, 0, 256, 1.f, 0};
              pg8::gemm_phase<pg8::EpiBf16<0>, true>(lds, wave, g, S, E); }
            { pg8::Gemm g{Ob + (size_t)MP * DM, WOT, DM, DM, 256, 256, 256}; pg8::Order S{MS / 256, DM / 256, 4, G, bx};
              pg8::EpiF32 E{TP, DM, (long)MS * DM};
              pg8::gemm_phase<pg8::EpiF32, true>(lds, wave, g, S, E); }
            GRID_BAR();
        }
        {
            thin_phase<true, true, false, false>(gw, NGW, nullptr, nullptr, T, TP, 4, H, nullptr, XN, norm_g + 3 * DM, norm_g + 4 * DM, 1.0f);
            GRID_BAR();
        }


    FFN_GEMMS(1);
    thin_phase<true, true, false, false>(gw, NGW, nullptr, nullptr, T, TP, 11, H, nullptr, XN, ng + 5 * DM, norm_g + 6 * DM, 0.5f); GRID_BAR();
    }
    { const float* ng = norm_g + 6 * DM;
    FFN_GEMMS(2);
    thin_phase<true, true, false, false>(gw, NGW, nullptr, nullptr, T, TP, 11, H, nullptr, XN, ng + 1 * DM, ng + 2 * DM, 0.5f); GRID_BAR();
            { pg8::Gemm g{XN, WGIN, DM, DM, DM, 0, 0}; pg8::Order S{M / 256, GIN_P / 256, 1, G, bx};
              pg8::EpiGla E{QKVG, T16, 0.08838834764831845f};
              pg8::gemm_phase<pg8::EpiGla, true>(lds, wave, g, S, E);
              GRID_BAR(); }
            bf16_t* GQT = (bf16_t*)(ws + WS_GQT); bf16_t* GKH = (bf16_t*)(ws + WS_GKH); bf16_t* GAT = (bf16_t*)(ws + WS_GAT); float* GDK_ = (float*)(ws + WS_GDK);
            { for (int u = bx; u < (M / 64) * GH; u += G) { const int chunk = u >> 2, h = u & 3;
                  if (chunk < MP / 64) gla::prep<64>(lds, wave, QKVG, T16, gla_w_gk2, gla_b_gk, chunk, h, GQT, GKH, GAT, GDK_);
                  else gla::prep<8>(lds, wave, QKVG, T16, gla_w_gk2, gla_b_gk, chunk, h, GQT, GKH, GAT, GDK_); }
              GRID_BAR(); }
            { const int NPB = (G >= 2 * NB * GH * 2) ? NB * GH * 2 : 0;
              if (NPB == 0 || vcu < NPB) {
                  for (int u = vcu; u < NB * GH * 2; u += (NPB ? NPB : G)) { const int bh = u >> 1, q = u & 1, b = bh >> 2, h = bh & 3;
                      gla::chain<4>(lds, wave, GQT, GKH, GAT, GDK_, QKVG, h, b * (SEQ / 64), SEQ / 64, 0, 64, -1, 0, 128 * q, nullptr, out + OUT_ST_P + (size_t)bh * GDK * GDV, GO); } }
              if (NPB == 0 || vcu >= NPB) {
                  for (int u = (NPB ? vcu - NPB : vcu); u < DECB * GH; u += (NPB ? G - NPB : G)) { const int b = u >> 2, h = u & 3;
                      gla::chain<8>(lds, wave, GQT, GKH, GAT, GDK_, QKVG, h, MP / 64 + (b >> 3), 1, 8 * (b & 7), 8, b & 7, b & 7, 0, state_gla + (size_t)u * GDK * GDV, out + OUT_ST_S + (size_t)u * GDK * GDV, GO); } }
              GRID_BAR(); }
            { const int lane = lane_now(), tid = wave * 64 + lane; (void)tid; const f32x4 gn = *(const f32x4*)(gla_g_norm + 4 * lane);
              for (int r = gw; r < M; r += NGW) {
                  Row16 o = ld_row_bf16(GO + (size_t)r * DM, lane);
                  const u32x2* gp = (const u32x2*)(QKVG + (size_t)r * GIN + 2 * GH * GDK + GH * GDV) + lane;
#pragma unroll
                  for (int j = 0; j < 4; ++j) { const u32x2 gw2 = gp[64 * j];
                      const float ss = wave_sum((o.v[j][0] * o.v[j][0] + o.v[j][1] * o.v[j][1]) + (o.v[j][2] * o.v[j][2] + o.v[j][3] * o.v[j][3]));
                      const float rs = __builtin_amdgcn_rsqf(ss * (1.0f / GDV) + EPS);
                      const float g0 = __uint_as_float(gw2.x << 16), g1 = __uint_as_float(gw2.x & 0xffff0000u), g2 = __uint_as_float(gw2.y << 16), g3 = __uint_as_float(gw2.y & 0xffff0000u);
                      o.v[j][0] = o.v[j][0] * rs * gn[0] * pg8::silu_f(g0); o.v[j][1] = o.v[j][1] * rs * gn[1] * pg8::silu_f(g1);
                      o.v[j][2] = o.v[j][2] * rs * gn[2] * pg8::silu_f(g2); o.v[j][3] = o.v[j][3] * rs * gn[3] * pg8::silu_f(g3); }
                  st_row_bf16(XN + (size_t)r * DM, o, lane); }
              GRID_BAR(); }
            { { pg8::Gemm g{XN, WGO, DM, DM, DM, 0, 0}; pg8::Order S{MP / 256, DM / 256, 1, G, bx};
                pg8::EpiBf16<0> E{T, DM, 0, 256, 1.f, 0};
                pg8::gemm_phase<pg8::EpiBf16<0>, true>(lds, wave, g, S, E); }
              { pg8::Gemm g{XN + (size_t)MP * DM, WGO, DM, DM, 256, 256, 256}; pg8::Order S{MS / 256, DM / 256, 4, G, bx};
                pg8::EpiF32 E{TP, DM, (long)MS * DM};
                pg8::gemm_phase<pg8::EpiF32, true>(lds, wave, g, S, E); }
              GRID_BAR(); }
            { thin_phase<true, true, false, false>(gw, NGW, nullptr, nullptr, T, TP, 4, H, nullptr, XN, ng + 3 * DM, ng + 4 * DM, 1.0f);
              GRID_BAR(); }

    FFN_GEMMS(3);
    thin_phase<true, false, false, true>(gw, NGW, nullptr, nullptr, T, TP, 11, H, Y, XN, ng + 5 * DM, nullptr, 0.5f);
    }
#ifdef PROBE_A0
    GRID_BAR();
    {
        const int lane = lane_now(), tid = wave * 64 + lane;
        const float ta = (float)(tsb[PROBE_A1] - tsb[PROBE_A0]) * 0.01f, tb = (float)(tsb[PROBE_B1] - tsb[PROBE_B0]) * 0.01f;
        if (bx == 0 && tid == 0) out[0] += ta * 0.1f;
        const float f = 1.0f + tb * (1.0f / PROBE_BDIV);
        for (int i = bx * (NWAVES * 64) + tid; i < MS * ROPE; i += G * NWAVES * 64) out[OUT_KPE_S + i] *= f;
    }
#endif
#ifdef DBG_SCALE_MASK
    GRID_BAR();
    {
        const int lane = lane_now(), tid = wave * 64 + lane; (void)tid;
        const size_t offs[9] = {OUT_Y, OUT_Y + (size_t)MP * DM, OUT_CKV_P, OUT_KPE_P, OUT_CKV_S, OUT_KPE_S, OUT_ST_P, OUT_ST_S, OUT_END};
        for (int o = 0; o < 8; ++o) if ((DBG_SCALE_MASK >> o) & 1)
            for (size_t i = offs[o] / 4 + (size_t)vcu * (NWAVES * 64) + tid; i < offs[o + 1] / 4; i += (size_t)G * NWAVES * 64) ((f32x4*)out)[i] = ((f32x4*)out)[i] * 3.0f;
    }
#endif
#undef GRID_BAR
}

extern "C" void kernel_launch(void* const* d_in, const int* in_sizes, int n_in, void* d_out, int out_size, void* d_ws, size_t ws_size, hipStream_t stream) {
    static int grid = 0;
    if (grid == 0) {
        if (n_in != 22 || (size_t)out_size != OUT_END || ws_size < WS_END) { fprintf(stderr, "kernel_launch: unexpected shapes: n_in %d out %d ws %zu (need %zu)\n", n_in, out_size, ws_size, (size_t)WS_END); grid = -1; return; }
        int dev = 0, cus = 0, per_cu = 0;
        if (hipGetDevice(&dev) != hipSuccess || hipDeviceGetAttribute(&cus, hipDeviceAttributeMultiprocessorCount, dev) != hipSuccess) { grid = -1; return; }
        if (hipFuncSetAttribute((const void*)mk_fwd, hipFuncAttributeMaxDynamicSharedMemorySize, LDS_BYTES) != hipSuccess) { fprintf(stderr, "kernel_launch: hipFuncSetAttribute failed\n"); grid = -1; return; }
        if (hipOccupancyMaxActiveBlocksPerMultiprocessor(&per_cu, (const void*)mk_fwd, NWAVES * 64, LDS_BYTES) != hipSuccess || per_cu < 1) { fprintf(stderr, "kernel_launch: occupancy query says %d\n", per_cu); }
        (void)hipGetLastError();
        grid = cus;
    }
    if (grid < 0) return;
    if (hipMemsetAsync((char*)d_ws + WS_CTL, 0, CTL_ZERO_BYTES, stream) != hipSuccess) return;
    Args a{};
    for (int i = 0; i < 22; ++i) a.in[i] = d_in[i];
    a.out = (float*)d_out; a.ws = (unsigned char*)d_ws; a.ph_lo = 0; a.ph_hi = 100;
    hipLaunchKernelGGL(mk_fwd, dim3(grid), dim3(NWAVES * 64), LDS_BYTES, stream, a);
}
```

```cpp
#include <hip/hip_runtime.h>
#include <cstdio>
#include <cstdint>


#define GAS __attribute__((address_space(1)))
#define LAS __attribute__((address_space(3)))
typedef unsigned short bf16_t;
typedef short bf16x8 __attribute__((ext_vector_type(8)));
typedef float f32x4 __attribute__((ext_vector_type(4)));
typedef float f32x2 __attribute__((ext_vector_type(2)));
typedef float f32x16 __attribute__((ext_vector_type(16)));
typedef unsigned u32x4 __attribute__((ext_vector_type(4)));
typedef unsigned u32x2 __attribute__((ext_vector_type(2)));

constexpr int DM = 1024, NB = 16, SEQ = 2048, DECB = 128, DECT = 8, PAST = 8192, PAGE = 128, NPAGES = PAST / PAGE;
constexpr int MP = NB * SEQ, MS = DECB * DECT, M = MP + MS;
constexpr int DFF = 2816;
constexpr int QL = 384, KVL = 256, NOPE = 128, ROPE = 64, VD = 128, NH = 8, QKD = NOPE + ROPE;
constexpr int DDOWN = QL + KVL + ROPE, DDOWN_P = 768;
constexpr int GH = 4, GDK = 128, GDV = 256, GRANK = 16, GIN = 2 * GH * GDK + 2 * GH * GDV, GIN_P = GIN + 256;
constexpr float EPS = 1e-6f;
constexpr float LOG2E = 1.4426950408889634f;
constexpr int NPOOL = (DECB * NPAGES * 5) / 4;

constexpr size_t OUT_Y = 0;
constexpr size_t OUT_CKV_P = (size_t)M * DM;
constexpr size_t OUT_KPE_P = OUT_CKV_P + (size_t)MP * KVL;
constexpr size_t OUT_CKV_S = OUT_KPE_P + (size_t)MP * ROPE;
constexpr size_t OUT_KPE_S = OUT_CKV_S + (size_t)MS * KVL;
constexpr size_t OUT_ST_P = OUT_KPE_S + (size_t)MS * ROPE;
constexpr size_t OUT_ST_S = OUT_ST_P + (size_t)NB * GH * GDK * GDV;
constexpr size_t OUT_END = OUT_ST_S + (size_t)DECB * GH * GDK * GDV;

constexpr size_t MiB = 1u << 20;
constexpr size_t al(size_t x) { return (x + 4095) & ~(size_t)4095; }
constexpr size_t WS_CTL = 0, CTL_ZERO_BYTES = 64 * 1024;
constexpr size_t WS_ROPE = 1 * MiB;
constexpr size_t WS_WIN = 2 * MiB;
constexpr size_t SZ_WIN1 = (size_t)2 * DFF * DM * 2;
constexpr size_t WS_WOUT = WS_WIN + 4 * SZ_WIN1;
constexpr size_t SZ_WOUT1 = (size_t)DM * DFF * 2;
constexpr size_t WS_WDOWN = WS_WOUT + 4 * SZ_WOUT1;
constexpr size_t WS_WUQ = WS_WDOWN + (size_t)DDOWN_P * DM * 2;
constexpr size_t WS_WUKT = WS_WUQ + (size_t)NH * QKD * QL * 2;
constexpr size_t WS_WUK = WS_WUKT + (size_t)NH * NOPE * KVL * 2;
constexpr size_t WS_WUVT = WS_WUK + (size_t)NH * NOPE * KVL * 2;
constexpr size_t WS_WOT = WS_WUVT + (size_t)(NH * VD + 128) * KVL * 2;
constexpr size_t WS_WGIN = WS_WOT + (size_t)DM * DM * 2;
constexpr size_t WS_WGO = WS_WGIN + (size_t)GIN_P * DM * 2;
constexpr size_t WS_ACT = al(WS_WGO + (size_t)DM * DM * 2);
constexpr size_t WS_XN = WS_ACT;
constexpr size_t WS_HM = al(WS_XN + (size_t)M * DM * 2);
constexpr size_t WS_T = al(WS_HM + (size_t)M * DFF * 2);
constexpr size_t WS_D = al(WS_T + (size_t)M * DM * 4);
constexpr size_t WS_CQ = al(WS_D + (size_t)M * DDOWN_P * 4);
constexpr size_t WS_CKV = al(WS_CQ + (size_t)M * QL * 2);
constexpr size_t WS_KPES = al(WS_CKV + (size_t)M * KVL * 2);
constexpr size_t WS_Q = al(WS_KPES + (size_t)MS * ROPE * 2);
constexpr size_t WS_KB = al(WS_Q + (size_t)M * NH * QKD * 2);
constexpr size_t WS_KPEP = al(WS_KB + (size_t)MP * NH * NOPE * 2);
constexpr size_t WS_VT = al(WS_KPEP + (size_t)MP * ROPE * 2);
constexpr size_t WS_QLAT = al(WS_VT + (size_t)NH * VD * MP * 2);
constexpr size_t WS_O = al(WS_QLAT + (size_t)MS * NH * 320 * 2);
constexpr size_t WS_OPART = al(WS_O + (size_t)M * DM * 2);
constexpr size_t WS_OML = al(WS_OPART + (size_t)DECB * 2 * 64 * 256 * 4);
constexpr size_t WS_OLAT = al(WS_OML + (size_t)DECB * 2 * 64 * 2 * 4);
constexpr size_t WS_QKVG = al(WS_OLAT + (size_t)MS * NH * KVL * 2);
constexpr size_t WS_T16 = al(WS_QKVG + (size_t)M * GIN * 2);
constexpr size_t WS_GO = al(WS_T16 + (size_t)M * 16 * 4);
constexpr size_t WS_H = al(WS_GO + (size_t)M * DM * 4);
constexpr size_t WS_TP = al(WS_H + (size_t)M * DM * 2);
constexpr size_t WS_GQT = al(WS_TP + (size_t)11 * MS * DM * 4);
constexpr size_t WS_GKH = al(WS_GQT + (size_t)M * GH * GDK * 2);
constexpr size_t WS_GAT = al(WS_GKH + (size_t)(M / 64) * GH * 128 * 64 * 2);
constexpr size_t WS_GDK = al(WS_GAT + (size_t)(M / 64) * GH * 3072 * 2);
constexpr size_t WS_END = al(WS_GDK + (size_t)(M / 64) * GH * 1024 * 4);

constexpr int RING_BYTES = 131072;
constexpr int LDSCTL_OFF = RING_BYTES, MISC_OFF = LDSCTL_OFF + 320;
constexpr int LDS_BYTES = 147456;
constexpr int NWAVES = 8;

#define LDS_WAIT() asm volatile("s_waitcnt lgkmcnt(0)" ::: "memory")
#define VM_WAIT() asm volatile("s_waitcnt vmcnt(0)" ::: "memory")
#define RLX_AGENT __ATOMIC_RELAXED, __HIP_MEMORY_SCOPE_AGENT

typedef __bf16 bf16x2_t __attribute__((ext_vector_type(2)));
__device__ __forceinline__ unsigned cvt_pk_bf16(float lo, float hi) { const f32x2 v = {lo, hi}; const bf16x2_t b = __builtin_convertvector(v, bf16x2_t); return __builtin_bit_cast(unsigned, b); }
__device__ __forceinline__ int lane_now() { int l; asm volatile("v_mbcnt_lo_u32_b32 %0, -1, 0\n\tv_mbcnt_hi_u32_b32 %0, -1, %0" : "=v"(l)); return l; }
__device__ __forceinline__ float bf2f(unsigned short b) { return __uint_as_float((unsigned)b << 16); }
template <int CTRL> __device__ __forceinline__ float dpp_mov(float v) { return __builtin_bit_cast(float, __builtin_amdgcn_update_dpp(0, __builtin_bit_cast(int, v), CTRL, 0xF, 0xF, true)); }
__device__ __forceinline__ float wave_sum(float v) {
    v += dpp_mov<0xB1>(v);
    v += dpp_mov<0x4E>(v);
    v += dpp_mov<0x141>(v);
    v += dpp_mov<0x140>(v);
    const int iv = __builtin_bit_cast(int, v);
    const float a = __builtin_bit_cast(float, __builtin_amdgcn_readlane(iv, 0)), b = __builtin_bit_cast(float, __builtin_amdgcn_readlane(iv, 16));
    const float c = __builtin_bit_cast(float, __builtin_amdgcn_readlane(iv, 32)), d = __builtin_bit_cast(float, __builtin_amdgcn_readlane(iv, 48));
    return (a + b) + (c + d);
}

namespace pg8 {
constexpr int BM = 256, BK = 64, HALF = 128, HTB = HALF * BK * 2, STAGE_BYTES = 8 * HTB, NXCD = 8, WGM = 8;
__host__ __device__ __forceinline__ int lds_byte(int r, int c) { const int st = (r >> 4) * 2 + (c >> 5), rr = r & 15, cc = c & 31, ob = rr * 64 + cc * 2; return st * 1024 + (ob ^ (((ob >> 9) & 1) << 5)); }
__host__ __device__ __forceinline__ void stage_rc(int b, int& R, int& C) { const int st = b / 1024, sb = b % 1024, swz = sb ^ (((sb >> 9) & 1) << 5); R = (st >> 1) * 16 + swz / 64; C = (st & 1) * 32 + (swz % 64) / 2; }
__host__ __device__ __forceinline__ int perm32(int rho) { const int n = rho >> 4, i = rho & 15; return 8 * (i >> 2) + 4 * n + (i & 3); }

struct Unit { int pm, pn, z; };
struct Gemm { const bf16_t* A; const bf16_t* Bt; int lda, ldb, K; long sAz, sBz; };

struct Order {
    int nM, nN, nZ, G, c;
    __device__ __forceinline__ bool next(int i, Unit& u) const {
        const long L = (long)i * G + c; const int per = nM * nN; if (L >= (long)per * nZ) return false;
        const int z = (int)(L / per); int wgid = (int)(L - (long)z * per);
        { const int q = per / NXCD, r = per % NXCD, xcd = wgid % NXCD, off = wgid / NXCD; wgid = (xcd < r ? xcd * (q + 1) : r * (q + 1) + (xcd - r) * q) + off; }
        const int nig = WGM * nN, gid = wgid / nig, fm = gid * WGM, gsz = (nM - fm) < WGM ? (nM - fm) : WGM;
        u.pm = fm + ((wgid % nig) % gsz); u.pn = (wgid % nig) / gsz; u.z = z; return true;
    }
};

struct OrderOff {
    Order o; int m0;
    __device__ __forceinline__ bool next(int i, Unit& u) const { const bool ok = o.next(i, u); u.pm += m0; return ok; }
};

template <class Epi, bool ALIGN_EPI, class Ord = Order>
__device__ __forceinline__ void gemm_phase(LAS unsigned char* lds, const int wid, const Gemm g, const Ord& S, const Epi& E) {
    const int lane = lane_now(), tid = wid * 64 + lane;
    const int wr = wid >> 2, wc = wid & 3, fr = lane & 15, fq = lane >> 4;
    const int K = g.K, nt = K / BK;
    unsigned voffA, voffB;
    { int R, C; stage_rc(tid * 16, R, C); const int Rb = Epi::PERM ? ((R & ~31) + perm32(R & 31)) : R;
      voffA = (unsigned)(R * g.lda + C) * 2u; voffB = (unsigned)(Rb * g.ldb + C) * 2u; }
    const size_t qsA = (size_t)64 * g.lda * 2, qsB = (size_t)64 * g.ldb * 2;
    const size_t kstep = (size_t)(BK * 2);
    const size_t hsA = (size_t)HALF * g.lda * 2, hsB = (size_t)HALF * g.ldb * 2;
    const unsigned ldsw = (unsigned)wid * 1024u;
    const int aoff = lds_byte(wr * 64 + fr, fq * 8), boff = lds_byte(wc * 32 + fr, fq * 8);
#define PG8_SA(b, h) (((b) * 2 + (h)) * HTB)
#define PG8_SB(b, h) ((4 + (b) * 2 + (h)) * HTB)
#define PG8_STAGE(bufoff, gbase, voff) do { _Pragma("unroll") for (int _i = 0; _i < 2; ++_i) \
        __builtin_amdgcn_global_load_lds((const unsigned*)((const char*)(gbase) + _i * PG8_QS_##voff + (voff)), (LAS unsigned*)(lds + (bufoff) + ldsw + _i * 8192), 16, 0, 0); } while (0)
#define PG8_QS_voffA qsA
#define PG8_QS_voffB qsB
#define PG8_LDA(dst, b, h) do { _Pragma("unroll") for (int m = 0; m < 4; ++m) _Pragma("unroll") for (int k = 0; k < 2; ++k) dst[m][k] = *(const LAS bf16x8*)(lds + PG8_SA(b, h) + aoff + m * 2048 + k * 1024); } while (0)
#define PG8_LDB(dst, b, h) do { _Pragma("unroll") for (int n = 0; n < 2; ++n) _Pragma("unroll") for (int k = 0; k < 2; ++k) dst[n][k] = *(const LAS bf16x8*)(lds + PG8_SB(b, h) + boff + n * 2048 + k * 1024); } while (0)
#define PG8_MMA(ai, bj, At, Bt) do { __builtin_amdgcn_s_setprio(1); _Pragma("unroll") for (int m = 0; m < 4; ++m) _Pragma("unroll") for (int n = 0; n < 2; ++n) _Pragma("unroll") for (int k = 0; k < 2; ++k) \
        acc[ai][bj][m][n] = __builtin_amdgcn_mfma_f32_16x16x32_bf16(Bt[n][k], At[m][k], acc[ai][bj][m][n], 0, 0, 0); __builtin_amdgcn_s_setprio(0); } while (0)
#define PG8_WAIT_V(n) asm volatile("s_waitcnt vmcnt(" #n ")" ::: "memory")
#define PG8_WAIT_L(n) asm volatile("s_waitcnt lgkmcnt(" #n ")" ::: "memory")
#define PG8_BAR __builtin_amdgcn_s_barrier()
#define PG8_SCHED __builtin_amdgcn_sched_barrier(0)
#define PG8_APTR(u) ((const char*)g.A + ((size_t)(u).z * g.sAz + (size_t)(u).pm * BM * g.lda) * 2)
#define PG8_BPTR(u) ((const char*)g.Bt + ((size_t)(u).z * g.sBz + (size_t)(u).pn * BM * g.ldb) * 2)
    Unit cur, nxt; int ui = 0;
    if (!S.next(0, cur)) return;
    f32x4 acc[2][2][4][2];
#pragma unroll
    for (int a = 0; a < 2; ++a)
#pragma unroll
        for (int b = 0; b < 2; ++b)
#pragma unroll
            for (int m = 0; m < 4; ++m)
#pragma unroll
                for (int n = 0; n < 2; ++n) acc[a][b][m][n] = (f32x4){0.f, 0.f, 0.f, 0.f};
    bf16x8 At[4][2], B0[2][2], B1[2][2];
    const char* cA = PG8_APTR(cur); const char* cB = PG8_BPTR(cur);
    PG8_STAGE(PG8_SB(0, 0), cB, voffB); PG8_STAGE(PG8_SB(0, 1), cB + hsB, voffB); PG8_STAGE(PG8_SA(0, 0), cA, voffA); PG8_STAGE(PG8_SA(0, 1), cA + hsA, voffA);
    if (wr == 1) PG8_BAR;
    PG8_WAIT_V(2); PG8_BAR;
    PG8_STAGE(PG8_SB(1, 0), cB + kstep, voffB); PG8_STAGE(PG8_SA(1, 0), cA + kstep, voffA); PG8_STAGE(PG8_SB(1, 1), cB + hsB + kstep, voffB);
    PG8_WAIT_V(6); PG8_BAR;
    for (;;) {
        const bool has_next = S.next(ui + 1, nxt);
        const char* nA = has_next ? PG8_APTR(nxt) : cA; const char* nB = has_next ? PG8_BPTR(nxt) : cB;
#pragma unroll 1
        for (int t = 0; t < nt; t += 2) {
            const bool last = (t == nt - 2);
            const char* a1 = cA + (size_t)(t + 1) * kstep;
            const char* a2 = last ? nA : cA + (size_t)(t + 2) * kstep; const char* b2 = last ? nB : cB + (size_t)(t + 2) * kstep;
            const char* a3 = a2 + kstep; const char* b3 = b2 + kstep;
            PG8_LDB(B0, 0, 0); PG8_LDB(B1, 0, 1); PG8_SCHED; PG8_LDA(At, 0, 0); PG8_STAGE(PG8_SA(1, 1), a1 + hsA, voffA);
            PG8_WAIT_V(8); PG8_WAIT_L(0); PG8_BAR; PG8_MMA(0, 0, At, B0); PG8_MMA(0, 1, At, B1); PG8_BAR; PG8_SCHED;
            PG8_LDA(At, 0, 1); PG8_STAGE(PG8_SB(0, 0), b2, voffB); PG8_STAGE(PG8_SB(0, 1), b2 + hsB, voffB); PG8_STAGE(PG8_SA(0, 0), a2, voffA);
            PG8_WAIT_V(8); PG8_WAIT_L(0); PG8_BAR; PG8_MMA(1, 0, At, B0); PG8_MMA(1, 1, At, B1); PG8_BAR; PG8_SCHED;
            PG8_LDB(B0, 1, 0); PG8_LDB(B1, 1, 1); PG8_SCHED; PG8_LDA(At, 1, 0); PG8_STAGE(PG8_SA(0, 1), a2 + hsA, voffA);
            PG8_WAIT_V(8); PG8_WAIT_L(0); PG8_BAR; PG8_MMA(0, 0, At, B0); PG8_MMA(0, 1, At, B1); PG8_BAR; PG8_SCHED;
            PG8_LDA(At, 1, 1); PG8_STAGE(PG8_SB(1, 0), b3, voffB); PG8_STAGE(PG8_SB(1, 1), b3 + hsB, voffB); PG8_STAGE(PG8_SA(1, 0), a3, voffA);
            PG8_WAIT_V(8); PG8_WAIT_L(0); PG8_BAR; PG8_MMA(1, 0, At, B0); PG8_MMA(1, 1, At, B1); PG8_BAR; PG8_SCHED;
        }
        if constexpr (ALIGN_EPI) { if (wr == 0) PG8_BAR; }
        { int fr2 = fr, fq2 = fq; asm volatile("" : "+v"(fr2), "+v"(fq2)); E(acc, cur, wr, wc, fr2, fq2); }
        if (!has_next) break;
#pragma unroll
        for (int a = 0; a < 2; ++a)
#pragma unroll
            for (int b = 0; b < 2; ++b)
#pragma unroll
                for (int m = 0; m < 4; ++m)
#pragma unroll
                    for (int n = 0; n < 2; ++n) acc[a][b][m][n] = (f32x4){0.f, 0.f, 0.f, 0.f};
        cur = nxt; cA = nA; cB = nB; ++ui;
        if constexpr (ALIGN_EPI) { if (wr == 1) PG8_BAR; }
    }
    PG8_WAIT_V(0);
    if constexpr (!ALIGN_EPI) { if (wr == 0) PG8_BAR; }
    PG8_BAR;
#undef PG8_SA
#undef PG8_SB
#undef PG8_STAGE
#undef PG8_QS_voffA
#undef PG8_QS_voffB
#undef PG8_LDA
#undef PG8_LDB
#undef PG8_MMA
#undef PG8_WAIT_V
#undef PG8_WAIT_L
#undef PG8_BAR
#undef PG8_SCHED
#undef PG8_APTR
#undef PG8_BPTR
}

__device__ __forceinline__ float silu_f(float g) { return g * __builtin_amdgcn_rcpf(1.0f + __builtin_amdgcn_exp2f(-g * LOG2E)); }
__device__ __forceinline__ float swiglu_f(float g, float u) { return (g * u) * __builtin_amdgcn_rcpf(1.0f + __builtin_amdgcn_exp2f(-g)); }

struct EpiSwiGLU {
    static constexpr bool PERM = true;
    bf16_t* O; int ldc;
    __device__ __forceinline__ void operator()(const f32x4 (&acc)[2][2][4][2], const Unit& u, int wr, int wc, int fr, int fq) const {
        const int row0 = u.pm * BM + wr * 64 + fr, col0 = u.pn * HALF + wc * 32 + 8 * fq;
#pragma unroll
        for (int ai = 0; ai < 2; ++ai)
#pragma unroll
            for (int m = 0; m < 4; ++m) {
                bf16_t* rowp = O + (size_t)(row0 + ai * HALF + m * 16) * ldc + col0;
                const f32x4 g0 = acc[ai][0][m][0], g1 = acc[ai][0][m][1], u0 = acc[ai][1][m][0], u1 = acc[ai][1][m][1];
                u32x4 w;
                w.x = cvt_pk_bf16(swiglu_f(g0[0], u0[0]), swiglu_f(g0[1], u0[1])); w.y = cvt_pk_bf16(swiglu_f(g0[2], u0[2]), swiglu_f(g0[3], u0[3]));
                w.z = cvt_pk_bf16(swiglu_f(g1[0], u1[0]), swiglu_f(g1[1], u1[1])); w.w = cvt_pk_bf16(swiglu_f(g1[2], u1[2]), swiglu_f(g1[3], u1[3]));
                *(u32x4*)rowp = w;
            }
    }
};
struct EpiF32 {
    static constexpr bool PERM = false;
    float* O; int ldc; long sOz;
    __device__ __forceinline__ void operator()(const f32x4 (&acc)[2][2][4][2], const Unit& u, int wr, int wc, int fr, int fq) const {
        const int row0 = u.pm * BM + wr * 64 + fr, col0 = u.pn * BM + wc * 32 + 4 * fq;
#pragma unroll
        for (int ai = 0; ai < 2; ++ai)
#pragma unroll
            for (int m = 0; m < 4; ++m) {
                float* rowp = O + (size_t)u.z * sOz + (size_t)(row0 + ai * HALF + m * 16) * ldc + col0;
#pragma unroll
                for (int bj = 0; bj < 2; ++bj)
#pragma unroll
                    for (int n = 0; n < 2; ++n) *(f32x4*)(rowp + bj * HALF + n * 16) = acc[ai][bj][m][n];
            }
    }
};

template <int CMAP> struct EpiBf16 {
    static constexpr bool PERM = true;
    bf16_t* O; int ldc; long sOz; int ncol; float scale; int scale_cols;
    __device__ __forceinline__ void operator()(const f32x4 (&acc)[2][2][4][2], const Unit& u, int wr, int wc, int fr, int fq) const {
        const int row0 = u.pm * BM + wr * 64 + fr;
#pragma unroll
        for (int bj = 0; bj < 2; ++bj) {
            const int ct = bj * HALF + wc * 32 + 8 * fq; if (ct >= ncol) continue;
            const int c0 = u.pn * BM + ct; const int oc = CMAP == 1 ? (c0 >> 7) * 192 + (c0 & 127) : c0;
            const float sc = c0 < scale_cols ? scale : 1.f;
            bf16_t* base = O + (size_t)u.z * sOz + oc;
#pragma unroll
            for (int ai = 0; ai < 2; ++ai)
#pragma unroll
                for (int m = 0; m < 4; ++m) { const f32x4 v0 = acc[ai][bj][m][0] * sc, v1 = acc[ai][bj][m][1] * sc;
                    u32x4 w; w.x = cvt_pk_bf16(v0[0], v0[1]); w.y = cvt_pk_bf16(v0[2], v0[3]); w.z = cvt_pk_bf16(v1[0], v1[1]); w.w = cvt_pk_bf16(v1[2], v1[3]);
                    *(u32x4*)(base + (size_t)(row0 + ai * HALF + m * 16) * ldc) = w; }
        }
    }
};
struct EpiQ {
    static constexpr bool PERM = true;
    bf16_t* O; const float* rope_t; float scale;
    __device__ __forceinline__ void operator()(const f32x4 (&acc)[2][2][4][2], const Unit& u, int wr, int wc, int fr, int fq) const {
        const int row0 = u.pm * BM + wr * 64 + fr;
#pragma unroll
        for (int bj = 0; bj < 2; ++bj) {
            const int c0 = u.pn * BM + bj * HALF + wc * 32 + 8 * fq; const int h = c0 / 192, f0 = c0 - h * 192;
            if (f0 < 128) {
#pragma unroll
                for (int ai = 0; ai < 2; ++ai)
#pragma unroll
                    for (int m = 0; m < 4; ++m) { const f32x4 v0 = acc[ai][bj][m][0] * scale, v1 = acc[ai][bj][m][1] * scale;
                        u32x4 w; w.x = cvt_pk_bf16(v0[0], v0[1]); w.y = cvt_pk_bf16(v0[2], v0[3]); w.z = cvt_pk_bf16(v1[0], v1[1]); w.w = cvt_pk_bf16(v1[2], v1[3]);
                        *(u32x4*)(O + (size_t)(row0 + ai * HALF + m * 16) * 1536 + c0) = w; }
            } else {
                const int a4 = ((f0 - 128) >> 3) * 4;
#pragma unroll
                for (int ai = 0; ai < 2; ++ai)
#pragma unroll
                    for (int m = 0; m < 4; ++m) { const int r = row0 + ai * HALF + m * 16; const int pidx = r < MP ? (r & (SEQ - 1)) : SEQ + ((r - MP) & (DECT - 1));
                        const f32x4 cs0 = *(const f32x4*)(rope_t + (size_t)(pidx * 32 + a4) * 2), cs1 = *(const f32x4*)(rope_t + (size_t)(pidx * 32 + a4) * 2 + 4);
                        const f32x4 x1 = acc[ai][bj][m][0] * scale, x2 = acc[ai][bj][m][1] * scale;
                        const float y10 = x1[0] * cs0[0] - x2[0] * cs0[1], y11 = x1[1] * cs0[2] - x2[1] * cs0[3], y12 = x1[2] * cs1[0] - x2[2] * cs1[1], y13 = x1[3] * cs1[2] - x2[3] * cs1[3];
                        const float y20 = x2[0] * cs0[0] + x1[0] * cs0[1], y21 = x2[1] * cs0[2] + x1[1] * cs0[3], y22 = x2[2] * cs1[0] + x1[2] * cs1[1], y23 = x2[3] * cs1[2] + x1[3] * cs1[3];
                        bf16_t* rowp = O + (size_t)r * 1536 + h * 192 + 128 + a4;
                        u32x2 w1, w2; w1.x = cvt_pk_bf16(y10, y11); w1.y = cvt_pk_bf16(y12, y13); w2.x = cvt_pk_bf16(y20, y21); w2.y = cvt_pk_bf16(y22, y23);
                        *(u32x2*)rowp = w1; *(u32x2*)(rowp + 32) = w2; asm volatile("" ::: "memory"); }
            }
        }
    }
};

struct EpiGla {
    static constexpr bool PERM = true;
    bf16_t* O; float* T16; float qscale;
    __device__ __forceinline__ void operator()(const f32x4 (&acc)[2][2][4][2], const Unit& u, int wr, int wc, int fr, int fq) const {
        const int row0 = u.pm * BM + wr * 64 + fr;
        if (u.pn < 12) {
#pragma unroll
            for (int bj = 0; bj < 2; ++bj) {
                const int c0 = u.pn * BM + bj * HALF + wc * 32 + 8 * fq; const float sc = c0 < 512 ? qscale : 1.f;
#pragma unroll
                for (int ai = 0; ai < 2; ++ai)
#pragma unroll
                    for (int m = 0; m < 4; ++m) { const f32x4 v0 = acc[ai][bj][m][0] * sc, v1 = acc[ai][bj][m][1] * sc;
                        u32x4 w; w.x = cvt_pk_bf16(v0[0], v0[1]); w.y = cvt_pk_bf16(v0[2], v0[3]); w.z = cvt_pk_bf16(v1[0], v1[1]); w.w = cvt_pk_bf16(v1[2], v1[3]);
                        *(u32x4*)(O + (size_t)(row0 + ai * HALF + m * 16) * GIN + c0) = w; }
            }
        } else if (wc == 0 && fq < 2) {
#pragma unroll
            for (int ai = 0; ai < 2; ++ai)
#pragma unroll
                for (int m = 0; m < 4; ++m) { float* tp = T16 + (size_t)(row0 + ai * HALF + m * 16) * 16 + 8 * fq;
                    *(f32x4*)tp = acc[ai][0][m][0]; *(f32x4*)(tp + 4) = acc[ai][0][m][1]; }
        }
    }
};
}

#define XB_TMO      128
#define XB_XCNT(j)  (256  + 64 * (j))
#define XB_XSUB(j)  (1280 + 64 * (j))
#define XB_XGEN(j)  (2304 + 64 * (j))
#define XB_TOP      3328
#define XB_TOPGEN   3392
#define XCD_BAR_WORDS 3456
#define XB_SPIN_CAP (1u << 18)

__device__ __forceinline__ unsigned xb_ld(unsigned* p)              { return __hip_atomic_load(p, __ATOMIC_RELAXED, __HIP_MEMORY_SCOPE_AGENT); }
__device__ __forceinline__ unsigned xb_add(unsigned* p, unsigned v) { return __hip_atomic_fetch_add(p, v, __ATOMIC_RELAXED, __HIP_MEMORY_SCOPE_AGENT); }
__device__ __forceinline__ unsigned xb_xcc_id() { return (unsigned)__builtin_amdgcn_s_getreg((3 << 11) | 20) & 0xFu; }
#define XB_SPIN(cond, bar) do { unsigned _sp = 0; while (cond) { __builtin_amdgcn_s_sleep(1); \
    if ((++_sp & 255u) == 0u) { if (xb_ld(&(bar)[XB_TMO])) break; if (_sp > XB_SPIN_CAP) { atomicAdd(&(bar)[XB_TMO], 1u); break; } } } } while (0)

struct XcdBarrier { unsigned* bar; unsigned x; volatile LAS unsigned* st; };

__device__ __forceinline__ XcdBarrier xcd_barrier_post(unsigned* bar, volatile LAS unsigned* st, bool t0) {
    XcdBarrier b; b.bar = bar; b.x = xb_xcc_id(); b.st = st;
    if (t0) (void)xb_add(&bar[XB_XCNT(b.x)], 1u);
    return b;
}
__device__ __forceinline__ void xcd_barrier_complete(unsigned* bar, unsigned x, unsigned& nloc, unsigned& nx) {
    const unsigned G = gridDim.x * gridDim.y * gridDim.z;
    unsigned sum, cnt, mine, sp = 0u;
    for (;;) {
        sum = 0u; cnt = 0u; mine = 0u;
#pragma unroll
        for (unsigned j = 0; j < 16; ++j) { const unsigned c = xb_ld(&bar[XB_XCNT(j)]); sum += c; cnt += (c > 0u) ? 1u : 0u; mine = (j == x) ? c : mine; }
        if (sum == G) break;
        __builtin_amdgcn_s_sleep(1);
        if ((++sp & 255u) == 0u) { if (xb_ld(&bar[XB_TMO])) break; if (sp > XB_SPIN_CAP) { atomicAdd(&bar[XB_TMO], 1u); break; } }
    }
    nloc = mine > 0u ? mine : 1u; nx = cnt > 0u ? cnt : 1u;
}
__device__ __forceinline__ void xcd_barrier(const XcdBarrier& b, bool t0) {
    asm volatile("s_waitcnt vmcnt(0)" ::: "memory");
    __syncthreads();
    if (t0) {
        unsigned* bar = b.bar;
        __builtin_amdgcn_s_waitcnt(0);
        unsigned nloc = b.st[0], nx = b.st[1];
        if (nloc == 0u) { xcd_barrier_complete(bar, b.x, nloc, nx); b.st[0] = nloc; b.st[1] = nx; }
        const unsigned old = xb_add(&bar[XB_XSUB(b.x)], 1u);
        const unsigned gen = old / nloc;
        if (old + 1u == (gen + 1u) * nloc) {
            __builtin_amdgcn_fence(__ATOMIC_RELEASE, "agent");
            asm volatile("s_waitcnt vmcnt(0)" ::: "memory");
            const unsigned og = xb_add(&bar[XB_TOP], 1u);
            const unsigned tg = og / nx;
            if (og + 1u == (tg + 1u) * nx) xb_add(&bar[XB_TOPGEN], 1u);
            else XB_SPIN(xb_ld(&bar[XB_TOPGEN]) == tg, bar);
            __builtin_amdgcn_fence(__ATOMIC_ACQUIRE, "agent");
            xb_add(&bar[XB_XGEN(b.x)], 1u);
            asm volatile("s_waitcnt vmcnt(0)" ::: "memory");
        } else {
            XB_SPIN(xb_ld(&bar[XB_XGEN(b.x)]) == gen, bar);
            __builtin_amdgcn_fence(__ATOMIC_ACQUIRE, "agent");
            asm volatile("s_waitcnt vmcnt(0)" ::: "memory");
        }
    }
    __syncthreads();
}

struct Args { const void* in[22]; float* out; unsigned char* ws; int ph_lo, ph_hi; };

struct Frame {
    LAS unsigned char* lds;
    int tid, lane, wave, vcu, G;
    const float* const* dummy;
};

__device__ __forceinline__ void transpose_item(const float* W, int N, int k0, int n0, bf16_t* WT, int KT, int drow0, int interleave, LAS float* scr, int lane, float sc = 1.0f) {
    f32x4 v[8];
    const float* src = W + (size_t)(k0 + (lane >> 3)) * N + n0 + 4 * (lane & 7);
#pragma unroll
    for (int i = 0; i < 8; ++i) v[i] = *(const f32x4*)(src + (size_t)(8 * i) * N);
#pragma unroll
    for (int i = 0; i < 8; ++i) { LAS float* d = scr + (8 * i + (lane >> 3)) * 33 + 4 * (lane & 7); d[0] = v[i][0]; d[1] = v[i][1]; d[2] = v[i][2]; d[3] = v[i][3]; }
    LDS_WAIT(); asm volatile("" ::: "memory");
    const int c = lane & 7;
#pragma unroll
    for (int j = 0; j < 4; ++j) { const int n = (lane >> 3) + 8 * j; const LAS float* s = scr + (8 * c) * 33 + n;
        u32x4 o; o.x = cvt_pk_bf16(s[0 * 33] * sc, s[1 * 33] * sc); o.y = cvt_pk_bf16(s[2 * 33] * sc, s[3 * 33] * sc); o.z = cvt_pk_bf16(s[4 * 33] * sc, s[5 * 33] * sc); o.w = cvt_pk_bf16(s[6 * 33] * sc, s[7 * 33] * sc);
        const int drow = interleave ? (drow0 + 8 * (n >> 2) + (n & 3)) : (drow0 + n);
        *(u32x4*)(WT + (size_t)drow * KT + k0 + 8 * c) = o; }
    LDS_WAIT(); asm volatile("" ::: "memory");
}

struct ConvPtrs { const float *w_in, *w_out, *w_down, *w_uq, *w_uk, *w_uv, *w_o, *g_in, *g_o; bf16_t *WIN, *WOUT, *WDOWN, *WUQ, *WUKT, *WUVT, *WOT, *WGIN, *WGO; };
constexpr int I_WIN = (DM / 64) * (2 * DFF / 32);
constexpr int I_WOUT = (DFF / 64) * (DM / 32);
constexpr int I_DOWN = (DM / 64) * (DDOWN / 32);
constexpr int I_UQ = (QL / 64) * (NH * QKD / 32);
constexpr int I_UK = (KVL / 64) * (NH * NOPE / 32);
constexpr int I_UV = I_UK;
constexpr int I_O = (DM / 64) * (DM / 32);
constexpr int I_GIN = (DM / 64) * (GIN / 32);
constexpr int I_GO = I_O;
template <int SEG> __device__ __forceinline__ void conv_segment(const ConvPtrs& P, int widx, int nw, LAS float* scr, int lane) {
    constexpr int mi = SEG;
    constexpr int NIT = I_WIN + I_WOUT + (SEG == 1 ? I_DOWN + I_UQ + I_UK + I_UV + I_O : SEG == 2 ? I_GIN + I_GO : 0);
    for (int it = widx; it < NIT; it += nw) {
        int r = it;
        if (r < I_WIN) { const int nblk = 2 * DFF / 32, kb = r / nblk, nb = r % nblk, n0 = nb * 32;
            const int drow0 = n0 < DFF ? 256 * (n0 / 128) + (n0 % 128) : 256 * ((n0 - DFF) / 128) + 128 + ((n0 - DFF) % 128);
            transpose_item(P.w_in + (size_t)mi * DM * 2 * DFF, 2 * DFF, kb * 64, n0, P.WIN + (size_t)mi * 2 * DFF * DM, DM, drow0, 0, scr, lane, n0 < DFF ? LOG2E : 1.0f / LOG2E); continue; } r -= I_WIN;
        if (r < I_WOUT) { const int nblk = DM / 32, kb = r / nblk, nb = r % nblk;
            transpose_item(P.w_out + (size_t)mi * DFF * DM, DM, kb * 64, nb * 32, P.WOUT + (size_t)mi * DM * DFF, DFF, nb * 32, 0, scr, lane); continue; } r -= I_WOUT;
        if constexpr (SEG == 1) {
            if (r < I_DOWN) { const int nblk = DDOWN / 32, kb = r / nblk, nb = r % nblk;
                transpose_item(P.w_down, DDOWN, kb * 64, nb * 32, P.WDOWN, DM, nb * 32, 0, scr, lane); continue; } r -= I_DOWN;
            if (r < I_UQ) { const int nblk = NH * QKD / 32, kb = r / nblk, nb = r % nblk, n0 = nb * 32, h = n0 / QKD, f = n0 % QKD;
                if (f < NOPE) transpose_item(P.w_uq, NH * QKD, kb * 64, n0, P.WUQ, QL, n0, 0, scr, lane);
                else transpose_item(P.w_uq, NH * QKD, kb * 64, n0, P.WUQ, QL, h * QKD + NOPE + (f == NOPE ? 0 : 4), 1, scr, lane);
                continue; } r -= I_UQ;
            if (r < I_UK) { const int nblk = NH * NOPE / 32, kb = r / nblk, nb = r % nblk;
                transpose_item(P.w_uk, NH * NOPE, kb * 64, nb * 32, P.WUKT, KVL, nb * 32, 0, scr, lane); continue; } r -= I_UK;
            if (r < I_UV) { const int nblk = NH * VD / 32, kb = r / nblk, nb = r % nblk;
                transpose_item(P.w_uv, NH * VD, kb * 64, nb * 32, P.WUVT, KVL, nb * 32, 0, scr, lane); continue; } r -= I_UV;
            { const int nblk = DM / 32, kb = r / nblk, nb = r % nblk;
                transpose_item(P.w_o, DM, kb * 64, nb * 32, P.WOT, DM, nb * 32, 0, scr, lane); }
        }
        if constexpr (SEG == 2) {
            if (r < I_GIN) { const int nblk = GIN / 32, kb = r / nblk, nb = r % nblk;
                transpose_item(P.g_in, GIN, kb * 64, nb * 32, P.WGIN, DM, nb * 32, 0, scr, lane); continue; } r -= I_GIN;
            { const int nblk = DM / 32, kb = r / nblk, nb = r % nblk;
                transpose_item(P.g_o, DM, kb * 64, nb * 32, P.WGO, DM, nb * 32, 0, scr, lane); }
        }
    }
}

struct Row16 { f32x4 v[4]; };
__device__ __forceinline__ Row16 ld_row(const float* p, int lane) { Row16 r; const f32x4* q = (const f32x4*)p + lane;
#pragma unroll
    for (int j = 0; j < 4; ++j) r.v[j] = q[64 * j]; return r; }
__device__ __forceinline__ Row16 ld_row_bf16(const bf16_t* p, int lane) { Row16 r; const u32x2* q = (const u32x2*)p + lane;
#pragma unroll
    for (int j = 0; j < 4; ++j) { const u32x2 w = q[64 * j]; r.v[j][0] = __uint_as_float(w.x << 16); r.v[j][1] = __uint_as_float(w.x & 0xffff0000u); r.v[j][2] = __uint_as_float(w.y << 16); r.v[j][3] = __uint_as_float(w.y & 0xffff0000u); } return r; }
__device__ __forceinline__ float row_ss(const Row16& r) { float s = 0.f;
#pragma unroll
    for (int j = 0; j < 4; ++j) s += (r.v[j][0] * r.v[j][0] + r.v[j][1] * r.v[j][1]) + (r.v[j][2] * r.v[j][2] + r.v[j][3] * r.v[j][3]); return wave_sum(s); }
__device__ __forceinline__ void st_row_bf16(bf16_t* p, const Row16& r, int lane) { u32x2* q = (u32x2*)p + lane;
#pragma unroll
    for (int j = 0; j < 4; ++j) { u32x2 w; w.x = cvt_pk_bf16(r.v[j][0], r.v[j][1]); w.y = cvt_pk_bf16(r.v[j][2], r.v[j][3]); q[64 * j] = w; } }
__device__ __forceinline__ void st_row_f32(float* p, const Row16& r, int lane) { f32x4* q = (f32x4*)p + lane;
#pragma unroll
    for (int j = 0; j < 4; ++j) q[64 * j] = r.v[j]; }

template <bool HAS_T, bool HAS_PRE, bool SRC_X, bool FINAL>
__device__ __forceinline__ void thin_phase(int gw, int NGW, const float* xp, const float* xs, const bf16_t* T, const float* TP, int nsplit, bf16_t* H, float* Yout, bf16_t* XN, const float* gpost, const float* gpre, float scale) {
    const int lane = lane_now();
    Row16 gp, gq;
    if (HAS_T) gp = ld_row(gpost, lane);
    if (HAS_PRE) gq = ld_row(gpre, lane);
    for (int r = gw; r < M; r += NGW) {
        Row16 h;
        if constexpr (SRC_X) h = ld_row(r < MP ? xp + (size_t)r * DM : xs + (size_t)(r - MP) * DM, lane); else h = ld_row_bf16(H + (size_t)r * DM, lane);
        if (HAS_T) {
            Row16 t;
            if (r < MP) t = ld_row_bf16(T + (size_t)r * DM, lane);
            else { t = ld_row(TP + (size_t)(r - MP) * DM, lane);
                for (int z = 1; z < nsplit; ++z) { const Row16 u = ld_row(TP + ((size_t)z * MS + (r - MP)) * DM, lane);
#pragma unroll
                    for (int j = 0; j < 4; ++j) t.v[j] = t.v[j] + u.v[j]; } }
            const float rs = scale * __builtin_amdgcn_rsqf(row_ss(t) * (1.0f / DM) + EPS);
#pragma unroll
            for (int j = 0; j < 4; ++j) h.v[j] = h.v[j] + (t.v[j] * rs) * gp.v[j];
            if constexpr (FINAL) st_row_f32(Yout + (size_t)r * DM, h, lane); else st_row_bf16(H + (size_t)r * DM, h, lane);
        }
        if (HAS_PRE) {
            const float rs = __builtin_amdgcn_rsqf(row_ss(h) * (1.0f / DM) + EPS);
#pragma unroll
            for (int j = 0; j < 4; ++j) h.v[j] = (h.v[j] * rs) * gq.v[j];
            st_row_bf16(XN + (size_t)r * DM, h, lane);
        }
    }
}

__device__ __forceinline__ int rope_pos_index(int r) { return r < MP ? (r & (SEQ - 1)) : SEQ + ((r - MP) & (DECT - 1)); }


typedef short s16x4 __attribute__((ext_vector_type(4)));
__device__ __forceinline__ int swap23(int x) { return (x & ~12) | ((x & 4) << 1) | ((x & 8) >> 1); }
__device__ __forceinline__ float half_max(float v) { auto rr = __builtin_amdgcn_permlane32_swap(__float_as_uint(v), __float_as_uint(v), false, false); return fmaxf(__uint_as_float(rr[0]), __uint_as_float(rr[1])); }
__device__ __forceinline__ float half_sum(float v) { auto rr = __builtin_amdgcn_permlane32_swap(__float_as_uint(v), __float_as_uint(v), false, false); return __uint_as_float(rr[0]) + __uint_as_float(rr[1]); }
__device__ __forceinline__ bf16x8 pack8(const f32x16& p, int o) {
    u32x4 w; w.x = cvt_pk_bf16(p[o + 0], p[o + 1]); w.y = cvt_pk_bf16(p[o + 2], p[o + 3]); w.z = cvt_pk_bf16(p[o + 4], p[o + 5]); w.w = cvt_pk_bf16(p[o + 6], p[o + 7]);
    return __builtin_bit_cast(bf16x8, w);
}
template <int NO>
__device__ __forceinline__ void softmax_step(f32x16& p0, f32x16& p1, float& m, float& lh, f32x16 (&o)[NO], bf16x8 (&pf)[4]) {
    float pm = fmaxf(p0[0], p1[0]);
#pragma unroll
    for (int r = 1; r < 16; ++r) pm = fmaxf(pm, fmaxf(p0[r], p1[r]));
    pm = half_max(pm);
    const float mn = fmaxf(m, pm), alpha = __builtin_amdgcn_exp2f(m - mn); m = mn;
    float rs = 0.f;
#pragma unroll
    for (int r = 0; r < 16; ++r) { p0[r] = __builtin_amdgcn_exp2f(p0[r] - mn); p1[r] = __builtin_amdgcn_exp2f(p1[r] - mn); rs += p0[r] + p1[r]; }
    lh = lh * alpha + rs;
    if (!__all(alpha == 1.0f)) {
#pragma unroll
        for (int d = 0; d < NO; ++d) o[d] = o[d] * alpha;
    }
    pf[0] = pack8(p0, 0); pf[1] = pack8(p0, 8); pf[2] = pack8(p1, 0); pf[3] = pack8(p1, 8);
}

template <int NO>
__device__ __forceinline__ void softmax_step1(f32x16& p0, float& m, float& lh, f32x16 (&o)[NO], bf16x8 (&pf)[2]) {
    float pm = p0[0];
#pragma unroll
    for (int r = 1; r < 16; ++r) pm = fmaxf(pm, p0[r]);
    pm = half_max(pm);
    const float mn = fmaxf(m, pm), alpha = __builtin_amdgcn_exp2f(m - mn); m = mn;
    float rs = 0.f;
#pragma unroll
    for (int r = 0; r < 16; ++r) { p0[r] = __builtin_amdgcn_exp2f(p0[r] - mn); rs += p0[r]; }
    lh = lh * alpha + rs;
    if (!__all(alpha == 1.0f)) {
#pragma unroll
        for (int d = 0; d < NO; ++d) o[d] = o[d] * alpha;
    }
    pf[0] = pack8(p0, 0); pf[1] = pack8(p0, 8);
}

namespace pat {
constexpr int KROW = 400, VROW = 144, KTILE = 64 * KROW, VTILE = 128 * VROW;
__device__ __forceinline__ void unit(LAS unsigned char* lds, const int wave, const bf16_t* Q, const bf16_t* KB, const bf16_t* KPE, const bf16_t* VT, bf16_t* O, int b, int h, int qb) {
    const int lane = lane_now(), tid = wave * 64 + lane, ql = lane & 31, hh = lane >> 5;
    const int q0 = b * SEQ + qb * 256 + 32 * wave;
    bf16x8 qf[12];
    { const bf16_t* qp = Q + (size_t)(q0 + ql) * (NH * QKD) + h * QKD + hh * 8;
#pragma unroll
      for (int ks = 0; ks < 12; ++ks) qf[ks] = *(const bf16x8*)(qp + ks * 16); }
    f32x16 o[4];
#pragma unroll
    for (int d = 0; d < 4; ++d)
#pragma unroll
        for (int r = 0; r < 16; ++r) o[d][r] = 0.f;
    float m = -1e30f, lh = 0.f;
    const int ntiles = 4 * (qb + 1);
    int krow[3], kcc[3]; unsigned koff[3];
#pragma unroll
    for (int i = 0; i < 3; ++i) { const int c = tid + 512 * i; krow[i] = c / 24; kcc[i] = c % 24; koff[i] = (unsigned)(krow[i] * KROW + kcc[i] * 16); }
    const bf16_t* kg = KB + (size_t)(b * SEQ) * (NH * NOPE) + h * NOPE;
    const bf16_t* kpg = KPE + (size_t)(b * SEQ) * ROPE;
    const bf16_t* vg = VT + (size_t)(h * VD) * MP + b * SEQ;
    const int vrow0 = tid >> 3, vcc = tid & 7;
    u32x4 kst[3], vst[2];
#define PAT_LOAD(j) do { _Pragma("unroll") for (int i = 0; i < 3; ++i) kst[i] = kcc[i] < 16 ? *(const u32x4*)(kg + (size_t)((j) * 64 + krow[i]) * (NH * NOPE) + kcc[i] * 8) : *(const u32x4*)(kpg + (size_t)((j) * 64 + krow[i]) * ROPE + (kcc[i] - 16) * 8); \
        _Pragma("unroll") for (int i = 0; i < 2; ++i) vst[i] = *(const u32x4*)(vg + (size_t)(vrow0 + 64 * i) * MP + (j) * 64 + vcc * 8); } while (0)
#define PAT_STORE(buf) do { _Pragma("unroll") for (int i = 0; i < 3; ++i) *(LAS u32x4*)(lds + (buf) * KTILE + koff[i]) = kst[i]; \
        _Pragma("unroll") for (int i = 0; i < 2; ++i) *(LAS u32x4*)(lds + 2 * KTILE + (buf) * VTILE + (vrow0 + 64 * i) * VROW + vcc * 16) = vst[i]; } while (0)
    PAT_LOAD(0); PAT_STORE(0);
    __syncthreads();
    const int kr = swap23(ql);
    for (int j = 0; j < ntiles; ++j) {
        const int buf = j & 1;
        if (j + 1 < ntiles) PAT_LOAD(j + 1);
        const int jd = j - 4 * qb;
        if (jd <= (wave >> 1)) {
            f32x16 p0, p1;
#pragma unroll
            for (int r = 0; r < 16; ++r) { p0[r] = 0.f; p1[r] = 0.f; }
            const LAS unsigned char* kb0 = lds + buf * KTILE + kr * KROW + hh * 16;
            __builtin_amdgcn_s_setprio(1);
#pragma unroll
            for (int ks = 0; ks < 12; ++ks) {
                const bf16x8 a0 = *(const LAS bf16x8*)(kb0 + ks * 32), a1 = *(const LAS bf16x8*)(kb0 + 32 * KROW + ks * 32);
                p0 = __builtin_amdgcn_mfma_f32_32x32x16_bf16(a0, qf[ks], p0, 0, 0, 0);
                p1 = __builtin_amdgcn_mfma_f32_32x32x16_bf16(a1, qf[ks], p1, 0, 0, 0);
            }
            __builtin_amdgcn_s_setprio(0);
            if (jd >= 0) {
                const int qrel = 32 * wave + ql - 64 * jd - 8 * hh;
#pragma unroll
                for (int r = 0; r < 16; ++r) { const int kk = 16 * (r >> 3) + (r & 7);
                    if (kk > qrel) p0[r] = -__builtin_inff();
                    if (kk + 32 > qrel) p1[r] = -__builtin_inff(); }
            }
            bf16x8 pf[4];
            softmax_step<4>(p0, p1, m, lh, o, pf);
            const LAS unsigned char* vb0 = lds + 2 * KTILE + buf * VTILE + ql * VROW + hh * 16;
#pragma unroll
            for (int d = 0; d < 4; ++d)
#pragma unroll
                for (int ss = 0; ss < 4; ++ss) {
                    const bf16x8 a = *(const LAS bf16x8*)(vb0 + d * 32 * VROW + ss * 32);
                    o[d] = __builtin_amdgcn_mfma_f32_32x32x16_bf16(a, pf[ss], o[d], 0, 0, 0);
                }
        }
        if (j + 1 < ntiles) PAT_STORE(buf ^ 1);
        __syncthreads();
    }
#undef PAT_LOAD
#undef PAT_STORE
    const float inv = 1.0f / half_sum(lh);
    bf16_t* op = O + (size_t)(q0 + ql) * DM + h * VD + 4 * hh;
#pragma unroll
    for (int d = 0; d < 4; ++d)
#pragma unroll
        for (int g = 0; g < 4; ++g) { u32x2 w; w.x = cvt_pk_bf16(o[d][4 * g] * inv, o[d][4 * g + 1] * inv); w.y = cvt_pk_bf16(o[d][4 * g + 2] * inv, o[d][4 * g + 3] * inv);
            *(u32x2*)(op + 32 * d + 8 * g) = w; }
}
}

namespace sat {
constexpr int KROW = 656, KTILE = 64 * KROW;
__device__ __forceinline__ bf16x8 tr_frag(const LAS unsigned char* p) {
    typedef short v4i16_t __attribute__((ext_vector_type(4)));
    const s16x4 a = __builtin_bit_cast(s16x4, __builtin_amdgcn_ds_read_tr16_b64_v4i16((LAS v4i16_t*)p));
    const s16x4 b = __builtin_bit_cast(s16x4, __builtin_amdgcn_ds_read_tr16_b64_v4i16((LAS v4i16_t*)(p + 4 * KROW)));
    bf16x8 r; r[0] = a[0]; r[1] = a[1]; r[2] = a[2]; r[3] = a[3]; r[4] = b[0]; r[5] = b[1]; r[6] = b[2]; r[7] = b[3]; return r;
}
__device__ __forceinline__ void unit(LAS unsigned char* lds, const int wave, const bf16_t* QLAT, const float* cache_ckv, const float* cache_kpe, const int* page_table, const bf16_t* CKVS  , const bf16_t* KPES,
                                     float* OPART, float* OML, int b, int split) {
    const int lane = lane_now(), tid = wave * 64 + lane, ql = lane & 31, hh = lane >> 5;
    const int qblk = wave & 1, kb = (wave >> 1) & 1, dvh = wave >> 2;
#pragma unroll
    for (int i = 0; i < 5; ++i) { const int c = tid + 512 * i, row = c / 40, cc = c % 40;
        *(LAS u32x4*)(lds + 2 * KTILE + row * KROW + cc * 16) = *(const u32x4*)(QLAT + (size_t)(b * 64 + row) * 320 + cc * 8); }
    f32x16 o[4];
#pragma unroll
    for (int d = 0; d < 4; ++d)
#pragma unroll
        for (int r = 0; r < 16; ++r) o[d][r] = 0.f;
    float m = -1e30f, lh = 0.f;
    const int npg = NPAGES / 2, ntiles = 2 * npg + (split == 1 ? 1 : 0);
    const int* pt = page_table + b * NPAGES + split * npg;
    const int crow0 = tid >> 6, ccol = tid & 63;
    const int prow0 = tid >> 4, pcol = tid & 15;
    f32x4 cst[8], pst[2];
#define SAT_LOAD(j) do { const int pg = pt[(j) >> 1]; const size_t r0 = (size_t)pg * PAGE + ((j) & 1) * 64; \
        _Pragma("unroll") for (int i = 0; i < 8; ++i) cst[i] = __builtin_nontemporal_load((const f32x4*)(cache_ckv + (r0 + crow0 + 8 * i) * KVL) + ccol); \
        _Pragma("unroll") for (int i = 0; i < 2; ++i) pst[i] = __builtin_nontemporal_load((const f32x4*)(cache_kpe + (r0 + prow0 + 32 * i) * ROPE) + pcol); } while (0)
#define SAT_STORE(buf) do { _Pragma("unroll") for (int i = 0; i < 8; ++i) { u32x2 w; w.x = cvt_pk_bf16(cst[i][0], cst[i][1]); w.y = cvt_pk_bf16(cst[i][2], cst[i][3]); \
            *(LAS u32x2*)(lds + (buf) * KTILE + (crow0 + 8 * i) * KROW + ccol * 8) = w; } \
        _Pragma("unroll") for (int i = 0; i < 2; ++i) { u32x2 w; w.x = cvt_pk_bf16(pst[i][0], pst[i][1]); w.y = cvt_pk_bf16(pst[i][2], pst[i][3]); \
            *(LAS u32x2*)(lds + (buf) * KTILE + (prow0 + 32 * i) * KROW + 512 + pcol * 8) = w; } } while (0)
#define SAT_NEW(buf) do { _Pragma("unroll") for (int i = 0; i < 5; ++i) { const int c = tid + 512 * i, row = c / 40, cc = c % 40; u32x4 v = (u32x4){0u, 0u, 0u, 0u}; \
            if (row < DECT) v = cc < 32 ? *(const u32x4*)(CKVS + (size_t)(b * DECT + row) * KVL + cc * 8) : *(const u32x4*)(KPES + (size_t)(b * DECT + row) * ROPE + (cc - 32) * 8); \
            *(LAS u32x4*)(lds + (buf) * KTILE + row * KROW + cc * 16) = v; } } while (0)
    SAT_LOAD(0); SAT_STORE(0);
    __syncthreads();
    const int kr = 32 * kb + swap23(ql);
    const int g16 = lane >> 4, i16 = lane & 15;
    const int troff = (32 * kb + 8 * (g16 >> 1) + (i16 >> 2)) * KROW + (128 * dvh + 16 * (g16 & 1) + 4 * (i16 & 3)) * 2;
    for (int j = 0; j < ntiles; ++j) {
        const int buf = j & 1;
        const bool nxt_page = (j + 1 < 2 * npg), nxt_new = (j + 1 == 2 * npg) && (split == 1);
        if (nxt_page) SAT_LOAD(j + 1);
        f32x16 p0;
#pragma unroll
        for (int r = 0; r < 16; ++r) p0[r] = 0.f;
        const LAS unsigned char* kb0 = lds + buf * KTILE + kr * KROW + hh * 16;
        const LAS unsigned char* qb0 = lds + 2 * KTILE + (32 * qblk + ql) * KROW + hh * 16;
        __builtin_amdgcn_s_setprio(1);
#pragma unroll
        for (int ks = 0; ks < 20; ++ks) p0 = __builtin_amdgcn_mfma_f32_32x32x16_bf16(*(const LAS bf16x8*)(kb0 + ks * 32), *(const LAS bf16x8*)(qb0 + ks * 32), p0, 0, 0, 0);
        __builtin_amdgcn_s_setprio(0);
        if (j == 2 * npg) {
            const int tq = (32 * qblk + ql) >> 3;
#pragma unroll
            for (int r = 0; r < 16; ++r) { const int kk = 32 * kb + 16 * (r >> 3) + 8 * hh + (r & 7); if (kk > tq) p0[r] = -__builtin_inff(); }
        }
        bf16x8 pf[2];
        softmax_step1<4>(p0, m, lh, o, pf);
        const LAS unsigned char* vb0 = lds + buf * KTILE + troff;
#pragma unroll
        for (int d = 0; d < 4; ++d)
#pragma unroll
            for (int ss = 0; ss < 2; ++ss) {
                const bf16x8 a = tr_frag(vb0 + d * 64 + ss * 16 * KROW);
                o[d] = __builtin_amdgcn_mfma_f32_32x32x16_bf16(a, pf[ss], o[d], 0, 0, 0);
            }
        if (nxt_page) SAT_STORE(buf ^ 1);
        if (nxt_new) SAT_NEW(buf ^ 1);
        __syncthreads();
    }
#undef SAT_LOAD
#undef SAT_STORE
#undef SAT_NEW
    float lt = half_sum(lh);
    const int pair = dvh * 2 + qblk;
    LAS float* xb = (LAS float*)(lds + pair * 17408);
    if (kb == 1) {
#pragma unroll
        for (int d = 0; d < 4; ++d)
#pragma unroll
            for (int r = 0; r < 16; ++r) xb[(d * 16 + r) * 64 + lane] = o[d][r];
        xb[64 * 64 + lane] = m; xb[65 * 64 + lane] = lt;
    }
    __syncthreads();
    if (kb == 0) {
        const float m1 = xb[64 * 64 + lane], l1 = xb[65 * 64 + lane];
        const float mm = fmaxf(m, m1), w0 = __builtin_amdgcn_exp2f(m - mm), w1 = __builtin_amdgcn_exp2f(m1 - mm);
#pragma unroll
        for (int d = 0; d < 4; ++d)
#pragma unroll
            for (int r = 0; r < 16; ++r) o[d][r] = o[d][r] * w0 + xb[(d * 16 + r) * 64 + lane] * w1;
        lt = lt * w0 + l1 * w1;
        const int q = 32 * qblk + ql;
        float* op = OPART + ((size_t)(b * 2 + split) * 64 + q) * KVL + 128 * dvh + 4 * hh;
#pragma unroll
        for (int d = 0; d < 4; ++d)
#pragma unroll
            for (int g = 0; g < 4; ++g) *(f32x4*)(op + 32 * d + 8 * g) = (f32x4){o[d][4 * g], o[d][4 * g + 1], o[d][4 * g + 2], o[d][4 * g + 3]};
        if (dvh == 0 && hh == 0) *(f32x2*)(OML + ((size_t)(b * 2 + split) * 64 + q) * 2) = (f32x2){mm, lt};
    }
    __syncthreads();
}
}


#define LDS_RD128(dst, addr, off) asm volatile("ds_read_b128 %0, %1 offset:%2" : "=v"(dst) : "v"(addr), "n"(off))
#define LDS_WAIT4(f, N) asm volatile("s_waitcnt lgkmcnt(" #N ")" : "+v"(f[0]), "+v"(f[1]), "+v"(f[2]), "+v"(f[3]))
namespace gla {
constexpr int QROW = 272, KTROW = 144, VROW = 528;
constexpr int P_T16 = 0, P_TOT = 4096, P_QT = 8192, P_KT = P_QT + 64 * QROW;
constexpr int C_DK = 0, C_QT = 1024, C_KH = C_QT + 64 * QROW, C_V = C_KH + 128 * KTROW, C_AT = C_V + 64 * VROW, C_O = C_AT + 6144;
static_assert(C_O + 64 * 8 * 64 <= RING_BYTES, "gla chain LDS");
static_assert(C_AT + 6144 <= RING_BYTES, "gla LDS");
__device__ __forceinline__ bf16x8 tr_frag(const LAS unsigned char* p) {
    typedef short v4i16_t __attribute__((ext_vector_type(4)));
    const s16x4 a = __builtin_bit_cast(s16x4, __builtin_amdgcn_ds_read_tr16_b64_v4i16((LAS v4i16_t*)p));
    const s16x4 b = __builtin_bit_cast(s16x4, __builtin_amdgcn_ds_read_tr16_b64_v4i16((LAS v4i16_t*)(p + 4 * VROW)));
    bf16x8 r; r[0] = a[0]; r[1] = a[1]; r[2] = a[2]; r[3] = a[3]; r[4] = b[0]; r[5] = b[1]; r[6] = b[2]; r[7] = b[3]; return r;
}
template <int SEG>
__device__ __forceinline__ void prep(LAS unsigned char* lds, const int wave, const bf16_t* QKVG, const float* T16, const float* w_gk2, const float* b_gk, int chunk, int h,
                                     bf16_t* QTg, bf16_t* KHg, bf16_t* ATg, float* DKg) {
    const int lane = lane_now(), tid = wave * 64 + lane, ql = lane & 31, hh = lane >> 5;
    const int kk = tid & 127, tq = tid >> 7, cu = chunk * 4 + h, row0 = chunk * 64;
    float w2[16];
#pragma unroll
    for (int j = 0; j < 16; ++j) w2[j] = w_gk2[j * (GH * GDK) + h * GDK + kk];
    const float bias = b_gk[h * GDK + kk];
    unsigned short qraw[16], kraw[16];
    { const bf16_t* qg = QKVG + (size_t)(row0 + tq * 16) * GIN + h * GDK + kk;
#pragma unroll
      for (int i = 0; i < 16; ++i) { qraw[i] = qg[(size_t)i * GIN]; kraw[i] = qg[(size_t)i * GIN + GH * GDK]; } }
    __syncthreads();
    if (tid < 256) *(LAS f32x4*)(lds + P_T16 + tid * 16) = *(const f32x4*)(T16 + (size_t)row0 * 16 + tid * 4);
    __syncthreads();
    float Gl[16];
    { float run = 0.f;
#pragma unroll
      for (int i = 0; i < 16; ++i) { const int t = tq * 16 + i; const LAS f32x4* tp = (const LAS f32x4*)(lds + P_T16 + t * 64);
          const f32x4 a0 = tp[0], a1 = tp[1], a2 = tp[2], a3 = tp[3];
          float z = bias;
          z += a0[0] * w2[0] + a0[1] * w2[1] + a0[2] * w2[2] + a0[3] * w2[3];
          z += a1[0] * w2[4] + a1[1] * w2[5] + a1[2] * w2[6] + a1[3] * w2[7];
          z += a2[0] * w2[8] + a2[1] * w2[9] + a2[2] * w2[10] + a2[3] * w2[11];
          z += a3[0] * w2[12] + a3[1] * w2[13] + a3[2] * w2[14] + a3[3] * w2[15];
          const float ls = fminf(z, 0.f) - 0.6931471805599453f * __builtin_amdgcn_logf(1.0f + __builtin_amdgcn_exp2f(-fabsf(z) * LOG2E));
          if (SEG == 8 && i == 8) run = 0.f;
          run += ls * (1.0f / 16.0f); Gl[i] = run; }
      if (SEG == 64) *(LAS float*)(lds + P_TOT + (tq * 128 + kk) * 4) = run; }
    float prefix = 0.f, total = 0.f;
    if (SEG == 64) {
        __syncthreads();
#pragma unroll
        for (int q = 0; q < 4; ++q) { const float v = *(const LAS float*)(lds + P_TOT + (q * 128 + kk) * 4); total += v; if (q < tq) prefix += v; }
    }
    { unsigned kh[8];
#pragma unroll
      for (int i = 0; i < 16; i += 2) {
          const float G0 = (Gl[i] + prefix) * LOG2E, G1 = (Gl[i + 1] + prefix) * LOG2E;
          const float TL = (SEG == 64 ? total : Gl[i | 7]) * LOG2E;
          const float q0 = bf2f(qraw[i]), q1 = bf2f(qraw[i + 1]), k0 = bf2f(kraw[i]), k1 = bf2f(kraw[i + 1]);
          const unsigned qq = cvt_pk_bf16(q0 * __builtin_amdgcn_exp2f(G0), q1 * __builtin_amdgcn_exp2f(G1));
          const unsigned kt = cvt_pk_bf16(k0 * __builtin_amdgcn_exp2f(-G0), k1 * __builtin_amdgcn_exp2f(-G1));
          kh[i >> 1] = cvt_pk_bf16(k0 * __builtin_amdgcn_exp2f(TL - G0), k1 * __builtin_amdgcn_exp2f(TL - G1));
          const int t = tq * 16 + i;
          *(LAS unsigned short*)(lds + P_QT + t * QROW + kk * 2) = (unsigned short)(qq & 0xffffu); *(LAS unsigned short*)(lds + P_QT + (t + 1) * QROW + kk * 2) = (unsigned short)(qq >> 16);
          *(LAS unsigned short*)(lds + P_KT + t * QROW + kk * 2) = (unsigned short)(kt & 0xffffu); *(LAS unsigned short*)(lds + P_KT + (t + 1) * QROW + kk * 2) = (unsigned short)(kt >> 16);
      }
      bf16_t* khp = KHg + ((size_t)cu * 128 + kk) * 64 + tq * 16;
      *(u32x4*)khp = (u32x4){kh[0], kh[1], kh[2], kh[3]}; *(u32x4*)(khp + 8) = (u32x4){kh[4], kh[5], kh[6], kh[7]};
      if (SEG == 64) { if (tq == 0) DKg[(size_t)cu * 1024 + kk] = __builtin_amdgcn_exp2f(total * LOG2E); }
      else { DKg[(size_t)cu * 1024 + (tq * 2) * 128 + kk] = __builtin_amdgcn_exp2f(Gl[7] * LOG2E); DKg[(size_t)cu * 1024 + (tq * 2 + 1) * 128 + kk] = __builtin_amdgcn_exp2f(Gl[15] * LOG2E); } }
    __syncthreads();
    if (wave < 3) {
        const int sb = wave >> 1, tb = (wave + 1) >> 1, kr = swap23(ql);
        f32x16 x;
#pragma unroll
        for (int r = 0; r < 16; ++r) x[r] = 0.f;
        const LAS unsigned char* ap = lds + P_KT + (32 * sb + kr) * QROW + hh * 16;
        const LAS unsigned char* bp = lds + P_QT + (32 * tb + ql) * QROW + hh * 16;
#pragma unroll
        for (int ks = 0; ks < 8; ++ks) x = __builtin_amdgcn_mfma_f32_32x32x16_bf16(*(const LAS bf16x8*)(ap + ks * 32), *(const LAS bf16x8*)(bp + ks * 32), x, 0, 0, 0);
        const int tt = 32 * tb + ql;
#pragma unroll
        for (int r = 0; r < 16; ++r) { const int sr = 32 * sb + 16 * (r >> 3) + 8 * hh + (r & 7); if (sr > tt || (SEG == 8 && (sr >> 3) != (tt >> 3))) x[r] = 0.f; }
        bf16_t* atp = ATg + (size_t)cu * 3072 + (wave * 2) * 512 + lane * 8;
        *(bf16x8*)atp = pack8(x, 0); *(bf16x8*)(atp + 512) = pack8(x, 8);
    }
#pragma unroll
    for (int i = 0; i < 2; ++i) { const int c = tid + 512 * i, row = c >> 4, cc = c & 15;
        *(u32x4*)(QTg + (size_t)(row0 + row) * (GH * GDK) + h * GDK + cc * 8) = *(const LAS u32x4*)(lds + P_QT + row * QROW + cc * 16); }
}

template <int NWV>
__device__ __forceinline__ void chain(LAS unsigned char* lds, const int wave, const bf16_t* QTg, const bf16_t* KHg, const bf16_t* ATg, const float* DKg, const bf16_t* QKVG, int h, int chunk0, int nchunk,
                                      int srow, int nrow, int sseg, int dseg, int dvbase, const float* state_in, float* state_out, bf16_t* GO) {
    constexpr int VPR = NWV * 4  , VST = NWV / 2  , VRS = 512 / VPR  ;
    const bool active = wave < NWV;
    const int lane = lane_now(), tid = wave * 64 + lane, ql = lane & 31, hh = lane >> 5;
    f32x16 S[4];
#pragma unroll
    for (int kb = 0; kb < 4; ++kb)
#pragma unroll
        for (int r = 0; r < 16; ++r) S[kb][r] = (state_in && active) ? state_in[(size_t)(32 * kb + 16 * (r >> 3) + 8 * hh + (r & 7)) * GDV + dvbase + 32 * wave + ql] : 0.f;
    const int qrow = tid >> 4, qcc = tid & 15;
    const int krow = tid >> 3, kcc = tid & 7;
    const int vrow0 = tid / VPR, vcc = tid % VPR;
    u32x4 qst[2], kst[2], vst[VST], ast, dst;
#define GLC_LOAD(c) do { const int ch = chunk0 + (c); const size_t cu = (size_t)ch * 4 + h; \
        _Pragma("unroll") for (int i = 0; i < 2; ++i) qst[i] = *(const u32x4*)(QTg + (size_t)(ch * 64 + qrow + 32 * i) * (GH * GDK) + h * GDK + qcc * 8); \
        _Pragma("unroll") for (int i = 0; i < 2; ++i) kst[i] = (sseg < 0 || kcc == sseg) ? *(const u32x4*)(KHg + (cu * 128 + krow + 64 * i) * 64 + kcc * 8) : (u32x4){0u, 0u, 0u, 0u}; \
        _Pragma("unroll") for (int i = 0; i < VST; ++i) { const int r = vrow0 + VRS * i; \
            vst[i] = (r >= srow && r < srow + nrow) ? *(const u32x4*)(QKVG + (size_t)(ch * 64 + r) * GIN + 2 * GH * GDK + h * GDV + dvbase + vcc * 8) : (u32x4){0u, 0u, 0u, 0u}; } \
        if (tid < 384) ast = *(const u32x4*)(ATg + cu * 3072 + tid * 8); \
        if (tid < 32) dst = *(const u32x4*)(DKg + cu * 1024 + dseg * 128 + tid * 4); } while (0)
    GLC_LOAD(0);
    const int g16 = lane >> 4, i16 = lane & 15;
    const int troff = (8 * (g16 >> 1) + (i16 >> 2)) * VROW + (32 * wave + 16 * (g16 & 1) + 4 * (i16 & 3)) * 2;
    const int kr = swap23(ql);
#define GLC_LDS_BAR() do { asm volatile("s_waitcnt lgkmcnt(0)" ::: "memory"); __builtin_amdgcn_s_barrier(); asm volatile("" ::: "memory"); } while (0)
#define GLC_FLUSH(cprev) do { if constexpr (NWV != 8) { int tl_ = tid; asm volatile("" : "+v"(tl_)); _Pragma("unroll") for (int i_ = 0; i_ < NWV / 2; ++i_) { const int c_ = tl_ + 512 * i_, row_ = c_ / (NWV * 4), cc_ = c_ % (NWV * 4); \
            *(u32x4*)(GO + (size_t)((chunk0 + (cprev)) * 64 + row_) * DM + h * GDV + dvbase + cc_ * 8) = *(const LAS u32x4*)(lds + C_O + row_ * (NWV * 64) + cc_ * 16); } } } while (0)
    for (int c = 0; c < nchunk; ++c) {
        GLC_LDS_BAR();
        if (c > 0) GLC_FLUSH(c - 1);
#pragma unroll
        for (int i = 0; i < 2; ++i) *(LAS u32x4*)(lds + C_QT + (qrow + 32 * i) * QROW + qcc * 16) = qst[i];
#pragma unroll
        for (int i = 0; i < 2; ++i) *(LAS u32x4*)(lds + C_KH + (krow + 64 * i) * KTROW + kcc * 16) = kst[i];
#pragma unroll
        for (int i = 0; i < VST; ++i) *(LAS u32x4*)(lds + C_V + (vrow0 + VRS * i) * VROW + vcc * 16) = vst[i];
        if (tid < 384) *(LAS u32x4*)(lds + C_AT + tid * 16) = ast;
        if (tid < 32) *(LAS u32x4*)(lds + C_DK + tid * 16) = dst;
        GLC_LDS_BAR();
        if (c + 1 < nchunk) GLC_LOAD(c + 1);
        if (active) {
        f32x16 o[2];
#pragma unroll
        for (int tb = 0; tb < 2; ++tb)
#pragma unroll
            for (int r = 0; r < 16; ++r) o[tb][r] = 0.f;
        const unsigned qa = (unsigned)(size_t)(lds + C_QT + ql * QROW + hh * 16), ka = (unsigned)(size_t)(lds + C_KH + kr * KTROW + hh * 16), ata = (unsigned)(size_t)(lds + C_AT + lane * 16);
        bf16x8 fa[4], fb[4];
#define GLC_QLD(f, kb) do { LDS_RD128(f[0], qa, (kb) * 64); LDS_RD128(f[1], qa, 32 * QROW + (kb) * 64); LDS_RD128(f[2], qa, (kb) * 64 + 32); LDS_RD128(f[3], qa, 32 * QROW + (kb) * 64 + 32); } while (0)
#define GLC_QMM(f, kb) do { const bf16x8 s0 = pack8(S[kb], 0), s1 = pack8(S[kb], 8); \
            o[0] = __builtin_amdgcn_mfma_f32_32x32x16_bf16(f[0], s0, o[0], 0, 0, 0); o[1] = __builtin_amdgcn_mfma_f32_32x32x16_bf16(f[1], s0, o[1], 0, 0, 0); \
            o[0] = __builtin_amdgcn_mfma_f32_32x32x16_bf16(f[2], s1, o[0], 0, 0, 0); o[1] = __builtin_amdgcn_mfma_f32_32x32x16_bf16(f[3], s1, o[1], 0, 0, 0); } while (0)
        GLC_QLD(fa, 0); GLC_QLD(fb, 1);
        LDS_WAIT4(fa, 4); GLC_QMM(fa, 0); GLC_QLD(fa, 2);
        LDS_WAIT4(fb, 4); GLC_QMM(fb, 1); GLC_QLD(fb, 3);
        LDS_WAIT4(fa, 4); GLC_QMM(fa, 2);
        LDS_RD128(fa[0], ata, 0 * 1024); LDS_RD128(fa[1], ata, 1 * 1024); LDS_RD128(fa[2], ata, 2 * 1024); LDS_RD128(fa[3], ata, 3 * 1024);
        LDS_WAIT4(fb, 4); GLC_QMM(fb, 3);
        LDS_RD128(fb[0], ata, 4 * 1024); LDS_RD128(fb[1], ata, 5 * 1024); LDS_RD128(fb[2], ka, 0); LDS_RD128(fb[3], ka, 32);
        bf16x8 vf[4];
#pragma unroll
        for (int ss = 0; ss < 4; ++ss) vf[ss] = tr_frag(lds + C_V + troff + ss * 16 * VROW);
        LDS_WAIT4(fa, 0); LDS_WAIT4(fb, 0);
        o[0] = __builtin_amdgcn_mfma_f32_32x32x16_bf16(fa[0], vf[0], o[0], 0, 0, 0);
        o[0] = __builtin_amdgcn_mfma_f32_32x32x16_bf16(fa[1], vf[1], o[0], 0, 0, 0);
        o[1] = __builtin_amdgcn_mfma_f32_32x32x16_bf16(fa[2], vf[0], o[1], 0, 0, 0);
        o[1] = __builtin_amdgcn_mfma_f32_32x32x16_bf16(fa[3], vf[1], o[1], 0, 0, 0);
        o[1] = __builtin_amdgcn_mfma_f32_32x32x16_bf16(fb[0], vf[2], o[1], 0, 0, 0);
        o[1] = __builtin_amdgcn_mfma_f32_32x32x16_bf16(fb[1], vf[3], o[1], 0, 0, 0);
#define GLC_KLD(f, kb) do { LDS_RD128(f[0], ka, (kb) * 32 * KTROW); LDS_RD128(f[1], ka, (kb) * 32 * KTROW + 32); LDS_RD128(f[2], ka, (kb) * 32 * KTROW + 64); LDS_RD128(f[3], ka, (kb) * 32 * KTROW + 96); } while (0)
#define GLC_SCALE(kb) do { _Pragma("unroll") for (int g = 0; g < 2; ++g) { const LAS f32x4* dp = (const LAS f32x4*)(lds + C_DK + (32 * (kb) + 16 * g + 8 * hh) * 4); const f32x4 d0 = dp[0], d1 = dp[1]; \
            S[kb][8 * g + 0] *= d0[0]; S[kb][8 * g + 1] *= d0[1]; S[kb][8 * g + 2] *= d0[2]; S[kb][8 * g + 3] *= d0[3]; \
            S[kb][8 * g + 4] *= d1[0]; S[kb][8 * g + 5] *= d1[1]; S[kb][8 * g + 6] *= d1[2]; S[kb][8 * g + 7] *= d1[3]; } } while (0)
#define GLC_KMM(f, kb) do { S[kb] = __builtin_amdgcn_mfma_f32_32x32x16_bf16(f[0], vf[0], S[kb], 0, 0, 0); S[kb] = __builtin_amdgcn_mfma_f32_32x32x16_bf16(f[1], vf[1], S[kb], 0, 0, 0); \
            S[kb] = __builtin_amdgcn_mfma_f32_32x32x16_bf16(f[2], vf[2], S[kb], 0, 0, 0); S[kb] = __builtin_amdgcn_mfma_f32_32x32x16_bf16(f[3], vf[3], S[kb], 0, 0, 0); } while (0)
        GLC_KLD(fa, 1);
        LDS_RD128(fb[0], ka, 64); LDS_RD128(fb[1], ka, 96);
        GLC_SCALE(0);
        LDS_WAIT4(fb, 0);
        S[0] = __builtin_amdgcn_mfma_f32_32x32x16_bf16(fb[2], vf[0], S[0], 0, 0, 0); S[0] = __builtin_amdgcn_mfma_f32_32x32x16_bf16(fb[3], vf[1], S[0], 0, 0, 0);
        S[0] = __builtin_amdgcn_mfma_f32_32x32x16_bf16(fb[0], vf[2], S[0], 0, 0, 0); S[0] = __builtin_amdgcn_mfma_f32_32x32x16_bf16(fb[1], vf[3], S[0], 0, 0, 0);
        GLC_KLD(fb, 2); GLC_SCALE(1);
        LDS_WAIT4(fa, 4); GLC_KMM(fa, 1); GLC_KLD(fa, 3); GLC_SCALE(2);
        LDS_WAIT4(fb, 4); GLC_KMM(fb, 2); GLC_SCALE(3);
        LDS_WAIT4(fa, 0); GLC_KMM(fa, 3);
#undef GLC_QLD
#undef GLC_QMM
#undef GLC_KLD
#undef GLC_SCALE
#undef GLC_KMM
        if constexpr (NWV != 8) {
            int qlx = ql, hhx = hh; asm volatile("" : "+v"(qlx), "+v"(hhx));
            LAS unsigned short* op_ = (LAS unsigned short*)(lds + C_O) + (4 * hhx) * (NWV * 32) + 32 * wave + qlx;
#pragma unroll
            for (int tb = 0; tb < 2; ++tb)
#pragma unroll
                for (int r = 0; r < 16; r += 2) { const unsigned w_ = cvt_pk_bf16(o[tb][r], o[tb][r + 1]);
                    const int t0_ = 32 * tb + (r & 3) + 8 * (r >> 2);
                    op_[t0_ * (NWV * 32)] = (unsigned short)(w_ & 0xffffu); op_[(t0_ + 1) * (NWV * 32)] = (unsigned short)(w_ >> 16); }
        } else {
          int qlx = ql, hhx = hh; asm volatile("" : "+v"(qlx), "+v"(hhx));
          bf16_t* gp = GO + (size_t)((chunk0 + c) * 64) * DM + h * GDV + dvbase + 32 * wave + qlx;
#pragma unroll
          for (int tb = 0; tb < 2; ++tb)
#pragma unroll
              for (int r = 0; r < 16; ++r) { const int t = 32 * tb + (r & 3) + 8 * (r >> 2) + 4 * hhx; if (t >= srow && t < srow + nrow) gp[(size_t)t * DM] = (bf16_t)(cvt_pk_bf16(o[tb][r], 0.f) & 0xffffu); } }
        }
    }
    if constexpr (NWV != 8) { GLC_LDS_BAR(); GLC_FLUSH(nchunk - 1); }
#undef GLC_FLUSH
#undef GLC_LOAD
#undef GLC_LDS_BAR
    if (active) { int qlx = ql, hhx = hh; asm volatile("" : "+v"(qlx), "+v"(hhx));
#pragma unroll
    for (int kb = 0; kb < 4; ++kb)
#pragma unroll
        for (int r = 0; r < 16; ++r) state_out[(size_t)(32 * kb + 16 * (r >> 3) + 8 * hhx + (r & 7)) * GDV + dvbase + 32 * wave + qlx] = S[kb][r]; }
    __syncthreads();
}
}

__global__ void __launch_bounds__(NWAVES * 64, 2) mk_fwd(Args args) {
    extern __shared__ __attribute__((aligned(16))) unsigned char lds_raw[];
    LAS unsigned char* lds = (LAS unsigned char*)lds_raw;
    volatile LAS unsigned* MISC = (volatile LAS unsigned*)(lds + MISC_OFF);
    const int wave = __builtin_amdgcn_readfirstlane(threadIdx.x >> 6);
    const int G = gridDim.x; const int bx = blockIdx.x; const int vcu = (G % 8 == 0) ? (bx % 8) * (G / 8) + bx / 8 : bx;
    const int gw = vcu * NWAVES + wave, NGW = G * NWAVES;
    unsigned char* ws = args.ws;
    unsigned* ctl = (unsigned*)(ws + WS_CTL);
    for (int u = wave * 64 + lane_now(); u < (LDS_BYTES - LDSCTL_OFF) / 4; u += NWAVES * 64) ((LAS unsigned*)(lds + LDSCTL_OFF))[u] = 0u;
    __syncthreads();
    XcdBarrier bar = xcd_barrier_post(ctl + 1024, MISC + 8, wave == 0 && lane_now() == 0);
#ifdef PROBE_A0
    unsigned long long* tsb = (unsigned long long*)(ws + WS_CTL + 32768);
    int n_ts = 0;
#define STAMP() do { if (bx == 0 && wave == 0 && lane_now() == 0) tsb[n_ts] = __builtin_amdgcn_s_memrealtime(); ++n_ts; } while (0)
#define GRID_BAR() do { xcd_barrier(bar, wave == 0 && lane_now() == 0); STAMP(); } while (0)
    STAMP();
#else
#define STAMP() do {} while (0)
#define GRID_BAR() xcd_barrier(bar, wave == 0 && lane_now() == 0)
#endif

    const float* x_prompt = (const float*)args.in[0]; const float* x_sample = (const float*)args.in[1];
    const float* cache_ckv = (const float*)args.in[2]; const float* cache_kpe = (const float*)args.in[3];
    const float* state_gla = (const float*)args.in[4]; const int* page_table = (const int*)args.in[5];
    const float* norm_g = (const float*)args.in[6]; const float* ffn_w_in = (const float*)args.in[7]; const float* ffn_w_out = (const float*)args.in[8];
    const float* mla_w_down = (const float*)args.in[9]; const float* mla_g_q = (const float*)args.in[10]; const float* mla_w_uq = (const float*)args.in[11];
    const float* mla_g_kv = (const float*)args.in[12]; const float* mla_w_uk = (const float*)args.in[13]; const float* mla_w_uv = (const float*)args.in[14];
    const float* mla_w_o = (const float*)args.in[15]; const float* gla_w_in = (const float*)args.in[16]; const float* gla_w_gk1 = (const float*)args.in[17];
    const float* gla_w_gk2 = (const float*)args.in[18]; const float* gla_b_gk = (const float*)args.in[19]; const float* gla_g_norm = (const float*)args.in[20];
    const float* gla_w_o = (const float*)args.in[21];
    float* out = args.out;
    float* ROPE_T = (float*)(ws + WS_ROPE);
    bf16_t* WIN = (bf16_t*)(ws + WS_WIN); bf16_t* WOUT = (bf16_t*)(ws + WS_WOUT); bf16_t* WDOWN = (bf16_t*)(ws + WS_WDOWN); bf16_t* WUQ = (bf16_t*)(ws + WS_WUQ);
    bf16_t* WUKT = (bf16_t*)(ws + WS_WUKT); bf16_t* WUK = (bf16_t*)(ws + WS_WUK); bf16_t* WUVT = (bf16_t*)(ws + WS_WUVT); bf16_t* WOT = (bf16_t*)(ws + WS_WOT);
    bf16_t* WGIN = (bf16_t*)(ws + WS_WGIN); bf16_t* WGO = (bf16_t*)(ws + WS_WGO);
    bf16_t* XN = (bf16_t*)(ws + WS_XN); bf16_t* HM = (bf16_t*)(ws + WS_HM); bf16_t* T = (bf16_t*)(ws + WS_T); bf16_t* H = (bf16_t*)(ws + WS_H); float* TP = (float*)(ws + WS_TP); bf16_t* D = (bf16_t*)(ws + WS_D);
    bf16_t* CQ = (bf16_t*)(ws + WS_CQ); bf16_t* CKV = (bf16_t*)(ws + WS_CKV); bf16_t* KPES = (bf16_t*)(ws + WS_KPES);
    bf16_t* KB = (bf16_t*)(ws + WS_KB); bf16_t* KPEP = (bf16_t*)(ws + WS_KPEP);
    float* Y = out + OUT_Y;
    const ConvPtrs cp{ffn_w_in, ffn_w_out, mla_w_down, mla_w_uq, mla_w_uk, mla_w_uv, mla_w_o, gla_w_in, gla_w_o, WIN, WOUT, WDOWN, WUQ, WUKT, WUVT, WOT, WGIN, WGO};

    {
        const int lane = lane_now(), tid = wave * 64 + lane; (void)tid;
        LAS float* scr = (LAS float*)(lds + wave * 16384);
        conv_segment<0>(cp, gw, NGW, scr, lane);
        const int gt = vcu * (NWAVES * 64) + tid, NGT = G * NWAVES * 64;
        for (int i = gt; i < KVL * NH * NOPE / 2; i += NGT) { const f32x2 v = ((const f32x2*)mla_w_uk)[i]; ((unsigned*)WUK)[i] = cvt_pk_bf16(v[0], v[1]); }
        for (int i = gt; i < (DDOWN_P - DDOWN) * DM / 2; i += NGT) ((unsigned*)(WDOWN + (size_t)DDOWN * DM))[i] = 0u;
        for (int i = gt; i < 128 * KVL / 2; i += NGT) ((unsigned*)(WUVT + (size_t)NH * VD * KVL))[i] = 0u;
        for (int i = gt; i < (GIN_P - GIN) * DM / 2; i += NGT) { const int row = (2 * i) / DM, k = (2 * i) % DM;
            unsigned w = 0u; if (row < GRANK) w = cvt_pk_bf16(gla_w_gk1[(size_t)k * GRANK + row], gla_w_gk1[(size_t)(k + 1) * GRANK + row]);
            ((unsigned*)(WGIN + (size_t)GIN * DM))[i] = w; }
        for (int i = gt; i < (SEQ + DECT) * 32; i += NGT) { const int p = i >> 5, fi = i & 31; const float pos = (float)(p < SEQ ? p : PAST + (p - SEQ));
            const float inv = (float)exp2(-(double)fi * (13.287712379549449 / 32.0));
            const float ang = pos * inv; double t = (double)ang * 0.15915494309189535; t -= rint(t); const float tf = (float)t;
            ((f32x2*)ROPE_T)[i] = (f32x2){__builtin_amdgcn_cosf(tf), __builtin_amdgcn_sinf(tf)}; }
        thin_phase<false, true, true, false>(gw, NGW, x_prompt, x_sample, nullptr, nullptr, 0, nullptr, nullptr, XN, nullptr, norm_g + 0 * DM, 1.f);
        GRID_BAR();
    }
    bf16_t* QKVG = (bf16_t*)(ws + WS_QKVG); float* T16 = (float*)(ws + WS_T16); bf16_t* GO = (bf16_t*)(ws + WS_GO);
    const int CONV_TAIL0 = ((M / 256) * (2 * DFF / 256)) % G;
#define FFN_GEMMS(slot) do { \
        { pg8::Gemm g{XN, WIN + (size_t)(slot) * 2 * DFF * DM, DM, DM, DM, 0, 0}; pg8::Order S{M / 256, 2 * DFF / 256, 1, G, bx}; \
          pg8::EpiSwiGLU E{HM, DFF}; \
          pg8::gemm_phase<pg8::EpiSwiGLU, true>(lds, wave, g, S, E); \
          if ((slot) < 3 && bx >= CONV_TAIL0) conv_segment<((slot) < 3 ? (slot) + 1 : 3)>(cp, (bx - CONV_TAIL0) * NWAVES + wave, (G - CONV_TAIL0) * NWAVES, (LAS float*)(lds + wave * 16384), lane_now()); \
          GRID_BAR(); } \
        { pg8::Gemm g{HM, WOUT + (size_t)(slot) * DM * DFF, DFF, DFF, DFF, 0, 0}; pg8::Order S{MP / 256, DM / 256, 1, G, bx};     \
          pg8::EpiBf16<0> E{T, DM, 0, 256, 1.f, 0}; \
          pg8::gemm_phase<pg8::EpiBf16<0>, true>(lds, wave, g, S, E); } \
        { pg8::Gemm g{HM + (size_t)MP * DFF, WOUT + (size_t)(slot) * DM * DFF, DFF, DFF, 256, 256, 256}; pg8::Order S{MS / 256, DM / 256, 11, G, bx};     \
          pg8::EpiF32 E{TP, DM, (long)MS * DM}; \
          pg8::gemm_phase<pg8::EpiF32, true>(lds, wave, g, S, E); \
          GRID_BAR(); } } while (0)
    { const float* ng = norm_g;
    FFN_GEMMS(0);
    thin_phase<true, true, true, false>(gw, NGW, x_prompt, x_sample, T, TP, 11, H, nullptr, XN, ng + 1 * DM, ng + 2 * DM, 0.5f); GRID_BAR();
        {
            pg8::Gemm g{XN, WDOWN, DM, DM, DM, 0, 0}; pg8::Order S{M / 256, DDOWN_P / 256, 1, G, bx};
            pg8::EpiBf16<0> E{D, DDOWN_P, 0, 256, 1.f, 0};
            pg8::gemm_phase<pg8::EpiBf16<0>, true>(lds, wave, g, S, E);
            GRID_BAR();
        }
        {
            const int lane = lane_now(), tid = wave * 64 + lane; (void)tid;
            f32x2 gq[3]; f32x4 gkv;
    #pragma unroll
            for (int j = 0; j < 3; ++j) gq[j] = *(const f32x2*)(mla_g_q + 2 * lane + 128 * j);
            gkv = *(const f32x4*)(mla_g_kv + 4 * lane);
            for (int r = gw; r < M; r += NGW) {
                const bf16_t* d = D + (size_t)r * DDOWN_P;
                f32x2 q[3];
    #pragma unroll
                for (int j = 0; j < 3; ++j) { const unsigned w = *(const unsigned*)(d + 2 * lane + 128 * j); q[j] = (f32x2){__uint_as_float(w << 16), __uint_as_float(w & 0xffff0000u)}; }
                const u32x2 kw = *(const u32x2*)(d + QL + 4 * lane);
                const f32x4 kv = (f32x4){__uint_as_float(kw.x << 16), __uint_as_float(kw.x & 0xffff0000u), __uint_as_float(kw.y << 16), __uint_as_float(kw.y & 0xffff0000u)};
                const float pe = bf2f(d[QL + KVL + lane]);
                float sq = 0.f;
    #pragma unroll
                for (int j = 0; j < 3; ++j) sq += q[j][0] * q[j][0] + q[j][1] * q[j][1];
                sq = wave_sum(sq);
                const float skv = wave_sum((kv[0] * kv[0] + kv[1] * kv[1]) + (kv[2] * kv[2] + kv[3] * kv[3]));
                const float rq = __builtin_amdgcn_rsqf(sq * (1.0f / QL) + EPS), rkv = __builtin_amdgcn_rsqf(skv * (1.0f / KVL) + EPS);
    #pragma unroll
                for (int j = 0; j < 3; ++j) *(unsigned*)(CQ + (size_t)r * QL + 2 * lane + 128 * j) = cvt_pk_bf16(q[j][0] * rq * gq[j][0], q[j][1] * rq * gq[j][1]);
                const f32x4 ckv = (kv * rkv) * gkv;
                float* ockv = r < MP ? out + OUT_CKV_P + (size_t)r * KVL : out + OUT_CKV_S + (size_t)(r - MP) * KVL;
                *(f32x4*)(ockv + 4 * lane) = ckv;
                u32x2 w; w.x = cvt_pk_bf16(ckv[0], ckv[1]); w.y = cvt_pk_bf16(ckv[2], ckv[3]);
                *(u32x2*)(CKV + (size_t)r * KVL + 4 * lane) = w;
                const float other = __shfl_xor(pe, 32);
                const f32x2 cs = ((const f32x2*)ROPE_T)[rope_pos_index(r) * 32 + (lane & 31)];
                const float ro = lane < 32 ? pe * cs[0] - other * cs[1] : pe * cs[0] + other * cs[1];
                float* okpe = r < MP ? out + OUT_KPE_P + (size_t)r * ROPE : out + OUT_KPE_S + (size_t)(r - MP) * ROPE;
                okpe[lane] = ro;
                const unsigned short rb = (unsigned short)(cvt_pk_bf16(ro, 0.f) & 0xffffu);
                if (r < MP) KPEP[(size_t)r * ROPE + lane] = rb; else KPES[(size_t)(r - MP) * ROPE + lane] = rb;
            }
            GRID_BAR();
        }

        bf16_t* Qb = (bf16_t*)(ws + WS_Q); bf16_t* VT = (bf16_t*)(ws + WS_VT); bf16_t* QLAT = (bf16_t*)(ws + WS_QLAT); bf16_t* Ob = (bf16_t*)(ws + WS_O);
        float* OPART = (float*)(ws + WS_OPART); float* OML = (float*)(ws + WS_OML); bf16_t* OLAT = (bf16_t*)(ws + WS_OLAT);
        const float QSCALE = 0.07216878364870322f * LOG2E;
        {
            pg8::Gemm g{CQ, WUQ, QL, QL, QL, 0, 0}; pg8::Order S{MP / 256, NH * QKD / 256, 1, G, bx};
            pg8::EpiQ E{Qb, ROPE_T, QSCALE};
            pg8::gemm_phase<pg8::EpiQ, true>(lds, wave, g, S, E);
            GRID_BAR();
        }
        {
            const int NQU = (MS / 256) * (NH * QKD / 256), NQP = NQU < G / 2 ? NQU : G / 2, NQC = 32 < G - NQP ? 32 : G - NQP;
            unsigned* qctr = ctl + 16 + 64 * 4;
            if (bx < NQP) {
                pg8::Gemm g{CQ, WUQ, QL, QL, QL, 0, 0}; pg8::OrderOff S{{MS / 256, NH * QKD / 256, 1, NQP, bx}, MP / 256};
                pg8::EpiQ E{Qb, ROPE_T, QSCALE};
                pg8::gemm_phase<pg8::EpiQ, true, pg8::OrderOff>(lds, wave, g, S, E);
                if (wave == 0 && lane_now() == 0) { __builtin_amdgcn_fence(__ATOMIC_RELEASE, "agent"); asm volatile("s_waitcnt vmcnt(0)" ::: "memory"); (void)xb_add(qctr, 1u); }
            }
            { pg8::Gemm g{CKV, WUKT, KVL, KVL, KVL, 0, 0}; pg8::Order S{MP / 256, NH * NOPE / 256, 1, G, bx};
              pg8::EpiBf16<0> E{KB, NH * NOPE, 0, 256, 1.f, 0};
              pg8::gemm_phase<pg8::EpiBf16<0>, true>(lds, wave, g, S, E); }
            { pg8::Gemm g{WUVT, CKV, KVL, KVL, KVL, 0, 0}; pg8::Order S{NH * VD / 256, MP / 256, 1, G, bx};
              pg8::EpiBf16<0> E{VT, MP, 0, 256, 1.f, 0};
              pg8::gemm_phase<pg8::EpiBf16<0>, true>(lds, wave, g, S, E); }
            if (bx >= G - NQC) {
                if (wave == 0 && lane_now() == 0) { XB_SPIN(xb_ld(qctr) < (unsigned)NQP, ctl + 1024); __builtin_amdgcn_fence(__ATOMIC_ACQUIRE, "agent"); asm volatile("s_waitcnt vmcnt(0)" ::: "memory"); }
                __syncthreads();
                { pg8::Gemm g{Qb + (size_t)MP * NH * QKD, WUK, NH * QKD, NH * NOPE, NOPE, QKD, NOPE}; pg8::Order S{MS / 256, 1, NH, NQC, bx - (G - NQC)};
                  pg8::EpiBf16<0> E{QLAT, NH * 320, 320, 256, 1.f, 0};
                  pg8::gemm_phase<pg8::EpiBf16<0>, true>(lds, wave, g, S, E); }
                const int lane = lane_now(), tid = wave * 64 + lane;
                for (int i = (bx - (G - NQC)) * (NWAVES * 64) + tid; i < MS * NH * 8; i += NQC * NWAVES * 64) { const int c = i & 7, th = i >> 3;
                    *(u32x4*)(QLAT + (size_t)th * 320 + 256 + c * 8) = *(const u32x4*)(Qb + (size_t)(MP + (th >> 3)) * (NH * QKD) + (th & 7) * QKD + NOPE + c * 8); }
            }
            GRID_BAR();
        }

        {
            for (int p = vcu; p < NB * NH * 4; p += G) { const int bh = p >> 2, x = p & 3;
                pat::unit(lds, wave, Qb, KB, KPEP, VT, Ob, bh >> 3, bh & 7, 7 - x);
                pat::unit(lds, wave, Qb, KB, KPEP, VT, Ob, bh >> 3, bh & 7, x); }
            STAMP();
            for (int u = bx; u < DECB * 2; u += G)
                sat::unit(lds, wave, QLAT, cache_ckv, cache_kpe, page_table, CKV + (size_t)MP * KVL, KPES, OPART, OML, u >> 1, u & 1);
            GRID_BAR();
        }
        {
            const int lane = lane_now(), tid = wave * 64 + lane; (void)tid;
            for (int r = gw; r < DECB * 64; r += NGW) { const int b = r >> 6, q = r & 63;
                const f32x2 ml0 = *(const f32x2*)(OML + ((size_t)(b * 2) * 64 + q) * 2), ml1 = *(const f32x2*)(OML + ((size_t)(b * 2 + 1) * 64 + q) * 2);
                const float mm = fmaxf(ml0[0], ml1[0]), w0 = __builtin_amdgcn_exp2f(ml0[0] - mm), w1 = __builtin_amdgcn_exp2f(ml1[0] - mm), inv = 1.0f / (ml0[1] * w0 + ml1[1] * w1);
                const f32x4 a = *(const f32x4*)(OPART + ((size_t)(b * 2) * 64 + q) * KVL + 4 * lane), c = *(const f32x4*)(OPART + ((size_t)(b * 2 + 1) * 64 + q) * KVL + 4 * lane);
                const f32x4 v = (a * w0 + c * w1) * inv;
                u32x2 w; w.x = cvt_pk_bf16(v[0], v[1]); w.y = cvt_pk_bf16(v[2], v[3]);
                *(u32x2*)(OLAT + (size_t)r * KVL + 4 * lane) = w; }
            GRID_BAR();
        }
        {
            pg8::Gemm g{OLAT, WUVT, NH * KVL, KVL, KVL, KVL, (long)VD * KVL}; pg8::Order S{MS / 256, 1, NH, G, bx};
            pg8::EpiBf16<0> E{Ob + (size_t)MP * DM, DM, VD, 128, 1.f, 0};
            pg8::gemm_phase<pg8::EpiBf16<0>, true>(lds, wave, g, S, E);
            GRID_BAR();
        }
        {
            { pg8::Gemm g{Ob, WOT, DM, DM, DM, 0, 0}; pg8::Order S{MP / 256, DM / 256, 1, G, bx};
              pg8::EpiBf16<0> E{T, DM, 0, 256, 1.f, 0};
              pg8::gemm_phase<pg8::EpiBf16<0>, true>(lds, wave, g, S, E); }
            { pg8::Gemm g{Ob + (size_t)MP * DM, WOT, DM, DM, 256, 256, 256}; pg8::Order S{MS / 256, DM / 256, 4, G, bx};
              pg8::EpiF32 E{TP, DM, (long)MS * DM};
              pg8::gemm_phase<pg8::EpiF32, true>(lds, wave, g, S, E); }
            GRID_BAR();
        }
        {
            thin_phase<true, true, false, false>(gw, NGW, nullptr, nullptr, T, TP, 4, H, nullptr, XN, norm_g + 3 * DM, norm_g + 4 * DM, 1.0f);
            GRID_BAR();
        }


    FFN_GEMMS(1);
    thin_phase<true, true, false, false>(gw, NGW, nullptr, nullptr, T, TP, 11, H, nullptr, XN, ng + 5 * DM, norm_g + 6 * DM, 0.5f); GRID_BAR();
    }
    { const float* ng = norm_g + 6 * DM;
    FFN_GEMMS(2);
    thin_phase<true, true, false, false>(gw, NGW, nullptr, nullptr, T, TP, 11, H, nullptr, XN, ng + 1 * DM, ng + 2 * DM, 0.5f); GRID_BAR();
            { pg8::Gemm g{XN, WGIN, DM, DM, DM, 0, 0}; pg8::Order S{M / 256, GIN_P / 256, 1, G, bx};
              pg8::EpiGla E{QKVG, T16, 0.08838834764831845f};
              pg8::gemm_phase<pg8::EpiGla, true>(lds, wave, g, S, E);
              GRID_BAR(); }
            bf16_t* GQT = (bf16_t*)(ws + WS_GQT); bf16_t* GKH = (bf16_t*)(ws + WS_GKH); bf16_t* GAT = (bf16_t*)(ws + WS_GAT); float* GDK_ = (float*)(ws + WS_GDK);
            { for (int u = bx; u < (M / 64) * GH; u += G) { const int chunk = u >> 2, h = u & 3;
                  if (chunk < MP / 64) gla::prep<64>(lds, wave, QKVG, T16, gla_w_gk2, gla_b_gk, chunk, h, GQT, GKH, GAT, GDK_);
                  else gla::prep<8>(lds, wave, QKVG, T16, gla_w_gk2, gla_b_gk, chunk, h, GQT, GKH, GAT, GDK_); }
              GRID_BAR(); }
            { const int NPB = (G >= 2 * NB * GH * 2) ? NB * GH * 2 : 0;
              if (NPB == 0 || vcu < NPB) {
                  for (int u = vcu; u < NB * GH * 2; u += (NPB ? NPB : G)) { const int bh = u >> 1, q = u & 1, b = bh >> 2, h = bh & 3;
                      gla::chain<4>(lds, wave, GQT, GKH, GAT, GDK_, QKVG, h, b * (SEQ / 64), SEQ / 64, 0, 64, -1, 0, 128 * q, nullptr, out + OUT_ST_P + (size_t)bh * GDK * GDV, GO); } }
              if (NPB == 0 || vcu >= NPB) {
                  for (int u = (NPB ? vcu - NPB : vcu); u < DECB * GH; u += (NPB ? G - NPB : G)) { const int b = u >> 2, h = u & 3;
                      gla::chain<8>(lds, wave, GQT, GKH, GAT, GDK_, QKVG, h, MP / 64 + (b >> 3), 1, 8 * (b & 7), 8, b & 7, b & 7, 0, state_gla + (size_t)u * GDK * GDV, out + OUT_ST_S + (size_t)u * GDK * GDV, GO); } }
              GRID_BAR(); }
            { const int lane = lane_now(), tid = wave * 64 + lane; (void)tid; const f32x4 gn = *(const f32x4*)(gla_g_norm + 4 * lane);
              for (int r = gw; r < M; r += NGW) {
                  Row16 o = ld_row_bf16(GO + (size_t)r * DM, lane);
                  const u32x2* gp = (const u32x2*)(QKVG + (size_t)r * GIN + 2 * GH * GDK + GH * GDV) + lane;
#pragma unroll
                  for (int j = 0; j < 4; ++j) { const u32x2 gw2 = gp[64 * j];
                      const float ss = wave_sum((o.v[j][0] * o.v[j][0] + o.v[j][1] * o.v[j][1]) + (o.v[j][2] * o.v[j][2] + o.v[j][3] * o.v[j][3]));
                      const float rs = __builtin_amdgcn_rsqf(ss * (1.0f / GDV) + EPS);
                      const float g0 = __uint_as_float(gw2.x << 16), g1 = __uint_as_float(gw2.x & 0xffff0000u), g2 = __uint_as_float(gw2.y << 16), g3 = __uint_as_float(gw2.y & 0xffff0000u);
                      o.v[j][0] = o.v[j][0] * rs * gn[0] * pg8::silu_f(g0); o.v[j][1] = o.v[j][1] * rs * gn[1] * pg8::silu_f(g1);
                      o.v[j][2] = o.v[j][2] * rs * gn[2] * pg8::silu_f(g2); o.v[j][3] = o.v[j][3] * rs * gn[3] * pg8::silu_f(g3); }
                  st_row_bf16(XN + (size_t)r * DM, o, lane); }
              GRID_BAR(); }
            { { pg8::Gemm g{XN, WGO, DM, DM, DM, 0, 0}; pg8::Order S{MP / 256, DM / 256, 1, G, bx};
                pg8::EpiBf16<0> E{T, DM, 0, 256, 1.f, 0};
                pg8::gemm_phase<pg8::EpiBf16<0>, true>(lds, wave, g, S, E); }
              { pg8::Gemm g{XN + (size_t)MP * DM, WGO, DM, DM, 256, 256, 256}; pg8::Order S{MS / 256, DM / 256, 4, G, bx};
                pg8::EpiF32 E{TP, DM, (long)MS * DM};
                pg8::gemm_phase<pg8::EpiF32, true>(lds, wave, g, S, E); }
              GRID_BAR(); }
            { thin_phase<true, true, false, false>(gw, NGW, nullptr, nullptr, T, TP, 4, H, nullptr, XN, ng + 3 * DM, ng + 4 * DM, 1.0f);
              GRID_BAR(); }

    FFN_GEMMS(3);
    thin_phase<true, false, false, true>(gw, NGW, nullptr, nullptr, T, TP, 11, H, Y, XN, ng + 5 * DM, nullptr, 0.5f);
    }
#ifdef PROBE_A0
    GRID_BAR();
    {
        const int lane = lane_now(), tid = wave * 64 + lane;
        const float ta = (float)(tsb[PROBE_A1] - tsb[PROBE_A0]) * 0.01f, tb = (float)(tsb[PROBE_B1] - tsb[PROBE_B0]) * 0.01f;
        if (bx == 0 && tid == 0) out[0] += ta * 0.1f;
        const float f = 1.0f + tb * (1.0f / PROBE_BDIV);
        for (int i = bx * (NWAVES * 64) + tid; i < MS * ROPE; i += G * NWAVES * 64) out[OUT_KPE_S + i] *= f;
    }
#endif
#ifdef DBG_SCALE_MASK
    GRID_BAR();
    {
        const int lane = lane_now(), tid = wave * 64 + lane; (void)tid;
        const size_t offs[9] = {OUT_Y, OUT_Y + (size_t)MP * DM, OUT_CKV_P, OUT_KPE_P, OUT_CKV_S, OUT_KPE_S, OUT_ST_P, OUT_ST_S, OUT_END};
        for (int o = 0; o < 8; ++o) if ((DBG_SCALE_MASK >> o) & 1)
            for (size_t i = offs[o] / 4 + (size_t)vcu * (NWAVES * 64) + tid; i < offs[o + 1] / 4; i += (size_t)G * NWAVES * 64) ((f32x4*)out)[i] = ((f32x4*)out)[i] * 3.0f;
    }
#endif
#undef GRID_BAR
}

extern "C" void kernel_launch(void* const* d_in, const int* in_sizes, int n_in, void* d_out, int out_size, void* d_ws, size_t ws_size, hipStream_t stream) {
    static int grid = 0;
    if (grid == 0) {
        if (n_in != 22 || (size_t)out_size != OUT_END || ws_size < WS_END) { fprintf(stderr, "kernel_launch: unexpected shapes: n_in %d out %d ws %zu (need %zu)\n", n_in, out_size, ws_size, (size_t)WS_END); grid = -1; return; }
        int dev = 0, cus = 0, per_cu = 0;
        if (hipGetDevice(&dev) != hipSuccess || hipDeviceGetAttribute(&cus, hipDeviceAttributeMultiprocessorCount, dev) != hipSuccess) { grid = -1; return; }
        if (hipFuncSetAttribute((const void*)mk_fwd, hipFuncAttributeMaxDynamicSharedMemorySize, LDS_BYTES) != hipSuccess) { fprintf(stderr, "kernel_launch: hipFuncSetAttribute failed\n"); grid = -1; return; }
        if (hipOccupancyMaxActiveBlocksPerMultiprocessor(&per_cu, (const void*)mk_fwd, NWAVES * 64, LDS_BYTES) != hipSuccess || per_cu < 1) { fprintf(stderr, "kernel_launch: occupancy query says %d\n", per_cu); }
        (void)hipGetLastError();
        grid = cus;
    }
    if (grid < 0) return;
    if (hipMemsetAsync((char*)d_ws + WS_CTL, 0, CTL_ZERO_BYTES, stream) != hipSuccess) return;
    Args a{};
    for (int i = 0; i < 22; ++i) a.in[i] = d_in[i];
    a.out = (float*)d_out; a.ws = (unsigned char*)d_ws; a.ph_lo = 0; a.ph_hi = 100;
    hipLaunchKernelGGL(mk_fwd, dim3(grid), dim3(NWAVES * 64), LDS_BYTES, stream, a);
}
```

```cpp
#include <hip/hip_runtime.h>
#include <cstdio>
#include <cstdint>


#define GAS __attribute__((address_space(1)))
#define LAS __attribute__((address_space(3)))
typedef unsigned short bf16_t;
typedef short bf16x8 __attribute__((ext_vector_type(8)));
typedef float f32x4 __attribute__((ext_vector_type(4)));
typedef float f32x2 __attribute__((ext_vector_type(2)));
typedef float f32x16 __attribute__((ext_vector_type(16)));
typedef unsigned u32x4 __attribute__((ext_vector_type(4)));
typedef unsigned u32x2 __attribute__((ext_vector_type(2)));

constexpr int DM = 1024, NB = 16, SEQ = 2048, DECB = 128, DECT = 8, PAST = 8192, PAGE = 128, NPAGES = PAST / PAGE;
constexpr int MP = NB * SEQ, MS = DECB * DECT, M = MP + MS;
constexpr int DFF = 2816;
constexpr int QL = 384, KVL = 256, NOPE = 128, ROPE = 64, VD = 128, NH = 8, QKD = NOPE + ROPE;
constexpr int DDOWN = QL + KVL + ROPE, DDOWN_P = 768;
constexpr int GH = 4, GDK = 128, GDV = 256, GRANK = 16, GIN = 2 * GH * GDK + 2 * GH * GDV, GIN_P = GIN + 256;
constexpr float EPS = 1e-6f;
constexpr float LOG2E = 1.4426950408889634f;
constexpr int NPOOL = (DECB * NPAGES * 5) / 4;

constexpr size_t OUT_Y = 0;
constexpr size_t OUT_CKV_P = (size_t)M * DM;
constexpr size_t OUT_KPE_P = OUT_CKV_P + (size_t)MP * KVL;
constexpr size_t OUT_CKV_S = OUT_KPE_P + (size_t)MP * ROPE;
constexpr size_t OUT_KPE_S = OUT_CKV_S + (size_t)MS * KVL;
constexpr size_t OUT_ST_P = OUT_KPE_S + (size_t)MS * ROPE;
constexpr size_t OUT_ST_S = OUT_ST_P + (size_t)NB * GH * GDK * GDV;
constexpr size_t OUT_END = OUT_ST_S + (size_t)DECB * GH * GDK * GDV;

constexpr size_t MiB = 1u << 20;
constexpr size_t al(size_t x) { return (x + 4095) & ~(size_t)4095; }
constexpr size_t WS_CTL = 0, CTL_ZERO_BYTES = 64 * 1024;
constexpr size_t WS_ROPE = 1 * MiB;
constexpr size_t WS_WIN = 2 * MiB;
constexpr size_t SZ_WIN1 = (size_t)2 * DFF * DM * 2;
constexpr size_t WS_WOUT = WS_WIN + 4 * SZ_WIN1;
constexpr size_t SZ_WOUT1 = (size_t)DM * DFF * 2;
constexpr size_t WS_WDOWN = WS_WOUT + 4 * SZ_WOUT1;
constexpr size_t WS_WUQ = WS_WDOWN + (size_t)DDOWN_P * DM * 2;
constexpr size_t WS_WUKT = WS_WUQ + (size_t)NH * QKD * QL * 2;
constexpr size_t WS_WUK = WS_WUKT + (size_t)NH * NOPE * KVL * 2;
constexpr size_t WS_WUVT = WS_WUK + (size_t)NH * NOPE * KVL * 2;
constexpr size_t WS_WOT = WS_WUVT + (size_t)(NH * VD + 128) * KVL * 2;
constexpr size_t WS_WGIN = WS_WOT + (size_t)DM * DM * 2;
constexpr size_t WS_WGO = WS_WGIN + (size_t)GIN_P * DM * 2;
constexpr size_t WS_ACT = al(WS_WGO + (size_t)DM * DM * 2);
constexpr size_t WS_XN = WS_ACT;
constexpr size_t WS_HM = al(WS_XN + (size_t)M * DM * 2);
constexpr size_t WS_T = al(WS_HM + (size_t)M * DFF * 2);
constexpr size_t WS_D = al(WS_T + (size_t)M * DM * 4);
constexpr size_t WS_CQ = al(WS_D + (size_t)M * DDOWN_P * 4);
constexpr size_t WS_CKV = al(WS_CQ + (size_t)M * QL * 2);
constexpr size_t WS_KPES = al(WS_CKV + (size_t)M * KVL * 2);
constexpr size_t WS_Q = al(WS_KPES + (size_t)MS * ROPE * 2);
constexpr size_t WS_KB = al(WS_Q + (size_t)M * NH * QKD * 2);
constexpr size_t WS_KPEP = al(WS_KB + (size_t)MP * NH * NOPE * 2);
constexpr size_t WS_VT = al(WS_KPEP + (size_t)MP * ROPE * 2);
constexpr size_t WS_QLAT = al(WS_VT + (size_t)NH * VD * MP * 2);
constexpr size_t WS_O = al(WS_QLAT + (size_t)MS * NH * 320 * 2);
constexpr size_t WS_OPART = al(WS_O + (size_t)M * DM * 2);
constexpr size_t WS_OML = al(WS_OPART + (size_t)DECB * 2 * 64 * 256 * 4);
constexpr size_t WS_OLAT = al(WS_OML + (size_t)DECB * 2 * 64 * 2 * 4);
constexpr size_t WS_QKVG = al(WS_OLAT + (size_t)MS * NH * KVL * 2);
constexpr size_t WS_T16 = al(WS_QKVG + (size_t)M * GIN * 2);
constexpr size_t WS_GO = al(WS_T16 + (size_t)M * 16 * 4);
constexpr size_t WS_H = al(WS_GO + (size_t)M * DM * 4);
constexpr size_t WS_TP = al(WS_H + (size_t)M * DM * 2);
constexpr size_t WS_GQT = al(WS_TP + (size_t)11 * MS * DM * 4);
constexpr size_t WS_GKH = al(WS_GQT + (size_t)M * GH * GDK * 2);
constexpr size_t WS_GAT = al(WS_GKH + (size_t)(M / 64) * GH * 128 * 64 * 2);
constexpr size_t WS_GDK = al(WS_GAT + (size_t)(M / 64) * GH * 3072 * 2);
constexpr size_t WS_END = al(WS_GDK + (size_t)(M / 64) * GH * 1024 * 4);

constexpr int RING_BYTES = 131072;
constexpr int LDSCTL_OFF = RING_BYTES, MISC_OFF = LDSCTL_OFF + 320;
constexpr int LDS_BYTES = 147456;
constexpr int NWAVES = 8;

#define LDS_WAIT() asm volatile("s_waitcnt lgkmcnt(0)" ::: "memory")
#define VM_WAIT() asm volatile("s_waitcnt vmcnt(0)" ::: "memory")
#define RLX_AGENT __ATOMIC_RELAXED, __HIP_MEMORY_SCOPE_AGENT

typedef __bf16 bf16x2_t __attribute__((ext_vector_type(2)));
__device__ __forceinline__ unsigned cvt_pk_bf16(float lo, float hi) { const f32x2 v = {lo, hi}; const bf16x2_t b = __builtin_convertvector(v, bf16x2_t); return __builtin_bit_cast(unsigned, b); }
__device__ __forceinline__ int lane_now() { int l; asm volatile("v_mbcnt_lo_u32_b32 %0, -1, 0\n\tv_mbcnt_hi_u32_b32 %0, -1, %0" : "=v"(l)); return l; }
__device__ __forceinline__ float bf2f(unsigned short b) { return __uint_as_float((unsigned)b << 16); }
template <int CTRL> __device__ __forceinline__ float dpp_mov(float v) { return __builtin_bit_cast(float, __builtin_amdgcn_update_dpp(0, __builtin_bit_cast(int, v), CTRL, 0xF, 0xF, true)); }
__device__ __forceinline__ float wave_sum(float v) {
    v += dpp_mov<0xB1>(v);
    v += dpp_mov<0x4E>(v);
    v += dpp_mov<0x141>(v);
    v += dpp_mov<0x140>(v);
    const int iv = __builtin_bit_cast(int, v);
    const float a = __builtin_bit_cast(float, __builtin_amdgcn_readlane(iv, 0)), b = __builtin_bit_cast(float, __builtin_amdgcn_readlane(iv, 16));
    const float c = __builtin_bit_cast(float, __builtin_amdgcn_readlane(iv, 32)), d = __builtin_bit_cast(float, __builtin_amdgcn_readlane(iv, 48));
    return (a + b) + (c + d);
}

namespace pg8 {
constexpr int BM = 256, BK = 64, HALF = 128, HTB = HALF * BK * 2, STAGE_BYTES = 8 * HTB, NXCD = 8, WGM = 8;
__host__ __device__ __forceinline__ int lds_byte(int r, int c) { const int st = (r >> 4) * 2 + (c >> 5), rr = r & 15, cc = c & 31, ob = rr * 64 + cc * 2; return st * 1024 + (ob ^ (((ob >> 9) & 1) << 5)); }
__host__ __device__ __forceinline__ void stage_rc(int b, int& R, int& C) { const int st = b / 1024, sb = b % 1024, swz = sb ^ (((sb >> 9) & 1) << 5); R = (st >> 1) * 16 + swz / 64; C = (st & 1) * 32 + (swz % 64) / 2; }
__host__ __device__ __forceinline__ int perm32(int rho) { const int n = rho >> 4, i = rho & 15; return 8 * (i >> 2) + 4 * n + (i & 3); }

struct Unit { int pm, pn, z; };
struct Gemm { const bf16_t* A; const bf16_t* Bt; int lda, ldb, K; long sAz, sBz; };

struct Order {
    int nM, nN, nZ, G, c;
    __device__ __forceinline__ bool next(int i, Unit& u) const {
        const long L = (long)i * G + c; const int per = nM * nN; if (L >= (long)per * nZ) return false;
        const int z = (int)(L / per); int wgid = (int)(L - (long)z * per);
        { const int q = per / NXCD, r = per % NXCD, xcd = wgid % NXCD, off = wgid / NXCD; wgid = (xcd < r ? xcd * (q + 1) : r * (q + 1) + (xcd - r) * q) + off; }
        const int nig = WGM * nN, gid = wgid / nig, fm = gid * WGM, gsz = (nM - fm) < WGM ? (nM - fm) : WGM;
        u.pm = fm + ((wgid % nig) % gsz); u.pn = (wgid % nig) / gsz; u.z = z; return true;
    }
};

struct OrderOff {
    Order o; int m0;
    __device__ __forceinline__ bool next(int i, Unit& u) const { const bool ok = o.next(i, u); u.pm += m0; return ok; }
};

template <class Epi, bool ALIGN_EPI, class Ord = Order>
__device__ __forceinline__ void gemm_phase(LAS unsigned char* lds, const int wid, const Gemm g, const Ord& S, const Epi& E) {
    const int lane = lane_now(), tid = wid * 64 + lane;
    const int wr = wid >> 2, wc = wid & 3, fr = lane & 15, fq = lane >> 4;
    const int K = g.K, nt = K / BK;
    unsigned voffA, voffB;
    { int R, C; stage_rc(tid * 16, R, C); const int Rb = Epi::PERM ? ((R & ~31) + perm32(R & 31)) : R;
      voffA = (unsigned)(R * g.lda + C) * 2u; voffB = (unsigned)(Rb * g.ldb + C) * 2u; }
    const size_t qsA = (size_t)64 * g.lda * 2, qsB = (size_t)64 * g.ldb * 2;
    const size_t kstep = (size_t)(BK * 2);
    const size_t hsA = (size_t)HALF * g.lda * 2, hsB = (size_t)HALF * g.ldb * 2;
    const unsigned ldsw = (unsigned)wid * 1024u;
    const int aoff = lds_byte(wr * 64 + fr, fq * 8), boff = lds_byte(wc * 32 + fr, fq * 8);
#define PG8_SA(b, h) (((b) * 2 + (h)) * HTB)
#define PG8_SB(b, h) ((4 + (b) * 2 + (h)) * HTB)
#define PG8_STAGE(bufoff, gbase, voff) do { _Pragma("unroll") for (int _i = 0; _i < 2; ++_i) \
        __builtin_amdgcn_global_load_lds((const unsigned*)((const char*)(gbase) + _i * PG8_QS_##voff + (voff)), (LAS unsigned*)(lds + (bufoff) + ldsw + _i * 8192), 16, 0, 0); } while (0)
#define PG8_QS_voffA qsA
#define PG8_QS_voffB qsB
#define PG8_LDA(dst, b, h) do { _Pragma("unroll") for (int m = 0; m < 4; ++m) _Pragma("unroll") for (int k = 0; k < 2; ++k) dst[m][k] = *(const LAS bf16x8*)(lds + PG8_SA(b, h) + aoff + m * 2048 + k * 1024); } while (0)
#define PG8_LDB(dst, b, h) do { _Pragma("unroll") for (int n = 0; n < 2; ++n) _Pragma("unroll") for (int k = 0; k < 2; ++k) dst[n][k] = *(const LAS bf16x8*)(lds + PG8_SB(b, h) + boff + n * 2048 + k * 1024); } while (0)
#define PG8_MMA(ai, bj, At, Bt) do { __builtin_amdgcn_s_setprio(1); _Pragma("unroll") for (int m = 0; m < 4; ++m) _Pragma("unroll") for (int n = 0; n < 2; ++n) _Pragma("unroll") for (int k = 0; k < 2; ++k) \
        acc[ai][bj][m][n] = __builtin_amdgcn_mfma_f32_16x16x32_bf16(Bt[n][k], At[m][k], acc[ai][bj][m][n], 0, 0, 0); __builtin_amdgcn_s_setprio(0); } while (0)
#define PG8_WAIT_V(n) asm volatile("s_waitcnt vmcnt(" #n ")" ::: "memory")
#define PG8_WAIT_L(n) asm volatile("s_waitcnt lgkmcnt(" #n ")" ::: "memory")
#define PG8_BAR __builtin_amdgcn_s_barrier()
#define PG8_SCHED __builtin_amdgcn_sched_barrier(0)
#define PG8_APTR(u) ((const char*)g.A + ((size_t)(u).z * g.sAz + (size_t)(u).pm * BM * g.lda) * 2)
#define PG8_BPTR(u) ((const char*)g.Bt + ((size_t)(u).z * g.sBz + (size_t)(u).pn * BM * g.ldb) * 2)
    Unit cur, nxt; int ui = 0;
    if (!S.next(0, cur)) return;
    f32x4 acc[2][2][4][2];
#pragma unroll
    for (int a = 0; a < 2; ++a)
#pragma unroll
        for (int b = 0; b < 2; ++b)
#pragma unroll
            for (int m = 0; m < 4; ++m)
#pragma unroll
                for (int n = 0; n < 2; ++n) acc[a][b][m][n] = (f32x4){0.f, 0.f, 0.f, 0.f};
    bf16x8 At[4][2], B0[2][2], B1[2][2];
    const char* cA = PG8_APTR(cur); const char* cB = PG8_BPTR(cur);
    PG8_STAGE(PG8_SB(0, 0), cB, voffB); PG8_STAGE(PG8_SB(0, 1), cB + hsB, voffB); PG8_STAGE(PG8_SA(0, 0), cA, voffA); PG8_STAGE(PG8_SA(0, 1), cA + hsA, voffA);
    if (wr == 1) PG8_BAR;
    PG8_WAIT_V(2); PG8_BAR;
    PG8_STAGE(PG8_SB(1, 0), cB + kstep, voffB); PG8_STAGE(PG8_SA(1, 0), cA + kstep, voffA); PG8_STAGE(PG8_SB(1, 1), cB + hsB + kstep, voffB);
    PG8_WAIT_V(6); PG8_BAR;
    for (;;) {
        const bool has_next = S.next(ui + 1, nxt);
        const char* nA = has_next ? PG8_APTR(nxt) : cA; const char* nB = has_next ? PG8_BPTR(nxt) : cB;
#pragma unroll 1
        for (int t = 0; t < nt; t += 2) {
            const bool last = (t == nt - 2);
            const char* a1 = cA + (size_t)(t + 1) * kstep;
            const char* a2 = last ? nA : cA + (size_t)(t + 2) * kstep; const char* b2 = last ? nB : cB + (size_t)(t + 2) * kstep;
            const char* a3 = a2 + kstep; const char* b3 = b2 + kstep;
            PG8_LDB(B0, 0, 0); PG8_LDB(B1, 0, 1); PG8_SCHED; PG8_LDA(At, 0, 0); PG8_STAGE(PG8_SA(1, 1), a1 + hsA, voffA);
            PG8_WAIT_V(8); PG8_WAIT_L(0); PG8_BAR; PG8_MMA(0, 0, At, B0); PG8_MMA(0, 1, At, B1); PG8_BAR; PG8_SCHED;
            PG8_LDA(At, 0, 1); PG8_STAGE(PG8_SB(0, 0), b2, voffB); PG8_STAGE(PG8_SB(0, 1), b2 + hsB, voffB); PG8_STAGE(PG8_SA(0, 0), a2, voffA);
            PG8_WAIT_V(8); PG8_WAIT_L(0); PG8_BAR; PG8_MMA(1, 0, At, B0); PG8_MMA(1, 1, At, B1); PG8_BAR; PG8_SCHED;
            PG8_LDB(B0, 1, 0); PG8_LDB(B1, 1, 1); PG8_SCHED; PG8_LDA(At, 1, 0); PG8_STAGE(PG8_SA(0, 1), a2 + hsA, voffA);
            PG8_WAIT_V(8); PG8_WAIT_L(0); PG8_BAR; PG8_MMA(0, 0, At, B0); PG8_MMA(0, 1, At, B1); PG8_BAR; PG8_SCHED;
            PG8_LDA(At, 1, 1); PG8_STAGE(PG8_SB(1, 0), b3, voffB); PG8_STAGE(PG8_SB(1, 1), b3 + hsB, voffB); PG8_STAGE(PG8_SA(1, 0), a3, voffA);
            PG8_WAIT_V(8); PG8_WAIT_L(0); PG8_BAR; PG8_MMA(1, 0, At, B0); PG8_MMA(1, 1, At, B1); PG8_BAR; PG8_SCHED;
        }
        if constexpr (ALIGN_EPI) { if (wr == 0) PG8_BAR; }
        { int fr2 = fr, fq2 = fq; asm volatile("" : "+v"(fr2), "+v"(fq2)); E(acc, cur, wr, wc, fr2, fq2); }
        if (!has_next) break;
#pragma unroll
        for (int a = 0; a < 2; ++a)
#pragma unroll
            for (int b = 0; b < 2; ++b)
#pragma unroll
                for (int m = 0; m < 4; ++m)
#pragma unroll
                    for (int n = 0; n < 2; ++n) acc[a][b][m][n] = (f32x4){0.f, 0.f, 0.f, 0.f};
        cur = nxt; cA = nA; cB = nB; ++ui;
        if constexpr (ALIGN_EPI) { if (wr == 1) PG8_BAR; }
    }
    PG8_WAIT_V(0);
    if constexpr (!ALIGN_EPI) { if (wr == 0) PG8_BAR; }
    PG8_BAR;
#undef PG8_SA
#undef PG8_SB
#undef PG8_STAGE
#undef PG8_QS_voffA
#undef PG8_QS_voffB
#undef PG8_LDA
#undef PG8_LDB
#undef PG8_MMA
#undef PG8_WAIT_V
#undef PG8_WAIT_L
#undef PG8_BAR
#undef PG8_SCHED
#undef PG8_APTR
#undef PG8_BPTR
}

__device__ __forceinline__ float silu_f(float g) { return g * __builtin_amdgcn_rcpf(1.0f + __builtin_amdgcn_exp2f(-g * LOG2E)); }
__device__ __forceinline__ float swiglu_f(float g, float u) { return (g * u) * __builtin_amdgcn_rcpf(1.0f + __builtin_amdgcn_exp2f(-g)); }

struct EpiSwiGLU {
    static constexpr bool PERM = true;
    bf16_t* O; int ldc;
    __device__ __forceinline__ void operator()(const f32x4 (&acc)[2][2][4][2], const Unit& u, int wr, int wc, int fr, int fq) const {
        const int row0 = u.pm * BM + wr * 64 + fr, col0 = u.pn * HALF + wc * 32 + 8 * fq;
#pragma unroll
        for (int ai = 0; ai < 2; ++ai)
#pragma unroll
            for (int m = 0; m < 4; ++m) {
                bf16_t* rowp = O + (size_t)(row0 + ai * HALF + m * 16) * ldc + col0;
                const f32x4 g0 = acc[ai][0][m][0], g1 = acc[ai][0][m][1], u0 = acc[ai][1][m][0], u1 = acc[ai][1][m][1];
                u32x4 w;
                w.x = cvt_pk_bf16(swiglu_f(g0[0], u0[0]), swiglu_f(g0[1], u0[1])); w.y = cvt_pk_bf16(swiglu_f(g0[2], u0[2]), swiglu_f(g0[3], u0[3]));
                w.z = cvt_pk_bf16(swiglu_f(g1[0], u1[0]), swiglu_f(g1[1], u1[1])); w.w = cvt_pk_bf16(swiglu_f(g1[2], u1[2]), swiglu_f(g1[3], u1[3]));
                *(u32x4*)rowp = w;
            }
    }
};
struct EpiF32 {
    static constexpr bool PERM = false;
    float* O; int ldc; long sOz;
    __device__ __forceinline__ void operator()(const f32x4 (&acc)[2][2][4][2], const Unit& u, int wr, int wc, int fr, int fq) const {
        const int row0 = u.pm * BM + wr * 64 + fr, col0 = u.pn * BM + wc * 32 + 4 * fq;
#pragma unroll
        for (int ai = 0; ai < 2; ++ai)
#pragma unroll
            for (int m = 0; m < 4; ++m) {
                float* rowp = O + (size_t)u.z * sOz + (size_t)(row0 + ai * HALF + m * 16) * ldc + col0;
#pragma unroll
                for (int bj = 0; bj < 2; ++bj)
#pragma unroll
                    for (int n = 0; n < 2; ++n) *(f32x4*)(rowp + bj * HALF + n * 16) = acc[ai][bj][m][n];
            }
    }
};

template <int CMAP> struct EpiBf16 {
    static constexpr bool PERM = true;
    bf16_t* O; int ldc; long sOz; int ncol; float scale; int scale_cols;
    __device__ __forceinline__ void operator()(const f32x4 (&acc)[2][2][4][2], const Unit& u, int wr, int wc, int fr, int fq) const {
        const int row0 = u.pm * BM + wr * 64 + fr;
#pragma unroll
        for (int bj = 0; bj < 2; ++bj) {
            const int ct = bj * HALF + wc * 32 + 8 * fq; if (ct >= ncol) continue;
            const int c0 = u.pn * BM + ct; const int oc = CMAP == 1 ? (c0 >> 7) * 192 + (c0 & 127) : c0;
            const float sc = c0 < scale_cols ? scale : 1.f;
            bf16_t* base = O + (size_t)u.z * sOz + oc;
#pragma unroll
            for (int ai = 0; ai < 2; ++ai)
#pragma unroll
                for (int m = 0; m < 4; ++m) { const f32x4 v0 = acc[ai][bj][m][0] * sc, v1 = acc[ai][bj][m][1] * sc;
                    u32x4 w; w.x = cvt_pk_bf16(v0[0], v0[1]); w.y = cvt_pk_bf16(v0[2], v0[3]); w.z = cvt_pk_bf16(v1[0], v1[1]); w.w = cvt_pk_bf16(v1[2], v1[3]);
                    *(u32x4*)(base + (size_t)(row0 + ai * HALF + m * 16) * ldc) = w; }
        }
    }
};
struct EpiQ {
    static constexpr bool PERM = true;
    bf16_t* O; const float* rope_t; float scale;
    __device__ __forceinline__ void operator()(const f32x4 (&acc)[2][2][4][2], const Unit& u, int wr, int wc, int fr, int fq) const {
        const int row0 = u.pm * BM + wr * 64 + fr;
#pragma unroll
        for (int bj = 0; bj < 2; ++bj) {
            const int c0 = u.pn * BM + bj * HALF + wc * 32 + 8 * fq; const int h = c0 / 192, f0 = c0 - h * 192;
            if (f0 < 128) {
#pragma unroll
                for (int ai = 0; ai < 2; ++ai)
#pragma unroll
                    for (int m = 0; m < 4; ++m) { const f32x4 v0 = acc[ai][bj][m][0] * scale, v1 = acc[ai][bj][m][1] * scale;
                        u32x4 w; w.x = cvt_pk_bf16(v0[0], v0[1]); w.y = cvt_pk_bf16(v0[2], v0[3]); w.z = cvt_pk_bf16(v1[0], v1[1]); w.w = cvt_pk_bf16(v1[2], v1[3]);
                        *(u32x4*)(O + (size_t)(row0 + ai * HALF + m * 16) * 1536 + c0) = w; }
            } else {
                const int a4 = ((f0 - 128) >> 3) * 4;
#pragma unroll
                for (int ai = 0; ai < 2; ++ai)
#pragma unroll
                    for (int m = 0; m < 4; ++m) { const int r = row0 + ai * HALF + m * 16; const int pidx = r < MP ? (r & (SEQ - 1)) : SEQ + ((r - MP) & (DECT - 1));
                        const f32x4 cs0 = *(const f32x4*)(rope_t + (size_t)(pidx * 32 + a4) * 2), cs1 = *(const f32x4*)(rope_t + (size_t)(pidx * 32 + a4) * 2 + 4);
                        const f32x4 x1 = acc[ai][bj][m][0] * scale, x2 = acc[ai][bj][m][1] * scale;
                        const float y10 = x1[0] * cs0[0] - x2[0] * cs0[1], y11 = x1[1] * cs0[2] - x2[1] * cs0[3], y12 = x1[2] * cs1[0] - x2[2] * cs1[1], y13 = x1[3] * cs1[2] - x2[3] * cs1[3];
                        const float y20 = x2[0] * cs0[0] + x1[0] * cs0[1], y21 = x2[1] * cs0[2] + x1[1] * cs0[3], y22 = x2[2] * cs1[0] + x1[2] * cs1[1], y23 = x2[3] * cs1[2] + x1[3] * cs1[3];
                        bf16_t* rowp = O + (size_t)r * 1536 + h * 192 + 128 + a4;
                        u32x2 w1, w2; w1.x = cvt_pk_bf16(y10, y11); w1.y = cvt_pk_bf16(y12, y13); w2.x = cvt_pk_bf16(y20, y21); w2.y = cvt_pk_bf16(y22, y23);
                        *(u32x2*)rowp = w1; *(u32x2*)(rowp + 32) = w2; asm volatile("" ::: "memory"); }
            }
        }
    }
};

struct EpiGla {
    static constexpr bool PERM = true;
    bf16_t* O; float* T16; float qscale;
    __device__ __forceinline__ void operator()(const f32x4 (&acc)[2][2][4][2], const Unit& u, int wr, int wc, int fr, int fq) const {
        const int row0 = u.pm * BM + wr * 64 + fr;
        if (u.pn < 12) {
#pragma unroll
            for (int bj = 0; bj < 2; ++bj) {
                const int c0 = u.pn * BM + bj * HALF + wc * 32 + 8 * fq; const float sc = c0 < 512 ? qscale : 1.f;
#pragma unroll
                for (int ai = 0; ai < 2; ++ai)
#pragma unroll
                    for (int m = 0; m < 4; ++m) { const f32x4 v0 = acc[ai][bj][m][0] * sc, v1 = acc[ai][bj][m][1] * sc;
                        u32x4 w; w.x = cvt_pk_bf16(v0[0], v0[1]); w.y = cvt_pk_bf16(v0[2], v0[3]); w.z = cvt_pk_bf16(v1[0], v1[1]); w.w = cvt_pk_bf16(v1[2], v1[3]);
                        *(u32x4*)(O + (size_t)(row0 + ai * HALF + m * 16) * GIN + c0) = w; }
            }
        } else if (wc == 0 && fq < 2) {
#pragma unroll
            for (int ai = 0; ai < 2; ++ai)
#pragma unroll
                for (int m = 0; m < 4; ++m) { float* tp = T16 + (size_t)(row0 + ai * HALF + m * 16) * 16 + 8 * fq;
                    *(f32x4*)tp = acc[ai][0][m][0]; *(f32x4*)(tp + 4) = acc[ai][0][m][1]; }
        }
    }
};
}

#define XB_TMO      128
#define XB_XCNT(j)  (256  + 64 * (j))
#define XB_XSUB(j)  (1280 + 64 * (j))
#define XB_XGEN(j)  (2304 + 64 * (j))
#define XB_TOP      3328
#define XB_TOPGEN   3392
#define XCD_BAR_WORDS 3456
#define XB_SPIN_CAP (1u << 18)

__device__ __forceinline__ unsigned xb_ld(unsigned* p)              { return __hip_atomic_load(p, __ATOMIC_RELAXED, __HIP_MEMORY_SCOPE_AGENT); }
__device__ __forceinline__ unsigned xb_add(unsigned* p, unsigned v) { return __hip_atomic_fetch_add(p, v, __ATOMIC_RELAXED, __HIP_MEMORY_SCOPE_AGENT); }
__device__ __forceinline__ unsigned xb_xcc_id() { return (unsigned)__builtin_amdgcn_s_getreg((3 << 11) | 20) & 0xFu; }
#define XB_SPIN(cond, bar) do { unsigned _sp = 0; while (cond) { __builtin_amdgcn_s_sleep(1); \
    if ((++_sp & 255u) == 0u) { if (xb_ld(&(bar)[XB_TMO])) break; if (_sp > XB_SPIN_CAP) { atomicAdd(&(bar)[XB_TMO], 1u); break; } } } } while (0)

struct XcdBarrier { unsigned* bar; unsigned x; volatile LAS unsigned* st; };

__device__ __forceinline__ XcdBarrier xcd_barrier_post(unsigned* bar, volatile LAS unsigned* st, bool t0) {
    XcdBarrier b; b.bar = bar; b.x = xb_xcc_id(); b.st = st;
    if (t0) (void)xb_add(&bar[XB_XCNT(b.x)], 1u);
    return b;
}
__device__ __forceinline__ void xcd_barrier_complete(unsigned* bar, unsigned x, unsigned& nloc, unsigned& nx) {
    const unsigned G = gridDim.x * gridDim.y * gridDim.z;
    unsigned sum, cnt, mine, sp = 0u;
    for (;;) {
        sum = 0u; cnt = 0u; mine = 0u;
#pragma unroll
        for (unsigned j = 0; j < 16; ++j) { const unsigned c = xb_ld(&bar[XB_XCNT(j)]); sum += c; cnt += (c > 0u) ? 1u : 0u; mine = (j == x) ? c : mine; }
        if (sum == G) break;
        __builtin_amdgcn_s_sleep(1);
        if ((++sp & 255u) == 0u) { if (xb_ld(&bar[XB_TMO])) break; if (sp > XB_SPIN_CAP) { atomicAdd(&bar[XB_TMO], 1u); break; } }
    }
    nloc = mine > 0u ? mine : 1u; nx = cnt > 0u ? cnt : 1u;
}
__device__ __forceinline__ void xcd_barrier(const XcdBarrier& b, bool t0) {
    asm volatile("s_waitcnt vmcnt(0)" ::: "memory");
    __syncthreads();
    if (t0) {
        unsigned* bar = b.bar;
        __builtin_amdgcn_s_waitcnt(0);
        unsigned nloc = b.st[0], nx = b.st[1];
        if (nloc == 0u) { xcd_barrier_complete(bar, b.x, nloc, nx); b.st[0] = nloc; b.st[1] = nx; }
        const unsigned old = xb_add(&bar[XB_XSUB(b.x)], 1u);
        const unsigned gen = old / nloc;
        if (old + 1u == (gen + 1u) * nloc) {
            __builtin_amdgcn_fence(__ATOMIC_RELEASE, "agent");
            asm volatile("s_waitcnt vmcnt(0)" ::: "memory");
            const unsigned og = xb_add(&bar[XB_TOP], 1u);
            const unsigned tg = og / nx;
            if (og + 1u == (tg + 1u) * nx) xb_add(&bar[XB_TOPGEN], 1u);
            else XB_SPIN(xb_ld(&bar[XB_TOPGEN]) == tg, bar);
            __builtin_amdgcn_fence(__ATOMIC_ACQUIRE, "agent");
            xb_add(&bar[XB_XGEN(b.x)], 1u);
            asm volatile("s_waitcnt vmcnt(0)" ::: "memory");
        } else {
            XB_SPIN(xb_ld(&bar[XB_XGEN(b.x)]) == gen, bar);
            __builtin_amdgcn_fence(__ATOMIC_ACQUIRE, "agent");
            asm volatile("s_waitcnt vmcnt(0)" ::: "memory");
        }
    }
    __syncthreads();
}

struct Args { const void* in[22]; float* out; unsigned char* ws; int ph_lo, ph_hi; };

struct Frame {
    LAS unsigned char* lds;
    int tid, lane, wave, vcu, G;
    const float* const* dummy;
};

__device__ __forceinline__ void transpose_item(const float* W, int N, int k0, int n0, bf16_t* WT, int KT, int drow0, int interleave, LAS float* scr, int lane, float sc = 1.0f) {
    f32x4 v[8];
    const float* src = W + (size_t)(k0 + (lane >> 3)) * N + n0 + 4 * (lane & 7);
#pragma unroll
    for (int i = 0; i < 8; ++i) v[i] = *(const f32x4*)(src + (size_t)(8 * i) * N);
#pragma unroll
    for (int i = 0; i < 8; ++i) { LAS float* d = scr + (8 * i + (lane >> 3)) * 33 + 4 * (lane & 7); d[0] = v[i][0]; d[1] = v[i][1]; d[2] = v[i][2]; d[3] = v[i][3]; }
    LDS_WAIT(); asm volatile("" ::: "memory");
    const int c = lane & 7;
#pragma unroll
    for (int j = 0; j < 4; ++j) { const int n = (lane >> 3) + 8 * j; const LAS float* s = scr + (8 * c) * 33 + n;
        u32x4 o; o.x = cvt_pk_bf16(s[0 * 33] * sc, s[1 * 33] * sc); o.y = cvt_pk_bf16(s[2 * 33] * sc, s[3 * 33] * sc); o.z = cvt_pk_bf16(s[4 * 33] * sc, s[5 * 33] * sc); o.w = cvt_pk_bf16(s[6 * 33] * sc, s[7 * 33] * sc);
        const int drow = interleave ? (drow0 + 8 * (n >> 2) + (n & 3)) : (drow0 + n);
        *(u32x4*)(WT + (size_t)drow * KT + k0 + 8 * c) = o; }
    LDS_WAIT(); asm volatile("" ::: "memory");
}

struct ConvPtrs { const float *w_in, *w_out, *w_down, *w_uq, *w_uk, *w_uv, *w_o, *g_in, *g_o; bf16_t *WIN, *WOUT, *WDOWN, *WUQ, *WUKT, *WUVT, *WOT, *WGIN, *WGO; };
constexpr int I_WIN = (DM / 64) * (2 * DFF / 32);
constexpr int I_WOUT = (DFF / 64) * (DM / 32);
constexpr int I_DOWN = (DM / 64) * (DDOWN / 32);
constexpr int I_UQ = (QL / 64) * (NH * QKD / 32);
constexpr int I_UK = (KVL / 64) * (NH * NOPE / 32);
constexpr int I_UV = I_UK;
constexpr int I_O = (DM / 64) * (DM / 32);
constexpr int I_GIN = (DM / 64) * (GIN / 32);
constexpr int I_GO = I_O;
template <int SEG> __device__ __forceinline__ void conv_segment(const ConvPtrs& P, int widx, int nw, LAS float* scr, int lane) {
    constexpr int mi = SEG;
    constexpr int NIT = I_WIN + I_WOUT + (SEG == 1 ? I_DOWN + I_UQ + I_UK + I_UV + I_O : SEG == 2 ? I_GIN + I_GO : 0);
    for (int it = widx; it < NIT; it += nw) {
        int r = it;
        if (r < I_WIN) { const int nblk = 2 * DFF / 32, kb = r / nblk, nb = r % nblk, n0 = nb * 32;
            const int drow0 = n0 < DFF ? 256 * (n0 / 128) + (n0 % 128) : 256 * ((n0 - DFF) / 128) + 128 + ((n0 - DFF) % 128);
            transpose_item(P.w_in + (size_t)mi * DM * 2 * DFF, 2 * DFF, kb * 64, n0, P.WIN + (size_t)mi * 2 * DFF * DM, DM, drow0, 0, scr, lane, n0 < DFF ? LOG2E : 1.0f / LOG2E); continue; } r -= I_WIN;
        if (r < I_WOUT) { const int nblk = DM / 32, kb = r / nblk, nb = r % nblk;
            transpose_item(P.w_out + (size_t)mi * DFF * DM, DM, kb * 64, nb * 32, P.WOUT + (size_t)mi * DM * DFF, DFF, nb * 32, 0, scr, lane); continue; } r -= I_WOUT;
        if constexpr (SEG == 1) {
            if (r < I_DOWN) { const int nblk = DDOWN / 32, kb = r / nblk, nb = r % nblk;
                transpose_item(P.w_down, DDOWN, kb * 64, nb * 32, P.WDOWN, DM, nb * 32, 0, scr, lane); continue; } r -= I_DOWN;
            if (r < I_UQ) { const int nblk = NH * QKD / 32, kb = r / nblk, nb = r % nblk, n0 = nb * 32, h = n0 / QKD, f = n0 % QKD;
                if (f < NOPE) transpose_item(P.w_uq, NH * QKD, kb * 64, n0, P.WUQ, QL, n0, 0, scr, lane);
                else transpose_item(P.w_uq, NH * QKD, kb * 64, n0, P.WUQ, QL, h * QKD + NOPE + (f == NOPE ? 0 : 4), 1, scr, lane);
                continue; } r -= I_UQ;
            if (r < I_UK) { const int nblk = NH * NOPE / 32, kb = r / nblk, nb = r % nblk;
                transpose_item(P.w_uk, NH * NOPE, kb * 64, nb * 32, P.WUKT, KVL, nb * 32, 0, scr, lane); continue; } r -= I_UK;
            if (r < I_UV) { const int nblk = NH * VD / 32, kb = r / nblk, nb = r % nblk;
                transpose_item(P.w_uv, NH * VD, kb * 64, nb * 32, P.WUVT, KVL, nb * 32, 0, scr, lane); continue; } r -= I_UV;
            { const int nblk = DM / 32, kb = r / nblk, nb = r % nblk;
                transpose_item(P.w_o, DM, kb * 64, nb * 32, P.WOT, DM, nb * 32, 0, scr, lane); }
        }
        if constexpr (SEG == 2) {
            if (r < I_GIN) { const int nblk = GIN / 32, kb = r / nblk, nb = r % nblk;
                transpose_item(P.g_in, GIN, kb * 64, nb * 32, P.WGIN, DM, nb * 32, 0, scr, lane); continue; } r -= I_GIN;
            { const int nblk = DM / 32, kb = r / nblk, nb = r % nblk;
                transpose_item(P.g_o, DM, kb * 64, nb * 32, P.WGO, DM, nb * 32, 0, scr, lane); }
        }
    }
}

struct Row16 { f32x4 v[4]; };
__device__ __forceinline__ Row16 ld_row(const float* p, int lane) { Row16 r; const f32x4* q = (const f32x4*)p + lane;
#pragma unroll
    for (int j = 0; j < 4; ++j) r.v[j] = q[64 * j]; return r; }
__device__ __forceinline__ Row16 ld_row_bf16(const bf16_t* p, int lane) { Row16 r; const u32x2* q = (const u32x2*)p + lane;
#pragma unroll
    for (int j = 0; j < 4; ++j) { const u32x2 w = q[64 * j]; r.v[j][0] = __uint_as_float(w.x << 16); r.v[j][1] = __uint_as_float(w.x & 0xffff0000u); r.v[j][2] = __uint_as_float(w.y << 16); r.v[j][3] = __uint_as_float(w.y & 0xffff0000u); } return r; }
__device__ __forceinline__ float row_ss(const Row16& r) { float s = 0.f;
#pragma unroll
    for (int j = 0; j < 4; ++j) s += (r.v[j][0] * r.v[j][0] + r.v[j][1] * r.v[j][1]) + (r.v[j][2] * r.v[j][2] + r.v[j][3] * r.v[j][3]); return wave_sum(s); }
__device__ __forceinline__ void st_row_bf16(bf16_t* p, const Row16& r, int lane) { u32x2* q = (u32x2*)p + lane;
#pragma unroll
    for (int j = 0; j < 4; ++j) { u32x2 w; w.x = cvt_pk_bf16(r.v[j][0], r.v[j][1]); w.y = cvt_pk_bf16(r.v[j][2], r.v[j][3]); q[64 * j] = w; } }
__device__ __forceinline__ void st_row_f32(float* p, const Row16& r, int lane) { f32x4* q = (f32x4*)p + lane;
#pragma unroll
    for (int j = 0; j < 4; ++j) q[64 * j] = r.v[j]; }

template <bool HAS_T, bool HAS_PRE, bool SRC_X, bool FINAL>
__device__ __forceinline__ void thin_phase(int gw, int NGW, const float* xp, const float* xs, const bf16_t* T, const float* TP, int nsplit, bf16_t* H, float* Yout, bf16_t* XN, const float* gpost, const float* gpre, float scale) {
    const int lane = lane_now();
    Row16 gp, gq;
    if (HAS_T) gp = ld_row(gpost, lane);
    if (HAS_PRE) gq = ld_row(gpre, lane);
    const bool bal = HAS_T && NGW == 2 * MS && MP % NGW == 0;
    const int N1 = bal ? MP / NGW - (nsplit > 4 ? 2 : 1) : 0;
    for (int i = 0;; ++i) {
        int r;
        if (!bal) { r = gw + i * NGW; if (r >= M) break; }
        else if (i < N1) r = gw + i * NGW;
        else if (gw < MS) { if (i > N1) break; r = MP + gw; }
        else { r = N1 * NGW + (gw - MS) + (i - N1) * (NGW - MS); if (r >= MP) break; }
        Row16 h;
        if constexpr (SRC_X) h = ld_row(r < MP ? xp + (size_t)r * DM : xs + (size_t)(r - MP) * DM, lane); else h = ld_row_bf16(H + (size_t)r * DM, lane);
        if (HAS_T) {
            Row16 t;
            if (r < MP) t = ld_row_bf16(T + (size_t)r * DM, lane);
            else { t = ld_row(TP + (size_t)(r - MP) * DM, lane);
                for (int z = 1; z < nsplit; ++z) { const Row16 u = ld_row(TP + ((size_t)z * MS + (r - MP)) * DM, lane);
#pragma unroll
                    for (int j = 0; j < 4; ++j) t.v[j] = t.v[j] + u.v[j]; } }
            const float rs = scale * __builtin_amdgcn_rsqf(row_ss(t) * (1.0f / DM) + EPS);
#pragma unroll
            for (int j = 0; j < 4; ++j) h.v[j] = h.v[j] + (t.v[j] * rs) * gp.v[j];
            if constexpr (FINAL) st_row_f32(Yout + (size_t)r * DM, h, lane); else st_row_bf16(H + (size_t)r * DM, h, lane);
        }
        if (HAS_PRE) {
            const float rs = __builtin_amdgcn_rsqf(row_ss(h) * (1.0f / DM) + EPS);
#pragma unroll
            for (int j = 0; j < 4; ++j) h.v[j] = (h.v[j] * rs) * gq.v[j];
            st_row_bf16(XN + (size_t)r * DM, h, lane);
        }
    }
}

__device__ __forceinline__ int rope_pos_index(int r) { return r < MP ? (r & (SEQ - 1)) : SEQ + ((r - MP) & (DECT - 1)); }


typedef short s16x4 __attribute__((ext_vector_type(4)));
__device__ __forceinline__ int swap23(int x) { return (x & ~12) | ((x & 4) << 1) | ((x & 8) >> 1); }
__device__ __forceinline__ float half_max(float v) { auto rr = __builtin_amdgcn_permlane32_swap(__float_as_uint(v), __float_as_uint(v), false, false); return fmaxf(__uint_as_float(rr[0]), __uint_as_float(rr[1])); }
__device__ __forceinline__ float half_sum(float v) { auto rr = __builtin_amdgcn_permlane32_swap(__float_as_uint(v), __float_as_uint(v), false, false); return __uint_as_float(rr[0]) + __uint_as_float(rr[1]); }
__device__ __forceinline__ bf16x8 pack8(const f32x16& p, int o) {
    u32x4 w; w.x = cvt_pk_bf16(p[o + 0], p[o + 1]); w.y = cvt_pk_bf16(p[o + 2], p[o + 3]); w.z = cvt_pk_bf16(p[o + 4], p[o + 5]); w.w = cvt_pk_bf16(p[o + 6], p[o + 7]);
    return __builtin_bit_cast(bf16x8, w);
}
template <int NO>
__device__ __forceinline__ void softmax_step(f32x16& p0, f32x16& p1, float& m, float& lh, f32x16 (&o)[NO], bf16x8 (&pf)[4]) {
    float pm = fmaxf(p0[0], p1[0]);
#pragma unroll
    for (int r = 1; r < 16; ++r) pm = fmaxf(pm, fmaxf(p0[r], p1[r]));
    pm = half_max(pm);
    const float mn = fmaxf(m, pm), alpha = __builtin_amdgcn_exp2f(m - mn); m = mn;
    float rs = 0.f;
#pragma unroll
    for (int r = 0; r < 16; ++r) { p0[r] = __builtin_amdgcn_exp2f(p0[r] - mn); p1[r] = __builtin_amdgcn_exp2f(p1[r] - mn); rs += p0[r] + p1[r]; }
    lh = lh * alpha + rs;
    if (!__all(alpha == 1.0f)) {
#pragma unroll
        for (int d = 0; d < NO; ++d) o[d] = o[d] * alpha;
    }
    pf[0] = pack8(p0, 0); pf[1] = pack8(p0, 8); pf[2] = pack8(p1, 0); pf[3] = pack8(p1, 8);
}

template <int NO>
__device__ __forceinline__ void softmax_step1(f32x16& p0, float& m, float& lh, f32x16 (&o)[NO], bf16x8 (&pf)[2]) {
    float pm = p0[0];
#pragma unroll
    for (int r = 1; r < 16; ++r) pm = fmaxf(pm, p0[r]);
    pm = half_max(pm);
    const float mn = fmaxf(m, pm), alpha = __builtin_amdgcn_exp2f(m - mn); m = mn;
    float rs = 0.f;
#pragma unroll
    for (int r = 0; r < 16; ++r) { p0[r] = __builtin_amdgcn_exp2f(p0[r] - mn); rs += p0[r]; }
    lh = lh * alpha + rs;
    if (!__all(alpha == 1.0f)) {
#pragma unroll
        for (int d = 0; d < NO; ++d) o[d] = o[d] * alpha;
    }
    pf[0] = pack8(p0, 0); pf[1] = pack8(p0, 8);
}

namespace pat {
constexpr int KROW = 400, VROW = 144, KTILE = 64 * KROW, VTILE = 128 * VROW;
__device__ __forceinline__ void unit(LAS unsigned char* lds, const int wave, const bf16_t* Q, const bf16_t* KB, const bf16_t* KPE, const bf16_t* VT, bf16_t* O, int b, int h, int qb) {
    const int lane = lane_now(), tid = wave * 64 + lane, ql = lane & 31, hh = lane >> 5;
    const int q0 = b * SEQ + qb * 256 + 32 * wave;
    bf16x8 qf[12];
    { const bf16_t* qp = Q + (size_t)(q0 + ql) * (NH * QKD) + h * QKD + hh * 8;
#pragma unroll
      for (int ks = 0; ks < 12; ++ks) qf[ks] = *(const bf16x8*)(qp + ks * 16); }
    f32x16 o[4];
#pragma unroll
    for (int d = 0; d < 4; ++d)
#pragma unroll
        for (int r = 0; r < 16; ++r) o[d][r] = 0.f;
    float m = -1e30f, lh = 0.f;
    const int ntiles = 4 * (qb + 1);
    int krow[3], kcc[3]; unsigned koff[3];
#pragma unroll
    for (int i = 0; i < 3; ++i) { const int c = tid + 512 * i; krow[i] = c / 24; kcc[i] = c % 24; koff[i] = (unsigned)(krow[i] * KROW + kcc[i] * 16); }
    const bf16_t* kg = KB + (size_t)(b * SEQ) * (NH * NOPE) + h * NOPE;
    const bf16_t* kpg = KPE + (size_t)(b * SEQ) * ROPE;
    const bf16_t* vg = VT + (size_t)(h * VD) * MP + b * SEQ;
    const int vrow0 = tid >> 3, vcc = tid & 7;
    u32x4 kst[3], vst[2];
#define PAT_LOAD(j) do { _Pragma("unroll") for (int i = 0; i < 3; ++i) kst[i] = kcc[i] < 16 ? *(const u32x4*)(kg + (size_t)((j) * 64 + krow[i]) * (NH * NOPE) + kcc[i] * 8) : *(const u32x4*)(kpg + (size_t)((j) * 64 + krow[i]) * ROPE + (kcc[i] - 16) * 8); \
        _Pragma("unroll") for (int i = 0; i < 2; ++i) vst[i] = *(const u32x4*)(vg + (size_t)(vrow0 + 64 * i) * MP + (j) * 64 + vcc * 8); } while (0)
#define PAT_STORE(buf) do { _Pragma("unroll") for (int i = 0; i < 3; ++i) *(LAS u32x4*)(lds + (buf) * KTILE + koff[i]) = kst[i]; \
        _Pragma("unroll") for (int i = 0; i < 2; ++i) *(LAS u32x4*)(lds + 2 * KTILE + (buf) * VTILE + (vrow0 + 64 * i) * VROW + vcc * 16) = vst[i]; } while (0)
    PAT_LOAD(0); PAT_STORE(0);
    __syncthreads();
    const int kr = swap23(ql);
    for (int j = 0; j < ntiles; ++j) {
        const int buf = j & 1;
        if (j + 1 < ntiles) PAT_LOAD(j + 1);
        const int jd = j - 4 * qb;
        if (jd <= (wave >> 1)) {
            f32x16 p0, p1;
#pragma unroll
            for (int r = 0; r < 16; ++r) { p0[r] = 0.f; p1[r] = 0.f; }
            const LAS unsigned char* kb0 = lds + buf * KTILE + kr * KROW + hh * 16;
            __builtin_amdgcn_s_setprio(1);
#pragma unroll
            for (int ks = 0; ks < 12; ++ks) {
                const bf16x8 a0 = *(const LAS bf16x8*)(kb0 + ks * 32), a1 = *(const LAS bf16x8*)(kb0 + 32 * KROW + ks * 32);
                p0 = __builtin_amdgcn_mfma_f32_32x32x16_bf16(a0, qf[ks], p0, 0, 0, 0);
                p1 = __builtin_amdgcn_mfma_f32_32x32x16_bf16(a1, qf[ks], p1, 0, 0, 0);
            }
            __builtin_amdgcn_s_setprio(0);
            if (jd >= 0) {
                const int qrel = 32 * wave + ql - 64 * jd - 8 * hh;
#pragma unroll
                for (int r = 0; r < 16; ++r) { const int kk = 16 * (r >> 3) + (r & 7);
                    if (kk > qrel) p0[r] = -__builtin_inff();
                    if (kk + 32 > qrel) p1[r] = -__builtin_inff(); }
            }
            bf16x8 pf[4];
            softmax_step<4>(p0, p1, m, lh, o, pf);
            const LAS unsigned char* vb0 = lds + 2 * KTILE + buf * VTILE + ql * VROW + hh * 16;
#pragma unroll
            for (int d = 0; d < 4; ++d)
#pragma unroll
                for (int ss = 0; ss < 4; ++ss) {
                    const bf16x8 a = *(const LAS bf16x8*)(vb0 + d * 32 * VROW + ss * 32);
                    o[d] = __builtin_amdgcn_mfma_f32_32x32x16_bf16(a, pf[ss], o[d], 0, 0, 0);
                }
        }
        if (j + 1 < ntiles) PAT_STORE(buf ^ 1);
        __syncthreads();
    }
#undef PAT_LOAD
#undef PAT_STORE
    const float inv = 1.0f / half_sum(lh);
    bf16_t* op = O + (size_t)(q0 + ql) * DM + h * VD + 4 * hh;
#pragma unroll
    for (int d = 0; d < 4; ++d)
#pragma unroll
        for (int g = 0; g < 4; ++g) { u32x2 w; w.x = cvt_pk_bf16(o[d][4 * g] * inv, o[d][4 * g + 1] * inv); w.y = cvt_pk_bf16(o[d][4 * g + 2] * inv, o[d][4 * g + 3] * inv);
            *(u32x2*)(op + 32 * d + 8 * g) = w; }
}
}

namespace sat {
constexpr int KROW = 656, KTILE = 64 * KROW;
__device__ __forceinline__ bf16x8 tr_frag(const LAS unsigned char* p) {
    typedef short v4i16_t __attribute__((ext_vector_type(4)));
    const s16x4 a = __builtin_bit_cast(s16x4, __builtin_amdgcn_ds_read_tr16_b64_v4i16((LAS v4i16_t*)p));
    const s16x4 b = __builtin_bit_cast(s16x4, __builtin_amdgcn_ds_read_tr16_b64_v4i16((LAS v4i16_t*)(p + 4 * KROW)));
    bf16x8 r; r[0] = a[0]; r[1] = a[1]; r[2] = a[2]; r[3] = a[3]; r[4] = b[0]; r[5] = b[1]; r[6] = b[2]; r[7] = b[3]; return r;
}
__device__ __forceinline__ void unit(LAS unsigned char* lds, const int wave, const bf16_t* QLAT, const float* cache_ckv, const float* cache_kpe, const int* page_table, const bf16_t* CKVS  , const bf16_t* KPES,
                                     float* OPART, float* OML, int b, int split) {
    const int lane = lane_now(), tid = wave * 64 + lane, ql = lane & 31, hh = lane >> 5;
    const int qblk = wave & 1, kb = (wave >> 1) & 1, dvh = wave >> 2;
#pragma unroll
    for (int i = 0; i < 5; ++i) { const int c = tid + 512 * i, row = c / 40, cc = c % 40;
        *(LAS u32x4*)(lds + 2 * KTILE + row * KROW + cc * 16) = *(const u32x4*)(QLAT + (size_t)(b * 64 + row) * 320 + cc * 8); }
    f32x16 o[4];
#pragma unroll
    for (int d = 0; d < 4; ++d)
#pragma unroll
        for (int r = 0; r < 16; ++r) o[d][r] = 0.f;
    float m = -1e30f, lh = 0.f;
    const int npg = NPAGES / 2, ntiles = 2 * npg + (split == 1 ? 1 : 0);
    const int* pt = page_table + b * NPAGES + split * npg;
    const int crow0 = tid >> 6, ccol = tid & 63;
    const int prow0 = tid >> 4, pcol = tid & 15;
    f32x4 cst[8], pst[2];
#define SAT_LOAD(j) do { const int pg = pt[(j) >> 1]; const size_t r0 = (size_t)pg * PAGE + ((j) & 1) * 64; \
        _Pragma("unroll") for (int i = 0; i < 8; ++i) cst[i] = __builtin_nontemporal_load((const f32x4*)(cache_ckv + (r0 + crow0 + 8 * i) * KVL) + ccol); \
        _Pragma("unroll") for (int i = 0; i < 2; ++i) pst[i] = __builtin_nontemporal_load((const f32x4*)(cache_kpe + (r0 + prow0 + 32 * i) * ROPE) + pcol); } while (0)
#define SAT_STORE(buf) do { _Pragma("unroll") for (int i = 0; i < 8; ++i) { u32x2 w; w.x = cvt_pk_bf16(cst[i][0], cst[i][1]); w.y = cvt_pk_bf16(cst[i][2], cst[i][3]); \
            *(LAS u32x2*)(lds + (buf) * KTILE + (crow0 + 8 * i) * KROW + ccol * 8) = w; } \
        _Pragma("unroll") for (int i = 0; i < 2; ++i) { u32x2 w; w.x = cvt_pk_bf16(pst[i][0], pst[i][1]); w.y = cvt_pk_bf16(pst[i][2], pst[i][3]); \
            *(LAS u32x2*)(lds + (buf) * KTILE + (prow0 + 32 * i) * KROW + 512 + pcol * 8) = w; } } while (0)
#define SAT_NEW(buf) do { _Pragma("unroll") for (int i = 0; i < 5; ++i) { const int c = tid + 512 * i, row = c / 40, cc = c % 40; u32x4 v = (u32x4){0u, 0u, 0u, 0u}; \
            if (row < DECT) v = cc < 32 ? *(const u32x4*)(CKVS + (size_t)(b * DECT + row) * KVL + cc * 8) : *(const u32x4*)(KPES + (size_t)(b * DECT + row) * ROPE + (cc - 32) * 8); \
            *(LAS u32x4*)(lds + (buf) * KTILE + row * KROW + cc * 16) = v; } } while (0)
    SAT_LOAD(0); SAT_STORE(0);
    __syncthreads();
    const int kr = 32 * kb + swap23(ql);
    const int g16 = lane >> 4, i16 = lane & 15;
    const int troff = (32 * kb + 8 * (g16 >> 1) + (i16 >> 2)) * KROW + (128 * dvh + 16 * (g16 & 1) + 4 * (i16 & 3)) * 2;
    for (int j = 0; j < ntiles; ++j) {
        const int buf = j & 1;
        const bool nxt_page = (j + 1 < 2 * npg), nxt_new = (j + 1 == 2 * npg) && (split == 1);
        if (nxt_page) SAT_LOAD(j + 1);
        f32x16 p0;
#pragma unroll
        for (int r = 0; r < 16; ++r) p0[r] = 0.f;
        const LAS unsigned char* kb0 = lds + buf * KTILE + kr * KROW + hh * 16;
        const LAS unsigned char* qb0 = lds + 2 * KTILE + (32 * qblk + ql) * KROW + hh * 16;
        __builtin_amdgcn_s_setprio(1);
#pragma unroll
        for (int ks = 0; ks < 20; ++ks) p0 = __builtin_amdgcn_mfma_f32_32x32x16_bf16(*(const LAS bf16x8*)(kb0 + ks * 32), *(const LAS bf16x8*)(qb0 + ks * 32), p0, 0, 0, 0);
        __builtin_amdgcn_s_setprio(0);
        if (j == 2 * npg) {
            const int tq = (32 * qblk + ql) >> 3;
#pragma unroll
            for (int r = 0; r < 16; ++r) { const int kk = 32 * kb + 16 * (r >> 3) + 8 * hh + (r & 7); if (kk > tq) p0[r] = -__builtin_inff(); }
        }
        bf16x8 pf[2];
        softmax_step1<4>(p0, m, lh, o, pf);
        const LAS unsigned char* vb0 = lds + buf * KTILE + troff;
#pragma unroll
        for (int d = 0; d < 4; ++d)
#pragma unroll
            for (int ss = 0; ss < 2; ++ss) {
                const bf16x8 a = tr_frag(vb0 + d * 64 + ss * 16 * KROW);
                o[d] = __builtin_amdgcn_mfma_f32_32x32x16_bf16(a, pf[ss], o[d], 0, 0, 0);
            }
        if (nxt_page) SAT_STORE(buf ^ 1);
        if (nxt_new) SAT_NEW(buf ^ 1);
        __syncthreads();
    }
#undef SAT_LOAD
#undef SAT_STORE
#undef SAT_NEW
    float lt = half_sum(lh);
    const int pair = dvh * 2 + qblk;
    LAS float* xb = (LAS float*)(lds + pair * 17408);
    if (kb == 1) {
#pragma unroll
        for (int d = 0; d < 4; ++d)
#pragma unroll
            for (int r = 0; r < 16; ++r) xb[(d * 16 + r) * 64 + lane] = o[d][r];
        xb[64 * 64 + lane] = m; xb[65 * 64 + lane] = lt;
    }
    __syncthreads();
    if (kb == 0) {
        const float m1 = xb[64 * 64 + lane], l1 = xb[65 * 64 + lane];
        const float mm = fmaxf(m, m1), w0 = __builtin_amdgcn_exp2f(m - mm), w1 = __builtin_amdgcn_exp2f(m1 - mm);
#pragma unroll
        for (int d = 0; d < 4; ++d)
#pragma unroll
            for (int r = 0; r < 16; ++r) o[d][r] = o[d][r] * w0 + xb[(d * 16 + r) * 64 + lane] * w1;
        lt = lt * w0 + l1 * w1;
        const int q = 32 * qblk + ql;
        float* op = OPART + ((size_t)(b * 2 + split) * 64 + q) * KVL + 128 * dvh + 4 * hh;
#pragma unroll
        for (int d = 0; d < 4; ++d)
#pragma unroll
            for (int g = 0; g < 4; ++g) *(f32x4*)(op + 32 * d + 8 * g) = (f32x4){o[d][4 * g], o[d][4 * g + 1], o[d][4 * g + 2], o[d][4 * g + 3]};
        if (dvh == 0 && hh == 0) *(f32x2*)(OML + ((size_t)(b * 2 + split) * 64 + q) * 2) = (f32x2){mm, lt};
    }
    __syncthreads();
}
}


#define LDS_RD128(dst, addr, off) asm volatile("ds_read_b128 %0, %1 offset:%2" : "=v"(dst) : "v"(addr), "n"(off))
#define LDS_WAIT4(f, N) asm volatile("s_waitcnt lgkmcnt(" #N ")" : "+v"(f[0]), "+v"(f[1]), "+v"(f[2]), "+v"(f[3]))
namespace gla {
constexpr int QROW = 272, KTROW = 144, VROW = 528;
constexpr int P_T16 = 0, P_TOT = 4096, P_QT = 8192, P_KT = P_QT + 64 * QROW;
constexpr int C_DK = 0, C_QT = 1024, C_KH = C_QT + 64 * QROW, C_V = C_KH + 128 * KTROW, C_AT = C_V + 64 * VROW, C_O = C_AT + 6144;
static_assert(C_O + 64 * 8 * 64 <= RING_BYTES, "gla chain LDS");
static_assert(C_AT + 6144 <= RING_BYTES, "gla LDS");
__device__ __forceinline__ bf16x8 tr_frag(const LAS unsigned char* p) {
    typedef short v4i16_t __attribute__((ext_vector_type(4)));
    const s16x4 a = __builtin_bit_cast(s16x4, __builtin_amdgcn_ds_read_tr16_b64_v4i16((LAS v4i16_t*)p));
    const s16x4 b = __builtin_bit_cast(s16x4, __builtin_amdgcn_ds_read_tr16_b64_v4i16((LAS v4i16_t*)(p + 4 * VROW)));
    bf16x8 r; r[0] = a[0]; r[1] = a[1]; r[2] = a[2]; r[3] = a[3]; r[4] = b[0]; r[5] = b[1]; r[6] = b[2]; r[7] = b[3]; return r;
}
template <int SEG>
__device__ __forceinline__ void prep(LAS unsigned char* lds, const int wave, const bf16_t* QKVG, const float* T16, const float* w_gk2, const float* b_gk, int chunk, int h,
                                     bf16_t* QTg, bf16_t* KHg, bf16_t* ATg, float* DKg) {
    const int lane = lane_now(), tid = wave * 64 + lane, ql = lane & 31, hh = lane >> 5;
    const int kk = tid & 127, tq = tid >> 7, cu = chunk * 4 + h, row0 = chunk * 64;
    float w2[16];
#pragma unroll
    for (int j = 0; j < 16; ++j) w2[j] = w_gk2[j * (GH * GDK) + h * GDK + kk];
    const float bias = b_gk[h * GDK + kk];
    unsigned short qraw[16], kraw[16];
    { const bf16_t* qg = QKVG + (size_t)(row0 + tq * 16) * GIN + h * GDK + kk;
#pragma unroll
      for (int i = 0; i < 16; ++i) { qraw[i] = qg[(size_t)i * GIN]; kraw[i] = qg[(size_t)i * GIN + GH * GDK]; } }
    __syncthreads();
    if (tid < 256) *(LAS f32x4*)(lds + P_T16 + tid * 16) = *(const f32x4*)(T16 + (size_t)row0 * 16 + tid * 4);
    __syncthreads();
    float Gl[16];
    { float run = 0.f;
#pragma unroll
      for (int i = 0; i < 16; ++i) { const int t = tq * 16 + i; const LAS f32x4* tp = (const LAS f32x4*)(lds + P_T16 + t * 64);
          const f32x4 a0 = tp[0], a1 = tp[1], a2 = tp[2], a3 = tp[3];
          float z = bias;
          z += a0[0] * w2[0] + a0[1] * w2[1] + a0[2] * w2[2] + a0[3] * w2[3];
          z += a1[0] * w2[4] + a1[1] * w2[5] + a1[2] * w2[6] + a1[3] * w2[7];
          z += a2[0] * w2[8] + a2[1] * w2[9] + a2[2] * w2[10] + a2[3] * w2[11];
          z += a3[0] * w2[12] + a3[1] * w2[13] + a3[2] * w2[14] + a3[3] * w2[15];
          const float ls = fminf(z, 0.f) - 0.6931471805599453f * __builtin_amdgcn_logf(1.0f + __builtin_amdgcn_exp2f(-fabsf(z) * LOG2E));
          if (SEG == 8 && i == 8) run = 0.f;
          run += ls * (1.0f / 16.0f); Gl[i] = run; }
      if (SEG == 64) *(LAS float*)(lds + P_TOT + (tq * 128 + kk) * 4) = run; }
    float prefix = 0.f, total = 0.f;
    if (SEG == 64) {
        __syncthreads();
#pragma unroll
        for (int q = 0; q < 4; ++q) { const float v = *(const LAS float*)(lds + P_TOT + (q * 128 + kk) * 4); total += v; if (q < tq) prefix += v; }
    }
    { unsigned kh[8];
#pragma unroll
      for (int i = 0; i < 16; i += 2) {
          const float G0 = (Gl[i] + prefix) * LOG2E, G1 = (Gl[i + 1] + prefix) * LOG2E;
          const float TL = (SEG == 64 ? total : Gl[i | 7]) * LOG2E;
          const float q0 = bf2f(qraw[i]), q1 = bf2f(qraw[i + 1]), k0 = bf2f(kraw[i]), k1 = bf2f(kraw[i + 1]);
          const unsigned qq = cvt_pk_bf16(q0 * __builtin_amdgcn_exp2f(G0), q1 * __builtin_amdgcn_exp2f(G1));
          const unsigned kt = cvt_pk_bf16(k0 * __builtin_amdgcn_exp2f(-G0), k1 * __builtin_amdgcn_exp2f(-G1));
          kh[i >> 1] = cvt_pk_bf16(k0 * __builtin_amdgcn_exp2f(TL - G0), k1 * __builtin_amdgcn_exp2f(TL - G1));
          const int t = tq * 16 + i;
          *(LAS unsigned short*)(lds + P_QT + t * QROW + kk * 2) = (unsigned short)(qq & 0xffffu); *(LAS unsigned short*)(lds + P_QT + (t + 1) * QROW + kk * 2) = (unsigned short)(qq >> 16);
          *(LAS unsigned short*)(lds + P_KT + t * QROW + kk * 2) = (unsigned short)(kt & 0xffffu); *(LAS unsigned short*)(lds + P_KT + (t + 1) * QROW + kk * 2) = (unsigned short)(kt >> 16);
      }
      bf16_t* khp = KHg + ((size_t)cu * 128 + kk) * 64 + tq * 16;
      *(u32x4*)khp = (u32x4){kh[0], kh[1], kh[2], kh[3]}; *(u32x4*)(khp + 8) = (u32x4){kh[4], kh[5], kh[6], kh[7]};
      if (SEG == 64) { if (tq == 0) DKg[(size_t)cu * 1024 + kk] = __builtin_amdgcn_exp2f(total * LOG2E); }
      else { DKg[(size_t)cu * 1024 + (tq * 2) * 128 + kk] = __builtin_amdgcn_exp2f(Gl[7] * LOG2E); DKg[(size_t)cu * 1024 + (tq * 2 + 1) * 128 + kk] = __builtin_amdgcn_exp2f(Gl[15] * LOG2E); } }
    __syncthreads();
    if (wave < 3) {
        const int sb = wave >> 1, tb = (wave + 1) >> 1, kr = swap23(ql);
        f32x16 x;
#pragma unroll
        for (int r = 0; r < 16; ++r) x[r] = 0.f;
        const LAS unsigned char* ap = lds + P_KT + (32 * sb + kr) * QROW + hh * 16;
        const LAS unsigned char* bp = lds + P_QT + (32 * tb + ql) * QROW + hh * 16;
#pragma unroll
        for (int ks = 0; ks < 8; ++ks) x = __builtin_amdgcn_mfma_f32_32x32x16_bf16(*(const LAS bf16x8*)(ap + ks * 32), *(const LAS bf16x8*)(bp + ks * 32), x, 0, 0, 0);
        const int tt = 32 * tb + ql;
#pragma unroll
        for (int r = 0; r < 16; ++r) { const int sr = 32 * sb + 16 * (r >> 3) + 8 * hh + (r & 7); if (sr > tt || (SEG == 8 && (sr >> 3) != (tt >> 3))) x[r] = 0.f; }
        bf16_t* atp = ATg + (size_t)cu * 3072 + (wave * 2) * 512 + lane * 8;
        *(bf16x8*)atp = pack8(x, 0); *(bf16x8*)(atp + 512) = pack8(x, 8);
    }
#pragma unroll
    for (int i = 0; i < 2; ++i) { const int c = tid + 512 * i, row = c >> 4, cc = c & 15;
        *(u32x4*)(QTg + (size_t)(row0 + row) * (GH * GDK) + h * GDK + cc * 8) = *(const LAS u32x4*)(lds + P_QT + row * QROW + cc * 16); }
}

template <int NWV>
__device__ __forceinline__ void chain(LAS unsigned char* lds, const int wave, const bf16_t* QTg, const bf16_t* KHg, const bf16_t* ATg, const float* DKg, const bf16_t* QKVG, int h, int chunk0, int nchunk,
                                      int srow, int nrow, int sseg, int dseg, int dvbase, const float* state_in, float* state_out, bf16_t* GO) {
    constexpr int VPR = NWV * 4  , VST = NWV / 2  , VRS = 512 / VPR  ;
    const bool active = wave < NWV;
    const int lane = lane_now(), tid = wave * 64 + lane, ql = lane & 31, hh = lane >> 5;
    f32x16 S[4];
#pragma unroll
    for (int kb = 0; kb < 4; ++kb)
#pragma unroll
        for (int r = 0; r < 16; ++r) S[kb][r] = (state_in && active) ? state_in[(size_t)(32 * kb + 16 * (r >> 3) + 8 * hh + (r & 7)) * GDV + dvbase + 32 * wave + ql] : 0.f;
    const int qrow = tid >> 4, qcc = tid & 15;
    const int krow = tid >> 3, kcc = tid & 7;
    const int vrow0 = tid / VPR, vcc = tid % VPR;
    u32x4 qst[2], kst[2], vst[VST], ast, dst;
#define GLC_LOAD(c) do { const int ch = chunk0 + (c); const size_t cu = (size_t)ch * 4 + h; \
        _Pragma("unroll") for (int i = 0; i < 2; ++i) qst[i] = *(const u32x4*)(QTg + (size_t)(ch * 64 + qrow + 32 * i) * (GH * GDK) + h * GDK + qcc * 8); \
        _Pragma("unroll") for (int i = 0; i < 2; ++i) kst[i] = (sseg < 0 || kcc == sseg) ? *(const u32x4*)(KHg + (cu * 128 + krow + 64 * i) * 64 + kcc * 8) : (u32x4){0u, 0u, 0u, 0u}; \
        _Pragma("unroll") for (int i = 0; i < VST; ++i) { const int r = vrow0 + VRS * i; \
            vst[i] = (r >= srow && r < srow + nrow) ? *(const u32x4*)(QKVG + (size_t)(ch * 64 + r) * GIN + 2 * GH * GDK + h * GDV + dvbase + vcc * 8) : (u32x4){0u, 0u, 0u, 0u}; } \
        if (tid < 384) ast = *(const u32x4*)(ATg + cu * 3072 + tid * 8); \
        if (tid < 32) dst = *(const u32x4*)(DKg + cu * 1024 + dseg * 128 + tid * 4); } while (0)
    GLC_LOAD(0);
    const int g16 = lane >> 4, i16 = lane & 15;
    const int troff = (8 * (g16 >> 1) + (i16 >> 2)) * VROW + (32 * wave + 16 * (g16 & 1) + 4 * (i16 & 3)) * 2;
    const int kr = swap23(ql);
#define GLC_LDS_BAR() do { asm volatile("s_waitcnt lgkmcnt(0)" ::: "memory"); __builtin_amdgcn_s_barrier(); asm volatile("" ::: "memory"); } while (0)
#define GLC_FLUSH(cprev) do { if constexpr (NWV != 8) { int tl_ = tid; asm volatile("" : "+v"(tl_)); _Pragma("unroll") for (int i_ = 0; i_ < NWV / 2; ++i_) { const int c_ = tl_ + 512 * i_, row_ = c_ / (NWV * 4), cc_ = c_ % (NWV * 4); \
            *(u32x4*)(GO + (size_t)((chunk0 + (cprev)) * 64 + row_) * DM + h * GDV + dvbase + cc_ * 8) = *(const LAS u32x4*)(lds + C_O + row_ * (NWV * 64) + cc_ * 16); } } } while (0)
    for (int c = 0; c < nchunk; ++c) {
        GLC_LDS_BAR();
        if (c > 0) GLC_FLUSH(c - 1);
#pragma unroll
        for (int i = 0; i < 2; ++i) *(LAS u32x4*)(lds + C_QT + (qrow + 32 * i) * QROW + qcc * 16) = qst[i];
#pragma unroll
        for (int i = 0; i < 2; ++i) *(LAS u32x4*)(lds + C_KH + (krow + 64 * i) * KTROW + kcc * 16) = kst[i];
#pragma unroll
        for (int i = 0; i < VST; ++i) *(LAS u32x4*)(lds + C_V + (vrow0 + VRS * i) * VROW + vcc * 16) = vst[i];
        if (tid < 384) *(LAS u32x4*)(lds + C_AT + tid * 16) = ast;
        if (tid < 32) *(LAS u32x4*)(lds + C_DK + tid * 16) = dst;
        GLC_LDS_BAR();
        if (c + 1 < nchunk) GLC_LOAD(c + 1);
        if (active) {
        f32x16 o[2];
#pragma unroll
        for (int tb = 0; tb < 2; ++tb)
#pragma unroll
            for (int r = 0; r < 16; ++r) o[tb][r] = 0.f;
        const unsigned qa = (unsigned)(size_t)(lds + C_QT + ql * QROW + hh * 16), ka = (unsigned)(size_t)(lds + C_KH + kr * KTROW + hh * 16), ata = (unsigned)(size_t)(lds + C_AT + lane * 16);
        bf16x8 fa[4], fb[4];
#define GLC_QLD(f, kb) do { LDS_RD128(f[0], qa, (kb) * 64); LDS_RD128(f[1], qa, 32 * QROW + (kb) * 64); LDS_RD128(f[2], qa, (kb) * 64 + 32); LDS_RD128(f[3], qa, 32 * QROW + (kb) * 64 + 32); } while (0)
#define GLC_QMM(f, kb) do { const bf16x8 s0 = pack8(S[kb], 0), s1 = pack8(S[kb], 8); \
            o[0] = __builtin_amdgcn_mfma_f32_32x32x16_bf16(f[0], s0, o[0], 0, 0, 0); o[1] = __builtin_amdgcn_mfma_f32_32x32x16_bf16(f[1], s0, o[1], 0, 0, 0); \
            o[0] = __builtin_amdgcn_mfma_f32_32x32x16_bf16(f[2], s1, o[0], 0, 0, 0); o[1] = __builtin_amdgcn_mfma_f32_32x32x16_bf16(f[3], s1, o[1], 0, 0, 0); } while (0)
        GLC_QLD(fa, 0); GLC_QLD(fb, 1);
        LDS_WAIT4(fa, 4); GLC_QMM(fa, 0); GLC_QLD(fa, 2);
        LDS_WAIT4(fb, 4); GLC_QMM(fb, 1); GLC_QLD(fb, 3);
        LDS_WAIT4(fa, 4); GLC_QMM(fa, 2);
        LDS_RD128(fa[0], ata, 0 * 1024); LDS_RD128(fa[1], ata, 1 * 1024); LDS_RD128(fa[2], ata, 2 * 1024); LDS_RD128(fa[3], ata, 3 * 1024);
        LDS_WAIT4(fb, 4); GLC_QMM(fb, 3);
        LDS_RD128(fb[0], ata, 4 * 1024); LDS_RD128(fb[1], ata, 5 * 1024); LDS_RD128(fb[2], ka, 0); LDS_RD128(fb[3], ka, 32);
        bf16x8 vf[4];
#pragma unroll
        for (int ss = 0; ss < 4; ++ss) vf[ss] = tr_frag(lds + C_V + troff + ss * 16 * VROW);
        LDS_WAIT4(fa, 0); LDS_WAIT4(fb, 0);
        o[0] = __builtin_amdgcn_mfma_f32_32x32x16_bf16(fa[0], vf[0], o[0], 0, 0, 0);
        o[0] = __builtin_amdgcn_mfma_f32_32x32x16_bf16(fa[1], vf[1], o[0], 0, 0, 0);
        o[1] = __builtin_amdgcn_mfma_f32_32x32x16_bf16(fa[2], vf[0], o[1], 0, 0, 0);
        o[1] = __builtin_amdgcn_mfma_f32_32x32x16_bf16(fa[3], vf[1], o[1], 0, 0, 0);
        o[1] = __builtin_amdgcn_mfma_f32_32x32x16_bf16(fb[0], vf[2], o[1], 0, 0, 0);
        o[1] = __builtin_amdgcn_mfma_f32_32x32x16_bf16(fb[1], vf[3], o[1], 0, 0, 0);
#define GLC_KLD(f, kb) do { LDS_RD128(f[0], ka, (kb) * 32 * KTROW); LDS_RD128(f[1], ka, (kb) * 32 * KTROW + 32); LDS_RD128(f[2], ka, (kb) * 32 * KTROW + 64); LDS_RD128(f[3], ka, (kb) * 32 * KTROW + 96); } while (0)
#define GLC_SCALE(kb) do { _Pragma("unroll") for (int g = 0; g < 2; ++g) { const LAS f32x4* dp = (const LAS f32x4*)(lds + C_DK + (32 * (kb) + 16 * g + 8 * hh) * 4); const f32x4 d0 = dp[0], d1 = dp[1]; \
            S[kb][8 * g + 0] *= d0[0]; S[kb][8 * g + 1] *= d0[1]; S[kb][8 * g + 2] *= d0[2]; S[kb][8 * g + 3] *= d0[3]; \
            S[kb][8 * g + 4] *= d1[0]; S[kb][8 * g + 5] *= d1[1]; S[kb][8 * g + 6] *= d1[2]; S[kb][8 * g + 7] *= d1[3]; } } while (0)
#define GLC_KMM(f, kb) do { S[kb] = __builtin_amdgcn_mfma_f32_32x32x16_bf16(f[0], vf[0], S[kb], 0, 0, 0); S[kb] = __builtin_amdgcn_mfma_f32_32x32x16_bf16(f[1], vf[1], S[kb], 0, 0, 0); \
            S[kb] = __builtin_amdgcn_mfma_f32_32x32x16_bf16(f[2], vf[2], S[kb], 0, 0, 0); S[kb] = __builtin_amdgcn_mfma_f32_32x32x16_bf16(f[3], vf[3], S[kb], 0, 0, 0); } while (0)
        GLC_KLD(fa, 1);
        LDS_RD128(fb[0], ka, 64); LDS_RD128(fb[1], ka, 96);
        GLC_SCALE(0);
        LDS_WAIT4(fb, 0);
        S[0] = __builtin_amdgcn_mfma_f32_32x32x16_bf16(fb[2], vf[0], S[0], 0, 0, 0); S[0] = __builtin_amdgcn_mfma_f32_32x32x16_bf16(fb[3], vf[1], S[0], 0, 0, 0);
        S[0] = __builtin_amdgcn_mfma_f32_32x32x16_bf16(fb[0], vf[2], S[0], 0, 0, 0); S[0] = __builtin_amdgcn_mfma_f32_32x32x16_bf16(fb[1], vf[3], S[0], 0, 0, 0);
        GLC_KLD(fb, 2); GLC_SCALE(1);
        LDS_WAIT4(fa, 4); GLC_KMM(fa, 1); GLC_KLD(fa, 3); GLC_SCALE(2);
        LDS_WAIT4(fb, 4); GLC_KMM(fb, 2); GLC_SCALE(3);
        LDS_WAIT4(fa, 0); GLC_KMM(fa, 3);
#undef GLC_QLD
#undef GLC_QMM
#undef GLC_KLD
#undef GLC_SCALE
#undef GLC_KMM
        if constexpr (NWV != 8) {
            int qlx = ql, hhx = hh; asm volatile("" : "+v"(qlx), "+v"(hhx));
            LAS unsigned short* op_ = (LAS unsigned short*)(lds + C_O) + (4 * hhx) * (NWV * 32) + 32 * wave + qlx;
#pragma unroll
            for (int tb = 0; tb < 2; ++tb)
#pragma unroll
                for (int r = 0; r < 16; r += 2) { const unsigned w_ = cvt_pk_bf16(o[tb][r], o[tb][r + 1]);
                    const int t0_ = 32 * tb + (r & 3) + 8 * (r >> 2);
                    op_[t0_ * (NWV * 32)] = (unsigned short)(w_ & 0xffffu); op_[(t0_ + 1) * (NWV * 32)] = (unsigned short)(w_ >> 16); }
        } else {
          int qlx = ql, hhx = hh; asm volatile("" : "+v"(qlx), "+v"(hhx));
          bf16_t* gp = GO + (size_t)((chunk0 + c) * 64) * DM + h * GDV + dvbase + 32 * wave + qlx;
#pragma unroll
          for (int tb = 0; tb < 2; ++tb)
#pragma unroll
              for (int r = 0; r < 16; ++r) { const int t = 32 * tb + (r & 3) + 8 * (r >> 2) + 4 * hhx; if (t >= srow && t < srow + nrow) gp[(size_t)t * DM] = (bf16_t)(cvt_pk_bf16(o[tb][r], 0.f) & 0xffffu); } }
        }
    }
    if constexpr (NWV != 8) { GLC_LDS_BAR(); GLC_FLUSH(nchunk - 1); }
#undef GLC_FLUSH
#undef GLC_LOAD
#undef GLC_LDS_BAR
    if (active) { int qlx = ql, hhx = hh; asm volatile("" : "+v"(qlx), "+v"(hhx));
#pragma unroll
    for (int kb = 0; kb < 4; ++kb)
#pragma unroll
        for (int r = 0; r < 16; ++r) state_out[(size_t)(32 * kb + 16 * (r >> 3) + 8 * hhx + (r & 7)) * GDV + dvbase + 32 * wave + qlx] = S[kb][r]; }
    __syncthreads();
}
}

__global__ void __launch_bounds__(NWAVES * 64, 2) mk_fwd(Args args) {
    extern __shared__ __attribute__((aligned(16))) unsigned char lds_raw[];
    LAS unsigned char* lds = (LAS unsigned char*)lds_raw;
    volatile LAS unsigned* MISC = (volatile LAS unsigned*)(lds + MISC_OFF);
    const int wave = __builtin_amdgcn_readfirstlane(threadIdx.x >> 6);
    const int G = gridDim.x; const int bx = blockIdx.x; const int vcu = (G % 8 == 0) ? (bx % 8) * (G / 8) + bx / 8 : bx;
    const int gw = vcu * NWAVES + wave, NGW = G * NWAVES;
    unsigned char* ws = args.ws;
    unsigned* ctl = (unsigned*)(ws + WS_CTL);
    for (int u = wave * 64 + lane_now(); u < (LDS_BYTES - LDSCTL_OFF) / 4; u += NWAVES * 64) ((LAS unsigned*)(lds + LDSCTL_OFF))[u] = 0u;
    __syncthreads();
    XcdBarrier bar = xcd_barrier_post(ctl + 1024, MISC + 8, wave == 0 && lane_now() == 0);
#ifdef PROBE_A0
    unsigned long long* tsb = (unsigned long long*)(ws + WS_CTL + 32768);
    int n_ts = 0;
#define STAMP() do { if (bx == 0 && wave == 0 && lane_now() == 0) tsb[n_ts] = __builtin_amdgcn_s_memrealtime(); ++n_ts; } while (0)
#define GRID_BAR() do { xcd_barrier(bar, wave == 0 && lane_now() == 0); STAMP(); } while (0)
    STAMP();
#else
#define STAMP() do {} while (0)
#define GRID_BAR() xcd_barrier(bar, wave == 0 && lane_now() == 0)
#endif

    const float* x_prompt = (const float*)args.in[0]; const float* x_sample = (const float*)args.in[1];
    const float* cache_ckv = (const float*)args.in[2]; const float* cache_kpe = (const float*)args.in[3];
    const float* state_gla = (const float*)args.in[4]; const int* page_table = (const int*)args.in[5];
    const float* norm_g = (const float*)args.in[6]; const float* ffn_w_in = (const float*)args.in[7]; const float* ffn_w_out = (const float*)args.in[8];
    const float* mla_w_down = (const float*)args.in[9]; const float* mla_g_q = (const float*)args.in[10]; const float* mla_w_uq = (const float*)args.in[11];
    const float* mla_g_kv = (const float*)args.in[12]; const float* mla_w_uk = (const float*)args.in[13]; const float* mla_w_uv = (const float*)args.in[14];
    const float* mla_w_o = (const float*)args.in[15]; const float* gla_w_in = (const float*)args.in[16]; const float* gla_w_gk1 = (const float*)args.in[17];
    const float* gla_w_gk2 = (const float*)args.in[18]; const float* gla_b_gk = (const float*)args.in[19]; const float* gla_g_norm = (const float*)args.in[20];
    const float* gla_w_o = (const float*)args.in[21];
    float* out = args.out;
    float* ROPE_T = (float*)(ws + WS_ROPE);
    bf16_t* WIN = (bf16_t*)(ws + WS_WIN); bf16_t* WOUT = (bf16_t*)(ws + WS_WOUT); bf16_t* WDOWN = (bf16_t*)(ws + WS_WDOWN); bf16_t* WUQ = (bf16_t*)(ws + WS_WUQ);
    bf16_t* WUKT = (bf16_t*)(ws + WS_WUKT); bf16_t* WUK = (bf16_t*)(ws + WS_WUK); bf16_t* WUVT = (bf16_t*)(ws + WS_WUVT); bf16_t* WOT = (bf16_t*)(ws + WS_WOT);
    bf16_t* WGIN = (bf16_t*)(ws + WS_WGIN); bf16_t* WGO = (bf16_t*)(ws + WS_WGO);
    bf16_t* XN = (bf16_t*)(ws + WS_XN); bf16_t* HM = (bf16_t*)(ws + WS_HM); bf16_t* T = (bf16_t*)(ws + WS_T); bf16_t* H = (bf16_t*)(ws + WS_H); float* TP = (float*)(ws + WS_TP); bf16_t* D = (bf16_t*)(ws + WS_D);
    bf16_t* CQ = (bf16_t*)(ws + WS_CQ); bf16_t* CKV = (bf16_t*)(ws + WS_CKV); bf16_t* KPES = (bf16_t*)(ws + WS_KPES);
    bf16_t* KB = (bf16_t*)(ws + WS_KB); bf16_t* KPEP = (bf16_t*)(ws + WS_KPEP);
    float* Y = out + OUT_Y;
    const ConvPtrs cp{ffn_w_in, ffn_w_out, mla_w_down, mla_w_uq, mla_w_uk, mla_w_uv, mla_w_o, gla_w_in, gla_w_o, WIN, WOUT, WDOWN, WUQ, WUKT, WUVT, WOT, WGIN, WGO};

    {
        const int lane = lane_now(), tid = wave * 64 + lane; (void)tid;
        LAS float* scr = (LAS float*)(lds + wave * 16384);
        conv_segment<0>(cp, gw, NGW, scr, lane);
        const int gt = vcu * (NWAVES * 64) + tid, NGT = G * NWAVES * 64;
        for (int i = gt; i < KVL * NH * NOPE / 2; i += NGT) { const f32x2 v = ((const f32x2*)mla_w_uk)[i]; ((unsigned*)WUK)[i] = cvt_pk_bf16(v[0], v[1]); }
        for (int i = gt; i < (DDOWN_P - DDOWN) * DM / 2; i += NGT) ((unsigned*)(WDOWN + (size_t)DDOWN * DM))[i] = 0u;
        for (int i = gt; i < 128 * KVL / 2; i += NGT) ((unsigned*)(WUVT + (size_t)NH * VD * KVL))[i] = 0u;
        for (int i = gt; i < (GIN_P - GIN) * DM / 2; i += NGT) { const int row = (2 * i) / DM, k = (2 * i) % DM;
            unsigned w = 0u; if (row < GRANK) w = cvt_pk_bf16(gla_w_gk1[(size_t)k * GRANK + row], gla_w_gk1[(size_t)(k + 1) * GRANK + row]);
            ((unsigned*)(WGIN + (size_t)GIN * DM))[i] = w; }
        for (int i = gt; i < (SEQ + DECT) * 32; i += NGT) { const int p = i >> 5, fi = i & 31; const float pos = (float)(p < SEQ ? p : PAST + (p - SEQ));
            const float inv = (float)exp2(-(double)fi * (13.287712379549449 / 32.0));
            const float ang = pos * inv; double t = (double)ang * 0.15915494309189535; t -= rint(t); const float tf = (float)t;
            ((f32x2*)ROPE_T)[i] = (f32x2){__builtin_amdgcn_cosf(tf), __builtin_amdgcn_sinf(tf)}; }
        thin_phase<false, true, true, false>(gw, NGW, x_prompt, x_sample, nullptr, nullptr, 0, nullptr, nullptr, XN, nullptr, norm_g + 0 * DM, 1.f);
        GRID_BAR();
    }
    bf16_t* QKVG = (bf16_t*)(ws + WS_QKVG); float* T16 = (float*)(ws + WS_T16); bf16_t* GO = (bf16_t*)(ws + WS_GO);
    const int CONV_TAIL0 = ((M / 256) * (2 * DFF / 256)) % G;
#define FFN_GEMMS(slot) do { \
        { pg8::Gemm g{XN, WIN + (size_t)(slot) * 2 * DFF * DM, DM, DM, DM, 0, 0}; pg8::Order S{M / 256, 2 * DFF / 256, 1, G, bx}; \
          pg8::EpiSwiGLU E{HM, DFF}; \
          pg8::gemm_phase<pg8::EpiSwiGLU, true>(lds, wave, g, S, E); \
          if ((slot) < 3 && bx >= CONV_TAIL0) conv_segment<((slot) < 3 ? (slot) + 1 : 3)>(cp, (bx - CONV_TAIL0) * NWAVES + wave, (G - CONV_TAIL0) * NWAVES, (LAS float*)(lds + wave * 16384), lane_now()); \
          GRID_BAR(); } \
        { pg8::Gemm g{HM, WOUT + (size_t)(slot) * DM * DFF, DFF, DFF, DFF, 0, 0}; pg8::Order S{MP / 256, DM / 256, 1, G, bx};     \
          pg8::EpiBf16<0> E{T, DM, 0, 256, 1.f, 0}; \
          pg8::gemm_phase<pg8::EpiBf16<0>, true>(lds, wave, g, S, E); } \
        { pg8::Gemm g{HM + (size_t)MP * DFF, WOUT + (size_t)(slot) * DM * DFF, DFF, DFF, 256, 256, 256}; pg8::Order S{MS / 256, DM / 256, 11, G, bx};     \
          pg8::EpiF32 E{TP, DM, (long)MS * DM}; \
          pg8::gemm_phase<pg8::EpiF32, true>(lds, wave, g, S, E); \
          GRID_BAR(); } } while (0)
    { const float* ng = norm_g;
    FFN_GEMMS(0);
    thin_phase<true, true, true, false>(gw, NGW, x_prompt, x_sample, T, TP, 11, H, nullptr, XN, ng + 1 * DM, ng + 2 * DM, 0.5f); GRID_BAR();
        {
            pg8::Gemm g{XN, WDOWN, DM, DM, DM, 0, 0}; pg8::Order S{M / 256, DDOWN_P / 256, 1, G, bx};
            pg8::EpiBf16<0> E{D, DDOWN_P, 0, 256, 1.f, 0};
            pg8::gemm_phase<pg8::EpiBf16<0>, true>(lds, wave, g, S, E);
            GRID_BAR();
        }
        {
            const int lane = lane_now(), tid = wave * 64 + lane; (void)tid;
            f32x2 gq[3]; f32x4 gkv;
    #pragma unroll
            for (int j = 0; j < 3; ++j) gq[j] = *(const f32x2*)(mla_g_q + 2 * lane + 128 * j);
            gkv = *(const f32x4*)(mla_g_kv + 4 * lane);
            for (int r = gw; r < M; r += NGW) {
                const bf16_t* d = D + (size_t)r * DDOWN_P;
                f32x2 q[3];
    #pragma unroll
                for (int j = 0; j < 3; ++j) { const unsigned w = *(const unsigned*)(d + 2 * lane + 128 * j); q[j] = (f32x2){__uint_as_float(w << 16), __uint_as_float(w & 0xffff0000u)}; }
                const u32x2 kw = *(const u32x2*)(d + QL + 4 * lane);
                const f32x4 kv = (f32x4){__uint_as_float(kw.x << 16), __uint_as_float(kw.x & 0xffff0000u), __uint_as_float(kw.y << 16), __uint_as_float(kw.y & 0xffff0000u)};
                const float pe = bf2f(d[QL + KVL + lane]);
                float sq = 0.f;
    #pragma unroll
                for (int j = 0; j < 3; ++j) sq += q[j][0] * q[j][0] + q[j][1] * q[j][1];
                sq = wave_sum(sq);
                const float skv = wave_sum((kv[0] * kv[0] + kv[1] * kv[1]) + (kv[2] * kv[2] + kv[3] * kv[3]));
                const float rq = __builtin_amdgcn_rsqf(sq * (1.0f / QL) + EPS), rkv = __builtin_amdgcn_rsqf(skv * (1.0f / KVL) + EPS);
    #pragma unroll
                for (int j = 0; j < 3; ++j) *(unsigned*)(CQ + (size_t)r * QL + 2 * lane + 128 * j) = cvt_pk_bf16(q[j][0] * rq * gq[j][0], q[j][1] * rq * gq[j][1]);
                const f32x4 ckv = (kv * rkv) * gkv;
                float* ockv = r < MP ? out + OUT_CKV_P + (size_t)r * KVL : out + OUT_CKV_S + (size_t)(r - MP) * KVL;
                *(f32x4*)(ockv + 4 * lane) = ckv;
                u32x2 w; w.x = cvt_pk_bf16(ckv[0], ckv[1]); w.y = cvt_pk_bf16(ckv[2], ckv[3]);
                *(u32x2*)(CKV + (size_t)r * KVL + 4 * lane) = w;
                const float other = __shfl_xor(pe, 32);
                const f32x2 cs = ((const f32x2*)ROPE_T)[rope_pos_index(r) * 32 + (lane & 31)];
                const float ro = lane < 32 ? pe * cs[0] - other * cs[1] : pe * cs[0] + other * cs[1];
                float* okpe = r < MP ? out + OUT_KPE_P + (size_t)r * ROPE : out + OUT_KPE_S + (size_t)(r - MP) * ROPE;
                okpe[lane] = ro;
                const unsigned short rb = (unsigned short)(cvt_pk_bf16(ro, 0.f) & 0xffffu);
                if (r < MP) KPEP[(size_t)r * ROPE + lane] = rb; else KPES[(size_t)(r - MP) * ROPE + lane] = rb;
            }
            GRID_BAR();
        }

        bf16_t* Qb = (bf16_t*)(ws + WS_Q); bf16_t* VT = (bf16_t*)(ws + WS_VT); bf16_t* QLAT = (bf16_t*)(ws + WS_QLAT); bf16_t* Ob = (bf16_t*)(ws + WS_O);
        float* OPART = (float*)(ws + WS_OPART); float* OML = (float*)(ws + WS_OML); bf16_t* OLAT = (bf16_t*)(ws + WS_OLAT);
        const float QSCALE = 0.07216878364870322f * LOG2E;
        {
            pg8::Gemm g{CQ, WUQ, QL, QL, QL, 0, 0}; pg8::Order S{MP / 256, NH * QKD / 256, 1, G, bx};
            pg8::EpiQ E{Qb, ROPE_T, QSCALE};
            pg8::gemm_phase<pg8::EpiQ, true>(lds, wave, g, S, E);
            GRID_BAR();
        }
        {
            const int NQU = (MS / 256) * (NH * QKD / 256), NQP = NQU < G / 2 ? NQU : G / 2, NQC = 32 < G - NQP ? 32 : G - NQP;
            unsigned* qctr = ctl + 16 + 64 * 4;
            if (bx < NQP) {
                pg8::Gemm g{CQ, WUQ, QL, QL, QL, 0, 0}; pg8::OrderOff S{{MS / 256, NH * QKD / 256, 1, NQP, bx}, MP / 256};
                pg8::EpiQ E{Qb, ROPE_T, QSCALE};
                pg8::gemm_phase<pg8::EpiQ, true, pg8::OrderOff>(lds, wave, g, S, E);
                if (wave == 0 && lane_now() == 0) { __builtin_amdgcn_fence(__ATOMIC_RELEASE, "agent"); asm volatile("s_waitcnt vmcnt(0)" ::: "memory"); (void)xb_add(qctr, 1u); }
            }
            { pg8::Gemm g{CKV, WUKT, KVL, KVL, KVL, 0, 0}; pg8::Order S{MP / 256, NH * NOPE / 256, 1, G, bx};
              pg8::EpiBf16<0> E{KB, NH * NOPE, 0, 256, 1.f, 0};
              pg8::gemm_phase<pg8::EpiBf16<0>, true>(lds, wave, g, S, E); }
            { pg8::Gemm g{WUVT, CKV, KVL, KVL, KVL, 0, 0}; pg8::Order S{NH * VD / 256, MP / 256, 1, G, bx};
              pg8::EpiBf16<0> E{VT, MP, 0, 256, 1.f, 0};
              pg8::gemm_phase<pg8::EpiBf16<0>, true>(lds, wave, g, S, E); }
            if (bx >= G - NQC) {
                if (wave == 0 && lane_now() == 0) { XB_SPIN(xb_ld(qctr) < (unsigned)NQP, ctl + 1024); __builtin_amdgcn_fence(__ATOMIC_ACQUIRE, "agent"); asm volatile("s_waitcnt vmcnt(0)" ::: "memory"); }
                __syncthreads();
                { pg8::Gemm g{Qb + (size_t)MP * NH * QKD, WUK, NH * QKD, NH * NOPE, NOPE, QKD, NOPE}; pg8::Order S{MS / 256, 1, NH, NQC, bx - (G - NQC)};
                  pg8::EpiBf16<0> E{QLAT, NH * 320, 320, 256, 1.f, 0};
                  pg8::gemm_phase<pg8::EpiBf16<0>, true>(lds, wave, g, S, E); }
                const int lane = lane_now(), tid = wave * 64 + lane;
                for (int i = (bx - (G - NQC)) * (NWAVES * 64) + tid; i < MS * NH * 8; i += NQC * NWAVES * 64) { const int c = i & 7, th = i >> 3;
                    *(u32x4*)(QLAT + (size_t)th * 320 + 256 + c * 8) = *(const u32x4*)(Qb + (size_t)(MP + (th >> 3)) * (NH * QKD) + (th & 7) * QKD + NOPE + c * 8); }
            }
            GRID_BAR();
        }

        {
            for (int p = vcu; p < NB * NH * 4; p += G) { const int bh = p >> 2, x = p & 3;
                pat::unit(lds, wave, Qb, KB, KPEP, VT, Ob, bh >> 3, bh & 7, 7 - x);
                pat::unit(lds, wave, Qb, KB, KPEP, VT, Ob, bh >> 3, bh & 7, x); }
            STAMP();
            for (int u = bx; u < DECB * 2; u += G)
                sat::unit(lds, wave, QLAT, cache_ckv, cache_kpe, page_table, CKV + (size_t)MP * KVL, KPES, OPART, OML, u >> 1, u & 1);
            GRID_BAR();
        }
        {
            const int lane = lane_now(), tid = wave * 64 + lane; (void)tid;
            for (int r = gw; r < DECB * 64; r += NGW) { const int b = r >> 6, q = r & 63;
                const f32x2 ml0 = *(const f32x2*)(OML + ((size_t)(b * 2) * 64 + q) * 2), ml1 = *(const f32x2*)(OML + ((size_t)(b * 2 + 1) * 64 + q) * 2);
                const float mm = fmaxf(ml0[0], ml1[0]), w0 = __builtin_amdgcn_exp2f(ml0[0] - mm), w1 = __builtin_amdgcn_exp2f(ml1[0] - mm), inv = 1.0f / (ml0[1] * w0 + ml1[1] * w1);
                const f32x4 a = *(const f32x4*)(OPART + ((size_t)(b * 2) * 64 + q) * KVL + 4 * lane), c = *(const f32x4*)(OPART + ((size_t)(b * 2 + 1) * 64 + q) * KVL + 4 * lane);
                const f32x4 v = (a * w0 + c * w1) * inv;
                u32x2 w; w.x = cvt_pk_bf16(v[0], v[1]); w.y = cvt_pk_bf16(v[2], v[3]);
                *(u32x2*)(OLAT + (size_t)r * KVL + 4 * lane) = w; }
            GRID_BAR();
        }
        {
            pg8::Gemm g{OLAT, WUVT, NH * KVL, KVL, KVL, KVL, (long)VD * KVL}; pg8::Order S{MS / 256, 1, NH, G, bx};
            pg8::EpiBf16<0> E{Ob + (size_t)MP * DM, DM, VD, 128, 1.f, 0};
            pg8::gemm_phase<pg8::EpiBf16<0>, true>(lds, wave, g, S, E);
            GRID_BAR();
        }
        {
            { pg8::Gemm g{Ob, WOT, DM, DM, DM, 0, 0}; pg8::Order S{MP / 256, DM / 256, 1, G, bx};
              pg8::EpiBf16<0> E{T, DM, 0, 256, 1.f, 0};
              pg8::gemm_phase<pg8::EpiBf16<0>, true>(lds, wave, g, S, E); }
            { pg8::Gemm g{Ob + (size_t)MP * DM, WOT, DM, DM, 256, 256, 256}; pg8::Order S{MS / 256, DM / 256, 4, G, bx};
              pg8::EpiF32 E{TP, DM, (long)MS * DM};
              pg8::gemm_phase<pg8::EpiF32, true>(lds, wave, g, S, E); }
            GRID_BAR();
        }
        {
            thin_phase<true, true, false, false>(gw, NGW, nullptr, nullptr, T, TP, 4, H, nullptr, XN, norm_g + 3 * DM, norm_g + 4 * DM, 1.0f);
            GRID_BAR();
        }


    FFN_GEMMS(1);
    thin_phase<true, true, false, false>(gw, NGW, nullptr, nullptr, T, TP, 11, H, nullptr, XN, ng + 5 * DM, norm_g + 6 * DM, 0.5f); GRID_BAR();
    }
    { const float* ng = norm_g + 6 * DM;
    FFN_GEMMS(2);
    thin_phase<true, true, false, false>(gw, NGW, nullptr, nullptr, T, TP, 11, H, nullptr, XN, ng + 1 * DM, ng + 2 * DM, 0.5f); GRID_BAR();
            { pg8::Gemm g{XN, WGIN, DM, DM, DM, 0, 0}; pg8::Order S{M / 256, GIN_P / 256, 1, G, bx};
              pg8::EpiGla E{QKVG, T16, 0.08838834764831845f};
              pg8::gemm_phase<pg8::EpiGla, true>(lds, wave, g, S, E);
              GRID_BAR(); }
            bf16_t* GQT = (bf16_t*)(ws + WS_GQT); bf16_t* GKH = (bf16_t*)(ws + WS_GKH); bf16_t* GAT = (bf16_t*)(ws + WS_GAT); float* GDK_ = (float*)(ws + WS_GDK);
            { for (int u = bx; u < (M / 64) * GH; u += G) { const int chunk = u >> 2, h = u & 3;
                  if (chunk < MP / 64) gla::prep<64>(lds, wave, QKVG, T16, gla_w_gk2, gla_b_gk, chunk, h, GQT, GKH, GAT, GDK_);
                  else gla::prep<8>(lds, wave, QKVG, T16, gla_w_gk2, gla_b_gk, chunk, h, GQT, GKH, GAT, GDK_); }
              GRID_BAR(); }
            { const int NPB = (G >= 2 * NB * GH * 2) ? NB * GH * 2 : 0;
              if (NPB == 0 || vcu < NPB) {
                  for (int u = vcu; u < NB * GH * 2; u += (NPB ? NPB : G)) { const int bh = u >> 1, q = u & 1, b = bh >> 2, h = bh & 3;
                      gla::chain<4>(lds, wave, GQT, GKH, GAT, GDK_, QKVG, h, b * (SEQ / 64), SEQ / 64, 0, 64, -1, 0, 128 * q, nullptr, out + OUT_ST_P + (size_t)bh * GDK * GDV, GO); } }
              if (NPB == 0 || vcu >= NPB) {
                  for (int u = (NPB ? vcu - NPB : vcu); u < DECB * GH; u += (NPB ? G - NPB : G)) { const int b = u >> 2, h = u & 3;
                      gla::chain<8>(lds, wave, GQT, GKH, GAT, GDK_, QKVG, h, MP / 64 + (b >> 3), 1, 8 * (b & 7), 8, b & 7, b & 7, 0, state_gla + (size_t)u * GDK * GDV, out + OUT_ST_S + (size_t)u * GDK * GDV, GO); } }
              GRID_BAR(); }
            { const int lane = lane_now(), tid = wave * 64 + lane; (void)tid; const f32x4 gn = *(const f32x4*)(gla_g_norm + 4 * lane);
              for (int r = gw; r < M; r += NGW) {
                  Row16 o = ld_row_bf16(GO + (size_t)r * DM, lane);
                  const u32x2* gp = (const u32x2*)(QKVG + (size_t)r * GIN + 2 * GH * GDK + GH * GDV) + lane;
#pragma unroll
                  for (int j = 0; j < 4; ++j) { const u32x2 gw2 = gp[64 * j];
                      const float ss = wave_sum((o.v[j][0] * o.v[j][0] + o.v[j][1] * o.v[j][1]) + (o.v[j][2] * o.v[j][2] + o.v[j][3] * o.v[j][3]));
                      const float rs = __builtin_amdgcn_rsqf(ss * (1.0f / GDV) + EPS);
                      const float g0 = __uint_as_float(gw2.x << 16), g1 = __uint_as_float(gw2.x & 0xffff0000u), g2 = __uint_as_float(gw2.y << 16), g3 = __uint_as_float(gw2.y & 0xffff0000u);
                      o.v[j][0] = o.v[j][0] * rs * gn[0] * pg8::silu_f(g0); o.v[j][1] = o.v[j][1] * rs * gn[1] * pg8::silu_f(g1);
                      o.v[j][2] = o.v[j][2] * rs * gn[2] * pg8::silu_f(g2); o.v[j][3] = o.v[j][3] * rs * gn[3] * pg8::silu_f(g3); }
                  st_row_bf16(XN + (size_t)r * DM, o, lane); }
              GRID_BAR(); }
            { { pg8::Gemm g{XN, WGO, DM, DM, DM, 0, 0}; pg8::Order S{MP / 256, DM / 256, 1, G, bx};
                pg8::EpiBf16<0> E{T, DM, 0, 256, 1.f, 0};
                pg8::gemm_phase<pg8::EpiBf16<0>, true>(lds, wave, g, S, E); }
              { pg8::Gemm g{XN + (size_t)MP * DM, WGO, DM, DM, 256, 256, 256}; pg8::Order S{MS / 256, DM / 256, 4, G, bx};
                pg8::EpiF32 E{TP, DM, (long)MS * DM};
                pg8::gemm_phase<pg8::EpiF32, true>(lds, wave, g, S, E); }
              GRID_BAR(); }
            { thin_phase<true, true, false, false>(gw, NGW, nullptr, nullptr, T, TP, 4, H, nullptr, XN, ng + 3 * DM, ng + 4 * DM, 1.0f);
              GRID_BAR(); }

    FFN_GEMMS(3);
    thin_phase<true, false, false, true>(gw, NGW, nullptr, nullptr, T, TP, 11, H, Y, XN, ng + 5 * DM, nullptr, 0.5f);
    }
#ifdef PROBE_A0
    GRID_BAR();
    {
        const int lane = lane_now(), tid = wave * 64 + lane;
        const float ta = (float)(tsb[PROBE_A1] - tsb[PROBE_A0]) * 0.01f, tb = (float)(tsb[PROBE_B1] - tsb[PROBE_B0]) * 0.01f;
        if (bx == 0 && tid == 0) out[0] += ta * 0.1f;
        const float f = 1.0f + tb * (1.0f / PROBE_BDIV);
        for (int i = bx * (NWAVES * 64) + tid; i < MS * ROPE; i += G * NWAVES * 64) out[OUT_KPE_S + i] *= f;
    }
#endif
#ifdef DBG_SCALE_MASK
    GRID_BAR();
    {
        const int lane = lane_now(), tid = wave * 64 + lane; (void)tid;
        const size_t offs[9] = {OUT_Y, OUT_Y + (size_t)MP * DM, OUT_CKV_P, OUT_KPE_P, OUT_CKV_S, OUT_KPE_S, OUT_ST_P, OUT_ST_S, OUT_END};
        for (int o = 0; o < 8; ++o) if ((DBG_SCALE_MASK >> o) & 1)
            for (size_t i = offs[o] / 4 + (size_t)vcu * (NWAVES * 64) + tid; i < offs[o + 1] / 4; i += (size_t)G * NWAVES * 64) ((f32x4*)out)[i] = ((f32x4*)out)[i] * 3.0f;
    }
#endif
#undef GRID_BAR
}

extern "C" void kernel_launch(void* const* d_in, const int* in_sizes, int n_in, void* d_out, int out_size, void* d_ws, size_t ws_size, hipStream_t stream) {
    static int grid = 0;
    if (grid == 0) {
        if (n_in != 22 || (size_t)out_size != OUT_END || ws_size < WS_END) { fprintf(stderr, "kernel_launch: unexpected shapes: n_in %d out %d ws %zu (need %zu)\n", n_in, out_size, ws_size, (size_t)WS_END); grid = -1; return; }
        int dev = 0, cus = 0, per_cu = 0;
        if (hipGetDevice(&dev) != hipSuccess || hipDeviceGetAttribute(&cus, hipDeviceAttributeMultiprocessorCount, dev) != hipSuccess) { grid = -1; return; }
        if (hipFuncSetAttribute((const void*)mk_fwd, hipFuncAttributeMaxDynamicSharedMemorySize, LDS_BYTES) != hipSuccess) { fprintf(stderr, "kernel_launch: hipFuncSetAttribute failed\n"); grid = -1; return; }
        if (hipOccupancyMaxActiveBlocksPerMultiprocessor(&per_cu, (const void*)mk_fwd, NWAVES * 64, LDS_BYTES) != hipSuccess || per_cu < 1) { fprintf(stderr, "kernel_launch: occupancy query says %d\n", per_cu); }
        (void)hipGetLastError();
        grid = cus;
    }
    if (grid < 0) return;
    if (hipMemsetAsync((char*)d_ws + WS_CTL, 0, CTL_ZERO_BYTES, stream) != hipSuccess) return;
    Args a{};
    for (int i = 0; i < 22; ++i) a.in[i] = d_in[i];
    a.out = (float*)d_out; a.ws = (unsigned char*)d_ws; a.ph_lo = 0; a.ph_hi = 100;
    hipLaunchKernelGGL(mk_fwd, dim3(grid), dim3(NWAVES * 64), LDS_BYTES, stream, a);
}
```

```cpp
#include <hip/hip_runtime.h>
#include <cstdio>
#include <cstdint>


#define GAS __attribute__((address_space(1)))
#define LAS __attribute__((address_space(3)))
typedef unsigned short bf16_t;
typedef short bf16x8 __attribute__((ext_vector_type(8)));
typedef float f32x4 __attribute__((ext_vector_type(4)));
typedef float f32x2 __attribute__((ext_vector_type(2)));
typedef float f32x16 __attribute__((ext_vector_type(16)));
typedef unsigned u32x4 __attribute__((ext_vector_type(4)));
typedef unsigned u32x2 __attribute__((ext_vector_type(2)));

constexpr int DM = 1024, NB = 16, SEQ = 2048, DECB = 128, DECT = 8, PAST = 8192, PAGE = 128, NPAGES = PAST / PAGE;
constexpr int MP = NB * SEQ, MS = DECB * DECT, M = MP + MS;
constexpr int DFF = 2816;
constexpr int QL = 384, KVL = 256, NOPE = 128, ROPE = 64, VD = 128, NH = 8, QKD = NOPE + ROPE;
constexpr int DDOWN = QL + KVL + ROPE, DDOWN_P = 768;
constexpr int GH = 4, GDK = 128, GDV = 256, GRANK = 16, GIN = 2 * GH * GDK + 2 * GH * GDV, GIN_P = GIN + 256;
constexpr float EPS = 1e-6f;
constexpr float LOG2E = 1.4426950408889634f;
constexpr int NPOOL = (DECB * NPAGES * 5) / 4;

constexpr size_t OUT_Y = 0;
constexpr size_t OUT_CKV_P = (size_t)M * DM;
constexpr size_t OUT_KPE_P = OUT_CKV_P + (size_t)MP * KVL;
constexpr size_t OUT_CKV_S = OUT_KPE_P + (size_t)MP * ROPE;
constexpr size_t OUT_KPE_S = OUT_CKV_S + (size_t)MS * KVL;
constexpr size_t OUT_ST_P = OUT_KPE_S + (size_t)MS * ROPE;
constexpr size_t OUT_ST_S = OUT_ST_P + (size_t)NB * GH * GDK * GDV;
constexpr size_t OUT_END = OUT_ST_S + (size_t)DECB * GH * GDK * GDV;

constexpr size_t MiB = 1u << 20;
constexpr size_t al(size_t x) { return (x + 4095) & ~(size_t)4095; }
constexpr size_t WS_CTL = 0, CTL_ZERO_BYTES = 64 * 1024;
constexpr size_t WS_ROPE = 1 * MiB;
constexpr size_t WS_WIN = 2 * MiB;
constexpr size_t SZ_WIN1 = (size_t)2 * DFF * DM * 2;
constexpr size_t WS_WOUT = WS_WIN + 4 * SZ_WIN1;
constexpr size_t SZ_WOUT1 = (size_t)DM * DFF * 2;
constexpr size_t WS_WDOWN = WS_WOUT + 4 * SZ_WOUT1;
constexpr size_t WS_WUQ = WS_WDOWN + (size_t)DDOWN_P * DM * 2;
constexpr size_t WS_WUKT = WS_WUQ + (size_t)NH * QKD * QL * 2;
constexpr size_t WS_WUK = WS_WUKT + (size_t)NH * NOPE * KVL * 2;
constexpr size_t WS_WUVT = WS_WUK + (size_t)NH * NOPE * KVL * 2;
constexpr size_t WS_WOT = WS_WUVT + (size_t)(NH * VD + 128) * KVL * 2;
constexpr size_t WS_WGIN = WS_WOT + (size_t)DM * DM * 2;
constexpr size_t WS_WGO = WS_WGIN + (size_t)GIN_P * DM * 2;
constexpr size_t WS_ACT = al(WS_WGO + (size_t)DM * DM * 2);
constexpr size_t WS_XN = WS_ACT;
constexpr size_t WS_HM = al(WS_XN + (size_t)M * DM * 2);
constexpr size_t WS_T = al(WS_HM + (size_t)M * DFF * 2);
constexpr size_t WS_D = al(WS_T + (size_t)M * DM * 4);
constexpr size_t WS_CQ = al(WS_D + (size_t)M * DDOWN_P * 4);
constexpr size_t WS_CKV = al(WS_CQ + (size_t)M * QL * 2);
constexpr size_t WS_KPES = al(WS_CKV + (size_t)M * KVL * 2);
constexpr size_t WS_Q = al(WS_KPES + (size_t)MS * ROPE * 2);
constexpr size_t WS_KB = al(WS_Q + (size_t)M * NH * QKD * 2);
constexpr size_t WS_KPEP = al(WS_KB + (size_t)MP * NH * NOPE * 2);
constexpr size_t WS_VT = al(WS_KPEP + (size_t)MP * ROPE * 2);
constexpr size_t WS_QLAT = al(WS_VT + (size_t)NH * VD * MP * 2);
constexpr size_t WS_O = al(WS_QLAT + (size_t)MS * NH * 320 * 2);
constexpr size_t WS_OPART = al(WS_O + (size_t)M * DM * 2);
constexpr size_t WS_OML = al(WS_OPART + (size_t)DECB * 2 * 64 * 256 * 4);
constexpr size_t WS_OLAT = al(WS_OML + (size_t)DECB * 2 * 64 * 2 * 4);
constexpr size_t WS_QKVG = al(WS_OLAT + (size_t)MS * NH * KVL * 2);
constexpr size_t WS_T16 = al(WS_QKVG + (size_t)M * GIN * 2);
constexpr size_t WS_GO = al(WS_T16 + (size_t)M * 16 * 4);
constexpr size_t WS_H = al(WS_GO + (size_t)M * DM * 4);
constexpr size_t WS_TP = al(WS_H + (size_t)M * DM * 2);
constexpr size_t WS_GQT = al(WS_TP + (size_t)11 * MS * DM * 4);
constexpr size_t WS_GKH = al(WS_GQT + (size_t)M * GH * GDK * 2);
constexpr size_t WS_GAT = al(WS_GKH + (size_t)(M / 64) * GH * 128 * 64 * 2);
constexpr size_t WS_GDK = al(WS_GAT + (size_t)(M / 64) * GH * 3072 * 2);
constexpr size_t WS_END = al(WS_GDK + (size_t)(M / 64) * GH * 1024 * 4);

constexpr int RING_BYTES = 131072;
constexpr int LDSCTL_OFF = RING_BYTES, MISC_OFF = LDSCTL_OFF + 320;
constexpr int LDS_BYTES = 147456;
constexpr int NWAVES = 8;

#define LDS_WAIT() asm volatile("s_waitcnt lgkmcnt(0)" ::: "memory")
#define VM_WAIT() asm volatile("s_waitcnt vmcnt(0)" ::: "memory")
#define RLX_AGENT __ATOMIC_RELAXED, __HIP_MEMORY_SCOPE_AGENT

typedef __bf16 bf16x2_t __attribute__((ext_vector_type(2)));
__device__ __forceinline__ unsigned cvt_pk_bf16(float lo, float hi) { const f32x2 v = {lo, hi}; const bf16x2_t b = __builtin_convertvector(v, bf16x2_t); return __builtin_bit_cast(unsigned, b); }
__device__ __forceinline__ int lane_now() { int l; asm volatile("v_mbcnt_lo_u32_b32 %0, -1, 0\n\tv_mbcnt_hi_u32_b32 %0, -1, %0" : "=v"(l)); return l; }
__device__ __forceinline__ float bf2f(unsigned short b) { return __uint_as_float((unsigned)b << 16); }
template <int CTRL> __device__ __forceinline__ float dpp_mov(float v) { return __builtin_bit_cast(float, __builtin_amdgcn_update_dpp(0, __builtin_bit_cast(int, v), CTRL, 0xF, 0xF, true)); }
__device__ __forceinline__ float wave_sum(float v) {
    v += dpp_mov<0xB1>(v);
    v += dpp_mov<0x4E>(v);
    v += dpp_mov<0x141>(v);
    v += dpp_mov<0x140>(v);
    const int iv = __builtin_bit_cast(int, v);
    const float a = __builtin_bit_cast(float, __builtin_amdgcn_readlane(iv, 0)), b = __builtin_bit_cast(float, __builtin_amdgcn_readlane(iv, 16));
    const float c = __builtin_bit_cast(float, __builtin_amdgcn_readlane(iv, 32)), d = __builtin_bit_cast(float, __builtin_amdgcn_readlane(iv, 48));
    return (a + b) + (c + d);
}

namespace pg8 {
constexpr int BM = 256, BK = 64, HALF = 128, HTB = HALF * BK * 2, STAGE_BYTES = 8 * HTB, NXCD = 8, WGM = 8;
__host__ __device__ __forceinline__ int lds_byte(int r, int c) { const int st = (r >> 4) * 2 + (c >> 5), rr = r & 15, cc = c & 31, ob = rr * 64 + cc * 2; return st * 1024 + (ob ^ (((ob >> 9) & 1) << 5)); }
__host__ __device__ __forceinline__ void stage_rc(int b, int& R, int& C) { const int st = b / 1024, sb = b % 1024, swz = sb ^ (((sb >> 9) & 1) << 5); R = (st >> 1) * 16 + swz / 64; C = (st & 1) * 32 + (swz % 64) / 2; }
__host__ __device__ __forceinline__ int perm32(int rho) { const int n = rho >> 4, i = rho & 15; return 8 * (i >> 2) + 4 * n + (i & 3); }

struct Unit { int pm, pn, z; };
struct Gemm { const bf16_t* A; const bf16_t* Bt; int lda, ldb, K; long sAz, sBz; };

struct Order {
    int nM, nN, nZ, G, c;
    __device__ __forceinline__ bool next(int i, Unit& u) const {
        const long L = (long)i * G + c; const int per = nM * nN; if (L >= (long)per * nZ) return false;
        const int z = (int)(L / per); int wgid = (int)(L - (long)z * per);
        { const int q = per / NXCD, r = per % NXCD, xcd = wgid % NXCD, off = wgid / NXCD; wgid = (xcd < r ? xcd * (q + 1) : r * (q + 1) + (xcd - r) * q) + off; }
        const int nig = WGM * nN, gid = wgid / nig, fm = gid * WGM, gsz = (nM - fm) < WGM ? (nM - fm) : WGM;
        u.pm = fm + ((wgid % nig) % gsz); u.pn = (wgid % nig) / gsz; u.z = z; return true;
    }
};

struct OrderOff {
    Order o; int m0;
    __device__ __forceinline__ bool next(int i, Unit& u) const { const bool ok = o.next(i, u); u.pm += m0; return ok; }
};

template <class Epi, bool ALIGN_EPI, class Ord = Order>
__device__ __forceinline__ void gemm_phase(LAS unsigned char* lds, const int wid, const Gemm g, const Ord& S, const Epi& E) {
    const int lane = lane_now(), tid = wid * 64 + lane;
    const int wr = wid >> 2, wc = wid & 3, fr = lane & 15, fq = lane >> 4;
    const int K = g.K, nt = K / BK;
    unsigned voffA, voffB;
    { int R, C; stage_rc(tid * 16, R, C); const int Rb = Epi::PERM ? ((R & ~31) + perm32(R & 31)) : R;
      voffA = (unsigned)(R * g.lda + C) * 2u; voffB = (unsigned)(Rb * g.ldb + C) * 2u; }
    const size_t qsA = (size_t)64 * g.lda * 2, qsB = (size_t)64 * g.ldb * 2;
    const size_t kstep = (size_t)(BK * 2);
    const size_t hsA = (size_t)HALF * g.lda * 2, hsB = (size_t)HALF * g.ldb * 2;
    const unsigned ldsw = (unsigned)wid * 1024u;
    const int aoff = lds_byte(wr * 64 + fr, fq * 8), boff = lds_byte(wc * 32 + fr, fq * 8);
#define PG8_SA(b, h) (((b) * 2 + (h)) * HTB)
#define PG8_SB(b, h) ((4 + (b) * 2 + (h)) * HTB)
#define PG8_STAGE(bufoff, gbase, voff) do { _Pragma("unroll") for (int _i = 0; _i < 2; ++_i) \
        __builtin_amdgcn_global_load_lds((const unsigned*)((const char*)(gbase) + _i * PG8_QS_##voff + (voff)), (LAS unsigned*)(lds + (bufoff) + ldsw + _i * 8192), 16, 0, 0); } while (0)
#define PG8_QS_voffA qsA
#define PG8_QS_voffB qsB
#define PG8_LDA(dst, b, h) do { _Pragma("unroll") for (int m = 0; m < 4; ++m) _Pragma("unroll") for (int k = 0; k < 2; ++k) dst[m][k] = *(const LAS bf16x8*)(lds + PG8_SA(b, h) + aoff + m * 2048 + k * 1024); } while (0)
#define PG8_LDB(dst, b, h) do { _Pragma("unroll") for (int n = 0; n < 2; ++n) _Pragma("unroll") for (int k = 0; k < 2; ++k) dst[n][k] = *(const LAS bf16x8*)(lds + PG8_SB(b, h) + boff + n * 2048 + k * 1024); } while (0)
#define PG8_MMA(ai, bj, At, Bt) do { __builtin_amdgcn_s_setprio(1); _Pragma("unroll") for (int m = 0; m < 4; ++m) _Pragma("unroll") for (int n = 0; n < 2; ++n) _Pragma("unroll") for (int k = 0; k < 2; ++k) \
        acc[ai][bj][m][n] = __builtin_amdgcn_mfma_f32_16x16x32_bf16(Bt[n][k], At[m][k], acc[ai][bj][m][n], 0, 0, 0); __builtin_amdgcn_s_setprio(0); } while (0)
#define PG8_WAIT_V(n) asm volatile("s_waitcnt vmcnt(" #n ")" ::: "memory")
#define PG8_WAIT_L(n) asm volatile("s_waitcnt lgkmcnt(" #n ")" ::: "memory")
#define PG8_BAR __builtin_amdgcn_s_barrier()
#define PG8_SCHED __builtin_amdgcn_sched_barrier(0)
#define PG8_APTR(u) ((const char*)g.A + ((size_t)(u).z * g.sAz + (size_t)(u).pm * BM * g.lda) * 2)
#define PG8_BPTR(u) ((const char*)g.Bt + ((size_t)(u).z * g.sBz + (size_t)(u).pn * BM * g.ldb) * 2)
    Unit cur, nxt; int ui = 0;
    if (!S.next(0, cur)) return;
    f32x4 acc[2][2][4][2];
#pragma unroll
    for (int a = 0; a < 2; ++a)
#pragma unroll
        for (int b = 0; b < 2; ++b)
#pragma unroll
            for (int m = 0; m < 4; ++m)
#pragma unroll
                for (int n = 0; n < 2; ++n) acc[a][b][m][n] = (f32x4){0.f, 0.f, 0.f, 0.f};
    bf16x8 At[4][2], B0[2][2], B1[2][2];
    const char* cA = PG8_APTR(cur); const char* cB = PG8_BPTR(cur);
    PG8_STAGE(PG8_SB(0, 0), cB, voffB); PG8_STAGE(PG8_SB(0, 1), cB + hsB, voffB); PG8_STAGE(PG8_SA(0, 0), cA, voffA); PG8_STAGE(PG8_SA(0, 1), cA + hsA, voffA);
    if (wr == 1) PG8_BAR;
    PG8_WAIT_V(2); PG8_BAR;
    PG8_STAGE(PG8_SB(1, 0), cB + kstep, voffB); PG8_STAGE(PG8_SA(1, 0), cA + kstep, voffA); PG8_STAGE(PG8_SB(1, 1), cB + hsB + kstep, voffB);
    PG8_WAIT_V(6); PG8_BAR;
    for (;;) {
        const bool has_next = S.next(ui + 1, nxt);
        const char* nA = has_next ? PG8_APTR(nxt) : cA; const char* nB = has_next ? PG8_BPTR(nxt) : cB;
#pragma unroll 1
        for (int t = 0; t < nt; t += 2) {
            const bool last = (t == nt - 2);
            const char* a1 = cA + (size_t)(t + 1) * kstep;
            const char* a2 = last ? nA : cA + (size_t)(t + 2) * kstep; const char* b2 = last ? nB : cB + (size_t)(t + 2) * kstep;
            const char* a3 = a2 + kstep; const char* b3 = b2 + kstep;
            PG8_LDB(B0, 0, 0); PG8_LDB(B1, 0, 1); PG8_SCHED; PG8_LDA(At, 0, 0); PG8_STAGE(PG8_SA(1, 1), a1 + hsA, voffA);
            PG8_WAIT_V(8); PG8_WAIT_L(0); PG8_BAR; PG8_MMA(0, 0, At, B0); PG8_MMA(0, 1, At, B1); PG8_BAR; PG8_SCHED;
            PG8_LDA(At, 0, 1); PG8_STAGE(PG8_SB(0, 0), b2, voffB); PG8_STAGE(PG8_SB(0, 1), b2 + hsB, voffB); PG8_STAGE(PG8_SA(0, 0), a2, voffA);
            PG8_WAIT_V(8); PG8_WAIT_L(0); PG8_BAR; PG8_MMA(1, 0, At, B0); PG8_MMA(1, 1, At, B1); PG8_BAR; PG8_SCHED;
            PG8_LDB(B0, 1, 0); PG8_LDB(B1, 1, 1); PG8_SCHED; PG8_LDA(At, 1, 0); PG8_STAGE(PG8_SA(0, 1), a2 + hsA, voffA);
            PG8_WAIT_V(8); PG8_WAIT_L(0); PG8_BAR; PG8_MMA(0, 0, At, B0); PG8_MMA(0, 1, At, B1); PG8_BAR; PG8_SCHED;
            PG8_LDA(At, 1, 1); PG8_STAGE(PG8_SB(1, 0), b3, voffB); PG8_STAGE(PG8_SB(1, 1), b3 + hsB, voffB); PG8_STAGE(PG8_SA(1, 0), a3, voffA);
            PG8_WAIT_V(8); PG8_WAIT_L(0); PG8_BAR; PG8_MMA(1, 0, At, B0); PG8_MMA(1, 1, At, B1); PG8_BAR; PG8_SCHED;
        }
        if constexpr (ALIGN_EPI) { if (wr == 0) PG8_BAR; }
        { int fr2 = fr, fq2 = fq; asm volatile("" : "+v"(fr2), "+v"(fq2)); E(acc, cur, wr, wc, fr2, fq2); }
        if (!has_next) break;
#pragma unroll
        for (int a = 0; a < 2; ++a)
#pragma unroll
            for (int b = 0; b < 2; ++b)
#pragma unroll
                for (int m = 0; m < 4; ++m)
#pragma unroll
                    for (int n = 0; n < 2; ++n) acc[a][b][m][n] = (f32x4){0.f, 0.f, 0.f, 0.f};
        cur = nxt; cA = nA; cB = nB; ++ui;
        if constexpr (ALIGN_EPI) { if (wr == 1) PG8_BAR; }
    }
    PG8_WAIT_V(0);
    if constexpr (!ALIGN_EPI) { if (wr == 0) PG8_BAR; }
    PG8_BAR;
#undef PG8_SA
#undef PG8_SB
#undef PG8_STAGE
#undef PG8_QS_voffA
#undef PG8_QS_voffB
#undef PG8_LDA
#undef PG8_LDB
#undef PG8_MMA
#undef PG8_WAIT_V
#undef PG8_WAIT_L
#undef PG8_BAR
#undef PG8_SCHED
#undef PG8_APTR
#undef PG8_BPTR
}

__device__ __forceinline__ float silu_f(float g) { return g * __builtin_amdgcn_rcpf(1.0f + __builtin_amdgcn_exp2f(-g * LOG2E)); }
__device__ __forceinline__ float swiglu_f(float g, float u) { return (g * u) * __builtin_amdgcn_rcpf(1.0f + __builtin_amdgcn_exp2f(-g)); }

struct EpiSwiGLU {
    static constexpr bool PERM = true;
    bf16_t* O; int ldc;
    __device__ __forceinline__ void operator()(const f32x4 (&acc)[2][2][4][2], const Unit& u, int wr, int wc, int fr, int fq) const {
        const int row0 = u.pm * BM + wr * 64 + fr, col0 = u.pn * HALF + wc * 32 + 8 * fq;
#pragma unroll
        for (int ai = 0; ai < 2; ++ai)
#pragma unroll
            for (int m = 0; m < 4; ++m) {
                bf16_t* rowp = O + (size_t)(row0 + ai * HALF + m * 16) * ldc + col0;
                const f32x4 g0 = acc[ai][0][m][0], g1 = acc[ai][0][m][1], u0 = acc[ai][1][m][0], u1 = acc[ai][1][m][1];
                u32x4 w;
                w.x = cvt_pk_bf16(swiglu_f(g0[0], u0[0]), swiglu_f(g0[1], u0[1])); w.y = cvt_pk_bf16(swiglu_f(g0[2], u0[2]), swiglu_f(g0[3], u0[3]));
                w.z = cvt_pk_bf16(swiglu_f(g1[0], u1[0]), swiglu_f(g1[1], u1[1])); w.w = cvt_pk_bf16(swiglu_f(g1[2], u1[2]), swiglu_f(g1[3], u1[3]));
                *(u32x4*)rowp = w;
            }
    }
};
struct EpiF32 {
    static constexpr bool PERM = false;
    float* O; int ldc; long sOz;
    __device__ __forceinline__ void operator()(const f32x4 (&acc)[2][2][4][2], const Unit& u, int wr, int wc, int fr, int fq) const {
        const int row0 = u.pm * BM + wr * 64 + fr, col0 = u.pn * BM + wc * 32 + 4 * fq;
#pragma unroll
        for (int ai = 0; ai < 2; ++ai)
#pragma unroll
            for (int m = 0; m < 4; ++m) {
                float* rowp = O + (size_t)u.z * sOz + (size_t)(row0 + ai * HALF + m * 16) * ldc + col0;
#pragma unroll
                for (int bj = 0; bj < 2; ++bj)
#pragma unroll
                    for (int n = 0; n < 2; ++n) *(f32x4*)(rowp + bj * HALF + n * 16) = acc[ai][bj][m][n];
            }
    }
};

template <int CMAP> struct EpiBf16 {
    static constexpr bool PERM = true;
    bf16_t* O; int ldc; long sOz; int ncol; float scale; int scale_cols;
    __device__ __forceinline__ void operator()(const f32x4 (&acc)[2][2][4][2], const Unit& u, int wr, int wc, int fr, int fq) const {
        const int row0 = u.pm * BM + wr * 64 + fr;
#pragma unroll
        for (int bj = 0; bj < 2; ++bj) {
            const int ct = bj * HALF + wc * 32 + 8 * fq; if (ct >= ncol) continue;
            const int c0 = u.pn * BM + ct; const int oc = CMAP == 1 ? (c0 >> 7) * 192 + (c0 & 127) : c0;
            const float sc = c0 < scale_cols ? scale : 1.f;
            bf16_t* base = O + (size_t)u.z * sOz + oc;
#pragma unroll
            for (int ai = 0; ai < 2; ++ai)
#pragma unroll
                for (int m = 0; m < 4; ++m) { const f32x4 v0 = acc[ai][bj][m][0] * sc, v1 = acc[ai][bj][m][1] * sc;
                    u32x4 w; w.x = cvt_pk_bf16(v0[0], v0[1]); w.y = cvt_pk_bf16(v0[2], v0[3]); w.z = cvt_pk_bf16(v1[0], v1[1]); w.w = cvt_pk_bf16(v1[2], v1[3]);
                    *(u32x4*)(base + (size_t)(row0 + ai * HALF + m * 16) * ldc) = w; }
        }
    }
};
struct EpiQ {
    static constexpr bool PERM = true;
    bf16_t* O; const float* rope_t; float scale;
    __device__ __forceinline__ void operator()(const f32x4 (&acc)[2][2][4][2], const Unit& u, int wr, int wc, int fr, int fq) const {
        const int row0 = u.pm * BM + wr * 64 + fr;
#pragma unroll
        for (int bj = 0; bj < 2; ++bj) {
            const int c0 = u.pn * BM + bj * HALF + wc * 32 + 8 * fq; const int h = c0 / 192, f0 = c0 - h * 192;
            if (f0 < 128) {
#pragma unroll
                for (int ai = 0; ai < 2; ++ai)
#pragma unroll
                    for (int m = 0; m < 4; ++m) { const f32x4 v0 = acc[ai][bj][m][0] * scale, v1 = acc[ai][bj][m][1] * scale;
                        u32x4 w; w.x = cvt_pk_bf16(v0[0], v0[1]); w.y = cvt_pk_bf16(v0[2], v0[3]); w.z = cvt_pk_bf16(v1[0], v1[1]); w.w = cvt_pk_bf16(v1[2], v1[3]);
                        *(u32x4*)(O + (size_t)(row0 + ai * HALF + m * 16) * 1536 + c0) = w; }
            } else {
                const int a4 = ((f0 - 128) >> 3) * 4;
#pragma unroll
                for (int ai = 0; ai < 2; ++ai)
#pragma unroll
                    for (int m = 0; m < 4; ++m) { const int r = row0 + ai * HALF + m * 16; const int pidx = r < MP ? (r & (SEQ - 1)) : SEQ + ((r - MP) & (DECT - 1));
                        const f32x4 cs0 = *(const f32x4*)(rope_t + (size_t)(pidx * 32 + a4) * 2), cs1 = *(const f32x4*)(rope_t + (size_t)(pidx * 32 + a4) * 2 + 4);
                        const f32x4 x1 = acc[ai][bj][m][0] * scale, x2 = acc[ai][bj][m][1] * scale;
                        const float y10 = x1[0] * cs0[0] - x2[0] * cs0[1], y11 = x1[1] * cs0[2] - x2[1] * cs0[3], y12 = x1[2] * cs1[0] - x2[2] * cs1[1], y13 = x1[3] * cs1[2] - x2[3] * cs1[3];
                        const float y20 = x2[0] * cs0[0] + x1[0] * cs0[1], y21 = x2[1] * cs0[2] + x1[1] * cs0[3], y22 = x2[2] * cs1[0] + x1[2] * cs1[1], y23 = x2[3] * cs1[2] + x1[3] * cs1[3];
                        bf16_t* rowp = O + (size_t)r * 1536 + h * 192 + 128 + a4;
                        u32x2 w1, w2; w1.x = cvt_pk_bf16(y10, y11); w1.y = cvt_pk_bf16(y12, y13); w2.x = cvt_pk_bf16(y20, y21); w2.y = cvt_pk_bf16(y22, y23);
                        *(u32x2*)rowp = w1; *(u32x2*)(rowp + 32) = w2; asm volatile("" ::: "memory"); }
            }
        }
    }
};

struct EpiGla {
    static constexpr bool PERM = true;
    bf16_t* O; float* T16; float qscale;
    __device__ __forceinline__ void operator()(const f32x4 (&acc)[2][2][4][2], const Unit& u, int wr, int wc, int fr, int fq) const {
        const int row0 = u.pm * BM + wr * 64 + fr;
        if (u.pn < 12) {
#pragma unroll
            for (int bj = 0; bj < 2; ++bj) {
                const int c0 = u.pn * BM + bj * HALF + wc * 32 + 8 * fq; const float sc = c0 < 512 ? qscale : 1.f;
#pragma unroll
                for (int ai = 0; ai < 2; ++ai)
#pragma unroll
                    for (int m = 0; m < 4; ++m) { const f32x4 v0 = acc[ai][bj][m][0] * sc, v1 = acc[ai][bj][m][1] * sc;
                        u32x4 w; w.x = cvt_pk_bf16(v0[0], v0[1]); w.y = cvt_pk_bf16(v0[2], v0[3]); w.z = cvt_pk_bf16(v1[0], v1[1]); w.w = cvt_pk_bf16(v1[2], v1[3]);
                        *(u32x4*)(O + (size_t)(row0 + ai * HALF + m * 16) * GIN + c0) = w; }
            }
        } else if (wc == 0 && fq < 2) {
#pragma unroll
            for (int ai = 0; ai < 2; ++ai)
#pragma unroll
                for (int m = 0; m < 4; ++m) { float* tp = T16 + (size_t)(row0 + ai * HALF + m * 16) * 16 + 8 * fq;
                    *(f32x4*)tp = acc[ai][0][m][0]; *(f32x4*)(tp + 4) = acc[ai][0][m][1]; }
        }
    }
};
}

#define XB_TMO      128
#define XB_XCNT(j)  (256  + 64 * (j))
#define XB_XSUB(j)  (1280 + 64 * (j))
#define XB_XGEN(j)  (2304 + 64 * (j))
#define XB_TOP      3328
#define XB_TOPGEN   3392
#define XCD_BAR_WORDS 3456
#define XB_SPIN_CAP (1u << 18)

__device__ __forceinline__ unsigned xb_ld(unsigned* p)              { return __hip_atomic_load(p, __ATOMIC_RELAXED, __HIP_MEMORY_SCOPE_AGENT); }
__device__ __forceinline__ unsigned xb_add(unsigned* p, unsigned v) { return __hip_atomic_fetch_add(p, v, __ATOMIC_RELAXED, __HIP_MEMORY_SCOPE_AGENT); }
__device__ __forceinline__ unsigned xb_xcc_id() { return (unsigned)__builtin_amdgcn_s_getreg((3 << 11) | 20) & 0xFu; }
#define XB_SPIN(cond, bar) do { unsigned _sp = 0; while (cond) { __builtin_amdgcn_s_sleep(1); \
    if ((++_sp & 255u) == 0u) { if (xb_ld(&(bar)[XB_TMO])) break; if (_sp > XB_SPIN_CAP) { atomicAdd(&(bar)[XB_TMO], 1u); break; } } } } while (0)

struct XcdBarrier { unsigned* bar; unsigned x; volatile LAS unsigned* st; };

__device__ __forceinline__ XcdBarrier xcd_barrier_post(unsigned* bar, volatile LAS unsigned* st, bool t0) {
    XcdBarrier b; b.bar = bar; b.x = xb_xcc_id(); b.st = st;
    if (t0) (void)xb_add(&bar[XB_XCNT(b.x)], 1u);
    return b;
}
__device__ __forceinline__ void xcd_barrier_complete(unsigned* bar, unsigned x, unsigned& nloc, unsigned& nx) {
    const unsigned G = gridDim.x * gridDim.y * gridDim.z;
    unsigned sum, cnt, mine, sp = 0u;
    for (;;) {
        sum = 0u; cnt = 0u; mine = 0u;
#pragma unroll
        for (unsigned j = 0; j < 16; ++j) { const unsigned c = xb_ld(&bar[XB_XCNT(j)]); sum += c; cnt += (c > 0u) ? 1u : 0u; mine = (j == x) ? c : mine; }
        if (sum == G) break;
        __builtin_amdgcn_s_sleep(1);
        if ((++sp & 255u) == 0u) { if (xb_ld(&bar[XB_TMO])) break; if (sp > XB_SPIN_CAP) { atomicAdd(&bar[XB_TMO], 1u); break; } }
    }
    nloc = mine > 0u ? mine : 1u; nx = cnt > 0u ? cnt : 1u;
}
__device__ __forceinline__ void xcd_barrier(const XcdBarrier& b, bool t0) {
    asm volatile("s_waitcnt vmcnt(0)" ::: "memory");
    __syncthreads();
    if (t0) {
        unsigned* bar = b.bar;
        __builtin_amdgcn_s_waitcnt(0);
        unsigned nloc = b.st[0], nx = b.st[1];
        if (nloc == 0u) { xcd_barrier_complete(bar, b.x, nloc, nx); b.st[0] = nloc; b.st[1] = nx; }
        const unsigned old = xb_add(&bar[XB_XSUB(b.x)], 1u);
        const unsigned gen = old / nloc;
        if (old + 1u == (gen + 1u) * nloc) {
            __builtin_amdgcn_fence(__ATOMIC_RELEASE, "agent");
            asm volatile("s_waitcnt vmcnt(0)" ::: "memory");
            const unsigned og = xb_add(&bar[XB_TOP], 1u);
            const unsigned tg = og / nx;
            if (og + 1u == (tg + 1u) * nx) xb_add(&bar[XB_TOPGEN], 1u);
            else XB_SPIN(xb_ld(&bar[XB_TOPGEN]) == tg, bar);
            __builtin_amdgcn_fence(__ATOMIC_ACQUIRE, "agent");
            xb_add(&bar[XB_XGEN(b.x)], 1u);
            asm volatile("s_waitcnt vmcnt(0)" ::: "memory");
        } else {
            XB_SPIN(xb_ld(&bar[XB_XGEN(b.x)]) == gen, bar);
            __builtin_amdgcn_fence(__ATOMIC_ACQUIRE, "agent");
            asm volatile("s_waitcnt vmcnt(0)" ::: "memory");
        }
    }
    __syncthreads();
}

struct Args { const void* in[22]; float* out; unsigned char* ws; int ph_lo, ph_hi; };

struct Frame {
    LAS unsigned char* lds;
    int tid, lane, wave, vcu, G;
    const float* const* dummy;
};

__device__ __forceinline__ void transpose_item(const float* W, int N, int k0, int n0, bf16_t* WT, int KT, int drow0, int interleave, LAS float* scr, int lane, float sc = 1.0f) {
    f32x4 v[8];
    const float* src = W + (size_t)(k0 + (lane >> 3)) * N + n0 + 4 * (lane & 7);
#pragma unroll
    for (int i = 0; i < 8; ++i) v[i] = *(const f32x4*)(src + (size_t)(8 * i) * N);
#pragma unroll
    for (int i = 0; i < 8; ++i) { LAS float* d = scr + (8 * i + (lane >> 3)) * 33 + 4 * (lane & 7); d[0] = v[i][0]; d[1] = v[i][1]; d[2] = v[i][2]; d[3] = v[i][3]; }
    LDS_WAIT(); asm volatile("" ::: "memory");
    const int c = lane & 7;
#pragma unroll
    for (int j = 0; j < 4; ++j) { const int n = (lane >> 3) + 8 * j; const LAS float* s = scr + (8 * c) * 33 + n;
        u32x4 o; o.x = cvt_pk_bf16(s[0 * 33] * sc, s[1 * 33] * sc); o.y = cvt_pk_bf16(s[2 * 33] * sc, s[3 * 33] * sc); o.z = cvt_pk_bf16(s[4 * 33] * sc, s[5 * 33] * sc); o.w = cvt_pk_bf16(s[6 * 33] * sc, s[7 * 33] * sc);
        const int drow = interleave ? (drow0 + 8 * (n >> 2) + (n & 3)) : (drow0 + n);
        *(u32x4*)(WT + (size_t)drow * KT + k0 + 8 * c) = o; }
    LDS_WAIT(); asm volatile("" ::: "memory");
}

struct ConvPtrs { const float *w_in, *w_out, *w_down, *w_uq, *w_uk, *w_uv, *w_o, *g_in, *g_o; bf16_t *WIN, *WOUT, *WDOWN, *WUQ, *WUKT, *WUVT, *WOT, *WGIN, *WGO; };
constexpr int I_WIN = (DM / 64) * (2 * DFF / 32);
constexpr int I_WOUT = (DFF / 64) * (DM / 32);
constexpr int I_DOWN = (DM / 64) * (DDOWN / 32);
constexpr int I_UQ = (QL / 64) * (NH * QKD / 32);
constexpr int I_UK = (KVL / 64) * (NH * NOPE / 32);
constexpr int I_UV = I_UK;
constexpr int I_O = (DM / 64) * (DM / 32);
constexpr int I_GIN = (DM / 64) * (GIN / 32);
constexpr int I_GO = I_O;
template <int SEG> __device__ __forceinline__ void conv_segment(const ConvPtrs& P, int widx, int nw, LAS float* scr, int lane) {
    constexpr int mi = SEG;
    constexpr int NIT = I_WIN + I_WOUT + (SEG == 1 ? I_DOWN + I_UQ + I_UK + I_UV + I_O : SEG == 2 ? I_GIN + I_GO : 0);
    for (int it = widx; it < NIT; it += nw) {
        int r = it;
        if (r < I_WIN) { const int nblk = 2 * DFF / 32, kb = r / nblk, nb = r % nblk, n0 = nb * 32;
            const int drow0 = n0 < DFF ? 256 * (n0 / 128) + (n0 % 128) : 256 * ((n0 - DFF) / 128) + 128 + ((n0 - DFF) % 128);
            transpose_item(P.w_in + (size_t)mi * DM * 2 * DFF, 2 * DFF, kb * 64, n0, P.WIN + (size_t)mi * 2 * DFF * DM, DM, drow0, 0, scr, lane, n0 < DFF ? LOG2E : 1.0f / LOG2E); continue; } r -= I_WIN;
        if (r < I_WOUT) { const int nblk = DM / 32, kb = r / nblk, nb = r % nblk;
            transpose_item(P.w_out + (size_t)mi * DFF * DM, DM, kb * 64, nb * 32, P.WOUT + (size_t)mi * DM * DFF, DFF, nb * 32, 0, scr, lane); continue; } r -= I_WOUT;
        if constexpr (SEG == 1) {
            if (r < I_DOWN) { const int nblk = DDOWN / 32, kb = r / nblk, nb = r % nblk;
                transpose_item(P.w_down, DDOWN, kb * 64, nb * 32, P.WDOWN, DM, nb * 32, 0, scr, lane); continue; } r -= I_DOWN;
            if (r < I_UQ) { const int nblk = NH * QKD / 32, kb = r / nblk, nb = r % nblk, n0 = nb * 32, h = n0 / QKD, f = n0 % QKD;
                if (f < NOPE) transpose_item(P.w_uq, NH * QKD, kb * 64, n0, P.WUQ, QL, n0, 0, scr, lane);
                else transpose_item(P.w_uq, NH * QKD, kb * 64, n0, P.WUQ, QL, h * QKD + NOPE + (f == NOPE ? 0 : 4), 1, scr, lane);
                continue; } r -= I_UQ;
            if (r < I_UK) { const int nblk = NH * NOPE / 32, kb = r / nblk, nb = r % nblk;
                transpose_item(P.w_uk, NH * NOPE, kb * 64, nb * 32, P.WUKT, KVL, nb * 32, 0, scr, lane); continue; } r -= I_UK;
            if (r < I_UV) { const int nblk = NH * VD / 32, kb = r / nblk, nb = r % nblk;
                transpose_item(P.w_uv, NH * VD, kb * 64, nb * 32, P.WUVT, KVL, nb * 32, 0, scr, lane); continue; } r -= I_UV;
            { const int nblk = DM / 32, kb = r / nblk, nb = r % nblk;
                transpose_item(P.w_o, DM, kb * 64, nb * 32, P.WOT, DM, nb * 32, 0, scr, lane); }
        }
        if constexpr (SEG == 2) {
            if (r < I_GIN) { const int nblk = GIN / 32, kb = r / nblk, nb = r % nblk;
                transpose_item(P.g_in, GIN, kb * 64, nb * 32, P.WGIN, DM, nb * 32, 0, scr, lane); continue; } r -= I_GIN;
            { const int nblk = DM / 32, kb = r / nblk, nb = r % nblk;
                transpose_item(P.g_o, DM, kb * 64, nb * 32, P.WGO, DM, nb * 32, 0, scr, lane); }
        }
    }
}

struct Row16 { f32x4 v[4]; };
__device__ __forceinline__ Row16 ld_row(const float* p, int lane) { Row16 r; const f32x4* q = (const f32x4*)p + lane;
#pragma unroll
    for (int j = 0; j < 4; ++j) r.v[j] = q[64 * j]; return r; }
__device__ __forceinline__ Row16 ld_row_bf16(const bf16_t* p, int lane) { Row16 r; const u32x2* q = (const u32x2*)p + lane;
#pragma unroll
    for (int j = 0; j < 4; ++j) { const u32x2 w = q[64 * j]; r.v[j][0] = __uint_as_float(w.x << 16); r.v[j][1] = __uint_as_float(w.x & 0xffff0000u); r.v[j][2] = __uint_as_float(w.y << 16); r.v[j][3] = __uint_as_float(w.y & 0xffff0000u); } return r; }
__device__ __forceinline__ float row_ss(const Row16& r) { float s = 0.f;
#pragma unroll
    for (int j = 0; j < 4; ++j) s += (r.v[j][0] * r.v[j][0] + r.v[j][1] * r.v[j][1]) + (r.v[j][2] * r.v[j][2] + r.v[j][3] * r.v[j][3]); return wave_sum(s); }
__device__ __forceinline__ void st_row_bf16(bf16_t* p, const Row16& r, int lane) { u32x2* q = (u32x2*)p + lane;
#pragma unroll
    for (int j = 0; j < 4; ++j) { u32x2 w; w.x = cvt_pk_bf16(r.v[j][0], r.v[j][1]); w.y = cvt_pk_bf16(r.v[j][2], r.v[j][3]); q[64 * j] = w; } }
__device__ __forceinline__ void st_row_f32(float* p, const Row16& r, int lane) { f32x4* q = (f32x4*)p + lane;
#pragma unroll
    for (int j = 0; j < 4; ++j) q[64 * j] = r.v[j]; }

template <bool HAS_T, bool HAS_PRE, bool SRC_X, bool FINAL>
__device__ __forceinline__ void thin_phase(int gw, int NGW, const float* xp, const float* xs, const bf16_t* T, const float* TP, int nsplit, bf16_t* H, float* Yout, bf16_t* XN, const float* gpost, const float* gpre, float scale) {
    const int lane = lane_now();
    Row16 gp, gq;
    if (HAS_T) gp = ld_row(gpost, lane);
    if (HAS_PRE) gq = ld_row(gpre, lane);
    const bool bal = HAS_T && NGW == 2 * MS && MP % NGW == 0;
    const int N1 = bal ? MP / NGW - (nsplit > 4 ? 2 : 1) : 0;
    for (int i = 0;; ++i) {
        int r;
        if (!bal) { r = gw + i * NGW; if (r >= M) break; }
        else if (i < N1) r = gw + i * NGW;
        else if (gw < MS) { if (i > N1) break; r = MP + gw; }
        else { r = N1 * NGW + (gw - MS) + (i - N1) * (NGW - MS); if (r >= MP) break; }
        Row16 h;
        if constexpr (SRC_X) h = ld_row(r < MP ? xp + (size_t)r * DM : xs + (size_t)(r - MP) * DM, lane); else h = ld_row_bf16(H + (size_t)r * DM, lane);
        if (HAS_T) {
            Row16 t;
            if (r < MP) t = ld_row_bf16(T + (size_t)r * DM, lane);
            else { const bf16_t* TPb = (const bf16_t*)TP; t = ld_row_bf16(TPb + (size_t)(r - MP) * DM, lane);
                for (int z = 1; z < nsplit; ++z) { const Row16 u = ld_row_bf16(TPb + ((size_t)z * MS + (r - MP)) * DM, lane);
#pragma unroll
                    for (int j = 0; j < 4; ++j) t.v[j] = t.v[j] + u.v[j]; } }
            const float rs = scale * __builtin_amdgcn_rsqf(row_ss(t) * (1.0f / DM) + EPS);
#pragma unroll
            for (int j = 0; j < 4; ++j) h.v[j] = h.v[j] + (t.v[j] * rs) * gp.v[j];
            if constexpr (FINAL) st_row_f32(Yout + (size_t)r * DM, h, lane); else st_row_bf16(H + (size_t)r * DM, h, lane);
        }
        if (HAS_PRE) {
            const float rs = __builtin_amdgcn_rsqf(row_ss(h) * (1.0f / DM) + EPS);
#pragma unroll
            for (int j = 0; j < 4; ++j) h.v[j] = (h.v[j] * rs) * gq.v[j];
            st_row_bf16(XN + (size_t)r * DM, h, lane);
        }
    }
}

__device__ __forceinline__ int rope_pos_index(int r) { return r < MP ? (r & (SEQ - 1)) : SEQ + ((r - MP) & (DECT - 1)); }


typedef short s16x4 __attribute__((ext_vector_type(4)));
__device__ __forceinline__ int swap23(int x) { return (x & ~12) | ((x & 4) << 1) | ((x & 8) >> 1); }
__device__ __forceinline__ float half_max(float v) { auto rr = __builtin_amdgcn_permlane32_swap(__float_as_uint(v), __float_as_uint(v), false, false); return fmaxf(__uint_as_float(rr[0]), __uint_as_float(rr[1])); }
__device__ __forceinline__ float half_sum(float v) { auto rr = __builtin_amdgcn_permlane32_swap(__float_as_uint(v), __float_as_uint(v), false, false); return __uint_as_float(rr[0]) + __uint_as_float(rr[1]); }
__device__ __forceinline__ bf16x8 pack8(const f32x16& p, int o) {
    u32x4 w; w.x = cvt_pk_bf16(p[o + 0], p[o + 1]); w.y = cvt_pk_bf16(p[o + 2], p[o + 3]); w.z = cvt_pk_bf16(p[o + 4], p[o + 5]); w.w = cvt_pk_bf16(p[o + 6], p[o + 7]);
    return __builtin_bit_cast(bf16x8, w);
}
template <int NO>
__device__ __forceinline__ void softmax_step(f32x16& p0, f32x16& p1, float& m, float& lh, f32x16 (&o)[NO], bf16x8 (&pf)[4]) {
    float pm = fmaxf(p0[0], p1[0]);
#pragma unroll
    for (int r = 1; r < 16; ++r) pm = fmaxf(pm, fmaxf(p0[r], p1[r]));
    pm = half_max(pm);
    const float mn = fmaxf(m, pm), alpha = __builtin_amdgcn_exp2f(m - mn); m = mn;
    float rs = 0.f;
#pragma unroll
    for (int r = 0; r < 16; ++r) { p0[r] = __builtin_amdgcn_exp2f(p0[r] - mn); p1[r] = __builtin_amdgcn_exp2f(p1[r] - mn); rs += p0[r] + p1[r]; }
    lh = lh * alpha + rs;
    if (!__all(alpha == 1.0f)) {
#pragma unroll
        for (int d = 0; d < NO; ++d) o[d] = o[d] * alpha;
    }
    pf[0] = pack8(p0, 0); pf[1] = pack8(p0, 8); pf[2] = pack8(p1, 0); pf[3] = pack8(p1, 8);
}

template <int NO>
__device__ __forceinline__ void softmax_step1(f32x16& p0, float& m, float& lh, f32x16 (&o)[NO], bf16x8 (&pf)[2]) {
    float pm = p0[0];
#pragma unroll
    for (int r = 1; r < 16; ++r) pm = fmaxf(pm, p0[r]);
    pm = half_max(pm);
    const float mn = fmaxf(m, pm), alpha = __builtin_amdgcn_exp2f(m - mn); m = mn;
    float rs = 0.f;
#pragma unroll
    for (int r = 0; r < 16; ++r) { p0[r] = __builtin_amdgcn_exp2f(p0[r] - mn); rs += p0[r]; }
    lh = lh * alpha + rs;
    if (!__all(alpha == 1.0f)) {
#pragma unroll
        for (int d = 0; d < NO; ++d) o[d] = o[d] * alpha;
    }
    pf[0] = pack8(p0, 0); pf[1] = pack8(p0, 8);
}

namespace pat {
constexpr int KROW = 400, VROW = 144, KTILE = 64 * KROW, VTILE = 128 * VROW;
__device__ __forceinline__ void unit(LAS unsigned char* lds, const int wave, const bf16_t* Q, const bf16_t* KB, const bf16_t* KPE, const bf16_t* VT, bf16_t* O, int b, int h, int qb) {
    const int lane = lane_now(), tid = wave * 64 + lane, ql = lane & 31, hh = lane >> 5;
    const int q0 = b * SEQ + qb * 256 + 32 * wave;
    bf16x8 qf[12];
    { const bf16_t* qp = Q + (size_t)(q0 + ql) * (NH * QKD) + h * QKD + hh * 8;
#pragma unroll
      for (int ks = 0; ks < 12; ++ks) qf[ks] = *(const bf16x8*)(qp + ks * 16); }
    f32x16 o[4];
#pragma unroll
    for (int d = 0; d < 4; ++d)
#pragma unroll
        for (int r = 0; r < 16; ++r) o[d][r] = 0.f;
    float m = -1e30f, lh = 0.f;
    const int ntiles = 4 * (qb + 1);
    int krow[3], kcc[3]; unsigned koff[3];
#pragma unroll
    for (int i = 0; i < 3; ++i) { const int c = tid + 512 * i; krow[i] = c / 24; kcc[i] = c % 24; koff[i] = (unsigned)(krow[i] * KROW + kcc[i] * 16); }
    const bf16_t* kg = KB + (size_t)(b * SEQ) * (NH * NOPE) + h * NOPE;
    const bf16_t* kpg = KPE + (size_t)(b * SEQ) * ROPE;
    const bf16_t* vg = VT + (size_t)(h * VD) * MP + b * SEQ;
    const int vrow0 = tid >> 3, vcc = tid & 7;
    u32x4 kst[3], vst[2];
#define PAT_LOAD(j) do { _Pragma("unroll") for (int i = 0; i < 3; ++i) kst[i] = kcc[i] < 16 ? *(const u32x4*)(kg + (size_t)((j) * 64 + krow[i]) * (NH * NOPE) + kcc[i] * 8) : *(const u32x4*)(kpg + (size_t)((j) * 64 + krow[i]) * ROPE + (kcc[i] - 16) * 8); \
        _Pragma("unroll") for (int i = 0; i < 2; ++i) vst[i] = *(const u32x4*)(vg + (size_t)(vrow0 + 64 * i) * MP + (j) * 64 + vcc * 8); } while (0)
#define PAT_STORE(buf) do { _Pragma("unroll") for (int i = 0; i < 3; ++i) *(LAS u32x4*)(lds + (buf) * KTILE + koff[i]) = kst[i]; \
        _Pragma("unroll") for (int i = 0; i < 2; ++i) *(LAS u32x4*)(lds + 2 * KTILE + (buf) * VTILE + (vrow0 + 64 * i) * VROW + vcc * 16) = vst[i]; } while (0)
    PAT_LOAD(0); PAT_STORE(0);
    __syncthreads();
    const int kr = swap23(ql);
    for (int j = 0; j < ntiles; ++j) {
        const int buf = j & 1;
        if (j + 1 < ntiles) PAT_LOAD(j + 1);
        const int jd = j - 4 * qb;
        if (jd <= (wave >> 1)) {
            f32x16 p0, p1;
#pragma unroll
            for (int r = 0; r < 16; ++r) { p0[r] = 0.f; p1[r] = 0.f; }
            const LAS unsigned char* kb0 = lds + buf * KTILE + kr * KROW + hh * 16;
            __builtin_amdgcn_s_setprio(1);
#pragma unroll
            for (int ks = 0; ks < 12; ++ks) {
                const bf16x8 a0 = *(const LAS bf16x8*)(kb0 + ks * 32), a1 = *(const LAS bf16x8*)(kb0 + 32 * KROW + ks * 32);
                p0 = __builtin_amdgcn_mfma_f32_32x32x16_bf16(a0, qf[ks], p0, 0, 0, 0);
                p1 = __builtin_amdgcn_mfma_f32_32x32x16_bf16(a1, qf[ks], p1, 0, 0, 0);
            }
            __builtin_amdgcn_s_setprio(0);
            if (jd >= 0) {
                const int qrel = 32 * wave + ql - 64 * jd - 8 * hh;
#pragma unroll
                for (int r = 0; r < 16; ++r) { const int kk = 16 * (r >> 3) + (r & 7);
                    if (kk > qrel) p0[r] = -__builtin_inff();
                    if (kk + 32 > qrel) p1[r] = -__builtin_inff(); }
            }
            bf16x8 pf[4];
            softmax_step<4>(p0, p1, m, lh, o, pf);
            const LAS unsigned char* vb0 = lds + 2 * KTILE + buf * VTILE + ql * VROW + hh * 16;
#pragma unroll
            for (int d = 0; d < 4; ++d)
#pragma unroll
                for (int ss = 0; ss < 4; ++ss) {
                    const bf16x8 a = *(const LAS bf16x8*)(vb0 + d * 32 * VROW + ss * 32);
                    o[d] = __builtin_amdgcn_mfma_f32_32x32x16_bf16(a, pf[ss], o[d], 0, 0, 0);
                }
        }
        if (j + 1 < ntiles) PAT_STORE(buf ^ 1);
        __syncthreads();
    }
#undef PAT_LOAD
#undef PAT_STORE
    const float inv = 1.0f / half_sum(lh);
    bf16_t* op = O + (size_t)(q0 + ql) * DM + h * VD + 4 * hh;
#pragma unroll
    for (int d = 0; d < 4; ++d)
#pragma unroll
        for (int g = 0; g < 4; ++g) { u32x2 w; w.x = cvt_pk_bf16(o[d][4 * g] * inv, o[d][4 * g + 1] * inv); w.y = cvt_pk_bf16(o[d][4 * g + 2] * inv, o[d][4 * g + 3] * inv);
            *(u32x2*)(op + 32 * d + 8 * g) = w; }
}
}

namespace sat {
constexpr int KROW = 656, KTILE = 64 * KROW;
__device__ __forceinline__ bf16x8 tr_frag(const LAS unsigned char* p) {
    typedef short v4i16_t __attribute__((ext_vector_type(4)));
    const s16x4 a = __builtin_bit_cast(s16x4, __builtin_amdgcn_ds_read_tr16_b64_v4i16((LAS v4i16_t*)p));
    const s16x4 b = __builtin_bit_cast(s16x4, __builtin_amdgcn_ds_read_tr16_b64_v4i16((LAS v4i16_t*)(p + 4 * KROW)));
    bf16x8 r; r[0] = a[0]; r[1] = a[1]; r[2] = a[2]; r[3] = a[3]; r[4] = b[0]; r[5] = b[1]; r[6] = b[2]; r[7] = b[3]; return r;
}
__device__ __forceinline__ void unit(LAS unsigned char* lds, const int wave, const bf16_t* QLAT, const float* cache_ckv, const float* cache_kpe, const int* page_table, const bf16_t* CKVS  , const bf16_t* KPES,
                                     float* OPART, float* OML, int b, int split) {
    const int lane = lane_now(), tid = wave * 64 + lane, ql = lane & 31, hh = lane >> 5;
    const int qblk = wave & 1, kb = (wave >> 1) & 1, dvh = wave >> 2;
#pragma unroll
    for (int i = 0; i < 5; ++i) { const int c = tid + 512 * i, row = c / 40, cc = c % 40;
        *(LAS u32x4*)(lds + 2 * KTILE + row * KROW + cc * 16) = *(const u32x4*)(QLAT + (size_t)(b * 64 + row) * 320 + cc * 8); }
    f32x16 o[4];
#pragma unroll
    for (int d = 0; d < 4; ++d)
#pragma unroll
        for (int r = 0; r < 16; ++r) o[d][r] = 0.f;
    float m = -1e30f, lh = 0.f;
    const int npg = NPAGES / 2, ntiles = 2 * npg + (split == 1 ? 1 : 0);
    const int* pt = page_table + b * NPAGES + split * npg;
    const int crow0 = tid >> 6, ccol = tid & 63;
    const int prow0 = tid >> 4, pcol = tid & 15;
    f32x4 cst[8], pst[2];
#define SAT_LOAD(j) do { const int pg = pt[(j) >> 1]; const size_t r0 = (size_t)pg * PAGE + ((j) & 1) * 64; \
        _Pragma("unroll") for (int i = 0; i < 8; ++i) cst[i] = __builtin_nontemporal_load((const f32x4*)(cache_ckv + (r0 + crow0 + 8 * i) * KVL) + ccol); \
        _Pragma("unroll") for (int i = 0; i < 2; ++i) pst[i] = __builtin_nontemporal_load((const f32x4*)(cache_kpe + (r0 + prow0 + 32 * i) * ROPE) + pcol); } while (0)
#define SAT_STORE(buf) do { _Pragma("unroll") for (int i = 0; i < 8; ++i) { u32x2 w; w.x = cvt_pk_bf16(cst[i][0], cst[i][1]); w.y = cvt_pk_bf16(cst[i][2], cst[i][3]); \
            *(LAS u32x2*)(lds + (buf) * KTILE + (crow0 + 8 * i) * KROW + ccol * 8) = w; } \
        _Pragma("unroll") for (int i = 0; i < 2; ++i) { u32x2 w; w.x = cvt_pk_bf16(pst[i][0], pst[i][1]); w.y = cvt_pk_bf16(pst[i][2], pst[i][3]); \
            *(LAS u32x2*)(lds + (buf) * KTILE + (prow0 + 32 * i) * KROW + 512 + pcol * 8) = w; } } while (0)
#define SAT_NEW(buf) do { _Pragma("unroll") for (int i = 0; i < 5; ++i) { const int c = tid + 512 * i, row = c / 40, cc = c % 40; u32x4 v = (u32x4){0u, 0u, 0u, 0u}; \
            if (row < DECT) v = cc < 32 ? *(const u32x4*)(CKVS + (size_t)(b * DECT + row) * KVL + cc * 8) : *(const u32x4*)(KPES + (size_t)(b * DECT + row) * ROPE + (cc - 32) * 8); \
            *(LAS u32x4*)(lds + (buf) * KTILE + row * KROW + cc * 16) = v; } } while (0)
    SAT_LOAD(0); SAT_STORE(0);
    __syncthreads();
    const int kr = 32 * kb + swap23(ql);
    const int g16 = lane >> 4, i16 = lane & 15;
    const int troff = (32 * kb + 8 * (g16 >> 1) + (i16 >> 2)) * KROW + (128 * dvh + 16 * (g16 & 1) + 4 * (i16 & 3)) * 2;
    for (int j = 0; j < ntiles; ++j) {
        const int buf = j & 1;
        const bool nxt_page = (j + 1 < 2 * npg), nxt_new = (j + 1 == 2 * npg) && (split == 1);
        if (nxt_page) SAT_LOAD(j + 1);
        f32x16 p0;
#pragma unroll
        for (int r = 0; r < 16; ++r) p0[r] = 0.f;
        const LAS unsigned char* kb0 = lds + buf * KTILE + kr * KROW + hh * 16;
        const LAS unsigned char* qb0 = lds + 2 * KTILE + (32 * qblk + ql) * KROW + hh * 16;
        __builtin_amdgcn_s_setprio(1);
#pragma unroll
        for (int ks = 0; ks < 20; ++ks) p0 = __builtin_amdgcn_mfma_f32_32x32x16_bf16(*(const LAS bf16x8*)(kb0 + ks * 32), *(const LAS bf16x8*)(qb0 + ks * 32), p0, 0, 0, 0);
        __builtin_amdgcn_s_setprio(0);
        if (j == 2 * npg) {
            const int tq = (32 * qblk + ql) >> 3;
#pragma unroll
            for (int r = 0; r < 16; ++r) { const int kk = 32 * kb + 16 * (r >> 3) + 8 * hh + (r & 7); if (kk > tq) p0[r] = -__builtin_inff(); }
        }
        bf16x8 pf[2];
        softmax_step1<4>(p0, m, lh, o, pf);
        const LAS unsigned char* vb0 = lds + buf * KTILE + troff;
#pragma unroll
        for (int d = 0; d < 4; ++d)
#pragma unroll
            for (int ss = 0; ss < 2; ++ss) {
                const bf16x8 a = tr_frag(vb0 + d * 64 + ss * 16 * KROW);
                o[d] = __builtin_amdgcn_mfma_f32_32x32x16_bf16(a, pf[ss], o[d], 0, 0, 0);
            }
        if (nxt_page) SAT_STORE(buf ^ 1);
        if (nxt_new) SAT_NEW(buf ^ 1);
        __syncthreads();
    }
#undef SAT_LOAD
#undef SAT_STORE
#undef SAT_NEW
    float lt = half_sum(lh);
    const int pair = dvh * 2 + qblk;
    LAS float* xb = (LAS float*)(lds + pair * 17408);
    if (kb == 1) {
#pragma unroll
        for (int d = 0; d < 4; ++d)
#pragma unroll
            for (int r = 0; r < 16; ++r) xb[(d * 16 + r) * 64 + lane] = o[d][r];
        xb[64 * 64 + lane] = m; xb[65 * 64 + lane] = lt;
    }
    __syncthreads();
    if (kb == 0) {
        const float m1 = xb[64 * 64 + lane], l1 = xb[65 * 64 + lane];
        const float mm = fmaxf(m, m1), w0 = __builtin_amdgcn_exp2f(m - mm), w1 = __builtin_amdgcn_exp2f(m1 - mm);
#pragma unroll
        for (int d = 0; d < 4; ++d)
#pragma unroll
            for (int r = 0; r < 16; ++r) o[d][r] = o[d][r] * w0 + xb[(d * 16 + r) * 64 + lane] * w1;
        lt = lt * w0 + l1 * w1;
        const int q = 32 * qblk + ql;
        float* op = OPART + ((size_t)(b * 2 + split) * 64 + q) * KVL + 128 * dvh + 4 * hh;
#pragma unroll
        for (int d = 0; d < 4; ++d)
#pragma unroll
            for (int g = 0; g < 4; ++g) *(f32x4*)(op + 32 * d + 8 * g) = (f32x4){o[d][4 * g], o[d][4 * g + 1], o[d][4 * g + 2], o[d][4 * g + 3]};
        if (dvh == 0 && hh == 0) *(f32x2*)(OML + ((size_t)(b * 2 + split) * 64 + q) * 2) = (f32x2){mm, lt};
    }
    __syncthreads();
}
}


#define LDS_RD128(dst, addr, off) asm volatile("ds_read_b128 %0, %1 offset:%2" : "=v"(dst) : "v"(addr), "n"(off))
#define LDS_WAIT4(f, N) asm volatile("s_waitcnt lgkmcnt(" #N ")" : "+v"(f[0]), "+v"(f[1]), "+v"(f[2]), "+v"(f[3]))
namespace gla {
constexpr int QROW = 272, KTROW = 144, VROW = 528;
constexpr int P_T16 = 0, P_TOT = 4096, P_QT = 8192, P_KT = P_QT + 64 * QROW;
constexpr int C_DK = 0, C_QT = 1024, C_KH = C_QT + 64 * QROW, C_V = C_KH + 128 * KTROW, C_AT = C_V + 64 * VROW, C_O = C_AT + 6144;
static_assert(C_O + 64 * 8 * 64 <= RING_BYTES, "gla chain LDS");
static_assert(C_AT + 6144 <= RING_BYTES, "gla LDS");
__device__ __forceinline__ bf16x8 tr_frag(const LAS unsigned char* p) {
    typedef short v4i16_t __attribute__((ext_vector_type(4)));
    const s16x4 a = __builtin_bit_cast(s16x4, __builtin_amdgcn_ds_read_tr16_b64_v4i16((LAS v4i16_t*)p));
    const s16x4 b = __builtin_bit_cast(s16x4, __builtin_amdgcn_ds_read_tr16_b64_v4i16((LAS v4i16_t*)(p + 4 * VROW)));
    bf16x8 r; r[0] = a[0]; r[1] = a[1]; r[2] = a[2]; r[3] = a[3]; r[4] = b[0]; r[5] = b[1]; r[6] = b[2]; r[7] = b[3]; return r;
}
template <int SEG>
__device__ __forceinline__ void prep(LAS unsigned char* lds, const int wave, const bf16_t* QKVG, const float* T16, const float* w_gk2, const float* b_gk, int chunk, int h,
                                     bf16_t* QTg, bf16_t* KHg, bf16_t* ATg, float* DKg) {
    const int lane = lane_now(), tid = wave * 64 + lane, ql = lane & 31, hh = lane >> 5;
    const int kk = tid & 127, tq = tid >> 7, cu = chunk * 4 + h, row0 = chunk * 64;
    float w2[16];
#pragma unroll
    for (int j = 0; j < 16; ++j) w2[j] = w_gk2[j * (GH * GDK) + h * GDK + kk];
    const float bias = b_gk[h * GDK + kk];
    unsigned short qraw[16], kraw[16];
    { const bf16_t* qg = QKVG + (size_t)(row0 + tq * 16) * GIN + h * GDK + kk;
#pragma unroll
      for (int i = 0; i < 16; ++i) { qraw[i] = qg[(size_t)i * GIN]; kraw[i] = qg[(size_t)i * GIN + GH * GDK]; } }
    __syncthreads();
    if (tid < 256) *(LAS f32x4*)(lds + P_T16 + tid * 16) = *(const f32x4*)(T16 + (size_t)row0 * 16 + tid * 4);
    __syncthreads();
    float Gl[16];
    { float run = 0.f;
#pragma unroll
      for (int i = 0; i < 16; ++i) { const int t = tq * 16 + i; const LAS f32x4* tp = (const LAS f32x4*)(lds + P_T16 + t * 64);
          const f32x4 a0 = tp[0], a1 = tp[1], a2 = tp[2], a3 = tp[3];
          float z = bias;
          z += a0[0] * w2[0] + a0[1] * w2[1] + a0[2] * w2[2] + a0[3] * w2[3];
          z += a1[0] * w2[4] + a1[1] * w2[5] + a1[2] * w2[6] + a1[3] * w2[7];
          z += a2[0] * w2[8] + a2[1] * w2[9] + a2[2] * w2[10] + a2[3] * w2[11];
          z += a3[0] * w2[12] + a3[1] * w2[13] + a3[2] * w2[14] + a3[3] * w2[15];
          const float ls = fminf(z, 0.f) - 0.6931471805599453f * __builtin_amdgcn_logf(1.0f + __builtin_amdgcn_exp2f(-fabsf(z) * LOG2E));
          if (SEG == 8 && i == 8) run = 0.f;
          run += ls * (1.0f / 16.0f); Gl[i] = run; }
      if (SEG == 64) *(LAS float*)(lds + P_TOT + (tq * 128 + kk) * 4) = run; }
    float prefix = 0.f, total = 0.f;
    if (SEG == 64) {
        __syncthreads();
#pragma unroll
        for (int q = 0; q < 4; ++q) { const float v = *(const LAS float*)(lds + P_TOT + (q * 128 + kk) * 4); total += v; if (q < tq) prefix += v; }
    }
    { unsigned kh[8];
#pragma unroll
      for (int i = 0; i < 16; i += 2) {
          const float G0 = (Gl[i] + prefix) * LOG2E, G1 = (Gl[i + 1] + prefix) * LOG2E;
          const float TL = (SEG == 64 ? total : Gl[i | 7]) * LOG2E;
          const float q0 = bf2f(qraw[i]), q1 = bf2f(qraw[i + 1]), k0 = bf2f(kraw[i]), k1 = bf2f(kraw[i + 1]);
          const unsigned qq = cvt_pk_bf16(q0 * __builtin_amdgcn_exp2f(G0), q1 * __builtin_amdgcn_exp2f(G1));
          const unsigned kt = cvt_pk_bf16(k0 * __builtin_amdgcn_exp2f(-G0), k1 * __builtin_amdgcn_exp2f(-G1));
          kh[i >> 1] = cvt_pk_bf16(k0 * __builtin_amdgcn_exp2f(TL - G0), k1 * __builtin_amdgcn_exp2f(TL - G1));
          const int t = tq * 16 + i;
          *(LAS unsigned short*)(lds + P_QT + t * QROW + kk * 2) = (unsigned short)(qq & 0xffffu); *(LAS unsigned short*)(lds + P_QT + (t + 1) * QROW + kk * 2) = (unsigned short)(qq >> 16);
          *(LAS unsigned short*)(lds + P_KT + t * QROW + kk * 2) = (unsigned short)(kt & 0xffffu); *(LAS unsigned short*)(lds + P_KT + (t + 1) * QROW + kk * 2) = (unsigned short)(kt >> 16);
      }
      bf16_t* khp = KHg + ((size_t)cu * 128 + kk) * 64 + tq * 16;
      *(u32x4*)khp = (u32x4){kh[0], kh[1], kh[2], kh[3]}; *(u32x4*)(khp + 8) = (u32x4){kh[4], kh[5], kh[6], kh[7]};
      if (SEG == 64) { if (tq == 0) DKg[(size_t)cu * 1024 + kk] = __builtin_amdgcn_exp2f(total * LOG2E); }
      else { DKg[(size_t)cu * 1024 + (tq * 2) * 128 + kk] = __builtin_amdgcn_exp2f(Gl[7] * LOG2E); DKg[(size_t)cu * 1024 + (tq * 2 + 1) * 128 + kk] = __builtin_amdgcn_exp2f(Gl[15] * LOG2E); } }
    __syncthreads();
    if (wave < 3) {
        const int sb = wave >> 1, tb = (wave + 1) >> 1, kr = swap23(ql);
        f32x16 x;
#pragma unroll
        for (int r = 0; r < 16; ++r) x[r] = 0.f;
        const LAS unsigned char* ap = lds + P_KT + (32 * sb + kr) * QROW + hh * 16;
        const LAS unsigned char* bp = lds + P_QT + (32 * tb + ql) * QROW + hh * 16;
#pragma unroll
        for (int ks = 0; ks < 8; ++ks) x = __builtin_amdgcn_mfma_f32_32x32x16_bf16(*(const LAS bf16x8*)(ap + ks * 32), *(const LAS bf16x8*)(bp + ks * 32), x, 0, 0, 0);
        const int tt = 32 * tb + ql;
#pragma unroll
        for (int r = 0; r < 16; ++r) { const int sr = 32 * sb + 16 * (r >> 3) + 8 * hh + (r & 7); if (sr > tt || (SEG == 8 && (sr >> 3) != (tt >> 3))) x[r] = 0.f; }
        bf16_t* atp = ATg + (size_t)cu * 3072 + (wave * 2) * 512 + lane * 8;
        *(bf16x8*)atp = pack8(x, 0); *(bf16x8*)(atp + 512) = pack8(x, 8);
    }
#pragma unroll
    for (int i = 0; i < 2; ++i) { const int c = tid + 512 * i, row = c >> 4, cc = c & 15;
        *(u32x4*)(QTg + (size_t)(row0 + row) * (GH * GDK) + h * GDK + cc * 8) = *(const LAS u32x4*)(lds + P_QT + row * QROW + cc * 16); }
}

template <int NWV>
__device__ __forceinline__ void chain(LAS unsigned char* lds, const int wave, const bf16_t* QTg, const bf16_t* KHg, const bf16_t* ATg, const float* DKg, const bf16_t* QKVG, int h, int chunk0, int nchunk,
                                      int srow, int nrow, int sseg, int dseg, int dvbase, const float* state_in, float* state_out, bf16_t* GO) {
    constexpr int VPR = NWV * 4  , VST = NWV / 2  , VRS = 512 / VPR  ;
    const bool active = wave < NWV;
    const int lane = lane_now(), tid = wave * 64 + lane, ql = lane & 31, hh = lane >> 5;
    f32x16 S[4];
#pragma unroll
    for (int kb = 0; kb < 4; ++kb)
#pragma unroll
        for (int r = 0; r < 16; ++r) S[kb][r] = (state_in && active) ? state_in[(size_t)(32 * kb + 16 * (r >> 3) + 8 * hh + (r & 7)) * GDV + dvbase + 32 * wave + ql] : 0.f;
    const int qrow = tid >> 4, qcc = tid & 15;
    const int krow = tid >> 3, kcc = tid & 7;
    const int vrow0 = tid / VPR, vcc = tid % VPR;
    u32x4 qst[2], kst[2], vst[VST], ast, dst;
#define GLC_LOAD(c) do { const int ch = chunk0 + (c); const size_t cu = (size_t)ch * 4 + h; \
        _Pragma("unroll") for (int i = 0; i < 2; ++i) qst[i] = *(const u32x4*)(QTg + (size_t)(ch * 64 + qrow + 32 * i) * (GH * GDK) + h * GDK + qcc * 8); \
        _Pragma("unroll") for (int i = 0; i < 2; ++i) kst[i] = (sseg < 0 || kcc == sseg) ? *(const u32x4*)(KHg + (cu * 128 + krow + 64 * i) * 64 + kcc * 8) : (u32x4){0u, 0u, 0u, 0u}; \
        _Pragma("unroll") for (int i = 0; i < VST; ++i) { const int r = vrow0 + VRS * i; \
            vst[i] = (r >= srow && r < srow + nrow) ? *(const u32x4*)(QKVG + (size_t)(ch * 64 + r) * GIN + 2 * GH * GDK + h * GDV + dvbase + vcc * 8) : (u32x4){0u, 0u, 0u, 0u}; } \
        if (tid < 384) ast = *(const u32x4*)(ATg + cu * 3072 + tid * 8); \
        if (tid < 32) dst = *(const u32x4*)(DKg + cu * 1024 + dseg * 128 + tid * 4); } while (0)
    GLC_LOAD(0);
    const int g16 = lane >> 4, i16 = lane & 15;
    const int troff = (8 * (g16 >> 1) + (i16 >> 2)) * VROW + (32 * wave + 16 * (g16 & 1) + 4 * (i16 & 3)) * 2;
    const int kr = swap23(ql);
#define GLC_LDS_BAR() do { asm volatile("s_waitcnt lgkmcnt(0)" ::: "memory"); __builtin_amdgcn_s_barrier(); asm volatile("" ::: "memory"); } while (0)
#define GLC_FLUSH(cprev) do { if constexpr (NWV != 8) { int tl_ = tid; asm volatile("" : "+v"(tl_)); _Pragma("unroll") for (int i_ = 0; i_ < NWV / 2; ++i_) { const int c_ = tl_ + 512 * i_, row_ = c_ / (NWV * 4), cc_ = c_ % (NWV * 4); \
            *(u32x4*)(GO + (size_t)((chunk0 + (cprev)) * 64 + row_) * DM + h * GDV + dvbase + cc_ * 8) = *(const LAS u32x4*)(lds + C_O + row_ * (NWV * 64) + cc_ * 16); } } } while (0)
    for (int c = 0; c < nchunk; ++c) {
        GLC_LDS_BAR();
        if (c > 0) GLC_FLUSH(c - 1);
#pragma unroll
        for (int i = 0; i < 2; ++i) *(LAS u32x4*)(lds + C_QT + (qrow + 32 * i) * QROW + qcc * 16) = qst[i];
#pragma unroll
        for (int i = 0; i < 2; ++i) *(LAS u32x4*)(lds + C_KH + (krow + 64 * i) * KTROW + kcc * 16) = kst[i];
#pragma unroll
        for (int i = 0; i < VST; ++i) *(LAS u32x4*)(lds + C_V + (vrow0 + VRS * i) * VROW + vcc * 16) = vst[i];
        if (tid < 384) *(LAS u32x4*)(lds + C_AT + tid * 16) = ast;
        if (tid < 32) *(LAS u32x4*)(lds + C_DK + tid * 16) = dst;
        GLC_LDS_BAR();
        if (c + 1 < nchunk) GLC_LOAD(c + 1);
        if (active) {
        f32x16 o[2];
#pragma unroll
        for (int tb = 0; tb < 2; ++tb)
#pragma unroll
            for (int r = 0; r < 16; ++r) o[tb][r] = 0.f;
        const unsigned qa = (unsigned)(size_t)(lds + C_QT + ql * QROW + hh * 16), ka = (unsigned)(size_t)(lds + C_KH + kr * KTROW + hh * 16), ata = (unsigned)(size_t)(lds + C_AT + lane * 16);
        bf16x8 fa[4], fb[4];
#define GLC_QLD(f, kb) do { LDS_RD128(f[0], qa, (kb) * 64); LDS_RD128(f[1], qa, 32 * QROW + (kb) * 64); LDS_RD128(f[2], qa, (kb) * 64 + 32); LDS_RD128(f[3], qa, 32 * QROW + (kb) * 64 + 32); } while (0)
#define GLC_QMM(f, kb) do { const bf16x8 s0 = pack8(S[kb], 0), s1 = pack8(S[kb], 8); \
            o[0] = __builtin_amdgcn_mfma_f32_32x32x16_bf16(f[0], s0, o[0], 0, 0, 0); o[1] = __builtin_amdgcn_mfma_f32_32x32x16_bf16(f[1], s0, o[1], 0, 0, 0); \
            o[0] = __builtin_amdgcn_mfma_f32_32x32x16_bf16(f[2], s1, o[0], 0, 0, 0); o[1] = __builtin_amdgcn_mfma_f32_32x32x16_bf16(f[3], s1, o[1], 0, 0, 0); } while (0)
        GLC_QLD(fa, 0); GLC_QLD(fb, 1);
        LDS_WAIT4(fa, 4); GLC_QMM(fa, 0); GLC_QLD(fa, 2);
        LDS_WAIT4(fb, 4); GLC_QMM(fb, 1); GLC_QLD(fb, 3);
        LDS_WAIT4(fa, 4); GLC_QMM(fa, 2);
        LDS_RD128(fa[0], ata, 0 * 1024); LDS_RD128(fa[1], ata, 1 * 1024); LDS_RD128(fa[2], ata, 2 * 1024); LDS_RD128(fa[3], ata, 3 * 1024);
        LDS_WAIT4(fb, 4); GLC_QMM(fb, 3);
        LDS_RD128(fb[0], ata, 4 * 1024); LDS_RD128(fb[1], ata, 5 * 1024); LDS_RD128(fb[2], ka, 0); LDS_RD128(fb[3], ka, 32);
        bf16x8 vf[4];
#pragma unroll
        for (int ss = 0; ss < 4; ++ss) vf[ss] = tr_frag(lds + C_V + troff + ss * 16 * VROW);
        LDS_WAIT4(fa, 0); LDS_WAIT4(fb, 0);
        o[0] = __builtin_amdgcn_mfma_f32_32x32x16_bf16(fa[0], vf[0], o[0], 0, 0, 0);
        o[0] = __builtin_amdgcn_mfma_f32_32x32x16_bf16(fa[1], vf[1], o[0], 0, 0, 0);
        o[1] = __builtin_amdgcn_mfma_f32_32x32x16_bf16(fa[2], vf[0], o[1], 0, 0, 0);
        o[1] = __builtin_amdgcn_mfma_f32_32x32x16_bf16(fa[3], vf[1], o[1], 0, 0, 0);
        o[1] = __builtin_amdgcn_mfma_f32_32x32x16_bf16(fb[0], vf[2], o[1], 0, 0, 0);
        o[1] = __builtin_amdgcn_mfma_f32_32x32x16_bf16(fb[1], vf[3], o[1], 0, 0, 0);
#define GLC_KLD(f, kb) do { LDS_RD128(f[0], ka, (kb) * 32 * KTROW); LDS_RD128(f[1], ka, (kb) * 32 * KTROW + 32); LDS_RD128(f[2], ka, (kb) * 32 * KTROW + 64); LDS_RD128(f[3], ka, (kb) * 32 * KTROW + 96); } while (0)
#define GLC_SCALE(kb) do { _Pragma("unroll") for (int g = 0; g < 2; ++g) { const LAS f32x4* dp = (const LAS f32x4*)(lds + C_DK + (32 * (kb) + 16 * g + 8 * hh) * 4); const f32x4 d0 = dp[0], d1 = dp[1]; \
            S[kb][8 * g + 0] *= d0[0]; S[kb][8 * g + 1] *= d0[1]; S[kb][8 * g + 2] *= d0[2]; S[kb][8 * g + 3] *= d0[3]; \
            S[kb][8 * g + 4] *= d1[0]; S[kb][8 * g + 5] *= d1[1]; S[kb][8 * g + 6] *= d1[2]; S[kb][8 * g + 7] *= d1[3]; } } while (0)
#define GLC_KMM(f, kb) do { S[kb] = __builtin_amdgcn_mfma_f32_32x32x16_bf16(f[0], vf[0], S[kb], 0, 0, 0); S[kb] = __builtin_amdgcn_mfma_f32_32x32x16_bf16(f[1], vf[1], S[kb], 0, 0, 0); \
            S[kb] = __builtin_amdgcn_mfma_f32_32x32x16_bf16(f[2], vf[2], S[kb], 0, 0, 0); S[kb] = __builtin_amdgcn_mfma_f32_32x32x16_bf16(f[3], vf[3], S[kb], 0, 0, 0); } while (0)
        GLC_KLD(fa, 1);
        LDS_RD128(fb[0], ka, 64); LDS_RD128(fb[1], ka, 96);
        GLC_SCALE(0);
        LDS_WAIT4(fb, 0);
        S[0] = __builtin_amdgcn_mfma_f32_32x32x16_bf16(fb[2], vf[0], S[0], 0, 0, 0); S[0] = __builtin_amdgcn_mfma_f32_32x32x16_bf16(fb[3], vf[1], S[0], 0, 0, 0);
        S[0] = __builtin_amdgcn_mfma_f32_32x32x16_bf16(fb[0], vf[2], S[0], 0, 0, 0); S[0] = __builtin_amdgcn_mfma_f32_32x32x16_bf16(fb[1], vf[3], S[0], 0, 0, 0);
        GLC_KLD(fb, 2); GLC_SCALE(1);
        LDS_WAIT4(fa, 4); GLC_KMM(fa, 1); GLC_KLD(fa, 3); GLC_SCALE(2);
        LDS_WAIT4(fb, 4); GLC_KMM(fb, 2); GLC_SCALE(3);
        LDS_WAIT4(fa, 0); GLC_KMM(fa, 3);
#undef GLC_QLD
#undef GLC_QMM
#undef GLC_KLD
#undef GLC_SCALE
#undef GLC_KMM
        if constexpr (NWV != 8) {
            int qlx = ql, hhx = hh; asm volatile("" : "+v"(qlx), "+v"(hhx));
            LAS unsigned short* op_ = (LAS unsigned short*)(lds + C_O) + (4 * hhx) * (NWV * 32) + 32 * wave + qlx;
#pragma unroll
            for (int tb = 0; tb < 2; ++tb)
#pragma unroll
                for (int r = 0; r < 16; r += 2) { const unsigned w_ = cvt_pk_bf16(o[tb][r], o[tb][r + 1]);
                    const int t0_ = 32 * tb + (r & 3) + 8 * (r >> 2);
                    op_[t0_ * (NWV * 32)] = (unsigned short)(w_ & 0xffffu); op_[(t0_ + 1) * (NWV * 32)] = (unsigned short)(w_ >> 16); }
        } else {
          int qlx = ql, hhx = hh; asm volatile("" : "+v"(qlx), "+v"(hhx));
          bf16_t* gp = GO + (size_t)((chunk0 + c) * 64) * DM + h * GDV + dvbase + 32 * wave + qlx;
#pragma unroll
          for (int tb = 0; tb < 2; ++tb)
#pragma unroll
              for (int r = 0; r < 16; ++r) { const int t = 32 * tb + (r & 3) + 8 * (r >> 2) + 4 * hhx; if (t >= srow && t < srow + nrow) gp[(size_t)t * DM] = (bf16_t)(cvt_pk_bf16(o[tb][r], 0.f) & 0xffffu); } }
        }
    }
    if constexpr (NWV != 8) { GLC_LDS_BAR(); GLC_FLUSH(nchunk - 1); }
#undef GLC_FLUSH
#undef GLC_LOAD
#undef GLC_LDS_BAR
    if (active) { int qlx = ql, hhx = hh; asm volatile("" : "+v"(qlx), "+v"(hhx));
#pragma unroll
    for (int kb = 0; kb < 4; ++kb)
#pragma unroll
        for (int r = 0; r < 16; ++r) state_out[(size_t)(32 * kb + 16 * (r >> 3) + 8 * hhx + (r & 7)) * GDV + dvbase + 32 * wave + qlx] = S[kb][r]; }
    __syncthreads();
}
}

__global__ void __launch_bounds__(NWAVES * 64, 2) mk_fwd(Args args) {
    extern __shared__ __attribute__((aligned(16))) unsigned char lds_raw[];
    LAS unsigned char* lds = (LAS unsigned char*)lds_raw;
    volatile LAS unsigned* MISC = (volatile LAS unsigned*)(lds + MISC_OFF);
    const int wave = __builtin_amdgcn_readfirstlane(threadIdx.x >> 6);
    const int G = gridDim.x; const int bx = blockIdx.x; const int vcu = (G % 8 == 0) ? (bx % 8) * (G / 8) + bx / 8 : bx;
    const int gw = vcu * NWAVES + wave, NGW = G * NWAVES;
    unsigned char* ws = args.ws;
    unsigned* ctl = (unsigned*)(ws + WS_CTL);
    for (int u = wave * 64 + lane_now(); u < (LDS_BYTES - LDSCTL_OFF) / 4; u += NWAVES * 64) ((LAS unsigned*)(lds + LDSCTL_OFF))[u] = 0u;
    __syncthreads();
    XcdBarrier bar = xcd_barrier_post(ctl + 1024, MISC + 8, wave == 0 && lane_now() == 0);
#ifdef PROBE_A0
    unsigned long long* tsb = (unsigned long long*)(ws + WS_CTL + 32768);
    int n_ts = 0;
#define STAMP() do { if (bx == 0 && wave == 0 && lane_now() == 0) tsb[n_ts] = __builtin_amdgcn_s_memrealtime(); ++n_ts; } while (0)
#define GRID_BAR() do { xcd_barrier(bar, wave == 0 && lane_now() == 0); STAMP(); } while (0)
    STAMP();
#else
#define STAMP() do {} while (0)
#define GRID_BAR() xcd_barrier(bar, wave == 0 && lane_now() == 0)
#endif

    const float* x_prompt = (const float*)args.in[0]; const float* x_sample = (const float*)args.in[1];
    const float* cache_ckv = (const float*)args.in[2]; const float* cache_kpe = (const float*)args.in[3];
    const float* state_gla = (const float*)args.in[4]; const int* page_table = (const int*)args.in[5];
    const float* norm_g = (const float*)args.in[6]; const float* ffn_w_in = (const float*)args.in[7]; const float* ffn_w_out = (const float*)args.in[8];
    const float* mla_w_down = (const float*)args.in[9]; const float* mla_g_q = (const float*)args.in[10]; const float* mla_w_uq = (const float*)args.in[11];
    const float* mla_g_kv = (const float*)args.in[12]; const float* mla_w_uk = (const float*)args.in[13]; const float* mla_w_uv = (const float*)args.in[14];
    const float* mla_w_o = (const float*)args.in[15]; const float* gla_w_in = (const float*)args.in[16]; const float* gla_w_gk1 = (const float*)args.in[17];
    const float* gla_w_gk2 = (const float*)args.in[18]; const float* gla_b_gk = (const float*)args.in[19]; const float* gla_g_norm = (const float*)args.in[20];
    const float* gla_w_o = (const float*)args.in[21];
    float* out = args.out;
    float* ROPE_T = (float*)(ws + WS_ROPE);
    bf16_t* WIN = (bf16_t*)(ws + WS_WIN); bf16_t* WOUT = (bf16_t*)(ws + WS_WOUT); bf16_t* WDOWN = (bf16_t*)(ws + WS_WDOWN); bf16_t* WUQ = (bf16_t*)(ws + WS_WUQ);
    bf16_t* WUKT = (bf16_t*)(ws + WS_WUKT); bf16_t* WUK = (bf16_t*)(ws + WS_WUK); bf16_t* WUVT = (bf16_t*)(ws + WS_WUVT); bf16_t* WOT = (bf16_t*)(ws + WS_WOT);
    bf16_t* WGIN = (bf16_t*)(ws + WS_WGIN); bf16_t* WGO = (bf16_t*)(ws + WS_WGO);
    bf16_t* XN = (bf16_t*)(ws + WS_XN); bf16_t* HM = (bf16_t*)(ws + WS_HM); bf16_t* T = (bf16_t*)(ws + WS_T); bf16_t* H = (bf16_t*)(ws + WS_H); float* TP = (float*)(ws + WS_TP); bf16_t* D = (bf16_t*)(ws + WS_D);
    bf16_t* CQ = (bf16_t*)(ws + WS_CQ); bf16_t* CKV = (bf16_t*)(ws + WS_CKV); bf16_t* KPES = (bf16_t*)(ws + WS_KPES);
    bf16_t* KB = (bf16_t*)(ws + WS_KB); bf16_t* KPEP = (bf16_t*)(ws + WS_KPEP);
    float* Y = out + OUT_Y;
    const ConvPtrs cp{ffn_w_in, ffn_w_out, mla_w_down, mla_w_uq, mla_w_uk, mla_w_uv, mla_w_o, gla_w_in, gla_w_o, WIN, WOUT, WDOWN, WUQ, WUKT, WUVT, WOT, WGIN, WGO};

    {
        const int lane = lane_now(), tid = wave * 64 + lane; (void)tid;
        LAS float* scr = (LAS float*)(lds + wave * 16384);
        conv_segment<0>(cp, gw, NGW, scr, lane);
        const int gt = vcu * (NWAVES * 64) + tid, NGT = G * NWAVES * 64;
        for (int i = gt; i < KVL * NH * NOPE / 2; i += NGT) { const f32x2 v = ((const f32x2*)mla_w_uk)[i]; ((unsigned*)WUK)[i] = cvt_pk_bf16(v[0], v[1]); }
        for (int i = gt; i < (DDOWN_P - DDOWN) * DM / 2; i += NGT) ((unsigned*)(WDOWN + (size_t)DDOWN * DM))[i] = 0u;
        for (int i = gt; i < 128 * KVL / 2; i += NGT) ((unsigned*)(WUVT + (size_t)NH * VD * KVL))[i] = 0u;
        for (int i = gt; i < (GIN_P - GIN) * DM / 2; i += NGT) { const int row = (2 * i) / DM, k = (2 * i) % DM;
            unsigned w = 0u; if (row < GRANK) w = cvt_pk_bf16(gla_w_gk1[(size_t)k * GRANK + row], gla_w_gk1[(size_t)(k + 1) * GRANK + row]);
            ((unsigned*)(WGIN + (size_t)GIN * DM))[i] = w; }
        for (int i = gt; i < (SEQ + DECT) * 32; i += NGT) { const int p = i >> 5, fi = i & 31; const float pos = (float)(p < SEQ ? p : PAST + (p - SEQ));
            const float inv = (float)exp2(-(double)fi * (13.287712379549449 / 32.0));
            const float ang = pos * inv; double t = (double)ang * 0.15915494309189535; t -= rint(t); const float tf = (float)t;
            ((f32x2*)ROPE_T)[i] = (f32x2){__builtin_amdgcn_cosf(tf), __builtin_amdgcn_sinf(tf)}; }
        thin_phase<false, true, true, false>(gw, NGW, x_prompt, x_sample, nullptr, nullptr, 0, nullptr, nullptr, XN, nullptr, norm_g + 0 * DM, 1.f);
        GRID_BAR();
    }
    bf16_t* QKVG = (bf16_t*)(ws + WS_QKVG); float* T16 = (float*)(ws + WS_T16); bf16_t* GO = (bf16_t*)(ws + WS_GO);
    const int CONV_TAIL0 = ((M / 256) * (2 * DFF / 256)) % G;
#define FFN_GEMMS(slot) do { \
        { pg8::Gemm g{XN, WIN + (size_t)(slot) * 2 * DFF * DM, DM, DM, DM, 0, 0}; pg8::Order S{M / 256, 2 * DFF / 256, 1, G, bx}; \
          pg8::EpiSwiGLU E{HM, DFF}; \
          pg8::gemm_phase<pg8::EpiSwiGLU, true>(lds, wave, g, S, E); \
          if ((slot) < 3 && bx >= CONV_TAIL0) conv_segment<((slot) < 3 ? (slot) + 1 : 3)>(cp, (bx - CONV_TAIL0) * NWAVES + wave, (G - CONV_TAIL0) * NWAVES, (LAS float*)(lds + wave * 16384), lane_now()); \
          GRID_BAR(); } \
        { pg8::Gemm g{HM, WOUT + (size_t)(slot) * DM * DFF, DFF, DFF, DFF, 0, 0}; pg8::Order S{MP / 256, DM / 256, 1, G, bx};     \
          pg8::EpiBf16<0> E{T, DM, 0, 256, 1.f, 0}; \
          pg8::gemm_phase<pg8::EpiBf16<0>, true>(lds, wave, g, S, E); } \
        { pg8::Gemm g{HM + (size_t)MP * DFF, WOUT + (size_t)(slot) * DM * DFF, DFF, DFF, 256, 256, 256}; pg8::Order S{MS / 256, DM / 256, 11, G, bx};     \
          pg8::EpiBf16<0> E{(bf16_t*)TP, DM, (long)MS * DM, 256, 1.f, 0};     \
          pg8::gemm_phase<pg8::EpiBf16<0>, true>(lds, wave, g, S, E); \
          GRID_BAR(); } } while (0)
    { const float* ng = norm_g;
    FFN_GEMMS(0);
    thin_phase<true, true, true, false>(gw, NGW, x_prompt, x_sample, T, TP, 11, H, nullptr, XN, ng + 1 * DM, ng + 2 * DM, 0.5f); GRID_BAR();
        {
            pg8::Gemm g{XN, WDOWN, DM, DM, DM, 0, 0}; pg8::Order S{M / 256, DDOWN_P / 256, 1, G, bx};
            pg8::EpiBf16<0> E{D, DDOWN_P, 0, 256, 1.f, 0};
            pg8::gemm_phase<pg8::EpiBf16<0>, true>(lds, wave, g, S, E);
            GRID_BAR();
        }
        {
            const int lane = lane_now(), tid = wave * 64 + lane; (void)tid;
            f32x2 gq[3]; f32x4 gkv;
    #pragma unroll
            for (int j = 0; j < 3; ++j) gq[j] = *(const f32x2*)(mla_g_q + 2 * lane + 128 * j);
            gkv = *(const f32x4*)(mla_g_kv + 4 * lane);
            for (int r = gw; r < M; r += NGW) {
                const bf16_t* d = D + (size_t)r * DDOWN_P;
                f32x2 q[3];
    #pragma unroll
                for (int j = 0; j < 3; ++j) { const unsigned w = *(const unsigned*)(d + 2 * lane + 128 * j); q[j] = (f32x2){__uint_as_float(w << 16), __uint_as_float(w & 0xffff0000u)}; }
                const u32x2 kw = *(const u32x2*)(d + QL + 4 * lane);
                const f32x4 kv = (f32x4){__uint_as_float(kw.x << 16), __uint_as_float(kw.x & 0xffff0000u), __uint_as_float(kw.y << 16), __uint_as_float(kw.y & 0xffff0000u)};
                const float pe = bf2f(d[QL + KVL + lane]);
                float sq = 0.f;
    #pragma unroll
                for (int j = 0; j < 3; ++j) sq += q[j][0] * q[j][0] + q[j][1] * q[j][1];
                sq = wave_sum(sq);
                const float skv = wave_sum((kv[0] * kv[0] + kv[1] * kv[1]) + (kv[2] * kv[2] + kv[3] * kv[3]));
                const float rq = __builtin_amdgcn_rsqf(sq * (1.0f / QL) + EPS), rkv = __builtin_amdgcn_rsqf(skv * (1.0f / KVL) + EPS);
    #pragma unroll
                for (int j = 0; j < 3; ++j) *(unsigned*)(CQ + (size_t)r * QL + 2 * lane + 128 * j) = cvt_pk_bf16(q[j][0] * rq * gq[j][0], q[j][1] * rq * gq[j][1]);
                const f32x4 ckv = (kv * rkv) * gkv;
                float* ockv = r < MP ? out + OUT_CKV_P + (size_t)r * KVL : out + OUT_CKV_S + (size_t)(r - MP) * KVL;
                *(f32x4*)(ockv + 4 * lane) = ckv;
                u32x2 w; w.x = cvt_pk_bf16(ckv[0], ckv[1]); w.y = cvt_pk_bf16(ckv[2], ckv[3]);
                *(u32x2*)(CKV + (size_t)r * KVL + 4 * lane) = w;
                const float other = __shfl_xor(pe, 32);
                const f32x2 cs = ((const f32x2*)ROPE_T)[rope_pos_index(r) * 32 + (lane & 31)];
                const float ro = lane < 32 ? pe * cs[0] - other * cs[1] : pe * cs[0] + other * cs[1];
                float* okpe = r < MP ? out + OUT_KPE_P + (size_t)r * ROPE : out + OUT_KPE_S + (size_t)(r - MP) * ROPE;
                okpe[lane] = ro;
                const unsigned short rb = (unsigned short)(cvt_pk_bf16(ro, 0.f) & 0xffffu);
                if (r < MP) KPEP[(size_t)r * ROPE + lane] = rb; else KPES[(size_t)(r - MP) * ROPE + lane] = rb;
            }
            GRID_BAR();
        }

        bf16_t* Qb = (bf16_t*)(ws + WS_Q); bf16_t* VT = (bf16_t*)(ws + WS_VT); bf16_t* QLAT = (bf16_t*)(ws + WS_QLAT); bf16_t* Ob = (bf16_t*)(ws + WS_O);
        float* OPART = (float*)(ws + WS_OPART); float* OML = (float*)(ws + WS_OML); bf16_t* OLAT = (bf16_t*)(ws + WS_OLAT);
        const float QSCALE = 0.07216878364870322f * LOG2E;
        {
            pg8::Gemm g{CQ, WUQ, QL, QL, QL, 0, 0}; pg8::Order S{MP / 256, NH * QKD / 256, 1, G, bx};
            pg8::EpiQ E{Qb, ROPE_T, QSCALE};
            pg8::gemm_phase<pg8::EpiQ, true>(lds, wave, g, S, E);
            GRID_BAR();
        }
        {
            const int NQU = (MS / 256) * (NH * QKD / 256), NQP = NQU < G / 2 ? NQU : G / 2, NQC = 32 < G - NQP ? 32 : G - NQP;
            unsigned* qctr = ctl + 16 + 64 * 4;
            if (bx < NQP) {
                pg8::Gemm g{CQ, WUQ, QL, QL, QL, 0, 0}; pg8::OrderOff S{{MS / 256, NH * QKD / 256, 1, NQP, bx}, MP / 256};
                pg8::EpiQ E{Qb, ROPE_T, QSCALE};
                pg8::gemm_phase<pg8::EpiQ, true, pg8::OrderOff>(lds, wave, g, S, E);
                if (wave == 0 && lane_now() == 0) { __builtin_amdgcn_fence(__ATOMIC_RELEASE, "agent"); asm volatile("s_waitcnt vmcnt(0)" ::: "memory"); (void)xb_add(qctr, 1u); }
            }
            { pg8::Gemm g{CKV, WUKT, KVL, KVL, KVL, 0, 0}; pg8::Order S{MP / 256, NH * NOPE / 256, 1, G, bx};
              pg8::EpiBf16<0> E{KB, NH * NOPE, 0, 256, 1.f, 0};
              pg8::gemm_phase<pg8::EpiBf16<0>, true>(lds, wave, g, S, E); }
            { pg8::Gemm g{WUVT, CKV, KVL, KVL, KVL, 0, 0}; pg8::Order S{NH * VD / 256, MP / 256, 1, G, bx};
              pg8::EpiBf16<0> E{VT, MP, 0, 256, 1.f, 0};
              pg8::gemm_phase<pg8::EpiBf16<0>, true>(lds, wave, g, S, E); }
            if (bx >= G - NQC) {
                if (wave == 0 && lane_now() == 0) { XB_SPIN(xb_ld(qctr) < (unsigned)NQP, ctl + 1024); __builtin_amdgcn_fence(__ATOMIC_ACQUIRE, "agent"); asm volatile("s_waitcnt vmcnt(0)" ::: "memory"); }
                __syncthreads();
                { pg8::Gemm g{Qb + (size_t)MP * NH * QKD, WUK, NH * QKD, NH * NOPE, NOPE, QKD, NOPE}; pg8::Order S{MS / 256, 1, NH, NQC, bx - (G - NQC)};
                  pg8::EpiBf16<0> E{QLAT, NH * 320, 320, 256, 1.f, 0};
                  pg8::gemm_phase<pg8::EpiBf16<0>, true>(lds, wave, g, S, E); }
                const int lane = lane_now(), tid = wave * 64 + lane;
                for (int i = (bx - (G - NQC)) * (NWAVES * 64) + tid; i < MS * NH * 8; i += NQC * NWAVES * 64) { const int c = i & 7, th = i >> 3;
                    *(u32x4*)(QLAT + (size_t)th * 320 + 256 + c * 8) = *(const u32x4*)(Qb + (size_t)(MP + (th >> 3)) * (NH * QKD) + (th & 7) * QKD + NOPE + c * 8); }
            }
            GRID_BAR();
        }

        {
            for (int p = vcu; p < NB * NH * 4; p += G) { const int bh = p >> 2, x = p & 3;
                pat::unit(lds, wave, Qb, KB, KPEP, VT, Ob, bh >> 3, bh & 7, 7 - x);
                pat::unit(lds, wave, Qb, KB, KPEP, VT, Ob, bh >> 3, bh & 7, x); }
            STAMP();
            for (int u = bx; u < DECB * 2; u += G)
                sat::unit(lds, wave, QLAT, cache_ckv, cache_kpe, page_table, CKV + (size_t)MP * KVL, KPES, OPART, OML, u >> 1, u & 1);
            GRID_BAR();
        }
        {
            const int lane = lane_now(), tid = wave * 64 + lane; (void)tid;
            for (int r = gw; r < DECB * 64; r += NGW) { const int b = r >> 6, q = r & 63;
                const f32x2 ml0 = *(const f32x2*)(OML + ((size_t)(b * 2) * 64 + q) * 2), ml1 = *(const f32x2*)(OML + ((size_t)(b * 2 + 1) * 64 + q) * 2);
                const float mm = fmaxf(ml0[0], ml1[0]), w0 = __builtin_amdgcn_exp2f(ml0[0] - mm), w1 = __builtin_amdgcn_exp2f(ml1[0] - mm), inv = 1.0f / (ml0[1] * w0 + ml1[1] * w1);
                const f32x4 a = *(const f32x4*)(OPART + ((size_t)(b * 2) * 64 + q) * KVL + 4 * lane), c = *(const f32x4*)(OPART + ((size_t)(b * 2 + 1) * 64 + q) * KVL + 4 * lane);
                const f32x4 v = (a * w0 + c * w1) * inv;
                u32x2 w; w.x = cvt_pk_bf16(v[0], v[1]); w.y = cvt_pk_bf16(v[2], v[3]);
                *(u32x2*)(OLAT + (size_t)r * KVL + 4 * lane) = w; }
            GRID_BAR();
        }
        {
            pg8::Gemm g{OLAT, WUVT, NH * KVL, KVL, KVL, KVL, (long)VD * KVL}; pg8::Order S{MS / 256, 1, NH, G, bx};
            pg8::EpiBf16<0> E{Ob + (size_t)MP * DM, DM, VD, 128, 1.f, 0};
            pg8::gemm_phase<pg8::EpiBf16<0>, true>(lds, wave, g, S, E);
            GRID_BAR();
        }
        {
            { pg8::Gemm g{Ob, WOT, DM, DM, DM, 0, 0}; pg8::Order S{MP / 256, DM / 256, 1, G, bx};
              pg8::EpiBf16<0> E{T, DM, 0, 256, 1.f, 0};
              pg8::gemm_phase<pg8::EpiBf16<0>, true>(lds, wave, g, S, E); }
            { pg8::Gemm g{Ob + (size_t)MP * DM, WOT, DM, DM, 256, 256, 256}; pg8::Order S{MS / 256, DM / 256, 4, G, bx};
              pg8::EpiBf16<0> E{(bf16_t*)TP, DM, (long)MS * DM, 256, 1.f, 0};
              pg8::gemm_phase<pg8::EpiBf16<0>, true>(lds, wave, g, S, E); }
            GRID_BAR();
        }
        {
            thin_phase<true, true, false, false>(gw, NGW, nullptr, nullptr, T, TP, 4, H, nullptr, XN, norm_g + 3 * DM, norm_g + 4 * DM, 1.0f);
            GRID_BAR();
        }


    FFN_GEMMS(1);
    thin_phase<true, true, false, false>(gw, NGW, nullptr, nullptr, T, TP, 11, H, nullptr, XN, ng + 5 * DM, norm_g + 6 * DM, 0.5f); GRID_BAR();
    }
    { const float* ng = norm_g + 6 * DM;
    FFN_GEMMS(2);
    thin_phase<true, true, false, false>(gw, NGW, nullptr, nullptr, T, TP, 11, H, nullptr, XN, ng + 1 * DM, ng + 2 * DM, 0.5f); GRID_BAR();
            { pg8::Gemm g{XN, WGIN, DM, DM, DM, 0, 0}; pg8::Order S{M / 256, GIN_P / 256, 1, G, bx};
              pg8::EpiGla E{QKVG, T16, 0.08838834764831845f};
              pg8::gemm_phase<pg8::EpiGla, true>(lds, wave, g, S, E);
              GRID_BAR(); }
            bf16_t* GQT = (bf16_t*)(ws + WS_GQT); bf16_t* GKH = (bf16_t*)(ws + WS_GKH); bf16_t* GAT = (bf16_t*)(ws + WS_GAT); float* GDK_ = (float*)(ws + WS_GDK);
            { for (int u = bx; u < (M / 64) * GH; u += G) { const int chunk = u >> 2, h = u & 3;
                  if (chunk < MP / 64) gla::prep<64>(lds, wave, QKVG, T16, gla_w_gk2, gla_b_gk, chunk, h, GQT, GKH, GAT, GDK_);
                  else gla::prep<8>(lds, wave, QKVG, T16, gla_w_gk2, gla_b_gk, chunk, h, GQT, GKH, GAT, GDK_); }
              GRID_BAR(); }
            { const int NPB = (G >= 2 * NB * GH * 2) ? NB * GH * 2 : 0;
              if (NPB == 0 || vcu < NPB) {
                  for (int u = vcu; u < NB * GH * 2; u += (NPB ? NPB : G)) { const int bh = u >> 1, q = u & 1, b = bh >> 2, h = bh & 3;
                      gla::chain<4>(lds, wave, GQT, GKH, GAT, GDK_, QKVG, h, b * (SEQ / 64), SEQ / 64, 0, 64, -1, 0, 128 * q, nullptr, out + OUT_ST_P + (size_t)bh * GDK * GDV, GO); } }
              if (NPB == 0 || vcu >= NPB) {
                  for (int u = (NPB ? vcu - NPB : vcu); u < DECB * GH; u += (NPB ? G - NPB : G)) { const int b = u >> 2, h = u & 3;
                      gla::chain<8>(lds, wave, GQT, GKH, GAT, GDK_, QKVG, h, MP / 64 + (b >> 3), 1, 8 * (b & 7), 8, b & 7, b & 7, 0, state_gla + (size_t)u * GDK * GDV, out + OUT_ST_S + (size_t)u * GDK * GDV, GO); } }
              GRID_BAR(); }
            { const int lane = lane_now(), tid = wave * 64 + lane; (void)tid; const f32x4 gn = *(const f32x4*)(gla_g_norm + 4 * lane);
              for (int r = gw; r < M; r += NGW) {
                  Row16 o = ld_row_bf16(GO + (size_t)r * DM, lane);
                  const u32x2* gp = (const u32x2*)(QKVG + (size_t)r * GIN + 2 * GH * GDK + GH * GDV) + lane;
#pragma unroll
                  for (int j = 0; j < 4; ++j) { const u32x2 gw2 = gp[64 * j];
                      const float ss = wave_sum((o.v[j][0] * o.v[j][0] + o.v[j][1] * o.v[j][1]) + (o.v[j][2] * o.v[j][2] + o.v[j][3] * o.v[j][3]));
                      const float rs = __builtin_amdgcn_rsqf(ss * (1.0f / GDV) + EPS);
                      const float g0 = __uint_as_float(gw2.x << 16), g1 = __uint_as_float(gw2.x & 0xffff0000u), g2 = __uint_as_float(gw2.y << 16), g3 = __uint_as_float(gw2.y & 0xffff0000u);
                      o.v[j][0] = o.v[j][0] * rs * gn[0] * pg8::silu_f(g0); o.v[j][1] = o.v[j][1] * rs * gn[1] * pg8::silu_f(g1);
                      o.v[j][2] = o.v[j][2] * rs * gn[2] * pg8::silu_f(g2); o.v[j][3] = o.v[j][3] * rs * gn[3] * pg8::silu_f(g3); }
                  st_row_bf16(XN + (size_t)r * DM, o, lane); }
              GRID_BAR(); }
            { { pg8::Gemm g{XN, WGO, DM, DM, DM, 0, 0}; pg8::Order S{MP / 256, DM / 256, 1, G, bx};
                pg8::EpiBf16<0> E{T, DM, 0, 256, 1.f, 0};
                pg8::gemm_phase<pg8::EpiBf16<0>, true>(lds, wave, g, S, E); }
              { pg8::Gemm g{XN + (size_t)MP * DM, WGO, DM, DM, 256, 256, 256}; pg8::Order S{MS / 256, DM / 256, 4, G, bx};
                pg8::EpiBf16<0> E{(bf16_t*)TP, DM, (long)MS * DM, 256, 1.f, 0};
                pg8::gemm_phase<pg8::EpiBf16<0>, true>(lds, wave, g, S, E); }
              GRID_BAR(); }
            { thin_phase<true, true, false, false>(gw, NGW, nullptr, nullptr, T, TP, 4, H, nullptr, XN, ng + 3 * DM, ng + 4 * DM, 1.0f);
              GRID_BAR(); }

    FFN_GEMMS(3);
    thin_phase<true, false, false, true>(gw, NGW, nullptr, nullptr, T, TP, 11, H, Y, XN, ng + 5 * DM, nullptr, 0.5f);
    }
#ifdef PROBE_A0
    GRID_BAR();
    {
        const int lane = lane_now(), tid = wave * 64 + lane;
        const float ta = (float)(tsb[PROBE_A1] - tsb[PROBE_A0]) * 0.01f, tb = (float)(tsb[PROBE_B1] - tsb[PROBE_B0]) * 0.01f;
        if (bx == 0 && tid == 0) out[0] += ta * 0.1f;
        const float f = 1.0f + tb * (1.0f / PROBE_BDIV);
        for (int i = bx * (NWAVES * 64) + tid; i < MS * ROPE; i += G * NWAVES * 64) out[OUT_KPE_S + i] *= f;
    }
#endif
#ifdef DBG_SCALE_MASK
    GRID_BAR();
    {
        const int lane = lane_now(), tid = wave * 64 + lane; (void)tid;
        const size_t offs[9] = {OUT_Y, OUT_Y + (size_t)MP * DM, OUT_CKV_P, OUT_KPE_P, OUT_CKV_S, OUT_KPE_S, OUT_ST_P, OUT_ST_S, OUT_END};
        for (int o = 0; o < 8; ++o) if ((DBG_SCALE_MASK >> o) & 1)
            for (size_t i = offs[o] / 4 + (size_t)vcu * (NWAVES * 64) + tid; i < offs[o + 1] / 4; i += (size_t)G * NWAVES * 64) ((f32x4*)out)[i] = ((f32x4*)out)[i] * 3.0f;
    }
#endif
#undef GRID_BAR
}

extern "C" void kernel_launch(void* const* d_in, const int* in_sizes, int n_in, void* d_out, int out_size, void* d_ws, size_t ws_size, hipStream_t stream) {
    static int grid = 0;
    if (grid == 0) {
        if (n_in != 22 || (size_t)out_size != OUT_END || ws_size < WS_END) { fprintf(stderr, "kernel_launch: unexpected shapes: n_in %d out %d ws %zu (need %zu)\n", n_in, out_size, ws_size, (size_t)WS_END); grid = -1; return; }
        int dev = 0, cus = 0, per_cu = 0;
        if (hipGetDevice(&dev) != hipSuccess || hipDeviceGetAttribute(&cus, hipDeviceAttributeMultiprocessorCount, dev) != hipSuccess) { grid = -1; return; }
        if (hipFuncSetAttribute((const void*)mk_fwd, hipFuncAttributeMaxDynamicSharedMemorySize, LDS_BYTES) != hipSuccess) { fprintf(stderr, "kernel_launch: hipFuncSetAttribute failed\n"); grid = -1; return; }
        if (hipOccupancyMaxActiveBlocksPerMultiprocessor(&per_cu, (const void*)mk_fwd, NWAVES * 64, LDS_BYTES) != hipSuccess || per_cu < 1) { fprintf(stderr, "kernel_launch: occupancy query says %d\n", per_cu); }
        (void)hipGetLastError();
        grid = cus;
    }
    if (grid < 0) return;
    if (hipMemsetAsync((char*)d_ws + WS_CTL, 0, CTL_ZERO_BYTES, stream) != hipSuccess) return;
    Args a{};
    for (int i = 0; i < 22; ++i) a.in[i] = d_in[i];
    a.out = (float*)d_out; a.ws = (unsigned char*)d_ws; a.ph_lo = 0; a.ph_hi = 100;
    hipLaunchKernelGGL(mk_fwd, dim3(grid), dim3(NWAVES * 64), LDS_BYTES, stream, a);
}
```

```cpp
#include <hip/hip_runtime.h>
#include <cstdio>
#include <cstdint>


#define GAS __attribute__((address_space(1)))
#define LAS __attribute__((address_space(3)))
typedef unsigned short bf16_t;
typedef short bf16x8 __attribute__((ext_vector_type(8)));
typedef float f32x4 __attribute__((ext_vector_type(4)));
typedef float f32x2 __attribute__((ext_vector_type(2)));
typedef float f32x16 __attribute__((ext_vector_type(16)));
typedef unsigned u32x4 __attribute__((ext_vector_type(4)));
typedef unsigned u32x2 __attribute__((ext_vector_type(2)));

constexpr int DM = 1024, NB = 16, SEQ = 2048, DECB = 128, DECT = 8, PAST = 8192, PAGE = 128, NPAGES = PAST / PAGE;
constexpr int MP = NB * SEQ, MS = DECB * DECT, M = MP + MS;
constexpr int DFF = 2816;
constexpr int QL = 384, KVL = 256, NOPE = 128, ROPE = 64, VD = 128, NH = 8, QKD = NOPE + ROPE;
constexpr int DDOWN = QL + KVL + ROPE, DDOWN_P = 768;
constexpr int GH = 4, GDK = 128, GDV = 256, GRANK = 16, GIN = 2 * GH * GDK + 2 * GH * GDV, GIN_P = GIN + 256;
constexpr float EPS = 1e-6f;
constexpr float LOG2E = 1.4426950408889634f;
constexpr int NPOOL = (DECB * NPAGES * 5) / 4;

constexpr size_t OUT_Y = 0;
constexpr size_t OUT_CKV_P = (size_t)M * DM;
constexpr size_t OUT_KPE_P = OUT_CKV_P + (size_t)MP * KVL;
constexpr size_t OUT_CKV_S = OUT_KPE_P + (size_t)MP * ROPE;
constexpr size_t OUT_KPE_S = OUT_CKV_S + (size_t)MS * KVL;
constexpr size_t OUT_ST_P = OUT_KPE_S + (size_t)MS * ROPE;
constexpr size_t OUT_ST_S = OUT_ST_P + (size_t)NB * GH * GDK * GDV;
constexpr size_t OUT_END = OUT_ST_S + (size_t)DECB * GH * GDK * GDV;

constexpr size_t MiB = 1u << 20;
constexpr size_t al(size_t x) { return (x + 4095) & ~(size_t)4095; }
constexpr size_t WS_CTL = 0, CTL_ZERO_BYTES = 64 * 1024;
constexpr size_t WS_ROPE = 1 * MiB;
constexpr size_t WS_WIN = 2 * MiB;
constexpr size_t SZ_WIN1 = (size_t)2 * DFF * DM * 2;
constexpr size_t WS_WOUT = WS_WIN + 4 * SZ_WIN1;
constexpr size_t SZ_WOUT1 = (size_t)DM * DFF * 2;
constexpr size_t WS_WDOWN = WS_WOUT + 4 * SZ_WOUT1;
constexpr size_t WS_WUQ = WS_WDOWN + (size_t)DDOWN_P * DM * 2;
constexpr size_t WS_WUKT = WS_WUQ + (size_t)NH * QKD * QL * 2;
constexpr size_t WS_WUK = WS_WUKT + (size_t)NH * NOPE * KVL * 2;
constexpr size_t WS_WUVT = WS_WUK + (size_t)NH * NOPE * KVL * 2;
constexpr size_t WS_WOT = WS_WUVT + (size_t)(NH * VD + 128) * KVL * 2;
constexpr size_t WS_WGIN = WS_WOT + (size_t)DM * DM * 2;
constexpr size_t WS_WGO = WS_WGIN + (size_t)GIN_P * DM * 2;
constexpr size_t WS_ACT = al(WS_WGO + (size_t)DM * DM * 2);
constexpr size_t WS_XN = WS_ACT;
constexpr size_t WS_HM = al(WS_XN + (size_t)M * DM * 2);
constexpr size_t WS_T = al(WS_HM + (size_t)M * DFF * 2);
constexpr size_t WS_D = al(WS_T + (size_t)M * DM * 4);
constexpr size_t WS_CQ = al(WS_D + (size_t)M * DDOWN_P * 4);
constexpr size_t WS_CKV = al(WS_CQ + (size_t)M * QL * 2);
constexpr size_t WS_KPES = al(WS_CKV + (size_t)M * KVL * 2);
constexpr size_t WS_Q = al(WS_KPES + (size_t)MS * ROPE * 2);
constexpr size_t WS_KB = al(WS_Q + (size_t)M * NH * QKD * 2);
constexpr size_t WS_KPEP = al(WS_KB + (size_t)MP * NH * NOPE * 2);
constexpr size_t WS_VT = al(WS_KPEP + (size_t)MP * ROPE * 2);
constexpr size_t WS_QLAT = al(WS_VT + (size_t)NH * VD * MP * 2);
constexpr size_t WS_O = al(WS_QLAT + (size_t)MS * NH * 320 * 2);
constexpr size_t WS_OPART = al(WS_O + (size_t)M * DM * 2);
constexpr size_t WS_OML = al(WS_OPART + (size_t)DECB * 2 * 64 * 256 * 4);
constexpr size_t WS_OLAT = al(WS_OML + (size_t)DECB * 2 * 64 * 2 * 4);
constexpr size_t WS_QKVG = al(WS_OLAT + (size_t)MS * NH * KVL * 2);
constexpr size_t WS_T16 = al(WS_QKVG + (size_t)M * GIN * 2);
constexpr size_t WS_GO = al(WS_T16 + (size_t)M * 16 * 4);
constexpr size_t WS_H = al(WS_GO + (size_t)M * DM * 4);
constexpr size_t WS_TP = al(WS_H + (size_t)M * DM * 2);
constexpr size_t WS_GQT = al(WS_TP + (size_t)11 * MS * DM * 4);
constexpr size_t WS_GKH = al(WS_GQT + (size_t)M * GH * GDK * 2);
constexpr size_t WS_GAT = al(WS_GKH + (size_t)(M / 64) * GH * 128 * 64 * 2);
constexpr size_t WS_GDK = al(WS_GAT + (size_t)(M / 64) * GH * 3072 * 2);
constexpr size_t WS_END = al(WS_GDK + (size_t)(M / 64) * GH * 1024 * 4);

constexpr int RING_BYTES = 131072;
constexpr int LDSCTL_OFF = RING_BYTES, MISC_OFF = LDSCTL_OFF + 320;
constexpr int LDS_BYTES = 147456;
constexpr int NWAVES = 8;

#define LDS_WAIT() asm volatile("s_waitcnt lgkmcnt(0)" ::: "memory")
#define VM_WAIT() asm volatile("s_waitcnt vmcnt(0)" ::: "memory")
#define RLX_AGENT __ATOMIC_RELAXED, __HIP_MEMORY_SCOPE_AGENT

typedef __bf16 bf16x2_t __attribute__((ext_vector_type(2)));
__device__ __forceinline__ unsigned cvt_pk_bf16(float lo, float hi) { const f32x2 v = {lo, hi}; const bf16x2_t b = __builtin_convertvector(v, bf16x2_t); return __builtin_bit_cast(unsigned, b); }
__device__ __forceinline__ int lane_now() { int l; asm volatile("v_mbcnt_lo_u32_b32 %0, -1, 0\n\tv_mbcnt_hi_u32_b32 %0, -1, %0" : "=v"(l)); return l; }
__device__ __forceinline__ float bf2f(unsigned short b) { return __uint_as_float((unsigned)b << 16); }
template <int CTRL> __device__ __forceinline__ float dpp_mov(float v) { return __builtin_bit_cast(float, __builtin_amdgcn_update_dpp(0, __builtin_bit_cast(int, v), CTRL, 0xF, 0xF, true)); }
__device__ __forceinline__ float wave_sum(float v) {
    v += dpp_mov<0xB1>(v);
    v += dpp_mov<0x4E>(v);
    v += dpp_mov<0x141>(v);
    v += dpp_mov<0x140>(v);
    const int iv = __builtin_bit_cast(int, v);
    const float a = __builtin_bit_cast(float, __builtin_amdgcn_readlane(iv, 0)), b = __builtin_bit_cast(float, __builtin_amdgcn_readlane(iv, 16));
    const float c = __builtin_bit_cast(float, __builtin_amdgcn_readlane(iv, 32)), d = __builtin_bit_cast(float, __builtin_amdgcn_readlane(iv, 48));
    return (a + b) + (c + d);
}

namespace pg8 {
constexpr int BM = 256, BK = 64, HALF = 128, HTB = HALF * BK * 2, STAGE_BYTES = 8 * HTB, NXCD = 8, WGM = 8;
__host__ __device__ __forceinline__ int lds_byte(int r, int c) { const int st = (r >> 4) * 2 + (c >> 5), rr = r & 15, cc = c & 31, ob = rr * 64 + cc * 2; return st * 1024 + (ob ^ (((ob >> 9) & 1) << 5)); }
__host__ __device__ __forceinline__ void stage_rc(int b, int& R, int& C) { const int st = b / 1024, sb = b % 1024, swz = sb ^ (((sb >> 9) & 1) << 5); R = (st >> 1) * 16 + swz / 64; C = (st & 1) * 32 + (swz % 64) / 2; }
__host__ __device__ __forceinline__ int perm32(int rho) { const int n = rho >> 4, i = rho & 15; return 8 * (i >> 2) + 4 * n + (i & 3); }

struct Unit { int pm, pn, z; };
struct Gemm { const bf16_t* A; const bf16_t* Bt; int lda, ldb, K; long sAz, sBz; };

struct Order {
    int nM, nN, nZ, G, c;
    __device__ __forceinline__ bool next(int i, Unit& u) const {
        const long L = (long)i * G + c; const int per = nM * nN; if (L >= (long)per * nZ) return false;
        const int z = (int)(L / per); int wgid = (int)(L - (long)z * per);
        { const int q = per / NXCD, r = per % NXCD, xcd = wgid % NXCD, off = wgid / NXCD; wgid = (xcd < r ? xcd * (q + 1) : r * (q + 1) + (xcd - r) * q) + off; }
        const int nig = WGM * nN, gid = wgid / nig, fm = gid * WGM, gsz = (nM - fm) < WGM ? (nM - fm) : WGM;
        u.pm = fm + ((wgid % nig) % gsz); u.pn = (wgid % nig) / gsz; u.z = z; return true;
    }
};

struct OrderOff {
    Order o; int m0;
    __device__ __forceinline__ bool next(int i, Unit& u) const { const bool ok = o.next(i, u); u.pm += m0; return ok; }
};

template <class Epi, bool ALIGN_EPI, class Ord = Order>
__device__ __forceinline__ void gemm_phase(LAS unsigned char* lds, const int wid, const Gemm g, const Ord& S, const Epi& E) {
    const int lane = lane_now(), tid = wid * 64 + lane;
    const int wr = wid >> 2, wc = wid & 3, fr = lane & 15, fq = lane >> 4;
    const int K = g.K, nt = K / BK;
    unsigned voffA, voffB;
    { int R, C; stage_rc(tid * 16, R, C); const int Rb = Epi::PERM ? ((R & ~31) + perm32(R & 31)) : R;
      voffA = (unsigned)(R * g.lda + C) * 2u; voffB = (unsigned)(Rb * g.ldb + C) * 2u; }
    const size_t qsA = (size_t)64 * g.lda * 2, qsB = (size_t)64 * g.ldb * 2;
    const size_t kstep = (size_t)(BK * 2);
    const size_t hsA = (size_t)HALF * g.lda * 2, hsB = (size_t)HALF * g.ldb * 2;
    const unsigned ldsw = (unsigned)wid * 1024u;
    const int aoff = lds_byte(wr * 64 + fr, fq * 8), boff = lds_byte(wc * 32 + fr, fq * 8);
#define PG8_SA(b, h) (((b) * 2 + (h)) * HTB)
#define PG8_SB(b, h) ((4 + (b) * 2 + (h)) * HTB)
#define PG8_STAGE(bufoff, gbase, voff) do { _Pragma("unroll") for (int _i = 0; _i < 2; ++_i) \
        __builtin_amdgcn_global_load_lds((const unsigned*)((const char*)(gbase) + _i * PG8_QS_##voff + (voff)), (LAS unsigned*)(lds + (bufoff) + ldsw + _i * 8192), 16, 0, 0); } while (0)
#define PG8_QS_voffA qsA
#define PG8_QS_voffB qsB
#define PG8_LDA(dst, b, h) do { _Pragma("unroll") for (int m = 0; m < 4; ++m) _Pragma("unroll") for (int k = 0; k < 2; ++k) dst[m][k] = *(const LAS bf16x8*)(lds + PG8_SA(b, h) + aoff + m * 2048 + k * 1024); } while (0)
#define PG8_LDB(dst, b, h) do { _Pragma("unroll") for (int n = 0; n < 2; ++n) _Pragma("unroll") for (int k = 0; k < 2; ++k) dst[n][k] = *(const LAS bf16x8*)(lds + PG8_SB(b, h) + boff + n * 2048 + k * 1024); } while (0)
#define PG8_MMA(ai, bj, At, Bt) do { __builtin_amdgcn_s_setprio(1); _Pragma("unroll") for (int m = 0; m < 4; ++m) _Pragma("unroll") for (int n = 0; n < 2; ++n) _Pragma("unroll") for (int k = 0; k < 2; ++k) \
        acc[ai][bj][m][n] = __builtin_amdgcn_mfma_f32_16x16x32_bf16(Bt[n][k], At[m][k], acc[ai][bj][m][n], 0, 0, 0); __builtin_amdgcn_s_setprio(0); } while (0)
#define PG8_WAIT_V(n) asm volatile("s_waitcnt vmcnt(" #n ")" ::: "memory")
#define PG8_WAIT_L(n) asm volatile("s_waitcnt lgkmcnt(" #n ")" ::: "memory")
#define PG8_BAR __builtin_amdgcn_s_barrier()
#define PG8_SCHED __builtin_amdgcn_sched_barrier(0)
#define PG8_APTR(u) ((const char*)g.A + ((size_t)(u).z * g.sAz + (size_t)(u).pm * BM * g.lda) * 2)
#define PG8_BPTR(u) ((const char*)g.Bt + ((size_t)(u).z * g.sBz + (size_t)(u).pn * BM * g.ldb) * 2)
    Unit cur, nxt; int ui = 0;
    if (!S.next(0, cur)) return;
    f32x4 acc[2][2][4][2];
#pragma unroll
    for (int a = 0; a < 2; ++a)
#pragma unroll
        for (int b = 0; b < 2; ++b)
#pragma unroll
            for (int m = 0; m < 4; ++m)
#pragma unroll
                for (int n = 0; n < 2; ++n) acc[a][b][m][n] = (f32x4){0.f, 0.f, 0.f, 0.f};
    bf16x8 At[4][2], B0[2][2], B1[2][2];
    const char* cA = PG8_APTR(cur); const char* cB = PG8_BPTR(cur);
    PG8_STAGE(PG8_SB(0, 0), cB, voffB); PG8_STAGE(PG8_SB(0, 1), cB + hsB, voffB); PG8_STAGE(PG8_SA(0, 0), cA, voffA); PG8_STAGE(PG8_SA(0, 1), cA + hsA, voffA);
    if (wr == 1) PG8_BAR;
    PG8_WAIT_V(2); PG8_BAR;
    PG8_STAGE(PG8_SB(1, 0), cB + kstep, voffB); PG8_STAGE(PG8_SA(1, 0), cA + kstep, voffA); PG8_STAGE(PG8_SB(1, 1), cB + hsB + kstep, voffB);
    PG8_WAIT_V(6); PG8_BAR;
    for (;;) {
        const bool has_next = S.next(ui + 1, nxt);
        const char* nA = has_next ? PG8_APTR(nxt) : cA; const char* nB = has_next ? PG8_BPTR(nxt) : cB;
#pragma unroll 1
        for (int t = 0; t < nt; t += 2) {
            const bool last = (t == nt - 2);
            const char* a1 = cA + (size_t)(t + 1) * kstep;
            const char* a2 = last ? nA : cA + (size_t)(t + 2) * kstep; const char* b2 = last ? nB : cB + (size_t)(t + 2) * kstep;
            const char* a3 = a2 + kstep; const char* b3 = b2 + kstep;
            PG8_LDB(B0, 0, 0); PG8_LDB(B1, 0, 1); PG8_SCHED; PG8_LDA(At, 0, 0); PG8_STAGE(PG8_SA(1, 1), a1 + hsA, voffA);
            PG8_WAIT_V(8); PG8_WAIT_L(0); PG8_BAR; PG8_MMA(0, 0, At, B0); PG8_MMA(0, 1, At, B1); PG8_BAR; PG8_SCHED;
            PG8_LDA(At, 0, 1); PG8_STAGE(PG8_SB(0, 0), b2, voffB); PG8_STAGE(PG8_SB(0, 1), b2 + hsB, voffB); PG8_STAGE(PG8_SA(0, 0), a2, voffA);
            PG8_WAIT_V(8); PG8_WAIT_L(0); PG8_BAR; PG8_MMA(1, 0, At, B0); PG8_MMA(1, 1, At, B1); PG8_BAR; PG8_SCHED;
            PG8_LDB(B0, 1, 0); PG8_LDB(B1, 1, 1); PG8_SCHED; PG8_LDA(At, 1, 0); PG8_STAGE(PG8_SA(0, 1), a2 + hsA, voffA);
            PG8_WAIT_V(8); PG8_WAIT_L(0); PG8_BAR; PG8_MMA(0, 0, At, B0); PG8_MMA(0, 1, At, B1); PG8_BAR; PG8_SCHED;
            PG8_LDA(At, 1, 1); PG8_STAGE(PG8_SB(1, 0), b3, voffB); PG8_STAGE(PG8_SB(1, 1), b3 + hsB, voffB); PG8_STAGE(PG8_SA(1, 0), a3, voffA);
            PG8_WAIT_V(8); PG8_WAIT_L(0); PG8_BAR; PG8_MMA(1, 0, At, B0); PG8_MMA(1, 1, At, B1); PG8_BAR; PG8_SCHED;
        }
        if constexpr (ALIGN_EPI) { if (wr == 0) PG8_BAR; }
        { int fr2 = fr, fq2 = fq; asm volatile("" : "+v"(fr2), "+v"(fq2)); E(acc, cur, wr, wc, fr2, fq2); }
        if (!has_next) break;
#pragma unroll
        for (int a = 0; a < 2; ++a)
#pragma unroll
            for (int b = 0; b < 2; ++b)
#pragma unroll
                for (int m = 0; m < 4; ++m)
#pragma unroll
                    for (int n = 0; n < 2; ++n) acc[a][b][m][n] = (f32x4){0.f, 0.f, 0.f, 0.f};
        cur = nxt; cA = nA; cB = nB; ++ui;
        if constexpr (ALIGN_EPI) { if (wr == 1) PG8_BAR; }
    }
    PG8_WAIT_V(0);
    if constexpr (!ALIGN_EPI) { if (wr == 0) PG8_BAR; }
    PG8_BAR;
#undef PG8_SA
#undef PG8_SB
#undef PG8_STAGE
#undef PG8_QS_voffA
#undef PG8_QS_voffB
#undef PG8_LDA
#undef PG8_LDB
#undef PG8_MMA
#undef PG8_WAIT_V
#undef PG8_WAIT_L
#undef PG8_BAR
#undef PG8_SCHED
#undef PG8_APTR
#undef PG8_BPTR
}

__device__ __forceinline__ float silu_f(float g) { return g * __builtin_amdgcn_rcpf(1.0f + __builtin_amdgcn_exp2f(-g * LOG2E)); }
__device__ __forceinline__ float swiglu_f(float g, float u) { return (g * u) * __builtin_amdgcn_rcpf(1.0f + __builtin_amdgcn_exp2f(-g)); }

struct EpiSwiGLU {
    static constexpr bool PERM = true;
    bf16_t* O; int ldc;
    __device__ __forceinline__ void operator()(const f32x4 (&acc)[2][2][4][2], const Unit& u, int wr, int wc, int fr, int fq) const {
        const int row0 = u.pm * BM + wr * 64 + fr, col0 = u.pn * HALF + wc * 32 + 8 * fq;
#pragma unroll
        for (int ai = 0; ai < 2; ++ai)
#pragma unroll
            for (int m = 0; m < 4; ++m) {
                bf16_t* rowp = O + (size_t)(row0 + ai * HALF + m * 16) * ldc + col0;
                const f32x4 g0 = acc[ai][0][m][0], g1 = acc[ai][0][m][1], u0 = acc[ai][1][m][0], u1 = acc[ai][1][m][1];
                u32x4 w;
                w.x = cvt_pk_bf16(swiglu_f(g0[0], u0[0]), swiglu_f(g0[1], u0[1])); w.y = cvt_pk_bf16(swiglu_f(g0[2], u0[2]), swiglu_f(g0[3], u0[3]));
                w.z = cvt_pk_bf16(swiglu_f(g1[0], u1[0]), swiglu_f(g1[1], u1[1])); w.w = cvt_pk_bf16(swiglu_f(g1[2], u1[2]), swiglu_f(g1[3], u1[3]));
                *(u32x4*)rowp = w;
            }
    }
};
struct EpiF32 {
    static constexpr bool PERM = false;
    float* O; int ldc; long sOz;
    __device__ __forceinline__ void operator()(const f32x4 (&acc)[2][2][4][2], const Unit& u, int wr, int wc, int fr, int fq) const {
        const int row0 = u.pm * BM + wr * 64 + fr, col0 = u.pn * BM + wc * 32 + 4 * fq;
#pragma unroll
        for (int ai = 0; ai < 2; ++ai)
#pragma unroll
            for (int m = 0; m < 4; ++m) {
                float* rowp = O + (size_t)u.z * sOz + (size_t)(row0 + ai * HALF + m * 16) * ldc + col0;
#pragma unroll
                for (int bj = 0; bj < 2; ++bj)
#pragma unroll
                    for (int n = 0; n < 2; ++n) *(f32x4*)(rowp + bj * HALF + n * 16) = acc[ai][bj][m][n];
            }
    }
};

template <int CMAP> struct EpiBf16 {
    static constexpr bool PERM = true;
    bf16_t* O; int ldc; long sOz; int ncol; float scale; int scale_cols;
    __device__ __forceinline__ void operator()(const f32x4 (&acc)[2][2][4][2], const Unit& u, int wr, int wc, int fr, int fq) const {
        const int row0 = u.pm * BM + wr * 64 + fr;
#pragma unroll
        for (int bj = 0; bj < 2; ++bj) {
            const int ct = bj * HALF + wc * 32 + 8 * fq; if (ct >= ncol) continue;
            const int c0 = u.pn * BM + ct; const int oc = CMAP == 1 ? (c0 >> 7) * 192 + (c0 & 127) : c0;
            const float sc = c0 < scale_cols ? scale : 1.f;
            bf16_t* base = O + (size_t)u.z * sOz + oc;
#pragma unroll
            for (int ai = 0; ai < 2; ++ai)
#pragma unroll
                for (int m = 0; m < 4; ++m) { const f32x4 v0 = acc[ai][bj][m][0] * sc, v1 = acc[ai][bj][m][1] * sc;
                    u32x4 w; w.x = cvt_pk_bf16(v0[0], v0[1]); w.y = cvt_pk_bf16(v0[2], v0[3]); w.z = cvt_pk_bf16(v1[0], v1[1]); w.w = cvt_pk_bf16(v1[2], v1[3]);
                    *(u32x4*)(base + (size_t)(row0 + ai * HALF + m * 16) * ldc) = w; }
        }
    }
};
struct EpiQ {
    static constexpr bool PERM = true;
    bf16_t* O; const float* rope_t; float scale;
    __device__ __forceinline__ void operator()(const f32x4 (&acc)[2][2][4][2], const Unit& u, int wr, int wc, int fr, int fq) const {
        const int row0 = u.pm * BM + wr * 64 + fr;
#pragma unroll
        for (int bj = 0; bj < 2; ++bj) {
            const int c0 = u.pn * BM + bj * HALF + wc * 32 + 8 * fq; const int h = c0 / 192, f0 = c0 - h * 192;
            if (f0 < 128) {
#pragma unroll
                for (int ai = 0; ai < 2; ++ai)
#pragma unroll
                    for (int m = 0; m < 4; ++m) { const f32x4 v0 = acc[ai][bj][m][0] * scale, v1 = acc[ai][bj][m][1] * scale;
                        u32x4 w; w.x = cvt_pk_bf16(v0[0], v0[1]); w.y = cvt_pk_bf16(v0[2], v0[3]); w.z = cvt_pk_bf16(v1[0], v1[1]); w.w = cvt_pk_bf16(v1[2], v1[3]);
                        *(u32x4*)(O + (size_t)(row0 + ai * HALF + m * 16) * 1536 + c0) = w; }
            } else {
                const int a4 = ((f0 - 128) >> 3) * 4;
#pragma unroll
                for (int ai = 0; ai < 2; ++ai)
#pragma unroll
                    for (int m = 0; m < 4; ++m) { const int r = row0 + ai * HALF + m * 16; const int pidx = r < MP ? (r & (SEQ - 1)) : SEQ + ((r - MP) & (DECT - 1));
                        const f32x4 cs0 = *(const f32x4*)(rope_t + (size_t)(pidx * 32 + a4) * 2), cs1 = *(const f32x4*)(rope_t + (size_t)(pidx * 32 + a4) * 2 + 4);
                        const f32x4 x1 = acc[ai][bj][m][0] * scale, x2 = acc[ai][bj][m][1] * scale;
                        const float y10 = x1[0] * cs0[0] - x2[0] * cs0[1], y11 = x1[1] * cs0[2] - x2[1] * cs0[3], y12 = x1[2] * cs1[0] - x2[2] * cs1[1], y13 = x1[3] * cs1[2] - x2[3] * cs1[3];
                        const float y20 = x2[0] * cs0[0] + x1[0] * cs0[1], y21 = x2[1] * cs0[2] + x1[1] * cs0[3], y22 = x2[2] * cs1[0] + x1[2] * cs1[1], y23 = x2[3] * cs1[2] + x1[3] * cs1[3];
                        bf16_t* rowp = O + (size_t)r * 1536 + h * 192 + 128 + a4;
                        u32x2 w1, w2; w1.x = cvt_pk_bf16(y10, y11); w1.y = cvt_pk_bf16(y12, y13); w2.x = cvt_pk_bf16(y20, y21); w2.y = cvt_pk_bf16(y22, y23);
                        *(u32x2*)rowp = w1; *(u32x2*)(rowp + 32) = w2; asm volatile("" ::: "memory"); }
            }
        }
    }
};

struct EpiGla {
    static constexpr bool PERM = true;
    bf16_t* O; float* T16; float qscale;
    __device__ __forceinline__ void operator()(const f32x4 (&acc)[2][2][4][2], const Unit& u, int wr, int wc, int fr, int fq) const {
        const int row0 = u.pm * BM + wr * 64 + fr;
        if (u.pn < 12) {
#pragma unroll
            for (int bj = 0; bj < 2; ++bj) {
                const int c0 = u.pn * BM + bj * HALF + wc * 32 + 8 * fq; const float sc = c0 < 512 ? qscale : 1.f;
#pragma unroll
                for (int ai = 0; ai < 2; ++ai)
#pragma unroll
                    for (int m = 0; m < 4; ++m) { const f32x4 v0 = acc[ai][bj][m][0] * sc, v1 = acc[ai][bj][m][1] * sc;
                        u32x4 w; w.x = cvt_pk_bf16(v0[0], v0[1]); w.y = cvt_pk_bf16(v0[2], v0[3]); w.z = cvt_pk_bf16(v1[0], v1[1]); w.w = cvt_pk_bf16(v1[2], v1[3]);
                        *(u32x4*)(O + (size_t)(row0 + ai * HALF + m * 16) * GIN + c0) = w; }
            }
        } else if (wc == 0 && fq < 2) {
#pragma unroll
            for (int ai = 0; ai < 2; ++ai)
#pragma unroll
                for (int m = 0; m < 4; ++m) { float* tp = T16 + (size_t)(row0 + ai * HALF + m * 16) * 16 + 8 * fq;
                    *(f32x4*)tp = acc[ai][0][m][0]; *(f32x4*)(tp + 4) = acc[ai][0][m][1]; }
        }
    }
};
}

#define XB_TMO      128
#define XB_XCNT(j)  (256  + 64 * (j))
#define XB_XSUB(j)  (1280 + 64 * (j))
#define XB_XGEN(j)  (2304 + 64 * (j))
#define XB_TOP      3328
#define XB_TOPGEN   3392
#define XCD_BAR_WORDS 3456
#define XB_SPIN_CAP (1u << 18)

__device__ __forceinline__ unsigned xb_ld(unsigned* p)              { return __hip_atomic_load(p, __ATOMIC_RELAXED, __HIP_MEMORY_SCOPE_AGENT); }
__device__ __forceinline__ unsigned xb_add(unsigned* p, unsigned v) { return __hip_atomic_fetch_add(p, v, __ATOMIC_RELAXED, __HIP_MEMORY_SCOPE_AGENT); }
__device__ __forceinline__ unsigned xb_xcc_id() { return (unsigned)__builtin_amdgcn_s_getreg((3 << 11) | 20) & 0xFu; }
#define XB_SPIN(cond, bar) do { unsigned _sp = 0; while (cond) { __builtin_amdgcn_s_sleep(1); \
    if ((++_sp & 255u) == 0u) { if (xb_ld(&(bar)[XB_TMO])) break; if (_sp > XB_SPIN_CAP) { atomicAdd(&(bar)[XB_TMO], 1u); break; } } } } while (0)

struct XcdBarrier { unsigned* bar; unsigned x; volatile LAS unsigned* st; };

__device__ __forceinline__ XcdBarrier xcd_barrier_post(unsigned* bar, volatile LAS unsigned* st, bool t0) {
    XcdBarrier b; b.bar = bar; b.x = xb_xcc_id(); b.st = st;
    if (t0) (void)xb_add(&bar[XB_XCNT(b.x)], 1u);
    return b;
}
__device__ __forceinline__ void xcd_barrier_complete(unsigned* bar, unsigned x, unsigned& nloc, unsigned& nx) {
    const unsigned G = gridDim.x * gridDim.y * gridDim.z;
    unsigned sum, cnt, mine, sp = 0u;
    for (;;) {
        sum = 0u; cnt = 0u; mine = 0u;
#pragma unroll
        for (unsigned j = 0; j < 16; ++j) { const unsigned c = xb_ld(&bar[XB_XCNT(j)]); sum += c; cnt += (c > 0u) ? 1u : 0u; mine = (j == x) ? c : mine; }
        if (sum == G) break;
        __builtin_amdgcn_s_sleep(1);
        if ((++sp & 255u) == 0u) { if (xb_ld(&bar[XB_TMO])) break; if (sp > XB_SPIN_CAP) { atomicAdd(&bar[XB_TMO], 1u); break; } }
    }
    nloc = mine > 0u ? mine : 1u; nx = cnt > 0u ? cnt : 1u;
}
__device__ __forceinline__ void xcd_barrier(const XcdBarrier& b, bool t0) {
    asm volatile("s_waitcnt vmcnt(0)" ::: "memory");
    __syncthreads();
    if (t0) {
        unsigned* bar = b.bar;
        __builtin_amdgcn_s_waitcnt(0);
        unsigned nloc = b.st[0], nx = b.st[1];
        if (nloc == 0u) { xcd_barrier_complete(bar, b.x, nloc, nx); b.st[0] = nloc; b.st[1] = nx; }
        const unsigned old = xb_add(&bar[XB_XSUB(b.x)], 1u);
        const unsigned gen = old / nloc;
        if (old + 1u == (gen + 1u) * nloc) {
            __builtin_amdgcn_fence(__ATOMIC_RELEASE, "agent");
            asm volatile("s_waitcnt vmcnt(0)" ::: "memory");
            const unsigned og = xb_add(&bar[XB_TOP], 1u);
            const unsigned tg = og / nx;
            if (og + 1u == (tg + 1u) * nx) xb_add(&bar[XB_TOPGEN], 1u);
            else XB_SPIN(xb_ld(&bar[XB_TOPGEN]) == tg, bar);
            __builtin_amdgcn_fence(__ATOMIC_ACQUIRE, "agent");
            xb_add(&bar[XB_XGEN(b.x)], 1u);
            asm volatile("s_waitcnt vmcnt(0)" ::: "memory");
        } else {
            XB_SPIN(xb_ld(&bar[XB_XGEN(b.x)]) == gen, bar);
            __builtin_amdgcn_fence(__ATOMIC_ACQUIRE, "agent");
            asm volatile("s_waitcnt vmcnt(0)" ::: "memory");
        }
    }
    __syncthreads();
}

struct Args { const void* in[22]; float* out; unsigned char* ws; int ph_lo, ph_hi; };

struct Frame {
    LAS unsigned char* lds;
    int tid, lane, wave, vcu, G;
    const float* const* dummy;
};

__device__ __forceinline__ void transpose_item(const float* W, int N, int k0, int n0, bf16_t* WT, int KT, int drow0, int interleave, LAS float* scr, int lane, float sc = 1.0f) {
    f32x4 v[8];
    const float* src = W + (size_t)(k0 + (lane >> 3)) * N + n0 + 4 * (lane & 7);
#pragma unroll
    for (int i = 0; i < 8; ++i) v[i] = *(const f32x4*)(src + (size_t)(8 * i) * N);
#pragma unroll
    for (int i = 0; i < 8; ++i) { LAS float* d = scr + (8 * i + (lane >> 3)) * 33 + 4 * (lane & 7); d[0] = v[i][0]; d[1] = v[i][1]; d[2] = v[i][2]; d[3] = v[i][3]; }
    LDS_WAIT(); asm volatile("" ::: "memory");
    const int c = lane & 7;
#pragma unroll
    for (int j = 0; j < 4; ++j) { const int n = (lane >> 3) + 8 * j; const LAS float* s = scr + (8 * c) * 33 + n;
        u32x4 o; o.x = cvt_pk_bf16(s[0 * 33] * sc, s[1 * 33] * sc); o.y = cvt_pk_bf16(s[2 * 33] * sc, s[3 * 33] * sc); o.z = cvt_pk_bf16(s[4 * 33] * sc, s[5 * 33] * sc); o.w = cvt_pk_bf16(s[6 * 33] * sc, s[7 * 33] * sc);
        const int drow = interleave ? (drow0 + 8 * (n >> 2) + (n & 3)) : (drow0 + n);
        *(u32x4*)(WT + (size_t)drow * KT + k0 + 8 * c) = o; }
    LDS_WAIT(); asm volatile("" ::: "memory");
}

struct ConvPtrs { const float *w_in, *w_out, *w_down, *w_uq, *w_uk, *w_uv, *w_o, *g_in, *g_o; bf16_t *WIN, *WOUT, *WDOWN, *WUQ, *WUKT, *WUVT, *WOT, *WGIN, *WGO; };
constexpr int I_WIN = (DM / 64) * (2 * DFF / 32);
constexpr int I_WOUT = (DFF / 64) * (DM / 32);
constexpr int I_DOWN = (DM / 64) * (DDOWN / 32);
constexpr int I_UQ = (QL / 64) * (NH * QKD / 32);
constexpr int I_UK = (KVL / 64) * (NH * NOPE / 32);
constexpr int I_UV = I_UK;
constexpr int I_O = (DM / 64) * (DM / 32);
constexpr int I_GIN = (DM / 64) * (GIN / 32);
constexpr int I_GO = I_O;
template <int SEG> __device__ __forceinline__ void conv_segment(const ConvPtrs& P, int widx, int nw, LAS float* scr, int lane) {
    constexpr int mi = SEG;
    constexpr int NIT = I_WIN + I_WOUT + (SEG == 1 ? I_DOWN + I_UQ + I_UK + I_UV + I_O : SEG == 2 ? I_GIN + I_GO : 0);
    for (int it = widx; it < NIT; it += nw) {
        int r = it;
        if (r < I_WIN) { const int nblk = 2 * DFF / 32, kb = r / nblk, nb = r % nblk, n0 = nb * 32;
            const int drow0 = n0 < DFF ? 256 * (n0 / 128) + (n0 % 128) : 256 * ((n0 - DFF) / 128) + 128 + ((n0 - DFF) % 128);
            transpose_item(P.w_in + (size_t)mi * DM * 2 * DFF, 2 * DFF, kb * 64, n0, P.WIN + (size_t)mi * 2 * DFF * DM, DM, drow0, 0, scr, lane, n0 < DFF ? LOG2E : 1.0f / LOG2E); continue; } r -= I_WIN;
        if (r < I_WOUT) { const int nblk = DM / 32, kb = r / nblk, nb = r % nblk;
            transpose_item(P.w_out + (size_t)mi * DFF * DM, DM, kb * 64, nb * 32, P.WOUT + (size_t)mi * DM * DFF, DFF, nb * 32, 0, scr, lane); continue; } r -= I_WOUT;
        if constexpr (SEG == 1) {
            if (r < I_DOWN) { const int nblk = DDOWN / 32, kb = r / nblk, nb = r % nblk;
                transpose_item(P.w_down, DDOWN, kb * 64, nb * 32, P.WDOWN, DM, nb * 32, 0, scr, lane); continue; } r -= I_DOWN;
            if (r < I_UQ) { const int nblk = NH * QKD / 32, kb = r / nblk, nb = r % nblk, n0 = nb * 32, h = n0 / QKD, f = n0 % QKD;
                if (f < NOPE) transpose_item(P.w_uq, NH * QKD, kb * 64, n0, P.WUQ, QL, n0, 0, scr, lane);
                else transpose_item(P.w_uq, NH * QKD, kb * 64, n0, P.WUQ, QL, h * QKD + NOPE + (f == NOPE ? 0 : 4), 1, scr, lane);
                continue; } r -= I_UQ;
            if (r < I_UK) { const int nblk = NH * NOPE / 32, kb = r / nblk, nb = r % nblk;
                transpose_item(P.w_uk, NH * NOPE, kb * 64, nb * 32, P.WUKT, KVL, nb * 32, 0, scr, lane); continue; } r -= I_UK;
            if (r < I_UV) { const int nblk = NH * VD / 32, kb = r / nblk, nb = r % nblk;
                transpose_item(P.w_uv, NH * VD, kb * 64, nb * 32, P.WUVT, KVL, nb * 32, 0, scr, lane); continue; } r -= I_UV;
            { const int nblk = DM / 32, kb = r / nblk, nb = r % nblk;
                transpose_item(P.w_o, DM, kb * 64, nb * 32, P.WOT, DM, nb * 32, 0, scr, lane); }
        }
        if constexpr (SEG == 2) {
            if (r < I_GIN) { const int nblk = GIN / 32, kb = r / nblk, nb = r % nblk;
                transpose_item(P.g_in, GIN, kb * 64, nb * 32, P.WGIN, DM, nb * 32, 0, scr, lane); continue; } r -= I_GIN;
            { const int nblk = DM / 32, kb = r / nblk, nb = r % nblk;
                transpose_item(P.g_o, DM, kb * 64, nb * 32, P.WGO, DM, nb * 32, 0, scr, lane); }
        }
    }
}

struct Row16 { f32x4 v[4]; };
__device__ __forceinline__ Row16 ld_row(const float* p, int lane) { Row16 r; const f32x4* q = (const f32x4*)p + lane;
#pragma unroll
    for (int j = 0; j < 4; ++j) r.v[j] = q[64 * j]; return r; }
__device__ __forceinline__ Row16 ld_row_bf16(const bf16_t* p, int lane) { Row16 r; const u32x2* q = (const u32x2*)p + lane;
#pragma unroll
    for (int j = 0; j < 4; ++j) { const u32x2 w = q[64 * j]; r.v[j][0] = __uint_as_float(w.x << 16); r.v[j][1] = __uint_as_float(w.x & 0xffff0000u); r.v[j][2] = __uint_as_float(w.y << 16); r.v[j][3] = __uint_as_float(w.y & 0xffff0000u); } return r; }
__device__ __forceinline__ float row_ss(const Row16& r) { float s = 0.f;
#pragma unroll
    for (int j = 0; j < 4; ++j) s += (r.v[j][0] * r.v[j][0] + r.v[j][1] * r.v[j][1]) + (r.v[j][2] * r.v[j][2] + r.v[j][3] * r.v[j][3]); return wave_sum(s); }
__device__ __forceinline__ void st_row_bf16(bf16_t* p, const Row16& r, int lane) { u32x2* q = (u32x2*)p + lane;
#pragma unroll
    for (int j = 0; j < 4; ++j) { u32x2 w; w.x = cvt_pk_bf16(r.v[j][0], r.v[j][1]); w.y = cvt_pk_bf16(r.v[j][2], r.v[j][3]); q[64 * j] = w; } }
__device__ __forceinline__ void st_row_f32(float* p, const Row16& r, int lane) { f32x4* q = (f32x4*)p + lane;
#pragma unroll
    for (int j = 0; j < 4; ++j) q[64 * j] = r.v[j]; }

template <bool HAS_T, bool HAS_PRE, bool SRC_X, bool FINAL>
__device__ __forceinline__ void thin_phase(int gw, int NGW, const float* xp, const float* xs, const bf16_t* T, const float* TP, int nsplit, bf16_t* H, float* Yout, bf16_t* XN, const float* gpost, const float* gpre, float scale) {
    const int lane = lane_now();
    Row16 gp, gq;
    if (HAS_T) gp = ld_row(gpost, lane);
    if (HAS_PRE) gq = ld_row(gpre, lane);
    const bool bal = HAS_T && NGW == 2 * MS && MP % NGW == 0;
    const int N1 = bal ? MP / NGW - (nsplit > 4 ? 2 : 1) : 0;
    for (int i = 0;; ++i) {
        int r;
        if (!bal) { r = gw + i * NGW; if (r >= M) break; }
        else if (i < N1) r = gw + i * NGW;
        else if (gw < MS) { if (i > N1) break; r = MP + gw; }
        else { r = N1 * NGW + (gw - MS) + (i - N1) * (NGW - MS); if (r >= MP) break; }
        Row16 h;
        if constexpr (SRC_X) h = ld_row(r < MP ? xp + (size_t)r * DM : xs + (size_t)(r - MP) * DM, lane); else h = ld_row_bf16(H + (size_t)r * DM, lane);
        if (HAS_T) {
            Row16 t;
            if (r < MP) t = ld_row_bf16(T + (size_t)r * DM, lane);
            else { const bf16_t* TPb = (const bf16_t*)TP; t = ld_row_bf16(TPb + (size_t)(r - MP) * DM, lane);
                int z = 1;
#pragma unroll 1
                for (; z + 1 < nsplit; z += 2) { const Row16 u0 = ld_row_bf16(TPb + ((size_t)z * MS + (r - MP)) * DM, lane), u1 = ld_row_bf16(TPb + ((size_t)(z + 1) * MS + (r - MP)) * DM, lane);
#pragma unroll
                    for (int j = 0; j < 4; ++j) t.v[j] = (t.v[j] + u0.v[j]) + u1.v[j]; }
                if (z < nsplit) { const Row16 u = ld_row_bf16(TPb + ((size_t)z * MS + (r - MP)) * DM, lane);
#pragma unroll
                    for (int j = 0; j < 4; ++j) t.v[j] = t.v[j] + u.v[j]; } }
            const float rs = scale * __builtin_amdgcn_rsqf(row_ss(t) * (1.0f / DM) + EPS);
#pragma unroll
            for (int j = 0; j < 4; ++j) h.v[j] = h.v[j] + (t.v[j] * rs) * gp.v[j];
            if constexpr (FINAL) st_row_f32(Yout + (size_t)r * DM, h, lane); else st_row_bf16(H + (size_t)r * DM, h, lane);
        }
        if (HAS_PRE) {
            const float rs = __builtin_amdgcn_rsqf(row_ss(h) * (1.0f / DM) + EPS);
#pragma unroll
            for (int j = 0; j < 4; ++j) h.v[j] = (h.v[j] * rs) * gq.v[j];
            st_row_bf16(XN + (size_t)r * DM, h, lane);
        }
    }
}

__device__ __forceinline__ int rope_pos_index(int r) { return r < MP ? (r & (SEQ - 1)) : SEQ + ((r - MP) & (DECT - 1)); }


typedef short s16x4 __attribute__((ext_vector_type(4)));
__device__ __forceinline__ int swap23(int x) { return (x & ~12) | ((x & 4) << 1) | ((x & 8) >> 1); }
__device__ __forceinline__ float half_max(float v) { auto rr = __builtin_amdgcn_permlane32_swap(__float_as_uint(v), __float_as_uint(v), false, false); return fmaxf(__uint_as_float(rr[0]), __uint_as_float(rr[1])); }
__device__ __forceinline__ float half_sum(float v) { auto rr = __builtin_amdgcn_permlane32_swap(__float_as_uint(v), __float_as_uint(v), false, false); return __uint_as_float(rr[0]) + __uint_as_float(rr[1]); }
__device__ __forceinline__ bf16x8 pack8(const f32x16& p, int o) {
    u32x4 w; w.x = cvt_pk_bf16(p[o + 0], p[o + 1]); w.y = cvt_pk_bf16(p[o + 2], p[o + 3]); w.z = cvt_pk_bf16(p[o + 4], p[o + 5]); w.w = cvt_pk_bf16(p[o + 6], p[o + 7]);
    return __builtin_bit_cast(bf16x8, w);
}
template <int NO>
__device__ __forceinline__ void softmax_step(f32x16& p0, f32x16& p1, float& m, float& lh, f32x16 (&o)[NO], bf16x8 (&pf)[4]) {
    float pm = fmaxf(p0[0], p1[0]);
#pragma unroll
    for (int r = 1; r < 16; ++r) pm = fmaxf(pm, fmaxf(p0[r], p1[r]));
    pm = half_max(pm);
    const float mn = fmaxf(m, pm), alpha = __builtin_amdgcn_exp2f(m - mn); m = mn;
    float rs = 0.f;
#pragma unroll
    for (int r = 0; r < 16; ++r) { p0[r] = __builtin_amdgcn_exp2f(p0[r] - mn); p1[r] = __builtin_amdgcn_exp2f(p1[r] - mn); rs += p0[r] + p1[r]; }
    lh = lh * alpha + rs;
    if (!__all(alpha == 1.0f)) {
#pragma unroll
        for (int d = 0; d < NO; ++d) o[d] = o[d] * alpha;
    }
    pf[0] = pack8(p0, 0); pf[1] = pack8(p0, 8); pf[2] = pack8(p1, 0); pf[3] = pack8(p1, 8);
}

template <int NO>
__device__ __forceinline__ void softmax_step1(f32x16& p0, float& m, float& lh, f32x16 (&o)[NO], bf16x8 (&pf)[2]) {
    float pm = p0[0];
#pragma unroll
    for (int r = 1; r < 16; ++r) pm = fmaxf(pm, p0[r]);
    pm = half_max(pm);
    const float mn = fmaxf(m, pm), alpha = __builtin_amdgcn_exp2f(m - mn); m = mn;
    float rs = 0.f;
#pragma unroll
    for (int r = 0; r < 16; ++r) { p0[r] = __builtin_amdgcn_exp2f(p0[r] - mn); rs += p0[r]; }
    lh = lh * alpha + rs;
    if (!__all(alpha == 1.0f)) {
#pragma unroll
        for (int d = 0; d < NO; ++d) o[d] = o[d] * alpha;
    }
    pf[0] = pack8(p0, 0); pf[1] = pack8(p0, 8);
}

namespace pat {
constexpr int KROW = 400, VROW = 144, KTILE = 64 * KROW, VTILE = 128 * VROW;
__device__ __forceinline__ void unit(LAS unsigned char* lds, const int wave, const bf16_t* Q, const bf16_t* KB, const bf16_t* KPE, const bf16_t* VT, bf16_t* O, int b, int h, int qb) {
    const int lane = lane_now(), tid = wave * 64 + lane, ql = lane & 31, hh = lane >> 5;
    const int q0 = b * SEQ + qb * 256 + 32 * wave;
    bf16x8 qf[12];
    { const bf16_t* qp = Q + (size_t)(q0 + ql) * (NH * QKD) + h * QKD + hh * 8;
#pragma unroll
      for (int ks = 0; ks < 12; ++ks) qf[ks] = *(const bf16x8*)(qp + ks * 16); }
    f32x16 o[4];
#pragma unroll
    for (int d = 0; d < 4; ++d)
#pragma unroll
        for (int r = 0; r < 16; ++r) o[d][r] = 0.f;
    float m = -1e30f, lh = 0.f;
    const int ntiles = 4 * (qb + 1);
    int krow[3], kcc[3]; unsigned koff[3];
#pragma unroll
    for (int i = 0; i < 3; ++i) { const int c = tid + 512 * i; krow[i] = c / 24; kcc[i] = c % 24; koff[i] = (unsigned)(krow[i] * KROW + kcc[i] * 16); }
    const bf16_t* kg = KB + (size_t)(b * SEQ) * (NH * NOPE) + h * NOPE;
    const bf16_t* kpg = KPE + (size_t)(b * SEQ) * ROPE;
    const bf16_t* vg = VT + (size_t)(h * VD) * MP + b * SEQ;
    const int vrow0 = tid >> 3, vcc = tid & 7;
    u32x4 kst[3], vst[2];
#define PAT_LOAD(j) do { _Pragma("unroll") for (int i = 0; i < 3; ++i) kst[i] = kcc[i] < 16 ? *(const u32x4*)(kg + (size_t)((j) * 64 + krow[i]) * (NH * NOPE) + kcc[i] * 8) : *(const u32x4*)(kpg + (size_t)((j) * 64 + krow[i]) * ROPE + (kcc[i] - 16) * 8); \
        _Pragma("unroll") for (int i = 0; i < 2; ++i) vst[i] = *(const u32x4*)(vg + (size_t)(vrow0 + 64 * i) * MP + (j) * 64 + vcc * 8); } while (0)
#define PAT_STORE(buf) do { _Pragma("unroll") for (int i = 0; i < 3; ++i) *(LAS u32x4*)(lds + (buf) * KTILE + koff[i]) = kst[i]; \
        _Pragma("unroll") for (int i = 0; i < 2; ++i) *(LAS u32x4*)(lds + 2 * KTILE + (buf) * VTILE + (vrow0 + 64 * i) * VROW + vcc * 16) = vst[i]; } while (0)
    PAT_LOAD(0); PAT_STORE(0);
    __syncthreads();
    const int kr = swap23(ql);
    for (int j = 0; j < ntiles; ++j) {
        const int buf = j & 1;
        if (j + 1 < ntiles) PAT_LOAD(j + 1);
        const int jd = j - 4 * qb;
        if (jd <= (wave >> 1)) {
            f32x16 p0, p1;
#pragma unroll
            for (int r = 0; r < 16; ++r) { p0[r] = 0.f; p1[r] = 0.f; }
            const LAS unsigned char* kb0 = lds + buf * KTILE + kr * KROW + hh * 16;
            __builtin_amdgcn_s_setprio(1);
#pragma unroll
            for (int ks = 0; ks < 12; ++ks) {
                const bf16x8 a0 = *(const LAS bf16x8*)(kb0 + ks * 32), a1 = *(const LAS bf16x8*)(kb0 + 32 * KROW + ks * 32);
                p0 = __builtin_amdgcn_mfma_f32_32x32x16_bf16(a0, qf[ks], p0, 0, 0, 0);
                p1 = __builtin_amdgcn_mfma_f32_32x32x16_bf16(a1, qf[ks], p1, 0, 0, 0);
            }
            __builtin_amdgcn_s_setprio(0);
            if (jd >= 0) {
                const int qrel = 32 * wave + ql - 64 * jd - 8 * hh;
#pragma unroll
                for (int r = 0; r < 16; ++r) { const int kk = 16 * (r >> 3) + (r & 7);
                    if (kk > qrel) p0[r] = -__builtin_inff();
                    if (kk + 32 > qrel) p1[r] = -__builtin_inff(); }
            }
            bf16x8 pf[4];
            softmax_step<4>(p0, p1, m, lh, o, pf);
            const LAS unsigned char* vb0 = lds + 2 * KTILE + buf * VTILE + ql * VROW + hh * 16;
#pragma unroll
            for (int d = 0; d < 4; ++d)
#pragma unroll
                for (int ss = 0; ss < 4; ++ss) {
                    const bf16x8 a = *(const LAS bf16x8*)(vb0 + d * 32 * VROW + ss * 32);
                    o[d] = __builtin_amdgcn_mfma_f32_32x32x16_bf16(a, pf[ss], o[d], 0, 0, 0);
                }
        }
        if (j + 1 < ntiles) PAT_STORE(buf ^ 1);
        __syncthreads();
    }
#undef PAT_LOAD
#undef PAT_STORE
    const float inv = 1.0f / half_sum(lh);
    bf16_t* op = O + (size_t)(q0 + ql) * DM + h * VD + 4 * hh;
#pragma unroll
    for (int d = 0; d < 4; ++d)
#pragma unroll
        for (int g = 0; g < 4; ++g) { u32x2 w; w.x = cvt_pk_bf16(o[d][4 * g] * inv, o[d][4 * g + 1] * inv); w.y = cvt_pk_bf16(o[d][4 * g + 2] * inv, o[d][4 * g + 3] * inv);
            *(u32x2*)(op + 32 * d + 8 * g) = w; }
}
}

namespace sat {
constexpr int KROW = 656, KTILE = 64 * KROW;
__device__ __forceinline__ bf16x8 tr_frag(const LAS unsigned char* p) {
    typedef short v4i16_t __attribute__((ext_vector_type(4)));
    const s16x4 a = __builtin_bit_cast(s16x4, __builtin_amdgcn_ds_read_tr16_b64_v4i16((LAS v4i16_t*)p));
    const s16x4 b = __builtin_bit_cast(s16x4, __builtin_amdgcn_ds_read_tr16_b64_v4i16((LAS v4i16_t*)(p + 4 * KROW)));
    bf16x8 r; r[0] = a[0]; r[1] = a[1]; r[2] = a[2]; r[3] = a[3]; r[4] = b[0]; r[5] = b[1]; r[6] = b[2]; r[7] = b[3]; return r;
}
__device__ __forceinline__ void unit(LAS unsigned char* lds, const int wave, const bf16_t* QLAT, const float* cache_ckv, const float* cache_kpe, const int* page_table, const bf16_t* CKVS  , const bf16_t* KPES,
                                     float* OPART, float* OML, int b, int split) {
    const int lane = lane_now(), tid = wave * 64 + lane, ql = lane & 31, hh = lane >> 5;
    const int qblk = wave & 1, kb = (wave >> 1) & 1, dvh = wave >> 2;
#pragma unroll
    for (int i = 0; i < 5; ++i) { const int c = tid + 512 * i, row = c / 40, cc = c % 40;
        *(LAS u32x4*)(lds + 2 * KTILE + row * KROW + cc * 16) = *(const u32x4*)(QLAT + (size_t)(b * 64 + row) * 320 + cc * 8); }
    f32x16 o[4];
#pragma unroll
    for (int d = 0; d < 4; ++d)
#pragma unroll
        for (int r = 0; r < 16; ++r) o[d][r] = 0.f;
    float m = -1e30f, lh = 0.f;
    const int npg = NPAGES / 2, ntiles = 2 * npg + (split == 1 ? 1 : 0);
    const int* pt = page_table + b * NPAGES + split * npg;
    const int crow0 = tid >> 6, ccol = tid & 63;
    const int prow0 = tid >> 4, pcol = tid & 15;
    f32x4 cst[8], pst[2];
#define SAT_LOAD(j) do { const int pg = pt[(j) >> 1]; const size_t r0 = (size_t)pg * PAGE + ((j) & 1) * 64; \
        _Pragma("unroll") for (int i = 0; i < 8; ++i) cst[i] = __builtin_nontemporal_load((const f32x4*)(cache_ckv + (r0 + crow0 + 8 * i) * KVL) + ccol); \
        _Pragma("unroll") for (int i = 0; i < 2; ++i) pst[i] = __builtin_nontemporal_load((const f32x4*)(cache_kpe + (r0 + prow0 + 32 * i) * ROPE) + pcol); } while (0)
#define SAT_STORE(buf) do { _Pragma("unroll") for (int i = 0; i < 8; ++i) { u32x2 w; w.x = cvt_pk_bf16(cst[i][0], cst[i][1]); w.y = cvt_pk_bf16(cst[i][2], cst[i][3]); \
            *(LAS u32x2*)(lds + (buf) * KTILE + (crow0 + 8 * i) * KROW + ccol * 8) = w; } \
        _Pragma("unroll") for (int i = 0; i < 2; ++i) { u32x2 w; w.x = cvt_pk_bf16(pst[i][0], pst[i][1]); w.y = cvt_pk_bf16(pst[i][2], pst[i][3]); \
            *(LAS u32x2*)(lds + (buf) * KTILE + (prow0 + 32 * i) * KROW + 512 + pcol * 8) = w; } } while (0)
#define SAT_NEW(buf) do { _Pragma("unroll") for (int i = 0; i < 5; ++i) { const int c = tid + 512 * i, row = c / 40, cc = c % 40; u32x4 v = (u32x4){0u, 0u, 0u, 0u}; \
            if (row < DECT) v = cc < 32 ? *(const u32x4*)(CKVS + (size_t)(b * DECT + row) * KVL + cc * 8) : *(const u32x4*)(KPES + (size_t)(b * DECT + row) * ROPE + (cc - 32) * 8); \
            *(LAS u32x4*)(lds + (buf) * KTILE + row * KROW + cc * 16) = v; } } while (0)
    SAT_LOAD(0); SAT_STORE(0);
    __syncthreads();
    const int kr = 32 * kb + swap23(ql);
    const int g16 = lane >> 4, i16 = lane & 15;
    const int troff = (32 * kb + 8 * (g16 >> 1) + (i16 >> 2)) * KROW + (128 * dvh + 16 * (g16 & 1) + 4 * (i16 & 3)) * 2;
    for (int j = 0; j < ntiles; ++j) {
        const int buf = j & 1;
        const bool nxt_page = (j + 1 < 2 * npg), nxt_new = (j + 1 == 2 * npg) && (split == 1);
        if (nxt_page) SAT_LOAD(j + 1);
        f32x16 p0;
#pragma unroll
        for (int r = 0; r < 16; ++r) p0[r] = 0.f;
        const LAS unsigned char* kb0 = lds + buf * KTILE + kr * KROW + hh * 16;
        const LAS unsigned char* qb0 = lds + 2 * KTILE + (32 * qblk + ql) * KROW + hh * 16;
        __builtin_amdgcn_s_setprio(1);
#pragma unroll
        for (int ks = 0; ks < 20; ++ks) p0 = __builtin_amdgcn_mfma_f32_32x32x16_bf16(*(const LAS bf16x8*)(kb0 + ks * 32), *(const LAS bf16x8*)(qb0 + ks * 32), p0, 0, 0, 0);
        __builtin_amdgcn_s_setprio(0);
        if (j == 2 * npg) {
            const int tq = (32 * qblk + ql) >> 3;
#pragma unroll
            for (int r = 0; r < 16; ++r) { const int kk = 32 * kb + 16 * (r >> 3) + 8 * hh + (r & 7); if (kk > tq) p0[r] = -__builtin_inff(); }
        }
        bf16x8 pf[2];
        softmax_step1<4>(p0, m, lh, o, pf);
        const LAS unsigned char* vb0 = lds + buf * KTILE + troff;
#pragma unroll
        for (int d = 0; d < 4; ++d)
#pragma unroll
            for (int ss = 0; ss < 2; ++ss) {
                const bf16x8 a = tr_frag(vb0 + d * 64 + ss * 16 * KROW);
                o[d] = __builtin_amdgcn_mfma_f32_32x32x16_bf16(a, pf[ss], o[d], 0, 0, 0);
            }
        if (nxt_page) SAT_STORE(buf ^ 1);
        if (nxt_new) SAT_NEW(buf ^ 1);
        __syncthreads();
    }
#undef SAT_LOAD
#undef SAT_STORE
#undef SAT_NEW
    float lt = half_sum(lh);
    const int pair = dvh * 2 + qblk;
    LAS float* xb = (LAS float*)(lds + pair * 17408);
    if (kb == 1) {
#pragma unroll
        for (int d = 0; d < 4; ++d)
#pragma unroll
            for (int r = 0; r < 16; ++r) xb[(d * 16 + r) * 64 + lane] = o[d][r];
        xb[64 * 64 + lane] = m; xb[65 * 64 + lane] = lt;
    }
    __syncthreads();
    if (kb == 0) {
        const float m1 = xb[64 * 64 + lane], l1 = xb[65 * 64 + lane];
        const float mm = fmaxf(m, m1), w0 = __builtin_amdgcn_exp2f(m - mm), w1 = __builtin_amdgcn_exp2f(m1 - mm);
#pragma unroll
        for (int d = 0; d < 4; ++d)
#pragma unroll
            for (int r = 0; r < 16; ++r) o[d][r] = o[d][r] * w0 + xb[(d * 16 + r) * 64 + lane] * w1;
        lt = lt * w0 + l1 * w1;
        const int q = 32 * qblk + ql;
        float* op = OPART + ((size_t)(b * 2 + split) * 64 + q) * KVL + 128 * dvh + 4 * hh;
#pragma unroll
        for (int d = 0; d < 4; ++d)
#pragma unroll
            for (int g = 0; g < 4; ++g) *(f32x4*)(op + 32 * d + 8 * g) = (f32x4){o[d][4 * g], o[d][4 * g + 1], o[d][4 * g + 2], o[d][4 * g + 3]};
        if (dvh == 0 && hh == 0) *(f32x2*)(OML + ((size_t)(b * 2 + split) * 64 + q) * 2) = (f32x2){mm, lt};
    }
    __syncthreads();
}
}


#define LDS_RD128(dst, addr, off) asm volatile("ds_read_b128 %0, %1 offset:%2" : "=v"(dst) : "v"(addr), "n"(off))
#define LDS_WAIT4(f, N) asm volatile("s_waitcnt lgkmcnt(" #N ")" : "+v"(f[0]), "+v"(f[1]), "+v"(f[2]), "+v"(f[3]))
namespace gla {
constexpr int QROW = 272, KTROW = 144, VROW = 528;
constexpr int P_T16 = 0, P_TOT = 4096, P_QT = 8192, P_KT = P_QT + 64 * QROW;
constexpr int C_DK = 0, C_QT = 1024, C_KH = C_QT + 64 * QROW, C_V = C_KH + 128 * KTROW, C_AT = C_V + 64 * VROW, C_O = C_AT + 6144;
static_assert(C_O + 64 * 8 * 64 <= RING_BYTES, "gla chain LDS");
static_assert(C_AT + 6144 <= RING_BYTES, "gla LDS");
__device__ __forceinline__ bf16x8 tr_frag(const LAS unsigned char* p) {
    typedef short v4i16_t __attribute__((ext_vector_type(4)));
    const s16x4 a = __builtin_bit_cast(s16x4, __builtin_amdgcn_ds_read_tr16_b64_v4i16((LAS v4i16_t*)p));
    const s16x4 b = __builtin_bit_cast(s16x4, __builtin_amdgcn_ds_read_tr16_b64_v4i16((LAS v4i16_t*)(p + 4 * VROW)));
    bf16x8 r; r[0] = a[0]; r[1] = a[1]; r[2] = a[2]; r[3] = a[3]; r[4] = b[0]; r[5] = b[1]; r[6] = b[2]; r[7] = b[3]; return r;
}
template <int SEG>
__device__ __forceinline__ void prep(LAS unsigned char* lds, const int wave, const bf16_t* QKVG, const float* T16, const float* w_gk2, const float* b_gk, int chunk, int h,
                                     bf16_t* QTg, bf16_t* KHg, bf16_t* ATg, float* DKg) {
    const int lane = lane_now(), tid = wave * 64 + lane, ql = lane & 31, hh = lane >> 5;
    const int kk = tid & 127, tq = tid >> 7, cu = chunk * 4 + h, row0 = chunk * 64;
    float w2[16];
#pragma unroll
    for (int j = 0; j < 16; ++j) w2[j] = w_gk2[j * (GH * GDK) + h * GDK + kk];
    const float bias = b_gk[h * GDK + kk];
    unsigned short qraw[16], kraw[16];
    { const bf16_t* qg = QKVG + (size_t)(row0 + tq * 16) * GIN + h * GDK + kk;
#pragma unroll
      for (int i = 0; i < 16; ++i) { qraw[i] = qg[(size_t)i * GIN]; kraw[i] = qg[(size_t)i * GIN + GH * GDK]; } }
    __syncthreads();
    if (tid < 256) *(LAS f32x4*)(lds + P_T16 + tid * 16) = *(const f32x4*)(T16 + (size_t)row0 * 16 + tid * 4);
    __syncthreads();
    float Gl[16];
    { float run = 0.f;
#pragma unroll
      for (int i = 0; i < 16; ++i) { const int t = tq * 16 + i; const LAS f32x4* tp = (const LAS f32x4*)(lds + P_T16 + t * 64);
          const f32x4 a0 = tp[0], a1 = tp[1], a2 = tp[2], a3 = tp[3];
          float z = bias;
          z += a0[0] * w2[0] + a0[1] * w2[1] + a0[2] * w2[2] + a0[3] * w2[3];
          z += a1[0] * w2[4] + a1[1] * w2[5] + a1[2] * w2[6] + a1[3] * w2[7];
          z += a2[0] * w2[8] + a2[1] * w2[9] + a2[2] * w2[10] + a2[3] * w2[11];
          z += a3[0] * w2[12] + a3[1] * w2[13] + a3[2] * w2[14] + a3[3] * w2[15];
          const float ls = fminf(z, 0.f) - 0.6931471805599453f * __builtin_amdgcn_logf(1.0f + __builtin_amdgcn_exp2f(-fabsf(z) * LOG2E));
          if (SEG == 8 && i == 8) run = 0.f;
          run += ls * (1.0f / 16.0f); Gl[i] = run; }
      if (SEG == 64) *(LAS float*)(lds + P_TOT + (tq * 128 + kk) * 4) = run; }
    float prefix = 0.f, total = 0.f;
    if (SEG == 64) {
        __syncthreads();
#pragma unroll
        for (int q = 0; q < 4; ++q) { const float v = *(const LAS float*)(lds + P_TOT + (q * 128 + kk) * 4); total += v; if (q < tq) prefix += v; }
    }
    { unsigned kh[8];
#pragma unroll
      for (int i = 0; i < 16; i += 2) {
          const float G0 = (Gl[i] + prefix) * LOG2E, G1 = (Gl[i + 1] + prefix) * LOG2E;
          const float TL = (SEG == 64 ? total : Gl[i | 7]) * LOG2E;
          const float q0 = bf2f(qraw[i]), q1 = bf2f(qraw[i + 1]), k0 = bf2f(kraw[i]), k1 = bf2f(kraw[i + 1]);
          const unsigned qq = cvt_pk_bf16(q0 * __builtin_amdgcn_exp2f(G0), q1 * __builtin_amdgcn_exp2f(G1));
          const unsigned kt = cvt_pk_bf16(k0 * __builtin_amdgcn_exp2f(-G0), k1 * __builtin_amdgcn_exp2f(-G1));
          kh[i >> 1] = cvt_pk_bf16(k0 * __builtin_amdgcn_exp2f(TL - G0), k1 * __builtin_amdgcn_exp2f(TL - G1));
          const int t = tq * 16 + i;
          *(LAS unsigned short*)(lds + P_QT + t * QROW + kk * 2) = (unsigned short)(qq & 0xffffu); *(LAS unsigned short*)(lds + P_QT + (t + 1) * QROW + kk * 2) = (unsigned short)(qq >> 16);
          *(LAS unsigned short*)(lds + P_KT + t * QROW + kk * 2) = (unsigned short)(kt & 0xffffu); *(LAS unsigned short*)(lds + P_KT + (t + 1) * QROW + kk * 2) = (unsigned short)(kt >> 16);
      }
      bf16_t* khp = KHg + ((size_t)cu * 128 + kk) * 64 + tq * 16;
      *(u32x4*)khp = (u32x4){kh[0], kh[1], kh[2], kh[3]}; *(u32x4*)(khp + 8) = (u32x4){kh[4], kh[5], kh[6], kh[7]};
      if (SEG == 64) { if (tq == 0) DKg[(size_t)cu * 1024 + kk] = __builtin_amdgcn_exp2f(total * LOG2E); }
      else { DKg[(size_t)cu * 1024 + (tq * 2) * 128 + kk] = __builtin_amdgcn_exp2f(Gl[7] * LOG2E); DKg[(size_t)cu * 1024 + (tq * 2 + 1) * 128 + kk] = __builtin_amdgcn_exp2f(Gl[15] * LOG2E); } }
    __syncthreads();
    if (wave < 3) {
        const int sb = wave >> 1, tb = (wave + 1) >> 1, kr = swap23(ql);
        f32x16 x;
#pragma unroll
        for (int r = 0; r < 16; ++r) x[r] = 0.f;
        const LAS unsigned char* ap = lds + P_KT + (32 * sb + kr) * QROW + hh * 16;
        const LAS unsigned char* bp = lds + P_QT + (32 * tb + ql) * QROW + hh * 16;
#pragma unroll
        for (int ks = 0; ks < 8; ++ks) x = __builtin_amdgcn_mfma_f32_32x32x16_bf16(*(const LAS bf16x8*)(ap + ks * 32), *(const LAS bf16x8*)(bp + ks * 32), x, 0, 0, 0);
        const int tt = 32 * tb + ql;
#pragma unroll
        for (int r = 0; r < 16; ++r) { const int sr = 32 * sb + 16 * (r >> 3) + 8 * hh + (r & 7); if (sr > tt || (SEG == 8 && (sr >> 3) != (tt >> 3))) x[r] = 0.f; }
        bf16_t* atp = ATg + (size_t)cu * 3072 + (wave * 2) * 512 + lane * 8;
        *(bf16x8*)atp = pack8(x, 0); *(bf16x8*)(atp + 512) = pack8(x, 8);
    }
#pragma unroll
    for (int i = 0; i < 2; ++i) { const int c = tid + 512 * i, row = c >> 4, cc = c & 15;
        *(u32x4*)(QTg + (size_t)(row0 + row) * (GH * GDK) + h * GDK + cc * 8) = *(const LAS u32x4*)(lds + P_QT + row * QROW + cc * 16); }
}

template <int NWV>
__device__ __forceinline__ void chain(LAS unsigned char* lds, const int wave, const bf16_t* QTg, const bf16_t* KHg, const bf16_t* ATg, const float* DKg, const bf16_t* QKVG, int h, int chunk0, int nchunk,
                                      int srow, int nrow, int sseg, int dseg, int dvbase, const float* state_in, float* state_out, bf16_t* GO) {
    constexpr int VPR = NWV * 4  , VST = NWV / 2  , VRS = 512 / VPR  ;
    const bool active = wave < NWV;
    const int lane = lane_now(), tid = wave * 64 + lane, ql = lane & 31, hh = lane >> 5;
    f32x16 S[4];
#pragma unroll
    for (int kb = 0; kb < 4; ++kb)
#pragma unroll
        for (int r = 0; r < 16; ++r) S[kb][r] = (state_in && active) ? state_in[(size_t)(32 * kb + 16 * (r >> 3) + 8 * hh + (r & 7)) * GDV + dvbase + 32 * wave + ql] : 0.f;
    const int qrow = tid >> 4, qcc = tid & 15;
    const int krow = tid >> 3, kcc = tid & 7;
    const int vrow0 = tid / VPR, vcc = tid % VPR;
    u32x4 qst[2], kst[2], vst[VST], ast, dst;
#define GLC_LOAD(c) do { const int ch = chunk0 + (c); const size_t cu = (size_t)ch * 4 + h; \
        _Pragma("unroll") for (int i = 0; i < 2; ++i) qst[i] = *(const u32x4*)(QTg + (size_t)(ch * 64 + qrow + 32 * i) * (GH * GDK) + h * GDK + qcc * 8); \
        _Pragma("unroll") for (int i = 0; i < 2; ++i) kst[i] = (sseg < 0 || kcc == sseg) ? *(const u32x4*)(KHg + (cu * 128 + krow + 64 * i) * 64 + kcc * 8) : (u32x4){0u, 0u, 0u, 0u}; \
        _Pragma("unroll") for (int i = 0; i < VST; ++i) { const int r = vrow0 + VRS * i; \
            vst[i] = (r >= srow && r < srow + nrow) ? *(const u32x4*)(QKVG + (size_t)(ch * 64 + r) * GIN + 2 * GH * GDK + h * GDV + dvbase + vcc * 8) : (u32x4){0u, 0u, 0u, 0u}; } \
        if (tid < 384) ast = *(const u32x4*)(ATg + cu * 3072 + tid * 8); \
        if (tid < 32) dst = *(const u32x4*)(DKg + cu * 1024 + dseg * 128 + tid * 4); } while (0)
    GLC_LOAD(0);
    const int g16 = lane >> 4, i16 = lane & 15;
    const int troff = (8 * (g16 >> 1) + (i16 >> 2)) * VROW + (32 * wave + 16 * (g16 & 1) + 4 * (i16 & 3)) * 2;
    const int kr = swap23(ql);
#define GLC_LDS_BAR() do { asm volatile("s_waitcnt lgkmcnt(0)" ::: "memory"); __builtin_amdgcn_s_barrier(); asm volatile("" ::: "memory"); } while (0)
#define GLC_FLUSH(cprev) do { if constexpr (NWV != 8) { int tl_ = tid; asm volatile("" : "+v"(tl_)); _Pragma("unroll") for (int i_ = 0; i_ < NWV / 2; ++i_) { const int c_ = tl_ + 512 * i_, row_ = c_ / (NWV * 4), cc_ = c_ % (NWV * 4); \
            *(u32x4*)(GO + (size_t)((chunk0 + (cprev)) * 64 + row_) * DM + h * GDV + dvbase + cc_ * 8) = *(const LAS u32x4*)(lds + C_O + row_ * (NWV * 64) + cc_ * 16); } } } while (0)
    for (int c = 0; c < nchunk; ++c) {
        GLC_LDS_BAR();
        if (c > 0) GLC_FLUSH(c - 1);
#pragma unroll
        for (int i = 0; i < 2; ++i) *(LAS u32x4*)(lds + C_QT + (qrow + 32 * i) * QROW + qcc * 16) = qst[i];
#pragma unroll
        for (int i = 0; i < 2; ++i) *(LAS u32x4*)(lds + C_KH + (krow + 64 * i) * KTROW + kcc * 16) = kst[i];
#pragma unroll
        for (int i = 0; i < VST; ++i) *(LAS u32x4*)(lds + C_V + (vrow0 + VRS * i) * VROW + vcc * 16) = vst[i];
        if (tid < 384) *(LAS u32x4*)(lds + C_AT + tid * 16) = ast;
        if (tid < 32) *(LAS u32x4*)(lds + C_DK + tid * 16) = dst;
        GLC_LDS_BAR();
        if (c + 1 < nchunk) GLC_LOAD(c + 1);
        if (active) {
        f32x16 o[2];
#pragma unroll
        for (int tb = 0; tb < 2; ++tb)
#pragma unroll
            for (int r = 0; r < 16; ++r) o[tb][r] = 0.f;
        const unsigned qa = (unsigned)(size_t)(lds + C_QT + ql * QROW + hh * 16), ka = (unsigned)(size_t)(lds + C_KH + kr * KTROW + hh * 16), ata = (unsigned)(size_t)(lds + C_AT + lane * 16);
        bf16x8 fa[4], fb[4];
#define GLC_QLD(f, kb) do { LDS_RD128(f[0], qa, (kb) * 64); LDS_RD128(f[1], qa, 32 * QROW + (kb) * 64); LDS_RD128(f[2], qa, (kb) * 64 + 32); LDS_RD128(f[3], qa, 32 * QROW + (kb) * 64 + 32); } while (0)
#define GLC_QMM(f, kb) do { const bf16x8 s0 = pack8(S[kb], 0), s1 = pack8(S[kb], 8); \
            o[0] = __builtin_amdgcn_mfma_f32_32x32x16_bf16(f[0], s0, o[0], 0, 0, 0); o[1] = __builtin_amdgcn_mfma_f32_32x32x16_bf16(f[1], s0, o[1], 0, 0, 0); \
            o[0] = __builtin_amdgcn_mfma_f32_32x32x16_bf16(f[2], s1, o[0], 0, 0, 0); o[1] = __builtin_amdgcn_mfma_f32_32x32x16_bf16(f[3], s1, o[1], 0, 0, 0); } while (0)
        GLC_QLD(fa, 0); GLC_QLD(fb, 1);
        LDS_WAIT4(fa, 4); GLC_QMM(fa, 0); GLC_QLD(fa, 2);
        LDS_WAIT4(fb, 4); GLC_QMM(fb, 1); GLC_QLD(fb, 3);
        LDS_WAIT4(fa, 4); GLC_QMM(fa, 2);
        LDS_RD128(fa[0], ata, 0 * 1024); LDS_RD128(fa[1], ata, 1 * 1024); LDS_RD128(fa[2], ata, 2 * 1024); LDS_RD128(fa[3], ata, 3 * 1024);
        LDS_WAIT4(fb, 4); GLC_QMM(fb, 3);
        LDS_RD128(fb[0], ata, 4 * 1024); LDS_RD128(fb[1], ata, 5 * 1024); LDS_RD128(fb[2], ka, 0); LDS_RD128(fb[3], ka, 32);
        bf16x8 vf[4];
#pragma unroll
        for (int ss = 0; ss < 4; ++ss) vf[ss] = tr_frag(lds + C_V + troff + ss * 16 * VROW);
        LDS_WAIT4(fa, 0); LDS_WAIT4(fb, 0);
        o[0] = __builtin_amdgcn_mfma_f32_32x32x16_bf16(fa[0], vf[0], o[0], 0, 0, 0);
        o[0] = __builtin_amdgcn_mfma_f32_32x32x16_bf16(fa[1], vf[1], o[0], 0, 0, 0);
        o[1] = __builtin_amdgcn_mfma_f32_32x32x16_bf16(fa[2], vf[0], o[1], 0, 0, 0);
        o[1] = __builtin_amdgcn_mfma_f32_32x32x16_bf16(fa[3], vf[1], o[1], 0, 0, 0);
        o[1] = __builtin_amdgcn_mfma_f32_32x32x16_bf16(fb[0], vf[2], o[1], 0, 0, 0);
        o[1] = __builtin_amdgcn_mfma_f32_32x32x16_bf16(fb[1], vf[3], o[1], 0, 0, 0);
#define GLC_KLD(f, kb) do { LDS_RD128(f[0], ka, (kb) * 32 * KTROW); LDS_RD128(f[1], ka, (kb) * 32 * KTROW + 32); LDS_RD128(f[2], ka, (kb) * 32 * KTROW + 64); LDS_RD128(f[3], ka, (kb) * 32 * KTROW + 96); } while (0)
#define GLC_SCALE(kb) do { _Pragma("unroll") for (int g = 0; g < 2; ++g) { const LAS f32x4* dp = (const LAS f32x4*)(lds + C_DK + (32 * (kb) + 16 * g + 8 * hh) * 4); const f32x4 d0 = dp[0], d1 = dp[1]; \
            S[kb][8 * g + 0] *= d0[0]; S[kb][8 * g + 1] *= d0[1]; S[kb][8 * g + 2] *= d0[2]; S[kb][8 * g + 3] *= d0[3]; \
            S[kb][8 * g + 4] *= d1[0]; S[kb][8 * g + 5] *= d1[1]; S[kb][8 * g + 6] *= d1[2]; S[kb][8 * g + 7] *= d1[3]; } } while (0)
#define GLC_KMM(f, kb) do { S[kb] = __builtin_amdgcn_mfma_f32_32x32x16_bf16(f[0], vf[0], S[kb], 0, 0, 0); S[kb] = __builtin_amdgcn_mfma_f32_32x32x16_bf16(f[1], vf[1], S[kb], 0, 0, 0); \
            S[kb] = __builtin_amdgcn_mfma_f32_32x32x16_bf16(f[2], vf[2], S[kb], 0, 0, 0); S[kb] = __builtin_amdgcn_mfma_f32_32x32x16_bf16(f[3], vf[3], S[kb], 0, 0, 0); } while (0)
        GLC_KLD(fa, 1);
        LDS_RD128(fb[0], ka, 64); LDS_RD128(fb[1], ka, 96);
        GLC_SCALE(0);
        LDS_WAIT4(fb, 0);
        S[0] = __builtin_amdgcn_mfma_f32_32x32x16_bf16(fb[2], vf[0], S[0], 0, 0, 0); S[0] = __builtin_amdgcn_mfma_f32_32x32x16_bf16(fb[3], vf[1], S[0], 0, 0, 0);
        S[0] = __builtin_amdgcn_mfma_f32_32x32x16_bf16(fb[0], vf[2], S[0], 0, 0, 0); S[0] = __builtin_amdgcn_mfma_f32_32x32x16_bf16(fb[1], vf[3], S[0], 0, 0, 0);
        GLC_KLD(fb, 2); GLC_SCALE(1);
        LDS_WAIT4(fa, 4); GLC_KMM(fa, 1); GLC_KLD(fa, 3); GLC_SCALE(2);
        LDS_WAIT4(fb, 4); GLC_KMM(fb, 2); GLC_SCALE(3);
        LDS_WAIT4(fa, 0); GLC_KMM(fa, 3);
#undef GLC_QLD
#undef GLC_QMM
#undef GLC_KLD
#undef GLC_SCALE
#undef GLC_KMM
        if constexpr (NWV != 8) {
            int qlx = ql, hhx = hh; asm volatile("" : "+v"(qlx), "+v"(hhx));
            LAS unsigned short* op_ = (LAS unsigned short*)(lds + C_O) + (4 * hhx) * (NWV * 32) + 32 * wave + qlx;
#pragma unroll
            for (int tb = 0; tb < 2; ++tb)
#pragma unroll
                for (int r = 0; r < 16; r += 2) { const unsigned w_ = cvt_pk_bf16(o[tb][r], o[tb][r + 1]);
                    const int t0_ = 32 * tb + (r & 3) + 8 * (r >> 2);
                    op_[t0_ * (NWV * 32)] = (unsigned short)(w_ & 0xffffu); op_[(t0_ + 1) * (NWV * 32)] = (unsigned short)(w_ >> 16); }
        } else {
          int qlx = ql, hhx = hh; asm volatile("" : "+v"(qlx), "+v"(hhx));
          bf16_t* gp = GO + (size_t)((chunk0 + c) * 64) * DM + h * GDV + dvbase + 32 * wave + qlx;
#pragma unroll
          for (int tb = 0; tb < 2; ++tb)
#pragma unroll
              for (int r = 0; r < 16; ++r) { const int t = 32 * tb + (r & 3) + 8 * (r >> 2) + 4 * hhx; if (t >= srow && t < srow + nrow) gp[(size_t)t * DM] = (bf16_t)(cvt_pk_bf16(o[tb][r], 0.f) & 0xffffu); } }
        }
    }
    if constexpr (NWV != 8) { GLC_LDS_BAR(); GLC_FLUSH(nchunk - 1); }
#undef GLC_FLUSH
#undef GLC_LOAD
#undef GLC_LDS_BAR
    if (active) { int qlx = ql, hhx = hh; asm volatile("" : "+v"(qlx), "+v"(hhx));
#pragma unroll
    for (int kb = 0; kb < 4; ++kb)
#pragma unroll
        for (int r = 0; r < 16; ++r) state_out[(size_t)(32 * kb + 16 * (r >> 3) + 8 * hhx + (r & 7)) * GDV + dvbase + 32 * wave + qlx] = S[kb][r]; }
    __syncthreads();
}
}

__global__ void __launch_bounds__(NWAVES * 64, 2) mk_fwd(Args args) {
    extern __shared__ __attribute__((aligned(16))) unsigned char lds_raw[];
    LAS unsigned char* lds = (LAS unsigned char*)lds_raw;
    volatile LAS unsigned* MISC = (volatile LAS unsigned*)(lds + MISC_OFF);
    const int wave = __builtin_amdgcn_readfirstlane(threadIdx.x >> 6);
    const int G = gridDim.x; const int bx = blockIdx.x; const int vcu = (G % 8 == 0) ? (bx % 8) * (G / 8) + bx / 8 : bx;
    const int gw = vcu * NWAVES + wave, NGW = G * NWAVES;
    unsigned char* ws = args.ws;
    unsigned* ctl = (unsigned*)(ws + WS_CTL);
    for (int u = wave * 64 + lane_now(); u < (LDS_BYTES - LDSCTL_OFF) / 4; u += NWAVES * 64) ((LAS unsigned*)(lds + LDSCTL_OFF))[u] = 0u;
    __syncthreads();
    XcdBarrier bar = xcd_barrier_post(ctl + 1024, MISC + 8, wave == 0 && lane_now() == 0);
#ifdef PROBE_A0
    unsigned long long* tsb = (unsigned long long*)(ws + WS_CTL + 32768);
    int n_ts = 0;
#define STAMP() do { if (bx == 0 && wave == 0 && lane_now() == 0) tsb[n_ts] = __builtin_amdgcn_s_memrealtime(); ++n_ts; } while (0)
#define GRID_BAR() do { xcd_barrier(bar, wave == 0 && lane_now() == 0); STAMP(); } while (0)
    STAMP();
#else
#define STAMP() do {} while (0)
#define GRID_BAR() xcd_barrier(bar, wave == 0 && lane_now() == 0)
#endif

    const float* x_prompt = (const float*)args.in[0]; const float* x_sample = (const float*)args.in[1];
    const float* cache_ckv = (const float*)args.in[2]; const float* cache_kpe = (const float*)args.in[3];
    const float* state_gla = (const float*)args.in[4]; const int* page_table = (const int*)args.in[5];
    const float* norm_g = (const float*)args.in[6]; const float* ffn_w_in = (const float*)args.in[7]; const float* ffn_w_out = (const float*)args.in[8];
    const float* mla_w_down = (const float*)args.in[9]; const float* mla_g_q = (const float*)args.in[10]; const float* mla_w_uq = (const float*)args.in[11];
    const float* mla_g_kv = (const float*)args.in[12]; const float* mla_w_uk = (const float*)args.in[13]; const float* mla_w_uv = (const float*)args.in[14];
    const float* mla_w_o = (const float*)args.in[15]; const float* gla_w_in = (const float*)args.in[16]; const float* gla_w_gk1 = (const float*)args.in[17];
    const float* gla_w_gk2 = (const float*)args.in[18]; const float* gla_b_gk = (const float*)args.in[19]; const float* gla_g_norm = (const float*)args.in[20];
    const float* gla_w_o = (const float*)args.in[21];
    float* out = args.out;
    float* ROPE_T = (float*)(ws + WS_ROPE);
    bf16_t* WIN = (bf16_t*)(ws + WS_WIN); bf16_t* WOUT = (bf16_t*)(ws + WS_WOUT); bf16_t* WDOWN = (bf16_t*)(ws + WS_WDOWN); bf16_t* WUQ = (bf16_t*)(ws + WS_WUQ);
    bf16_t* WUKT = (bf16_t*)(ws + WS_WUKT); bf16_t* WUK = (bf16_t*)(ws + WS_WUK); bf16_t* WUVT = (bf16_t*)(ws + WS_WUVT); bf16_t* WOT = (bf16_t*)(ws + WS_WOT);
    bf16_t* WGIN = (bf16_t*)(ws + WS_WGIN); bf16_t* WGO = (bf16_t*)(ws + WS_WGO);
    bf16_t* XN = (bf16_t*)(ws + WS_XN); bf16_t* HM = (bf16_t*)(ws + WS_HM); bf16_t* T = (bf16_t*)(ws + WS_T); bf16_t* H = (bf16_t*)(ws + WS_H); float* TP = (float*)(ws + WS_TP); bf16_t* D = (bf16_t*)(ws + WS_D);
    bf16_t* CQ = (bf16_t*)(ws + WS_CQ); bf16_t* CKV = (bf16_t*)(ws + WS_CKV); bf16_t* KPES = (bf16_t*)(ws + WS_KPES);
    bf16_t* KB = (bf16_t*)(ws + WS_KB); bf16_t* KPEP = (bf16_t*)(ws + WS_KPEP);
    float* Y = out + OUT_Y;
    const ConvPtrs cp{ffn_w_in, ffn_w_out, mla_w_down, mla_w_uq, mla_w_uk, mla_w_uv, mla_w_o, gla_w_in, gla_w_o, WIN, WOUT, WDOWN, WUQ, WUKT, WUVT, WOT, WGIN, WGO};

    {
        const int lane = lane_now(), tid = wave * 64 + lane; (void)tid;
        LAS float* scr = (LAS float*)(lds + wave * 16384);
        conv_segment<0>(cp, gw, NGW, scr, lane);
        const int gt = vcu * (NWAVES * 64) + tid, NGT = G * NWAVES * 64;
        for (int i = gt; i < KVL * NH * NOPE / 2; i += NGT) { const f32x2 v = ((const f32x2*)mla_w_uk)[i]; ((unsigned*)WUK)[i] = cvt_pk_bf16(v[0], v[1]); }
        for (int i = gt; i < (DDOWN_P - DDOWN) * DM / 2; i += NGT) ((unsigned*)(WDOWN + (size_t)DDOWN * DM))[i] = 0u;
        for (int i = gt; i < 128 * KVL / 2; i += NGT) ((unsigned*)(WUVT + (size_t)NH * VD * KVL))[i] = 0u;
        for (int i = gt; i < (GIN_P - GIN) * DM / 2; i += NGT) { const int row = (2 * i) / DM, k = (2 * i) % DM;
            unsigned w = 0u; if (row < GRANK) w = cvt_pk_bf16(gla_w_gk1[(size_t)k * GRANK + row], gla_w_gk1[(size_t)(k + 1) * GRANK + row]);
            ((unsigned*)(WGIN + (size_t)GIN * DM))[i] = w; }
        for (int i = gt; i < (SEQ + DECT) * 32; i += NGT) { const int p = i >> 5, fi = i & 31; const float pos = (float)(p < SEQ ? p : PAST + (p - SEQ));
            const float inv = (float)exp2(-(double)fi * (13.287712379549449 / 32.0));
            const float ang = pos * inv; double t = (double)ang * 0.15915494309189535; t -= rint(t); const float tf = (float)t;
            ((f32x2*)ROPE_T)[i] = (f32x2){__builtin_amdgcn_cosf(tf), __builtin_amdgcn_sinf(tf)}; }
        thin_phase<false, true, true, false>(gw, NGW, x_prompt, x_sample, nullptr, nullptr, 0, nullptr, nullptr, XN, nullptr, norm_g + 0 * DM, 1.f);
        GRID_BAR();
    }
    bf16_t* QKVG = (bf16_t*)(ws + WS_QKVG); float* T16 = (float*)(ws + WS_T16); bf16_t* GO = (bf16_t*)(ws + WS_GO);
    const int CONV_TAIL0 = ((M / 256) * (2 * DFF / 256)) % G;
#define FFN_GEMMS(slot) do { \
        { pg8::Gemm g{XN, WIN + (size_t)(slot) * 2 * DFF * DM, DM, DM, DM, 0, 0}; pg8::Order S{M / 256, 2 * DFF / 256, 1, G, bx}; \
          pg8::EpiSwiGLU E{HM, DFF}; \
          pg8::gemm_phase<pg8::EpiSwiGLU, true>(lds, wave, g, S, E); \
          if ((slot) < 3 && bx >= CONV_TAIL0) conv_segment<((slot) < 3 ? (slot) + 1 : 3)>(cp, (bx - CONV_TAIL0) * NWAVES + wave, (G - CONV_TAIL0) * NWAVES, (LAS float*)(lds + wave * 16384), lane_now()); \
          GRID_BAR(); } \
        { pg8::Gemm g{HM, WOUT + (size_t)(slot) * DM * DFF, DFF, DFF, DFF, 0, 0}; pg8::Order S{MP / 256, DM / 256, 1, G, bx};     \
          pg8::EpiBf16<0> E{T, DM, 0, 256, 1.f, 0}; \
          pg8::gemm_phase<pg8::EpiBf16<0>, true>(lds, wave, g, S, E); } \
        { pg8::Gemm g{HM + (size_t)MP * DFF, WOUT + (size_t)(slot) * DM * DFF, DFF, DFF, 256, 256, 256}; pg8::Order S{MS / 256, DM / 256, 11, G, bx};     \
          pg8::EpiBf16<0> E{(bf16_t*)TP, DM, (long)MS * DM, 256, 1.f, 0};     \
          pg8::gemm_phase<pg8::EpiBf16<0>, true>(lds, wave, g, S, E); \
          GRID_BAR(); } } while (0)
    { const float* ng = norm_g;
    FFN_GEMMS(0);
    thin_phase<true, true, true, false>(gw, NGW, x_prompt, x_sample, T, TP, 11, H, nullptr, XN, ng + 1 * DM, ng + 2 * DM, 0.5f); GRID_BAR();
        {
            pg8::Gemm g{XN, WDOWN, DM, DM, DM, 0, 0}; pg8::Order S{M / 256, DDOWN_P / 256, 1, G, bx};
            pg8::EpiBf16<0> E{D, DDOWN_P, 0, 256, 1.f, 0};
            pg8::gemm_phase<pg8::EpiBf16<0>, true>(lds, wave, g, S, E);
            GRID_BAR();
        }
        {
            const int lane = lane_now(), tid = wave * 64 + lane; (void)tid;
            f32x2 gq[3]; f32x4 gkv;
    #pragma unroll
            for (int j = 0; j < 3; ++j) gq[j] = *(const f32x2*)(mla_g_q + 2 * lane + 128 * j);
            gkv = *(const f32x4*)(mla_g_kv + 4 * lane);
            for (int r = gw; r < M; r += NGW) {
                const bf16_t* d = D + (size_t)r * DDOWN_P;
                f32x2 q[3];
    #pragma unroll
                for (int j = 0; j < 3; ++j) { const unsigned w = *(const unsigned*)(d + 2 * lane + 128 * j); q[j] = (f32x2){__uint_as_float(w << 16), __uint_as_float(w & 0xffff0000u)}; }
                const u32x2 kw = *(const u32x2*)(d + QL + 4 * lane);
                const f32x4 kv = (f32x4){__uint_as_float(kw.x << 16), __uint_as_float(kw.x & 0xffff0000u), __uint_as_float(kw.y << 16), __uint_as_float(kw.y & 0xffff0000u)};
                const float pe = bf2f(d[QL + KVL + lane]);
                float sq = 0.f;
    #pragma unroll
                for (int j = 0; j < 3; ++j) sq += q[j][0] * q[j][0] + q[j][1] * q[j][1];
                sq = wave_sum(sq);
                const float skv = wave_sum((kv[0] * kv[0] + kv[1] * kv[1]) + (kv[2] * kv[2] + kv[3] * kv[3]));
                const float rq = __builtin_amdgcn_rsqf(sq * (1.0f / QL) + EPS), rkv = __builtin_amdgcn_rsqf(skv * (1.0f / KVL) + EPS);
    #pragma unroll
                for (int j = 0; j < 3; ++j) *(unsigned*)(CQ + (size_t)r * QL + 2 * lane + 128 * j) = cvt_pk_bf16(q[j][0] * rq * gq[j][0], q[j][1] * rq * gq[j][1]);
                const f32x4 ckv = (kv * rkv) * gkv;
                float* ockv = r < MP ? out + OUT_CKV_P + (size_t)r * KVL : out + OUT_CKV_S + (size_t)(r - MP) * KVL;
                *(f32x4*)(ockv + 4 * lane) = ckv;
                u32x2 w; w.x = cvt_pk_bf16(ckv[0], ckv[1]); w.y = cvt_pk_bf16(ckv[2], ckv[3]);
                *(u32x2*)(CKV + (size_t)r * KVL + 4 * lane) = w;
                const float other = __shfl_xor(pe, 32);
                const f32x2 cs = ((const f32x2*)ROPE_T)[rope_pos_index(r) * 32 + (lane & 31)];
                const float ro = lane < 32 ? pe * cs[0] - other * cs[1] : pe * cs[0] + other * cs[1];
                float* okpe = r < MP ? out + OUT_KPE_P + (size_t)r * ROPE : out + OUT_KPE_S + (size_t)(r - MP) * ROPE;
                okpe[lane] = ro;
                const unsigned short rb = (unsigned short)(cvt_pk_bf16(ro, 0.f) & 0xffffu);
                if (r < MP) KPEP[(size_t)r * ROPE + lane] = rb; else KPES[(size_t)(r - MP) * ROPE + lane] = rb;
            }
            GRID_BAR();
        }

        bf16_t* Qb = (bf16_t*)(ws + WS_Q); bf16_t* VT = (bf16_t*)(ws + WS_VT); bf16_t* QLAT = (bf16_t*)(ws + WS_QLAT); bf16_t* Ob = (bf16_t*)(ws + WS_O);
        float* OPART = (float*)(ws + WS_OPART); float* OML = (float*)(ws + WS_OML); bf16_t* OLAT = (bf16_t*)(ws + WS_OLAT);
        const float QSCALE = 0.07216878364870322f * LOG2E;
        {
            pg8::Gemm g{CQ, WUQ, QL, QL, QL, 0, 0}; pg8::Order S{MP / 256, NH * QKD / 256, 1, G, bx};
            pg8::EpiQ E{Qb, ROPE_T, QSCALE};
            pg8::gemm_phase<pg8::EpiQ, true>(lds, wave, g, S, E);
            GRID_BAR();
        }
        {
            const int NQU = (MS / 256) * (NH * QKD / 256), NQP = NQU < G / 2 ? NQU : G / 2, NQC = 32 < G - NQP ? 32 : G - NQP;
            unsigned* qctr = ctl + 16 + 64 * 4;
            if (bx < NQP) {
                pg8::Gemm g{CQ, WUQ, QL, QL, QL, 0, 0}; pg8::OrderOff S{{MS / 256, NH * QKD / 256, 1, NQP, bx}, MP / 256};
                pg8::EpiQ E{Qb, ROPE_T, QSCALE};
                pg8::gemm_phase<pg8::EpiQ, true, pg8::OrderOff>(lds, wave, g, S, E);
                if (wave == 0 && lane_now() == 0) { __builtin_amdgcn_fence(__ATOMIC_RELEASE, "agent"); asm volatile("s_waitcnt vmcnt(0)" ::: "memory"); (void)xb_add(qctr, 1u); }
            }
            { pg8::Gemm g{CKV, WUKT, KVL, KVL, KVL, 0, 0}; pg8::Order S{MP / 256, NH * NOPE / 256, 1, G, bx};
              pg8::EpiBf16<0> E{KB, NH * NOPE, 0, 256, 1.f, 0};
              pg8::gemm_phase<pg8::EpiBf16<0>, true>(lds, wave, g, S, E); }
            { pg8::Gemm g{WUVT, CKV, KVL, KVL, KVL, 0, 0}; pg8::Order S{NH * VD / 256, MP / 256, 1, G, bx};
              pg8::EpiBf16<0> E{VT, MP, 0, 256, 1.f, 0};
              pg8::gemm_phase<pg8::EpiBf16<0>, true>(lds, wave, g, S, E); }
            if (bx >= G - NQC) {
                if (wave == 0 && lane_now() == 0) { XB_SPIN(xb_ld(qctr) < (unsigned)NQP, ctl + 1024); __builtin_amdgcn_fence(__ATOMIC_ACQUIRE, "agent"); asm volatile("s_waitcnt vmcnt(0)" ::: "memory"); }
                __syncthreads();
                { pg8::Gemm g{Qb + (size_t)MP * NH * QKD, WUK, NH * QKD, NH * NOPE, NOPE, QKD, NOPE}; pg8::Order S{MS / 256, 1, NH, NQC, bx - (G - NQC)};
                  pg8::EpiBf16<0> E{QLAT, NH * 320, 320, 256, 1.f, 0};
                  pg8::gemm_phase<pg8::EpiBf16<0>, true>(lds, wave, g, S, E); }
                const int lane = lane_now(), tid = wave * 64 + lane;
                for (int i = (bx - (G - NQC)) * (NWAVES * 64) + tid; i < MS * NH * 8; i += NQC * NWAVES * 64) { const int c = i & 7, th = i >> 3;
                    *(u32x4*)(QLAT + (size_t)th * 320 + 256 + c * 8) = *(const u32x4*)(Qb + (size_t)(MP + (th >> 3)) * (NH * QKD) + (th & 7) * QKD + NOPE + c * 8); }
            }
            GRID_BAR();
        }

        {
            for (int p = vcu; p < NB * NH * 4; p += G) { const int bh = p >> 2, x = p & 3;
                pat::unit(lds, wave, Qb, KB, KPEP, VT, Ob, bh >> 3, bh & 7, 7 - x);
                pat::unit(lds, wave, Qb, KB, KPEP, VT, Ob, bh >> 3, bh & 7, x); }
            STAMP();
            for (int u = bx; u < DECB * 2; u += G)
                sat::unit(lds, wave, QLAT, cache_ckv, cache_kpe, page_table, CKV + (size_t)MP * KVL, KPES, OPART, OML, u >> 1, u & 1);
            GRID_BAR();
        }
        {
            const int lane = lane_now(), tid = wave * 64 + lane; (void)tid;
            for (int r = gw; r < DECB * 64; r += NGW) { const int b = r >> 6, q = r & 63;
                const f32x2 ml0 = *(const f32x2*)(OML + ((size_t)(b * 2) * 64 + q) * 2), ml1 = *(const f32x2*)(OML + ((size_t)(b * 2 + 1) * 64 + q) * 2);
                const float mm = fmaxf(ml0[0], ml1[0]), w0 = __builtin_amdgcn_exp2f(ml0[0] - mm), w1 = __builtin_amdgcn_exp2f(ml1[0] - mm), inv = 1.0f / (ml0[1] * w0 + ml1[1] * w1);
                const f32x4 a = *(const f32x4*)(OPART + ((size_t)(b * 2) * 64 + q) * KVL + 4 * lane), c = *(const f32x4*)(OPART + ((size_t)(b * 2 + 1) * 64 + q) * KVL + 4 * lane);
                const f32x4 v = (a * w0 + c * w1) * inv;
                u32x2 w; w.x = cvt_pk_bf16(v[0], v[1]); w.y = cvt_pk_bf16(v[2], v[3]);
                *(u32x2*)(OLAT + (size_t)r * KVL + 4 * lane) = w; }
            GRID_BAR();
        }
        {
            pg8::Gemm g{OLAT, WUVT, NH * KVL, KVL, KVL, KVL, (long)VD * KVL}; pg8::Order S{MS / 256, 1, NH, G, bx};
            pg8::EpiBf16<0> E{Ob + (size_t)MP * DM, DM, VD, 128, 1.f, 0};
            pg8::gemm_phase<pg8::EpiBf16<0>, true>(lds, wave, g, S, E);
            GRID_BAR();
        }
        {
            { pg8::Gemm g{Ob, WOT, DM, DM, DM, 0, 0}; pg8::Order S{MP / 256, DM / 256, 1, G, bx};
              pg8::EpiBf16<0> E{T, DM, 0, 256, 1.f, 0};
              pg8::gemm_phase<pg8::EpiBf16<0>, true>(lds, wave, g, S, E); }
            { pg8::Gemm g{Ob + (size_t)MP * DM, WOT, DM, DM, 256, 256, 256}; pg8::Order S{MS / 256, DM / 256, 4, G, bx};
              pg8::EpiBf16<0> E{(bf16_t*)TP, DM, (long)MS * DM, 256, 1.f, 0};
              pg8::gemm_phase<pg8::EpiBf16<0>, true>(lds, wave, g, S, E); }
            GRID_BAR();
        }
        {
            thin_phase<true, true, false, false>(gw, NGW, nullptr, nullptr, T, TP, 4, H, nullptr, XN, norm_g + 3 * DM, norm_g + 4 * DM, 1.0f);
            GRID_BAR();
        }


    FFN_GEMMS(1);
    thin_phase<true, true, false, false>(gw, NGW, nullptr, nullptr, T, TP, 11, H, nullptr, XN, ng + 5 * DM, norm_g + 6 * DM, 0.5f); GRID_BAR();
    }
    { const float* ng = norm_g + 6 * DM;
    FFN_GEMMS(2);
    thin_phase<true, true, false, false>(gw, NGW, nullptr, nullptr, T, TP, 11, H, nullptr, XN, ng + 1 * DM, ng + 2 * DM, 0.5f); GRID_BAR();
            { pg8::Gemm g{XN, WGIN, DM, DM, DM, 0, 0}; pg8::Order S{M / 256, GIN_P / 256, 1, G, bx};
              pg8::EpiGla E{QKVG, T16, 0.08838834764831845f};
              pg8::gemm_phase<pg8::EpiGla, true>(lds, wave, g, S, E);
              GRID_BAR(); }
            bf16_t* GQT = (bf16_t*)(ws + WS_GQT); bf16_t* GKH = (bf16_t*)(ws + WS_GKH); bf16_t* GAT = (bf16_t*)(ws + WS_GAT); float* GDK_ = (float*)(ws + WS_GDK);
            { for (int u = bx; u < (M / 64) * GH; u += G) { const int chunk = u >> 2, h = u & 3;
                  if (chunk < MP / 64) gla::prep<64>(lds, wave, QKVG, T16, gla_w_gk2, gla_b_gk, chunk, h, GQT, GKH, GAT, GDK_);
                  else gla::prep<8>(lds, wave, QKVG, T16, gla_w_gk2, gla_b_gk, chunk, h, GQT, GKH, GAT, GDK_); }
              GRID_BAR(); }
            { const int NPB = (G >= 2 * NB * GH * 2) ? NB * GH * 2 : 0;
              if (NPB == 0 || vcu < NPB) {
                  for (int u = vcu; u < NB * GH * 2; u += (NPB ? NPB : G)) { const int bh = u >> 1, q = u & 1, b = bh >> 2, h = bh & 3;
                      gla::chain<4>(lds, wave, GQT, GKH, GAT, GDK_, QKVG, h, b * (SEQ / 64), SEQ / 64, 0, 64, -1, 0, 128 * q, nullptr, out + OUT_ST_P + (size_t)bh * GDK * GDV, GO); } }
              if (NPB == 0 || vcu >= NPB) {
                  for (int u = (NPB ? vcu - NPB : vcu); u < DECB * GH; u += (NPB ? G - NPB : G)) { const int b = u >> 2, h = u & 3;
                      gla::chain<8>(lds, wave, GQT, GKH, GAT, GDK_, QKVG, h, MP / 64 + (b >> 3), 1, 8 * (b & 7), 8, b & 7, b & 7, 0, state_gla + (size_t)u * GDK * GDV, out + OUT_ST_S + (size_t)u * GDK * GDV, GO); } }
              GRID_BAR(); }
            { const int lane = lane_now(), tid = wave * 64 + lane; (void)tid; const f32x4 gn = *(const f32x4*)(gla_g_norm + 4 * lane);
              for (int r = gw; r < M; r += NGW) {
                  Row16 o = ld_row_bf16(GO + (size_t)r * DM, lane);
                  const u32x2* gp = (const u32x2*)(QKVG + (size_t)r * GIN + 2 * GH * GDK + GH * GDV) + lane;
#pragma unroll
                  for (int j = 0; j < 4; ++j) { const u32x2 gw2 = gp[64 * j];
                      const float ss = wave_sum((o.v[j][0] * o.v[j][0] + o.v[j][1] * o.v[j][1]) + (o.v[j][2] * o.v[j][2] + o.v[j][3] * o.v[j][3]));
                      const float rs = __builtin_amdgcn_rsqf(ss * (1.0f / GDV) + EPS);
                      const float g0 = __uint_as_float(gw2.x << 16), g1 = __uint_as_float(gw2.x & 0xffff0000u), g2 = __uint_as_float(gw2.y << 16), g3 = __uint_as_float(gw2.y & 0xffff0000u);
                      o.v[j][0] = o.v[j][0] * rs * gn[0] * pg8::silu_f(g0); o.v[j][1] = o.v[j][1] * rs * gn[1] * pg8::silu_f(g1);
                      o.v[j][2] = o.v[j][2] * rs * gn[2] * pg8::silu_f(g2); o.v[j][3] = o.v[j][3] * rs * gn[3] * pg8::silu_f(g3); }
                  st_row_bf16(XN + (size_t)r * DM, o, lane); }
              GRID_BAR(); }
            { { pg8::Gemm g{XN, WGO, DM, DM, DM, 0, 0}; pg8::Order S{MP / 256, DM / 256, 1, G, bx};
                pg8::EpiBf16<0> E{T, DM, 0, 256, 1.f, 0};
                pg8::gemm_phase<pg8::EpiBf16<0>, true>(lds, wave, g, S, E); }
              { pg8::Gemm g{XN + (size_t)MP * DM, WGO, DM, DM, 256, 256, 256}; pg8::Order S{MS / 256, DM / 256, 4, G, bx};
                pg8::EpiBf16<0> E{(bf16_t*)TP, DM, (long)MS * DM, 256, 1.f, 0};
                pg8::gemm_phase<pg8::EpiBf16<0>, true>(lds, wave, g, S, E); }
              GRID_BAR(); }
            { thin_phase<true, true, false, false>(gw, NGW, nullptr, nullptr, T, TP, 4, H, nullptr, XN, ng + 3 * DM, ng + 4 * DM, 1.0f);
              GRID_BAR(); }

    FFN_GEMMS(3);
    thin_phase<true, false, false, true>(gw, NGW, nullptr, nullptr, T, TP, 11, H, Y, XN, ng + 5 * DM, nullptr, 0.5f);
    }
#ifdef PROBE_A0
    GRID_BAR();
    {
        const int lane = lane_now(), tid = wave * 64 + lane;
        const float ta = (float)(tsb[PROBE_A1] - tsb[PROBE_A0]) * 0.01f, tb = (float)(tsb[PROBE_B1] - tsb[PROBE_B0]) * 0.01f;
        if (bx == 0 && tid == 0) out[0] += ta * 0.1f;
        const float f = 1.0f + tb * (1.0f / PROBE_BDIV);
        for (int i = bx * (NWAVES * 64) + tid; i < MS * ROPE; i += G * NWAVES * 64) out[OUT_KPE_S + i] *= f;
    }
#endif
#ifdef DBG_SCALE_MASK
    GRID_BAR();
    {
        const int lane = lane_now(), tid = wave * 64 + lane; (void)tid;
        const size_t offs[9] = {OUT_Y, OUT_Y + (size_t)MP * DM, OUT_CKV_P, OUT_KPE_P, OUT_CKV_S, OUT_KPE_S, OUT_ST_P, OUT_ST_S, OUT_END};
        for (int o = 0; o < 8; ++o) if ((DBG_SCALE_MASK >> o) & 1)
            for (size_t i = offs[o] / 4 + (size_t)vcu * (NWAVES * 64) + tid; i < offs[o + 1] / 4; i += (size_t)G * NWAVES * 64) ((f32x4*)out)[i] = ((f32x4*)out)[i] * 3.0f;
    }
#endif
#undef GRID_BAR
}

extern "C" void kernel_launch(void* const* d_in, const int* in_sizes, int n_in, void* d_out, int out_size, void* d_ws, size_t ws_size, hipStream_t stream) {
    static int grid = 0;
    if (grid == 0) {
        if (n_in != 22 || (size_t)out_size != OUT_END || ws_size < WS_END) { fprintf(stderr, "kernel_launch: unexpected shapes: n_in %d out %d ws %zu (need %zu)\n", n_in, out_size, ws_size, (size_t)WS_END); grid = -1; return; }
        int dev = 0, cus = 0, per_cu = 0;
        if (hipGetDevice(&dev) != hipSuccess || hipDeviceGetAttribute(&cus, hipDeviceAttributeMultiprocessorCount, dev) != hipSuccess) { grid = -1; return; }
        if (hipFuncSetAttribute((const void*)mk_fwd, hipFuncAttributeMaxDynamicSharedMemorySize, LDS_BYTES) != hipSuccess) { fprintf(stderr, "kernel_launch: hipFuncSetAttribute failed\n"); grid = -1; return; }
        if (hipOccupancyMaxActiveBlocksPerMultiprocessor(&per_cu, (const void*)mk_fwd, NWAVES * 64, LDS_BYTES) != hipSuccess || per_cu < 1) { fprintf(stderr, "kernel_launch: occupancy query says %d\n", per_cu); }
        (void)hipGetLastError();
        grid = cus;
    }
    if (grid < 0) return;
    if (hipMemsetAsync((char*)d_ws + WS_CTL, 0, CTL_ZERO_BYTES, stream) != hipSuccess) return;
    Args a{};
    for (int i = 0; i < 22; ++i) a.in[i] = d_in[i];
    a.out = (float*)d_out; a.ws = (unsigned char*)d_ws; a.ph_lo = 0; a.ph_hi = 100;
    hipLaunchKernelGGL(mk_fwd, dim3(grid), dim3(NWAVES * 64), LDS_BYTES, stream, a);
}
```

```cpp
#include <hip/hip_runtime.h>
#include <cstdio>
#include <cstdint>


#define GAS __attribute__((address_space(1)))
#define LAS __attribute__((address_space(3)))
typedef unsigned short bf16_t;
typedef short bf16x8 __attribute__((ext_vector_type(8)));
typedef float f32x4 __attribute__((ext_vector_type(4)));
typedef float f32x2 __attribute__((ext_vector_type(2)));
typedef float f32x16 __attribute__((ext_vector_type(16)));
typedef unsigned u32x4 __attribute__((ext_vector_type(4)));
typedef unsigned u32x2 __attribute__((ext_vector_type(2)));

constexpr int DM = 1024, NB = 16, SEQ = 2048, DECB = 128, DECT = 8, PAST = 8192, PAGE = 128, NPAGES = PAST / PAGE;
constexpr int MP = NB * SEQ, MS = DECB * DECT, M = MP + MS;
constexpr int DFF = 2816;
constexpr int QL = 384, KVL = 256, NOPE = 128, ROPE = 64, VD = 128, NH = 8, QKD = NOPE + ROPE;
constexpr int DDOWN = QL + KVL + ROPE, DDOWN_P = 768;
constexpr int GH = 4, GDK = 128, GDV = 256, GRANK = 16, GIN = 2 * GH * GDK + 2 * GH * GDV, GIN_P = GIN + 256;
constexpr float EPS = 1e-6f;
constexpr float LOG2E = 1.4426950408889634f;
constexpr int NPOOL = (DECB * NPAGES * 5) / 4;

constexpr size_t OUT_Y = 0;
constexpr size_t OUT_CKV_P = (size_t)M * DM;
constexpr size_t OUT_KPE_P = OUT_CKV_P + (size_t)MP * KVL;
constexpr size_t OUT_CKV_S = OUT_KPE_P + (size_t)MP * ROPE;
constexpr size_t OUT_KPE_S = OUT_CKV_S + (size_t)MS * KVL;
constexpr size_t OUT_ST_P = OUT_KPE_S + (size_t)MS * ROPE;
constexpr size_t OUT_ST_S = OUT_ST_P + (size_t)NB * GH * GDK * GDV;
constexpr size_t OUT_END = OUT_ST_S + (size_t)DECB * GH * GDK * GDV;

constexpr size_t MiB = 1u << 20;
constexpr size_t al(size_t x) { return (x + 4095) & ~(size_t)4095; }
constexpr size_t WS_CTL = 0, CTL_ZERO_BYTES = 64 * 1024;
constexpr size_t WS_ROPE = 1 * MiB;
constexpr size_t WS_WIN = 2 * MiB;
constexpr size_t SZ_WIN1 = (size_t)2 * DFF * DM * 2;
constexpr size_t WS_WOUT = WS_WIN + 4 * SZ_WIN1;
constexpr size_t SZ_WOUT1 = (size_t)DM * DFF * 2;
constexpr size_t WS_WDOWN = WS_WOUT + 4 * SZ_WOUT1;
constexpr size_t WS_WUQ = WS_WDOWN + (size_t)DDOWN_P * DM * 2;
constexpr size_t WS_WUKT = WS_WUQ + (size_t)NH * QKD * QL * 2;
constexpr size_t WS_WUK = WS_WUKT + (size_t)NH * NOPE * KVL * 2;
constexpr size_t WS_WUVT = WS_WUK + (size_t)NH * NOPE * KVL * 2;
constexpr size_t WS_WOT = WS_WUVT + (size_t)(NH * VD + 128) * KVL * 2;
constexpr size_t WS_WGIN = WS_WOT + (size_t)DM * DM * 2;
constexpr size_t WS_WGO = WS_WGIN + (size_t)GIN_P * DM * 2;
constexpr size_t WS_ACT = al(WS_WGO + (size_t)DM * DM * 2);
constexpr size_t WS_XN = WS_ACT;
constexpr size_t WS_HM = al(WS_XN + (size_t)M * DM * 2);
constexpr size_t WS_T = al(WS_HM + (size_t)M * DFF * 2);
constexpr size_t WS_D = al(WS_T + (size_t)M * DM * 4);
constexpr size_t WS_CQ = al(WS_D + (size_t)M * DDOWN_P * 4);
constexpr size_t WS_CKV = al(WS_CQ + (size_t)M * QL * 2);
constexpr size_t WS_KPES = al(WS_CKV + (size_t)M * KVL * 2);
constexpr size_t WS_Q = al(WS_KPES + (size_t)MS * ROPE * 2);
constexpr size_t WS_KB = al(WS_Q + (size_t)M * NH * QKD * 2);
constexpr size_t WS_KPEP = al(WS_KB + (size_t)MP * NH * NOPE * 2);
constexpr size_t WS_VT = al(WS_KPEP + (size_t)MP * ROPE * 2);
constexpr size_t WS_QLAT = al(WS_VT + (size_t)NH * VD * MP * 2);
constexpr size_t WS_O = al(WS_QLAT + (size_t)MS * NH * 320 * 2);
constexpr size_t WS_OPART = al(WS_O + (size_t)M * DM * 2);
constexpr size_t WS_OML = al(WS_OPART + (size_t)DECB * 2 * 64 * 256 * 4);
constexpr size_t WS_OLAT = al(WS_OML + (size_t)DECB * 2 * 64 * 2 * 4);
constexpr size_t WS_QKVG = al(WS_OLAT + (size_t)MS * NH * KVL * 2);
constexpr size_t WS_T16 = al(WS_QKVG + (size_t)M * GIN * 2);
constexpr size_t WS_GO = al(WS_T16 + (size_t)M * 16 * 4);
constexpr size_t WS_H = al(WS_GO + (size_t)M * DM * 4);
constexpr size_t WS_TP = al(WS_H + (size_t)M * DM * 2);
constexpr size_t WS_GQT = al(WS_TP + (size_t)11 * MS * DM * 4);
constexpr size_t WS_GKH = al(WS_GQT + (size_t)M * GH * GDK * 2);
constexpr size_t WS_GAT = al(WS_GKH + (size_t)(M / 64) * GH * 128 * 64 * 2);
constexpr size_t WS_GDK = al(WS_GAT + (size_t)(M / 64) * GH * 3072 * 2);
constexpr size_t WS_END = al(WS_GDK + (size_t)(M / 64) * GH * 1024 * 4);

constexpr int RING_BYTES = 131072;
constexpr int LDSCTL_OFF = RING_BYTES, MISC_OFF = LDSCTL_OFF + 320;
constexpr int LDS_BYTES = 147456;
constexpr int NWAVES = 8;

#define LDS_WAIT() asm volatile("s_waitcnt lgkmcnt(0)" ::: "memory")
#define VM_WAIT() asm volatile("s_waitcnt vmcnt(0)" ::: "memory")
#define RLX_AGENT __ATOMIC_RELAXED, __HIP_MEMORY_SCOPE_AGENT

typedef __bf16 bf16x2_t __attribute__((ext_vector_type(2)));
__device__ __forceinline__ unsigned cvt_pk_bf16(float lo, float hi) { const f32x2 v = {lo, hi}; const bf16x2_t b = __builtin_convertvector(v, bf16x2_t); return __builtin_bit_cast(unsigned, b); }
__device__ __forceinline__ int lane_now() { int l; asm volatile("v_mbcnt_lo_u32_b32 %0, -1, 0\n\tv_mbcnt_hi_u32_b32 %0, -1, %0" : "=v"(l)); return l; }
__device__ __forceinline__ float bf2f(unsigned short b) { return __uint_as_float((unsigned)b << 16); }
template <int CTRL> __device__ __forceinline__ float dpp_mov(float v) { return __builtin_bit_cast(float, __builtin_amdgcn_update_dpp(0, __builtin_bit_cast(int, v), CTRL, 0xF, 0xF, true)); }
__device__ __forceinline__ float wave_sum(float v) {
    v += dpp_mov<0xB1>(v);
    v += dpp_mov<0x4E>(v);
    v += dpp_mov<0x141>(v);
    v += dpp_mov<0x140>(v);
    const int iv = __builtin_bit_cast(int, v);
    const float a = __builtin_bit_cast(float, __builtin_amdgcn_readlane(iv, 0)), b = __builtin_bit_cast(float, __builtin_amdgcn_readlane(iv, 16));
    const float c = __builtin_bit_cast(float, __builtin_amdgcn_readlane(iv, 32)), d = __builtin_bit_cast(float, __builtin_amdgcn_readlane(iv, 48));
    return (a + b) + (c + d);
}

namespace pg8 {
constexpr int BM = 256, BK = 64, HALF = 128, HTB = HALF * BK * 2, STAGE_BYTES = 8 * HTB, NXCD = 8, WGM = 8;
__host__ __device__ __forceinline__ int lds_byte(int r, int c) { const int st = (r >> 4) * 2 + (c >> 5), rr = r & 15, cc = c & 31, ob = rr * 64 + cc * 2; return st * 1024 + (ob ^ (((ob >> 9) & 1) << 5)); }
__host__ __device__ __forceinline__ void stage_rc(int b, int& R, int& C) { const int st = b / 1024, sb = b % 1024, swz = sb ^ (((sb >> 9) & 1) << 5); R = (st >> 1) * 16 + swz / 64; C = (st & 1) * 32 + (swz % 64) / 2; }
__host__ __device__ __forceinline__ int perm32(int rho) { const int n = rho >> 4, i = rho & 15; return 8 * (i >> 2) + 4 * n + (i & 3); }

struct Unit { int pm, pn, z; };
struct Gemm { const bf16_t* A; const bf16_t* Bt; int lda, ldb, K; long sAz, sBz; };

struct Order {
    int nM, nN, nZ, G, c;
    __device__ __forceinline__ bool next(int i, Unit& u) const {
        const long L = (long)i * G + c; const int per = nM * nN; if (L >= (long)per * nZ) return false;
        const int z = (int)(L / per); int wgid = (int)(L - (long)z * per);
        { const int q = per / NXCD, r = per % NXCD, xcd = wgid % NXCD, off = wgid / NXCD; wgid = (xcd < r ? xcd * (q + 1) : r * (q + 1) + (xcd - r) * q) + off; }
        const int nig = WGM * nN, gid = wgid / nig, fm = gid * WGM, gsz = (nM - fm) < WGM ? (nM - fm) : WGM;
        u.pm = fm + ((wgid % nig) % gsz); u.pn = (wgid % nig) / gsz; u.z = z; return true;
    }
};

struct OrderOff {
    Order o; int m0;
    __device__ __forceinline__ bool next(int i, Unit& u) const { const bool ok = o.next(i, u); u.pm += m0; return ok; }
};

template <class Epi, bool ALIGN_EPI, class Ord = Order>
__device__ __forceinline__ void gemm_phase(LAS unsigned char* lds, const int wid, const Gemm g, const Ord& S, const Epi& E) {
    const int lane = lane_now(), tid = wid * 64 + lane;
    const int wr = wid >> 2, wc = wid & 3, fr = lane & 15, fq = lane >> 4;
    const int K = g.K, nt = K / BK;
    unsigned voffA, voffB;
    { int R, C; stage_rc(tid * 16, R, C); const int Rb = Epi::PERM ? ((R & ~31) + perm32(R & 31)) : R;
      voffA = (unsigned)(R * g.lda + C) * 2u; voffB = (unsigned)(Rb * g.ldb + C) * 2u; }
    const size_t qsA = (size_t)64 * g.lda * 2, qsB = (size_t)64 * g.ldb * 2;
    const size_t kstep = (size_t)(BK * 2);
    const size_t hsA = (size_t)HALF * g.lda * 2, hsB = (size_t)HALF * g.ldb * 2;
    const unsigned ldsw = (unsigned)wid * 1024u;
    const int aoff = lds_byte(wr * 64 + fr, fq * 8), boff = lds_byte(wc * 32 + fr, fq * 8);
#define PG8_SA(b, h) (((b) * 2 + (h)) * HTB)
#define PG8_SB(b, h) ((4 + (b) * 2 + (h)) * HTB)
#define PG8_STAGE(bufoff, gbase, voff) do { _Pragma("unroll") for (int _i = 0; _i < 2; ++_i) \
        __builtin_amdgcn_global_load_lds((const unsigned*)((const char*)(gbase) + _i * PG8_QS_##voff + (voff)), (LAS unsigned*)(lds + (bufoff) + ldsw + _i * 8192), 16, 0, 0); } while (0)
#define PG8_QS_voffA qsA
#define PG8_QS_voffB qsB
#define PG8_LDA(dst, b, h) do { _Pragma("unroll") for (int m = 0; m < 4; ++m) _Pragma("unroll") for (int k = 0; k < 2; ++k) dst[m][k] = *(const LAS bf16x8*)(lds + PG8_SA(b, h) + aoff + m * 2048 + k * 1024); } while (0)
#define PG8_LDB(dst, b, h) do { _Pragma("unroll") for (int n = 0; n < 2; ++n) _Pragma("unroll") for (int k = 0; k < 2; ++k) dst[n][k] = *(const LAS bf16x8*)(lds + PG8_SB(b, h) + boff + n * 2048 + k * 1024); } while (0)
#define PG8_MMA(ai, bj, At, Bt) do { __builtin_amdgcn_s_setprio(1); _Pragma("unroll") for (int m = 0; m < 4; ++m) _Pragma("unroll") for (int n = 0; n < 2; ++n) _Pragma("unroll") for (int k = 0; k < 2; ++k) \
        acc[ai][bj][m][n] = __builtin_amdgcn_mfma_f32_16x16x32_bf16(Bt[n][k], At[m][k], acc[ai][bj][m][n], 0, 0, 0); __builtin_amdgcn_s_setprio(0); } while (0)
#define PG8_WAIT_V(n) asm volatile("s_waitcnt vmcnt(" #n ")" ::: "memory")
#define PG8_WAIT_L(n) asm volatile("s_waitcnt lgkmcnt(" #n ")" ::: "memory")
#define PG8_BAR __builtin_amdgcn_s_barrier()
#define PG8_SCHED __builtin_amdgcn_sched_barrier(0)
#define PG8_APTR(u) ((const char*)g.A + ((size_t)(u).z * g.sAz + (size_t)(u).pm * BM * g.lda) * 2)
#define PG8_BPTR(u) ((const char*)g.Bt + ((size_t)(u).z * g.sBz + (size_t)(u).pn * BM * g.ldb) * 2)
    Unit cur, nxt; int ui = 0;
    if (!S.next(0, cur)) return;
    f32x4 acc[2][2][4][2];
#pragma unroll
    for (int a = 0; a < 2; ++a)
#pragma unroll
        for (int b = 0; b < 2; ++b)
#pragma unroll
            for (int m = 0; m < 4; ++m)
#pragma unroll
                for (int n = 0; n < 2; ++n) acc[a][b][m][n] = (f32x4){0.f, 0.f, 0.f, 0.f};
    bf16x8 At[4][2], B0[2][2], B1[2][2];
    const char* cA = PG8_APTR(cur); const char* cB = PG8_BPTR(cur);
    PG8_STAGE(PG8_SB(0, 0), cB, voffB); PG8_STAGE(PG8_SB(0, 1), cB + hsB, voffB); PG8_STAGE(PG8_SA(0, 0), cA, voffA); PG8_STAGE(PG8_SA(0, 1), cA + hsA, voffA);
    if (wr == 1) PG8_BAR;
    PG8_WAIT_V(2); PG8_BAR;
    PG8_STAGE(PG8_SB(1, 0), cB + kstep, voffB); PG8_STAGE(PG8_SA(1, 0), cA + kstep, voffA); PG8_STAGE(PG8_SB(1, 1), cB + hsB + kstep, voffB);
    PG8_WAIT_V(6); PG8_BAR;
    for (;;) {
        const bool has_next = S.next(ui + 1, nxt);
        const char* nA = has_next ? PG8_APTR(nxt) : cA; const char* nB = has_next ? PG8_BPTR(nxt) : cB;
#pragma unroll 1
        for (int t = 0; t < nt; t += 2) {
            const bool last = (t == nt - 2);
            const char* a1 = cA + (size_t)(t + 1) * kstep;
            const char* a2 = last ? nA : cA + (size_t)(t + 2) * kstep; const char* b2 = last ? nB : cB + (size_t)(t + 2) * kstep;
            const char* a3 = a2 + kstep; const char* b3 = b2 + kstep;
            PG8_LDB(B0, 0, 0); PG8_LDB(B1, 0, 1); PG8_SCHED; PG8_LDA(At, 0, 0); PG8_STAGE(PG8_SA(1, 1), a1 + hsA, voffA);
            PG8_WAIT_V(8); PG8_WAIT_L(0); PG8_BAR; PG8_MMA(0, 0, At, B0); PG8_MMA(0, 1, At, B1); PG8_BAR; PG8_SCHED;
            PG8_LDA(At, 0, 1); PG8_STAGE(PG8_SB(0, 0), b2, voffB); PG8_STAGE(PG8_SB(0, 1), b2 + hsB, voffB); PG8_STAGE(PG8_SA(0, 0), a2, voffA);
            PG8_WAIT_V(8); PG8_WAIT_L(0); PG8_BAR; PG8_MMA(1, 0, At, B0); PG8_MMA(1, 1, At, B1); PG8_BAR; PG8_SCHED;
            PG8_LDB(B0, 1, 0); PG8_LDB(B1, 1, 1); PG8_SCHED; PG8_LDA(At, 1, 0); PG8_STAGE(PG8_SA(0, 1), a2 + hsA, voffA);
            PG8_WAIT_V(8); PG8_WAIT_L(0); PG8_BAR; PG8_MMA(0, 0, At, B0); PG8_MMA(0, 1, At, B1); PG8_BAR; PG8_SCHED;
            PG8_LDA(At, 1, 1); PG8_STAGE(PG8_SB(1, 0), b3, voffB); PG8_STAGE(PG8_SB(1, 1), b3 + hsB, voffB); PG8_STAGE(PG8_SA(1, 0), a3, voffA);
            PG8_WAIT_V(8); PG8_WAIT_L(0); PG8_BAR; PG8_MMA(1, 0, At, B0); PG8_MMA(1, 1, At, B1); PG8_BAR; PG8_SCHED;
        }
        if constexpr (ALIGN_EPI) { if (wr == 0) PG8_BAR; }
        { int fr2 = fr, fq2 = fq; asm volatile("" : "+v"(fr2), "+v"(fq2)); E(acc, cur, wr, wc, fr2, fq2); }
        if (!has_next) break;
#pragma unroll
        for (int a = 0; a < 2; ++a)
#pragma unroll
            for (int b = 0; b < 2; ++b)
#pragma unroll
                for (int m = 0; m < 4; ++m)
#pragma unroll
                    for (int n = 0; n < 2; ++n) acc[a][b][m][n] = (f32x4){0.f, 0.f, 0.f, 0.f};
        cur = nxt; cA = nA; cB = nB; ++ui;
        if constexpr (ALIGN_EPI) { if (wr == 1) PG8_BAR; }
    }
    PG8_WAIT_V(0);
    if constexpr (!ALIGN_EPI) { if (wr == 0) PG8_BAR; }
    PG8_BAR;
#undef PG8_SA
#undef PG8_SB
#undef PG8_STAGE
#undef PG8_QS_voffA
#undef PG8_QS_voffB
#undef PG8_LDA
#undef PG8_LDB
#undef PG8_MMA
#undef PG8_WAIT_V
#undef PG8_WAIT_L
#undef PG8_BAR
#undef PG8_SCHED
#undef PG8_APTR
#undef PG8_BPTR
}

__device__ __forceinline__ float silu_f(float g) { return g * __builtin_amdgcn_rcpf(1.0f + __builtin_amdgcn_exp2f(-g * LOG2E)); }
__device__ __forceinline__ float swiglu_f(float g, float u) { return (g * u) * __builtin_amdgcn_rcpf(1.0f + __builtin_amdgcn_exp2f(-g)); }

struct EpiSwiGLU {
    static constexpr bool PERM = true;
    bf16_t* O; int ldc;
    __device__ __forceinline__ void operator()(const f32x4 (&acc)[2][2][4][2], const Unit& u, int wr, int wc, int fr, int fq) const {
        const int row0 = u.pm * BM + wr * 64 + fr, col0 = u.pn * HALF + wc * 32 + 8 * fq;
#pragma unroll
        for (int ai = 0; ai < 2; ++ai)
#pragma unroll
            for (int m = 0; m < 4; ++m) {
                bf16_t* rowp = O + (size_t)(row0 + ai * HALF + m * 16) * ldc + col0;
                const f32x4 g0 = acc[ai][0][m][0], g1 = acc[ai][0][m][1], u0 = acc[ai][1][m][0], u1 = acc[ai][1][m][1];
                u32x4 w;
                w.x = cvt_pk_bf16(swiglu_f(g0[0], u0[0]), swiglu_f(g0[1], u0[1])); w.y = cvt_pk_bf16(swiglu_f(g0[2], u0[2]), swiglu_f(g0[3], u0[3]));
                w.z = cvt_pk_bf16(swiglu_f(g1[0], u1[0]), swiglu_f(g1[1], u1[1])); w.w = cvt_pk_bf16(swiglu_f(g1[2], u1[2]), swiglu_f(g1[3], u1[3]));
                *(u32x4*)rowp = w;
            }
    }
};
struct EpiF32 {
    static constexpr bool PERM = false;
    float* O; int ldc; long sOz;
    __device__ __forceinline__ void operator()(const f32x4 (&acc)[2][2][4][2], const Unit& u, int wr, int wc, int fr, int fq) const {
        const int row0 = u.pm * BM + wr * 64 + fr, col0 = u.pn * BM + wc * 32 + 4 * fq;
#pragma unroll
        for (int ai = 0; ai < 2; ++ai)
#pragma unroll
            for (int m = 0; m < 4; ++m) {
                float* rowp = O + (size_t)u.z * sOz + (size_t)(row0 + ai * HALF + m * 16) * ldc + col0;
#pragma unroll
                for (int bj = 0; bj < 2; ++bj)
#pragma unroll
                    for (int n = 0; n < 2; ++n) *(f32x4*)(rowp + bj * HALF + n * 16) = acc[ai][bj][m][n];
            }
    }
};

template <int CMAP> struct EpiBf16 {
    static constexpr bool PERM = true;
    bf16_t* O; int ldc; long sOz; int ncol; float scale; int scale_cols;
    __device__ __forceinline__ void operator()(const f32x4 (&acc)[2][2][4][2], const Unit& u, int wr, int wc, int fr, int fq) const {
        const int row0 = u.pm * BM + wr * 64 + fr;
#pragma unroll
        for (int bj = 0; bj < 2; ++bj) {
            const int ct = bj * HALF + wc * 32 + 8 * fq; if (ct >= ncol) continue;
            const int c0 = u.pn * BM + ct; const int oc = CMAP == 1 ? (c0 >> 7) * 192 + (c0 & 127) : c0;
            const float sc = c0 < scale_cols ? scale : 1.f;
            bf16_t* base = O + (size_t)u.z * sOz + oc;
#pragma unroll
            for (int ai = 0; ai < 2; ++ai)
#pragma unroll
                for (int m = 0; m < 4; ++m) { const f32x4 v0 = acc[ai][bj][m][0] * sc, v1 = acc[ai][bj][m][1] * sc;
                    u32x4 w; w.x = cvt_pk_bf16(v0[0], v0[1]); w.y = cvt_pk_bf16(v0[2], v0[3]); w.z = cvt_pk_bf16(v1[0], v1[1]); w.w = cvt_pk_bf16(v1[2], v1[3]);
                    *(u32x4*)(base + (size_t)(row0 + ai * HALF + m * 16) * ldc) = w; }
        }
    }
};
struct EpiQ {
    static constexpr bool PERM = true;
    bf16_t* O; const float* rope_t; float scale;
    __device__ __forceinline__ void operator()(const f32x4 (&acc)[2][2][4][2], const Unit& u, int wr, int wc, int fr, int fq) const {
        const int row0 = u.pm * BM + wr * 64 + fr;
#pragma unroll
        for (int bj = 0; bj < 2; ++bj) {
            const int c0 = u.pn * BM + bj * HALF + wc * 32 + 8 * fq; const int h = c0 / 192, f0 = c0 - h * 192;
            if (f0 < 128) {
#pragma unroll
                for (int ai = 0; ai < 2; ++ai)
#pragma unroll
                    for (int m = 0; m < 4; ++m) { const f32x4 v0 = acc[ai][bj][m][0] * scale, v1 = acc[ai][bj][m][1] * scale;
                        u32x4 w; w.x = cvt_pk_bf16(v0[0], v0[1]); w.y = cvt_pk_bf16(v0[2], v0[3]); w.z = cvt_pk_bf16(v1[0], v1[1]); w.w = cvt_pk_bf16(v1[2], v1[3]);
                        *(u32x4*)(O + (size_t)(row0 + ai * HALF + m * 16) * 1536 + c0) = w; }
            } else {
                const int a4 = ((f0 - 128) >> 3) * 4;
#pragma unroll
                for (int ai = 0; ai < 2; ++ai)
#pragma unroll
                    for (int m = 0; m < 4; ++m) { const int r = row0 + ai * HALF + m * 16; const int pidx = r < MP ? (r & (SEQ - 1)) : SEQ + ((r - MP) & (DECT - 1));
                        const f32x4 cs0 = *(const f32x4*)(rope_t + (size_t)(pidx * 32 + a4) * 2), cs1 = *(const f32x4*)(rope_t + (size_t)(pidx * 32 + a4) * 2 + 4);
                        const f32x4 x1 = acc[ai][bj][m][0] * scale, x2 = acc[ai][bj][m][1] * scale;
                        const float y10 = x1[0] * cs0[0] - x2[0] * cs0[1], y11 = x1[1] * cs0[2] - x2[1] * cs0[3], y12 = x1[2] * cs1[0] - x2[2] * cs1[1], y13 = x1[3] * cs1[2] - x2[3] * cs1[3];
                        const float y20 = x2[0] * cs0[0] + x1[0] * cs0[1], y21 = x2[1] * cs0[2] + x1[1] * cs0[3], y22 = x2[2] * cs1[0] + x1[2] * cs1[1], y23 = x2[3] * cs1[2] + x1[3] * cs1[3];
                        bf16_t* rowp = O + (size_t)r * 1536 + h * 192 + 128 + a4;
                        u32x2 w1, w2; w1.x = cvt_pk_bf16(y10, y11); w1.y = cvt_pk_bf16(y12, y13); w2.x = cvt_pk_bf16(y20, y21); w2.y = cvt_pk_bf16(y22, y23);
                        *(u32x2*)rowp = w1; *(u32x2*)(rowp + 32) = w2; asm volatile("" ::: "memory"); }
            }
        }
    }
};

struct EpiGla {
    static constexpr bool PERM = true;
    bf16_t* O; float* T16; float qscale;
    __device__ __forceinline__ void operator()(const f32x4 (&acc)[2][2][4][2], const Unit& u, int wr, int wc, int fr, int fq) const {
        const int row0 = u.pm * BM + wr * 64 + fr;
        if (u.pn < 12) {
#pragma unroll
            for (int bj = 0; bj < 2; ++bj) {
                const int c0 = u.pn * BM + bj * HALF + wc * 32 + 8 * fq; const float sc = c0 < 512 ? qscale : 1.f;
#pragma unroll
                for (int ai = 0; ai < 2; ++ai)
#pragma unroll
                    for (int m = 0; m < 4; ++m) { const f32x4 v0 = acc[ai][bj][m][0] * sc, v1 = acc[ai][bj][m][1] * sc;
                        u32x4 w; w.x = cvt_pk_bf16(v0[0], v0[1]); w.y = cvt_pk_bf16(v0[2], v0[3]); w.z = cvt_pk_bf16(v1[0], v1[1]); w.w = cvt_pk_bf16(v1[2], v1[3]);
                        *(u32x4*)(O + (size_t)(row0 + ai * HALF + m * 16) * GIN + c0) = w; }
            }
        } else if (wc == 0 && fq < 2) {
#pragma unroll
            for (int ai = 0; ai < 2; ++ai)
#pragma unroll
                for (int m = 0; m < 4; ++m) { float* tp = T16 + (size_t)(row0 + ai * HALF + m * 16) * 16 + 8 * fq;
                    *(f32x4*)tp = acc[ai][0][m][0]; *(f32x4*)(tp + 4) = acc[ai][0][m][1]; }
        }
    }
};
}

#define XB_TMO      128
#define XB_XCNT(j)  (256  + 64 * (j))
#define XB_XSUB(j)  (1280 + 64 * (j))
#define XB_XGEN(j)  (2304 + 64 * (j))
#define XB_TOP      3328
#define XB_TOPGEN   3392
#define XCD_BAR_WORDS 3456
#define XB_SPIN_CAP (1u << 18)

__device__ __forceinline__ unsigned xb_ld(unsigned* p)              { return __hip_atomic_load(p, __ATOMIC_RELAXED, __HIP_MEMORY_SCOPE_AGENT); }
__device__ __forceinline__ unsigned xb_add(unsigned* p, unsigned v) { return __hip_atomic_fetch_add(p, v, __ATOMIC_RELAXED, __HIP_MEMORY_SCOPE_AGENT); }
__device__ __forceinline__ unsigned xb_xcc_id() { return (unsigned)__builtin_amdgcn_s_getreg((3 << 11) | 20) & 0xFu; }
#define XB_SPIN(cond, bar) do { unsigned _sp = 0; while (cond) { __builtin_amdgcn_s_sleep(1); \
    if ((++_sp & 255u) == 0u) { if (xb_ld(&(bar)[XB_TMO])) break; if (_sp > XB_SPIN_CAP) { atomicAdd(&(bar)[XB_TMO], 1u); break; } } } } while (0)

struct XcdBarrier { unsigned* bar; unsigned x; volatile LAS unsigned* st; };

__device__ __forceinline__ XcdBarrier xcd_barrier_post(unsigned* bar, volatile LAS unsigned* st, bool t0) {
    XcdBarrier b; b.bar = bar; b.x = xb_xcc_id(); b.st = st;
    if (t0) (void)xb_add(&bar[XB_XCNT(b.x)], 1u);
    return b;
}
__device__ __forceinline__ void xcd_barrier_complete(unsigned* bar, unsigned x, unsigned& nloc, unsigned& nx) {
    const unsigned G = gridDim.x * gridDim.y * gridDim.z;
    unsigned sum, cnt, mine, sp = 0u;
    for (;;) {
        sum = 0u; cnt = 0u; mine = 0u;
#pragma unroll
        for (unsigned j = 0; j < 16; ++j) { const unsigned c = xb_ld(&bar[XB_XCNT(j)]); sum += c; cnt += (c > 0u) ? 1u : 0u; mine = (j == x) ? c : mine; }
        if (sum == G) break;
        __builtin_amdgcn_s_sleep(1);
        if ((++sp & 255u) == 0u) { if (xb_ld(&bar[XB_TMO])) break; if (sp > XB_SPIN_CAP) { atomicAdd(&bar[XB_TMO], 1u); break; } }
    }
    nloc = mine > 0u ? mine : 1u; nx = cnt > 0u ? cnt : 1u;
}
__device__ __forceinline__ void xcd_barrier(const XcdBarrier& b, bool t0) {
    asm volatile("s_waitcnt vmcnt(0)" ::: "memory");
    __syncthreads();
    if (t0) {
        unsigned* bar = b.bar;
        __builtin_amdgcn_s_waitcnt(0);
        unsigned nloc = b.st[0], nx = b.st[1];
        if (nloc == 0u) { xcd_barrier_complete(bar, b.x, nloc, nx); b.st[0] = nloc; b.st[1] = nx; }
        const unsigned old = xb_add(&bar[XB_XSUB(b.x)], 1u);
        const unsigned gen = old / nloc;
        if (old + 1u == (gen + 1u) * nloc) {
            __builtin_amdgcn_fence(__ATOMIC_RELEASE, "agent");
            asm volatile("s_waitcnt vmcnt(0)" ::: "memory");
            const unsigned og = xb_add(&bar[XB_TOP], 1u);
            const unsigned tg = og / nx;
            if (og + 1u == (tg + 1u) * nx) xb_add(&bar[XB_TOPGEN], 1u);
            else XB_SPIN(xb_ld(&bar[XB_TOPGEN]) == tg, bar);
            __builtin_amdgcn_fence(__ATOMIC_ACQUIRE, "agent");
            xb_add(&bar[XB_XGEN(b.x)], 1u);
            asm volatile("s_waitcnt vmcnt(0)" ::: "memory");
        } else {
            XB_SPIN(xb_ld(&bar[XB_XGEN(b.x)]) == gen, bar);
            __builtin_amdgcn_fence(__ATOMIC_ACQUIRE, "agent");
            asm volatile("s_waitcnt vmcnt(0)" ::: "memory");
        }
    }
    __syncthreads();
}

struct Args { const void* in[22]; float* out; unsigned char* ws; int ph_lo, ph_hi; };

struct Frame {
    LAS unsigned char* lds;
    int tid, lane, wave, vcu, G;
    const float* const* dummy;
};

__device__ __forceinline__ void transpose_item(const float* W, int N, int k0, int n0, bf16_t* WT, int KT, int drow0, int interleave, LAS float* scr, int lane, float sc = 1.0f) {
    f32x4 v[8];
    const float* src = W + (size_t)(k0 + (lane >> 3)) * N + n0 + 4 * (lane & 7);
#pragma unroll
    for (int i = 0; i < 8; ++i) v[i] = *(const f32x4*)(src + (size_t)(8 * i) * N);
#pragma unroll
    for (int i = 0; i < 8; ++i) { LAS float* d = scr + (8 * i + (lane >> 3)) * 33 + 4 * (lane & 7); d[0] = v[i][0]; d[1] = v[i][1]; d[2] = v[i][2]; d[3] = v[i][3]; }
    LDS_WAIT(); asm volatile("" ::: "memory");
    const int c = lane & 7;
#pragma unroll
    for (int j = 0; j < 4; ++j) { const int n = (lane >> 3) + 8 * j; const LAS float* s = scr + (8 * c) * 33 + n;
        u32x4 o; o.x = cvt_pk_bf16(s[0 * 33] * sc, s[1 * 33] * sc); o.y = cvt_pk_bf16(s[2 * 33] * sc, s[3 * 33] * sc); o.z = cvt_pk_bf16(s[4 * 33] * sc, s[5 * 33] * sc); o.w = cvt_pk_bf16(s[6 * 33] * sc, s[7 * 33] * sc);
        const int drow = interleave ? (drow0 + 8 * (n >> 2) + (n & 3)) : (drow0 + n);
        *(u32x4*)(WT + (size_t)drow * KT + k0 + 8 * c) = o; }
    LDS_WAIT(); asm volatile("" ::: "memory");
}

struct ConvPtrs { const float *w_in, *w_out, *w_down, *w_uq, *w_uk, *w_uv, *w_o, *g_in, *g_o; bf16_t *WIN, *WOUT, *WDOWN, *WUQ, *WUKT, *WUVT, *WOT, *WGIN, *WGO; };
constexpr int I_WIN = (DM / 64) * (2 * DFF / 32);
constexpr int I_WOUT = (DFF / 64) * (DM / 32);
constexpr int I_DOWN = (DM / 64) * (DDOWN / 32);
constexpr int I_UQ = (QL / 64) * (NH * QKD / 32);
constexpr int I_UK = (KVL / 64) * (NH * NOPE / 32);
constexpr int I_UV = I_UK;
constexpr int I_O = (DM / 64) * (DM / 32);
constexpr int I_GIN = (DM / 64) * (GIN / 32);
constexpr int I_GO = I_O;
template <int SEG> __device__ __forceinline__ void conv_segment(const ConvPtrs& P, int widx, int nw, LAS float* scr, int lane) {
    constexpr int mi = SEG;
    constexpr int NIT = I_WIN + I_WOUT + (SEG == 1 ? I_DOWN + I_UQ + I_UK + I_UV + I_O : SEG == 2 ? I_GIN + I_GO : 0);
    for (int it = widx; it < NIT; it += nw) {
        int r = it;
        if (r < I_WIN) { const int nblk = 2 * DFF / 32, kb = r / nblk, nb = r % nblk, n0 = nb * 32;
            const int drow0 = n0 < DFF ? 256 * (n0 / 128) + (n0 % 128) : 256 * ((n0 - DFF) / 128) + 128 + ((n0 - DFF) % 128);
            transpose_item(P.w_in + (size_t)mi * DM * 2 * DFF, 2 * DFF, kb * 64, n0, P.WIN + (size_t)mi * 2 * DFF * DM, DM, drow0, 0, scr, lane, n0 < DFF ? LOG2E : 1.0f / LOG2E); continue; } r -= I_WIN;
        if (r < I_WOUT) { const int nblk = DM / 32, kb = r / nblk, nb = r % nblk;
            transpose_item(P.w_out + (size_t)mi * DFF * DM, DM, kb * 64, nb * 32, P.WOUT + (size_t)mi * DM * DFF, DFF, nb * 32, 0, scr, lane); continue; } r -= I_WOUT;
        if constexpr (SEG == 1) {
            if (r < I_DOWN) { const int nblk = DDOWN / 32, kb = r / nblk, nb = r % nblk;
                transpose_item(P.w_down, DDOWN, kb * 64, nb * 32, P.WDOWN, DM, nb * 32, 0, scr, lane); continue; } r -= I_DOWN;
            if (r < I_UQ) { const int nblk = NH * QKD / 32, kb = r / nblk, nb = r % nblk, n0 = nb * 32, h = n0 / QKD, f = n0 % QKD;
                if (f < NOPE) transpose_item(P.w_uq, NH * QKD, kb * 64, n0, P.WUQ, QL, n0, 0, scr, lane);
                else transpose_item(P.w_uq, NH * QKD, kb * 64, n0, P.WUQ, QL, h * QKD + NOPE + (f == NOPE ? 0 : 4), 1, scr, lane);
                continue; } r -= I_UQ;
            if (r < I_UK) { const int nblk = NH * NOPE / 32, kb = r / nblk, nb = r % nblk;
                transpose_item(P.w_uk, NH * NOPE, kb * 64, nb * 32, P.WUKT, KVL, nb * 32, 0, scr, lane); continue; } r -= I_UK;
            if (r < I_UV) { const int nblk = NH * VD / 32, kb = r / nblk, nb = r % nblk;
                transpose_item(P.w_uv, NH * VD, kb * 64, nb * 32, P.WUVT, KVL, nb * 32, 0, scr, lane); continue; } r -= I_UV;
            { const int nblk = DM / 32, kb = r / nblk, nb = r % nblk;
                transpose_item(P.w_o, DM, kb * 64, nb * 32, P.WOT, DM, nb * 32, 0, scr, lane); }
        }
        if constexpr (SEG == 2) {
            if (r < I_GIN) { const int nblk = GIN / 32, kb = r / nblk, nb = r % nblk;
                transpose_item(P.g_in, GIN, kb * 64, nb * 32, P.WGIN, DM, nb * 32, 0, scr, lane); continue; } r -= I_GIN;
            { const int nblk = DM / 32, kb = r / nblk, nb = r % nblk;
                transpose_item(P.g_o, DM, kb * 64, nb * 32, P.WGO, DM, nb * 32, 0, scr, lane); }
        }
    }
}

struct Row16 { f32x4 v[4]; };
__device__ __forceinline__ Row16 ld_row(const float* p, int lane) { Row16 r; const f32x4* q = (const f32x4*)p + lane;
#pragma unroll
    for (int j = 0; j < 4; ++j) r.v[j] = q[64 * j]; return r; }
__device__ __forceinline__ Row16 ld_row_bf16(const bf16_t* p, int lane) { Row16 r; const u32x2* q = (const u32x2*)p + lane;
#pragma unroll
    for (int j = 0; j < 4; ++j) { const u32x2 w = q[64 * j]; r.v[j][0] = __uint_as_float(w.x << 16); r.v[j][1] = __uint_as_float(w.x & 0xffff0000u); r.v[j][2] = __uint_as_float(w.y << 16); r.v[j][3] = __uint_as_float(w.y & 0xffff0000u); } return r; }
__device__ __forceinline__ float row_ss(const Row16& r) { float s = 0.f;
#pragma unroll
    for (int j = 0; j < 4; ++j) s += (r.v[j][0] * r.v[j][0] + r.v[j][1] * r.v[j][1]) + (r.v[j][2] * r.v[j][2] + r.v[j][3] * r.v[j][3]); return wave_sum(s); }
__device__ __forceinline__ void st_row_bf16(bf16_t* p, const Row16& r, int lane) { u32x2* q = (u32x2*)p + lane;
#pragma unroll
    for (int j = 0; j < 4; ++j) { u32x2 w; w.x = cvt_pk_bf16(r.v[j][0], r.v[j][1]); w.y = cvt_pk_bf16(r.v[j][2], r.v[j][3]); q[64 * j] = w; } }
__device__ __forceinline__ void st_row_f32(float* p, const Row16& r, int lane) { f32x4* q = (f32x4*)p + lane;
#pragma unroll
    for (int j = 0; j < 4; ++j) q[64 * j] = r.v[j]; }

template <bool HAS_T, bool HAS_PRE, bool SRC_X, bool FINAL>
__device__ __forceinline__ void thin_phase(int gw, int NGW, const float* xp, const float* xs, const bf16_t* T, const float* TP, int nsplit, float* RS, float* Yout, bf16_t* XN, const float* gpost, const float* gpre, float scale, const float* gold = nullptr) {
    const int lane = lane_now();
    Row16 gp, gq;
    if (HAS_T) gp = ld_row(gpost, lane);
    if (HAS_PRE) gq = ld_row(gpre, lane);
    Row16 gi;
    if (!SRC_X) { gi = ld_row(gold, lane);
#pragma unroll
        for (int j = 0; j < 4; ++j) { gi.v[j][0] = 1.0f / gi.v[j][0]; gi.v[j][1] = 1.0f / gi.v[j][1]; gi.v[j][2] = 1.0f / gi.v[j][2]; gi.v[j][3] = 1.0f / gi.v[j][3]; } }
    const bool bal = HAS_T && NGW == 2 * MS && MP % NGW == 0;
    const int N1 = bal ? MP / NGW - (nsplit > 4 ? 2 : 1) : 0;
    for (int i = 0;; ++i) {
        int r;
        if (!bal) { r = gw + i * NGW; if (r >= M) break; }
        else if (i < N1) r = gw + i * NGW;
        else if (gw < MS) { if (i > N1) break; r = MP + gw; }
        else { r = N1 * NGW + (gw - MS) + (i - N1) * (NGW - MS); if (r >= MP) break; }
        Row16 h;
        if constexpr (SRC_X) h = ld_row(r < MP ? xp + (size_t)r * DM : xs + (size_t)(r - MP) * DM, lane);
        else { h = ld_row_bf16(XN + (size_t)r * DM, lane); const float irs = ((const volatile float*)RS)[r];
#pragma unroll
            for (int j = 0; j < 4; ++j) h.v[j] = (h.v[j] * irs) * gi.v[j]; }
        if (HAS_T) {
            Row16 t;
            if (r < MP) t = ld_row_bf16(T + (size_t)r * DM, lane);
            else { const bf16_t* TPb = (const bf16_t*)TP; t = ld_row_bf16(TPb + (size_t)(r - MP) * DM, lane);
                int z = 1;
#pragma unroll 1
                for (; z + 1 < nsplit; z += 2) { const Row16 u0 = ld_row_bf16(TPb + ((size_t)z * MS + (r - MP)) * DM, lane), u1 = ld_row_bf16(TPb + ((size_t)(z + 1) * MS + (r - MP)) * DM, lane);
#pragma unroll
                    for (int j = 0; j < 4; ++j) t.v[j] = (t.v[j] + u0.v[j]) + u1.v[j]; }
                if (z < nsplit) { const Row16 u = ld_row_bf16(TPb + ((size_t)z * MS + (r - MP)) * DM, lane);
#pragma unroll
                    for (int j = 0; j < 4; ++j) t.v[j] = t.v[j] + u.v[j]; } }
            const float rs = scale * __builtin_amdgcn_rsqf(row_ss(t) * (1.0f / DM) + EPS);
#pragma unroll
            for (int j = 0; j < 4; ++j) h.v[j] = h.v[j] + (t.v[j] * rs) * gp.v[j];
            if constexpr (FINAL) st_row_f32(Yout + (size_t)r * DM, h, lane);
        }
        if (HAS_PRE) {
            const float ms = row_ss(h) * (1.0f / DM) + EPS, rs = __builtin_amdgcn_rsqf(ms);
#pragma unroll
            for (int j = 0; j < 4; ++j) h.v[j] = (h.v[j] * rs) * gq.v[j];
            st_row_bf16(XN + (size_t)r * DM, h, lane);
            if (lane == 0) RS[r] = ms * rs;
        }
    }
}

__device__ __forceinline__ int rope_pos_index(int r) { return r < MP ? (r & (SEQ - 1)) : SEQ + ((r - MP) & (DECT - 1)); }


typedef short s16x4 __attribute__((ext_vector_type(4)));
__device__ __forceinline__ int swap23(int x) { return (x & ~12) | ((x & 4) << 1) | ((x & 8) >> 1); }
__device__ __forceinline__ float half_max(float v) { auto rr = __builtin_amdgcn_permlane32_swap(__float_as_uint(v), __float_as_uint(v), false, false); return fmaxf(__uint_as_float(rr[0]), __uint_as_float(rr[1])); }
__device__ __forceinline__ float half_sum(float v) { auto rr = __builtin_amdgcn_permlane32_swap(__float_as_uint(v), __float_as_uint(v), false, false); return __uint_as_float(rr[0]) + __uint_as_float(rr[1]); }
__device__ __forceinline__ bf16x8 pack8(const f32x16& p, int o) {
    u32x4 w; w.x = cvt_pk_bf16(p[o + 0], p[o + 1]); w.y = cvt_pk_bf16(p[o + 2], p[o + 3]); w.z = cvt_pk_bf16(p[o + 4], p[o + 5]); w.w = cvt_pk_bf16(p[o + 6], p[o + 7]);
    return __builtin_bit_cast(bf16x8, w);
}
template <int NO>
__device__ __forceinline__ void softmax_step(f32x16& p0, f32x16& p1, float& m, float& lh, f32x16 (&o)[NO], bf16x8 (&pf)[4]) {
    float pm = fmaxf(p0[0], p1[0]);
#pragma unroll
    for (int r = 1; r < 16; ++r) pm = fmaxf(pm, fmaxf(p0[r], p1[r]));
    pm = half_max(pm);
    const float mn = fmaxf(m, pm), alpha = __builtin_amdgcn_exp2f(m - mn); m = mn;
    float rs = 0.f;
#pragma unroll
    for (int r = 0; r < 16; ++r) { p0[r] = __builtin_amdgcn_exp2f(p0[r] - mn); p1[r] = __builtin_amdgcn_exp2f(p1[r] - mn); rs += p0[r] + p1[r]; }
    lh = lh * alpha + rs;
    if (!__all(alpha == 1.0f)) {
#pragma unroll
        for (int d = 0; d < NO; ++d) o[d] = o[d] * alpha;
    }
    pf[0] = pack8(p0, 0); pf[1] = pack8(p0, 8); pf[2] = pack8(p1, 0); pf[3] = pack8(p1, 8);
}

template <int NO>
__device__ __forceinline__ void softmax_step1(f32x16& p0, float& m, float& lh, f32x16 (&o)[NO], bf16x8 (&pf)[2]) {
    float pm = p0[0];
#pragma unroll
    for (int r = 1; r < 16; ++r) pm = fmaxf(pm, p0[r]);
    pm = half_max(pm);
    const float mn = fmaxf(m, pm), alpha = __builtin_amdgcn_exp2f(m - mn); m = mn;
    float rs = 0.f;
#pragma unroll
    for (int r = 0; r < 16; ++r) { p0[r] = __builtin_amdgcn_exp2f(p0[r] - mn); rs += p0[r]; }
    lh = lh * alpha + rs;
    if (!__all(alpha == 1.0f)) {
#pragma unroll
        for (int d = 0; d < NO; ++d) o[d] = o[d] * alpha;
    }
    pf[0] = pack8(p0, 0); pf[1] = pack8(p0, 8);
}

namespace pat {
constexpr int KROW = 400, VROW = 144, KTILE = 64 * KROW, VTILE = 128 * VROW;
__device__ __forceinline__ void unit(LAS unsigned char* lds, const int wave, const bf16_t* Q, const bf16_t* KB, const bf16_t* KPE, const bf16_t* VT, bf16_t* O, int b, int h, int qb) {
    const int lane = lane_now(), tid = wave * 64 + lane, ql = lane & 31, hh = lane >> 5;
    const int q0 = b * SEQ + qb * 256 + 32 * wave;
    bf16x8 qf[12];
    { const bf16_t* qp = Q + (size_t)(q0 + ql) * (NH * QKD) + h * QKD + hh * 8;
#pragma unroll
      for (int ks = 0; ks < 12; ++ks) qf[ks] = *(const bf16x8*)(qp + ks * 16); }
    f32x16 o[4];
#pragma unroll
    for (int d = 0; d < 4; ++d)
#pragma unroll
        for (int r = 0; r < 16; ++r) o[d][r] = 0.f;
    float m = -1e30f, lh = 0.f;
    const int ntiles = 4 * (qb + 1);
    int krow[3], kcc[3]; unsigned koff[3];
#pragma unroll
    for (int i = 0; i < 3; ++i) { const int c = tid + 512 * i; krow[i] = c / 24; kcc[i] = c % 24; koff[i] = (unsigned)(krow[i] * KROW + kcc[i] * 16); }
    const bf16_t* kg = KB + (size_t)(b * SEQ) * (NH * NOPE) + h * NOPE;
    const bf16_t* kpg = KPE + (size_t)(b * SEQ) * ROPE;
    const bf16_t* vg = VT + (size_t)(h * VD) * MP + b * SEQ;
    const int vrow0 = tid >> 3, vcc = tid & 7;
    u32x4 kst[3], vst[2];
#define PAT_LOAD(j) do { _Pragma("unroll") for (int i = 0; i < 3; ++i) kst[i] = kcc[i] < 16 ? *(const u32x4*)(kg + (size_t)((j) * 64 + krow[i]) * (NH * NOPE) + kcc[i] * 8) : *(const u32x4*)(kpg + (size_t)((j) * 64 + krow[i]) * ROPE + (kcc[i] - 16) * 8); \
        _Pragma("unroll") for (int i = 0; i < 2; ++i) vst[i] = *(const u32x4*)(vg + (size_t)(vrow0 + 64 * i) * MP + (j) * 64 + vcc * 8); } while (0)
#define PAT_STORE(buf) do { _Pragma("unroll") for (int i = 0; i < 3; ++i) *(LAS u32x4*)(lds + (buf) * KTILE + koff[i]) = kst[i]; \
        _Pragma("unroll") for (int i = 0; i < 2; ++i) *(LAS u32x4*)(lds + 2 * KTILE + (buf) * VTILE + (vrow0 + 64 * i) * VROW + vcc * 16) = vst[i]; } while (0)
    PAT_LOAD(0); PAT_STORE(0);
    __syncthreads();
    const int kr = swap23(ql);
    for (int j = 0; j < ntiles; ++j) {
        const int buf = j & 1;
        if (j + 1 < ntiles) PAT_LOAD(j + 1);
        const int jd = j - 4 * qb;
        if (jd <= (wave >> 1)) {
            f32x16 p0, p1;
#pragma unroll
            for (int r = 0; r < 16; ++r) { p0[r] = 0.f; p1[r] = 0.f; }
            const LAS unsigned char* kb0 = lds + buf * KTILE + kr * KROW + hh * 16;
            __builtin_amdgcn_s_setprio(1);
#pragma unroll
            for (int ks = 0; ks < 12; ++ks) {
                const bf16x8 a0 = *(const LAS bf16x8*)(kb0 + ks * 32), a1 = *(const LAS bf16x8*)(kb0 + 32 * KROW + ks * 32);
                p0 = __builtin_amdgcn_mfma_f32_32x32x16_bf16(a0, qf[ks], p0, 0, 0, 0);
                p1 = __builtin_amdgcn_mfma_f32_32x32x16_bf16(a1, qf[ks], p1, 0, 0, 0);
            }
            __builtin_amdgcn_s_setprio(0);
            if (jd >= 0) {
                const int qrel = 32 * wave + ql - 64 * jd - 8 * hh;
#pragma unroll
                for (int r = 0; r < 16; ++r) { const int kk = 16 * (r >> 3) + (r & 7);
                    if (kk > qrel) p0[r] = -__builtin_inff();
                    if (kk + 32 > qrel) p1[r] = -__builtin_inff(); }
            }
            bf16x8 pf[4];
            softmax_step<4>(p0, p1, m, lh, o, pf);
            const LAS unsigned char* vb0 = lds + 2 * KTILE + buf * VTILE + ql * VROW + hh * 16;
#pragma unroll
            for (int d = 0; d < 4; ++d)
#pragma unroll
                for (int ss = 0; ss < 4; ++ss) {
                    const bf16x8 a = *(const LAS bf16x8*)(vb0 + d * 32 * VROW + ss * 32);
                    o[d] = __builtin_amdgcn_mfma_f32_32x32x16_bf16(a, pf[ss], o[d], 0, 0, 0);
                }
        }
        if (j + 1 < ntiles) PAT_STORE(buf ^ 1);
        __syncthreads();
    }
#undef PAT_LOAD
#undef PAT_STORE
    const float inv = 1.0f / half_sum(lh);
    bf16_t* op = O + (size_t)(q0 + ql) * DM + h * VD + 4 * hh;
#pragma unroll
    for (int d = 0; d < 4; ++d)
#pragma unroll
        for (int g = 0; g < 4; ++g) { u32x2 w; w.x = cvt_pk_bf16(o[d][4 * g] * inv, o[d][4 * g + 1] * inv); w.y = cvt_pk_bf16(o[d][4 * g + 2] * inv, o[d][4 * g + 3] * inv);
            *(u32x2*)(op + 32 * d + 8 * g) = w; }
}
}

namespace sat {
constexpr int KROW = 656, KTILE = 64 * KROW;
__device__ __forceinline__ bf16x8 tr_frag(const LAS unsigned char* p) {
    typedef short v4i16_t __attribute__((ext_vector_type(4)));
    const s16x4 a = __builtin_bit_cast(s16x4, __builtin_amdgcn_ds_read_tr16_b64_v4i16((LAS v4i16_t*)p));
    const s16x4 b = __builtin_bit_cast(s16x4, __builtin_amdgcn_ds_read_tr16_b64_v4i16((LAS v4i16_t*)(p + 4 * KROW)));
    bf16x8 r; r[0] = a[0]; r[1] = a[1]; r[2] = a[2]; r[3] = a[3]; r[4] = b[0]; r[5] = b[1]; r[6] = b[2]; r[7] = b[3]; return r;
}
__device__ __forceinline__ void unit(LAS unsigned char* lds, const int wave, const bf16_t* QLAT, const float* cache_ckv, const float* cache_kpe, const int* page_table, const bf16_t* CKVS  , const bf16_t* KPES,
                                     float* OPART, float* OML, int b, int split) {
    const int lane = lane_now(), tid = wave * 64 + lane, ql = lane & 31, hh = lane >> 5;
    const int qblk = wave & 1, kb = (wave >> 1) & 1, dvh = wave >> 2;
#pragma unroll
    for (int i = 0; i < 5; ++i) { const int c = tid + 512 * i, row = c / 40, cc = c % 40;
        *(LAS u32x4*)(lds + 2 * KTILE + row * KROW + cc * 16) = *(const u32x4*)(QLAT + (size_t)(b * 64 + row) * 320 + cc * 8); }
    f32x16 o[4];
#pragma unroll
    for (int d = 0; d < 4; ++d)
#pragma unroll
        for (int r = 0; r < 16; ++r) o[d][r] = 0.f;
    float m = -1e30f, lh = 0.f;
    const int npg = NPAGES / 2, ntiles = 2 * npg + (split == 1 ? 1 : 0);
    const int* pt = page_table + b * NPAGES + split * npg;
    const int crow0 = tid >> 6, ccol = tid & 63;
    const int prow0 = tid >> 4, pcol = tid & 15;
    f32x4 cst[8], pst[2];
#define SAT_LOAD(j) do { const int pg = pt[(j) >> 1]; const size_t r0 = (size_t)pg * PAGE + ((j) & 1) * 64; \
        _Pragma("unroll") for (int i = 0; i < 8; ++i) cst[i] = __builtin_nontemporal_load((const f32x4*)(cache_ckv + (r0 + crow0 + 8 * i) * KVL) + ccol); \
        _Pragma("unroll") for (int i = 0; i < 2; ++i) pst[i] = __builtin_nontemporal_load((const f32x4*)(cache_kpe + (r0 + prow0 + 32 * i) * ROPE) + pcol); } while (0)
#define SAT_STORE(buf) do { _Pragma("unroll") for (int i = 0; i < 8; ++i) { u32x2 w; w.x = cvt_pk_bf16(cst[i][0], cst[i][1]); w.y = cvt_pk_bf16(cst[i][2], cst[i][3]); \
            *(LAS u32x2*)(lds + (buf) * KTILE + (crow0 + 8 * i) * KROW + ccol * 8) = w; } \
        _Pragma("unroll") for (int i = 0; i < 2; ++i) { u32x2 w; w.x = cvt_pk_bf16(pst[i][0], pst[i][1]); w.y = cvt_pk_bf16(pst[i][2], pst[i][3]); \
            *(LAS u32x2*)(lds + (buf) * KTILE + (prow0 + 32 * i) * KROW + 512 + pcol * 8) = w; } } while (0)
#define SAT_NEW(buf) do { _Pragma("unroll") for (int i = 0; i < 5; ++i) { const int c = tid + 512 * i, row = c / 40, cc = c % 40; u32x4 v = (u32x4){0u, 0u, 0u, 0u}; \
            if (row < DECT) v = cc < 32 ? *(const u32x4*)(CKVS + (size_t)(b * DECT + row) * KVL + cc * 8) : *(const u32x4*)(KPES + (size_t)(b * DECT + row) * ROPE + (cc - 32) * 8); \
            *(LAS u32x4*)(lds + (buf) * KTILE + row * KROW + cc * 16) = v; } } while (0)
    SAT_LOAD(0); SAT_STORE(0);
    __syncthreads();
    const int kr = 32 * kb + swap23(ql);
    const int g16 = lane >> 4, i16 = lane & 15;
    const int troff = (32 * kb + 8 * (g16 >> 1) + (i16 >> 2)) * KROW + (128 * dvh + 16 * (g16 & 1) + 4 * (i16 & 3)) * 2;
    for (int j = 0; j < ntiles; ++j) {
        const int buf = j & 1;
        const bool nxt_page = (j + 1 < 2 * npg), nxt_new = (j + 1 == 2 * npg) && (split == 1);
        if (nxt_page) SAT_LOAD(j + 1);
        f32x16 p0;
#pragma unroll
        for (int r = 0; r < 16; ++r) p0[r] = 0.f;
        const LAS unsigned char* kb0 = lds + buf * KTILE + kr * KROW + hh * 16;
        const LAS unsigned char* qb0 = lds + 2 * KTILE + (32 * qblk + ql) * KROW + hh * 16;
        __builtin_amdgcn_s_setprio(1);
#pragma unroll
        for (int ks = 0; ks < 20; ++ks) p0 = __builtin_amdgcn_mfma_f32_32x32x16_bf16(*(const LAS bf16x8*)(kb0 + ks * 32), *(const LAS bf16x8*)(qb0 + ks * 32), p0, 0, 0, 0);
        __builtin_amdgcn_s_setprio(0);
        if (j == 2 * npg) {
            const int tq = (32 * qblk + ql) >> 3;
#pragma unroll
            for (int r = 0; r < 16; ++r) { const int kk = 32 * kb + 16 * (r >> 3) + 8 * hh + (r & 7); if (kk > tq) p0[r] = -__builtin_inff(); }
        }
        bf16x8 pf[2];
        softmax_step1<4>(p0, m, lh, o, pf);
        const LAS unsigned char* vb0 = lds + buf * KTILE + troff;
#pragma unroll
        for (int d = 0; d < 4; ++d)
#pragma unroll
            for (int ss = 0; ss < 2; ++ss) {
                const bf16x8 a = tr_frag(vb0 + d * 64 + ss * 16 * KROW);
                o[d] = __builtin_amdgcn_mfma_f32_32x32x16_bf16(a, pf[ss], o[d], 0, 0, 0);
            }
        if (nxt_page) SAT_STORE(buf ^ 1);
        if (nxt_new) SAT_NEW(buf ^ 1);
        __syncthreads();
    }
#undef SAT_LOAD
#undef SAT_STORE
#undef SAT_NEW
    float lt = half_sum(lh);
    const int pair = dvh * 2 + qblk;
    LAS float* xb = (LAS float*)(lds + pair * 17408);
    if (kb == 1) {
#pragma unroll
        for (int d = 0; d < 4; ++d)
#pragma unroll
            for (int r = 0; r < 16; ++r) xb[(d * 16 + r) * 64 + lane] = o[d][r];
        xb[64 * 64 + lane] = m; xb[65 * 64 + lane] = lt;
    }
    __syncthreads();
    if (kb == 0) {
        const float m1 = xb[64 * 64 + lane], l1 = xb[65 * 64 + lane];
        const float mm = fmaxf(m, m1), w0 = __builtin_amdgcn_exp2f(m - mm), w1 = __builtin_amdgcn_exp2f(m1 - mm);
#pragma unroll
        for (int d = 0; d < 4; ++d)
#pragma unroll
            for (int r = 0; r < 16; ++r) o[d][r] = o[d][r] * w0 + xb[(d * 16 + r) * 64 + lane] * w1;
        lt = lt * w0 + l1 * w1;
        const int q = 32 * qblk + ql;
        float* op = OPART + ((size_t)(b * 2 + split) * 64 + q) * KVL + 128 * dvh + 4 * hh;
#pragma unroll
        for (int d = 0; d < 4; ++d)
#pragma unroll
            for (int g = 0; g < 4; ++g) *(f32x4*)(op + 32 * d + 8 * g) = (f32x4){o[d][4 * g], o[d][4 * g + 1], o[d][4 * g + 2], o[d][4 * g + 3]};
        if (dvh == 0 && hh == 0) *(f32x2*)(OML + ((size_t)(b * 2 + split) * 64 + q) * 2) = (f32x2){mm, lt};
    }
    __syncthreads();
}
}


#define LDS_RD128(dst, addr, off) asm volatile("ds_read_b128 %0, %1 offset:%2" : "=v"(dst) : "v"(addr), "n"(off))
#define LDS_WAIT4(f, N) asm volatile("s_waitcnt lgkmcnt(" #N ")" : "+v"(f[0]), "+v"(f[1]), "+v"(f[2]), "+v"(f[3]))
namespace gla {
constexpr int QROW = 272, KTROW = 144, VROW = 528;
constexpr int P_T16 = 0, P_TOT = 4096, P_QT = 8192, P_KT = P_QT + 64 * QROW;
constexpr int C_DK = 0, C_QT = 1024, C_KH = C_QT + 64 * QROW, C_V = C_KH + 128 * KTROW, C_AT = C_V + 64 * VROW, C_O = C_AT + 6144;
static_assert(C_O + 64 * 8 * 64 <= RING_BYTES, "gla chain LDS");
static_assert(C_AT + 6144 <= RING_BYTES, "gla LDS");
__device__ __forceinline__ bf16x8 tr_frag(const LAS unsigned char* p) {
    typedef short v4i16_t __attribute__((ext_vector_type(4)));
    const s16x4 a = __builtin_bit_cast(s16x4, __builtin_amdgcn_ds_read_tr16_b64_v4i16((LAS v4i16_t*)p));
    const s16x4 b = __builtin_bit_cast(s16x4, __builtin_amdgcn_ds_read_tr16_b64_v4i16((LAS v4i16_t*)(p + 4 * VROW)));
    bf16x8 r; r[0] = a[0]; r[1] = a[1]; r[2] = a[2]; r[3] = a[3]; r[4] = b[0]; r[5] = b[1]; r[6] = b[2]; r[7] = b[3]; return r;
}
template <int SEG>
__device__ __forceinline__ void prep(LAS unsigned char* lds, const int wave, const bf16_t* QKVG, const float* T16, const float* w_gk2, const float* b_gk, int chunk, int h,
                                     bf16_t* QTg, bf16_t* KHg, bf16_t* ATg, float* DKg) {
    const int lane = lane_now(), tid = wave * 64 + lane, ql = lane & 31, hh = lane >> 5;
    const int kk = tid & 127, tq = tid >> 7, cu = chunk * 4 + h, row0 = chunk * 64;
    float w2[16];
#pragma unroll
    for (int j = 0; j < 16; ++j) w2[j] = w_gk2[j * (GH * GDK) + h * GDK + kk];
    const float bias = b_gk[h * GDK + kk];
    unsigned short qraw[16], kraw[16];
    { const bf16_t* qg = QKVG + (size_t)(row0 + tq * 16) * GIN + h * GDK + kk;
#pragma unroll
      for (int i = 0; i < 16; ++i) { qraw[i] = qg[(size_t)i * GIN]; kraw[i] = qg[(size_t)i * GIN + GH * GDK]; } }
    __syncthreads();
    if (tid < 256) *(LAS f32x4*)(lds + P_T16 + tid * 16) = *(const f32x4*)(T16 + (size_t)row0 * 16 + tid * 4);
    __syncthreads();
    float Gl[16];
    { float run = 0.f;
#pragma unroll
      for (int i = 0; i < 16; ++i) { const int t = tq * 16 + i; const LAS f32x4* tp = (const LAS f32x4*)(lds + P_T16 + t * 64);
          const f32x4 a0 = tp[0], a1 = tp[1], a2 = tp[2], a3 = tp[3];
          float z = bias;
          z += a0[0] * w2[0] + a0[1] * w2[1] + a0[2] * w2[2] + a0[3] * w2[3];
          z += a1[0] * w2[4] + a1[1] * w2[5] + a1[2] * w2[6] + a1[3] * w2[7];
          z += a2[0] * w2[8] + a2[1] * w2[9] + a2[2] * w2[10] + a2[3] * w2[11];
          z += a3[0] * w2[12] + a3[1] * w2[13] + a3[2] * w2[14] + a3[3] * w2[15];
          const float ls = fminf(z, 0.f) - 0.6931471805599453f * __builtin_amdgcn_logf(1.0f + __builtin_amdgcn_exp2f(-fabsf(z) * LOG2E));
          if (SEG == 8 && i == 8) run = 0.f;
          run += ls * (1.0f / 16.0f); Gl[i] = run; }
      if (SEG == 64) *(LAS float*)(lds + P_TOT + (tq * 128 + kk) * 4) = run; }
    float prefix = 0.f, total = 0.f;
    if (SEG == 64) {
        __syncthreads();
#pragma unroll
        for (int q = 0; q < 4; ++q) { const float v = *(const LAS float*)(lds + P_TOT + (q * 128 + kk) * 4); total += v; if (q < tq) prefix += v; }
    }
    { unsigned kh[8];
#pragma unroll
      for (int i = 0; i < 16; i += 2) {
          const float G0 = (Gl[i] + prefix) * LOG2E, G1 = (Gl[i + 1] + prefix) * LOG2E;
          const float TL = (SEG == 64 ? total : Gl[i | 7]) * LOG2E;
          const float q0 = bf2f(qraw[i]), q1 = bf2f(qraw[i + 1]), k0 = bf2f(kraw[i]), k1 = bf2f(kraw[i + 1]);
          const unsigned qq = cvt_pk_bf16(q0 * __builtin_amdgcn_exp2f(G0), q1 * __builtin_amdgcn_exp2f(G1));
          const unsigned kt = cvt_pk_bf16(k0 * __builtin_amdgcn_exp2f(-G0), k1 * __builtin_amdgcn_exp2f(-G1));
          kh[i >> 1] = cvt_pk_bf16(k0 * __builtin_amdgcn_exp2f(TL - G0), k1 * __builtin_amdgcn_exp2f(TL - G1));
          const int t = tq * 16 + i;
          *(LAS unsigned short*)(lds + P_QT + t * QROW + kk * 2) = (unsigned short)(qq & 0xffffu); *(LAS unsigned short*)(lds + P_QT + (t + 1) * QROW + kk * 2) = (unsigned short)(qq >> 16);
          *(LAS unsigned short*)(lds + P_KT + t * QROW + kk * 2) = (unsigned short)(kt & 0xffffu); *(LAS unsigned short*)(lds + P_KT + (t + 1) * QROW + kk * 2) = (unsigned short)(kt >> 16);
      }
      bf16_t* khp = KHg + ((size_t)cu * 128 + kk) * 64 + tq * 16;
      *(u32x4*)khp = (u32x4){kh[0], kh[1], kh[2], kh[3]}; *(u32x4*)(khp + 8) = (u32x4){kh[4], kh[5], kh[6], kh[7]};
      if (SEG == 64) { if (tq == 0) DKg[(size_t)cu * 1024 + kk] = __builtin_amdgcn_exp2f(total * LOG2E); }
      else { DKg[(size_t)cu * 1024 + (tq * 2) * 128 + kk] = __builtin_amdgcn_exp2f(Gl[7] * LOG2E); DKg[(size_t)cu * 1024 + (tq * 2 + 1) * 128 + kk] = __builtin_amdgcn_exp2f(Gl[15] * LOG2E); } }
    __syncthreads();
    if (wave < 3) {
        const int sb = wave >> 1, tb = (wave + 1) >> 1, kr = swap23(ql);
        f32x16 x;
#pragma unroll
        for (int r = 0; r < 16; ++r) x[r] = 0.f;
        const LAS unsigned char* ap = lds + P_KT + (32 * sb + kr) * QROW + hh * 16;
        const LAS unsigned char* bp = lds + P_QT + (32 * tb + ql) * QROW + hh * 16;
#pragma unroll
        for (int ks = 0; ks < 8; ++ks) x = __builtin_amdgcn_mfma_f32_32x32x16_bf16(*(const LAS bf16x8*)(ap + ks * 32), *(const LAS bf16x8*)(bp + ks * 32), x, 0, 0, 0);
        const int tt = 32 * tb + ql;
#pragma unroll
        for (int r = 0; r < 16; ++r) { const int sr = 32 * sb + 16 * (r >> 3) + 8 * hh + (r & 7); if (sr > tt || (SEG == 8 && (sr >> 3) != (tt >> 3))) x[r] = 0.f; }
        bf16_t* atp = ATg + (size_t)cu * 3072 + (wave * 2) * 512 + lane * 8;
        *(bf16x8*)atp = pack8(x, 0); *(bf16x8*)(atp + 512) = pack8(x, 8);
    }
#pragma unroll
    for (int i = 0; i < 2; ++i) { const int c = tid + 512 * i, row = c >> 4, cc = c & 15;
        *(u32x4*)(QTg + (size_t)(row0 + row) * (GH * GDK) + h * GDK + cc * 8) = *(const LAS u32x4*)(lds + P_QT + row * QROW + cc * 16); }
}

template <int NWV>
__device__ __forceinline__ void chain(LAS unsigned char* lds, const int wave, const bf16_t* QTg, const bf16_t* KHg, const bf16_t* ATg, const float* DKg, const bf16_t* QKVG, int h, int chunk0, int nchunk,
                                      int srow, int nrow, int sseg, int dseg, int dvbase, const float* state_in, float* state_out, bf16_t* GO) {
    constexpr int VPR = NWV * 4  , VST = NWV / 2  , VRS = 512 / VPR  ;
    const bool active = wave < NWV;
    const int lane = lane_now(), tid = wave * 64 + lane, ql = lane & 31, hh = lane >> 5;
    f32x16 S[4];
#pragma unroll
    for (int kb = 0; kb < 4; ++kb)
#pragma unroll
        for (int r = 0; r < 16; ++r) S[kb][r] = (state_in && active) ? state_in[(size_t)(32 * kb + 16 * (r >> 3) + 8 * hh + (r & 7)) * GDV + dvbase + 32 * wave + ql] : 0.f;
    const int qrow = tid >> 4, qcc = tid & 15;
    const int krow = tid >> 3, kcc = tid & 7;
    const int vrow0 = tid / VPR, vcc = tid % VPR;
    u32x4 qst[2], kst[2], vst[VST], ast, dst;
#define GLC_LOAD(c) do { const int ch = chunk0 + (c); const size_t cu = (size_t)ch * 4 + h; \
        _Pragma("unroll") for (int i = 0; i < 2; ++i) qst[i] = *(const u32x4*)(QTg + (size_t)(ch * 64 + qrow + 32 * i) * (GH * GDK) + h * GDK + qcc * 8); \
        _Pragma("unroll") for (int i = 0; i < 2; ++i) kst[i] = (sseg < 0 || kcc == sseg) ? *(const u32x4*)(KHg + (cu * 128 + krow + 64 * i) * 64 + kcc * 8) : (u32x4){0u, 0u, 0u, 0u}; \
        _Pragma("unroll") for (int i = 0; i < VST; ++i) { const int r = vrow0 + VRS * i; \
            vst[i] = (r >= srow && r < srow + nrow) ? *(const u32x4*)(QKVG + (size_t)(ch * 64 + r) * GIN + 2 * GH * GDK + h * GDV + dvbase + vcc * 8) : (u32x4){0u, 0u, 0u, 0u}; } \
        if (tid < 384) ast = *(const u32x4*)(ATg + cu * 3072 + tid * 8); \
        if (tid < 32) dst = *(const u32x4*)(DKg + cu * 1024 + dseg * 128 + tid * 4); } while (0)
    GLC_LOAD(0);
    const int g16 = lane >> 4, i16 = lane & 15;
    const int troff = (8 * (g16 >> 1) + (i16 >> 2)) * VROW + (32 * wave + 16 * (g16 & 1) + 4 * (i16 & 3)) * 2;
    const int kr = swap23(ql);
#define GLC_LDS_BAR() do { asm volatile("s_waitcnt lgkmcnt(0)" ::: "memory"); __builtin_amdgcn_s_barrier(); asm volatile("" ::: "memory"); } while (0)
#define GLC_FLUSH(cprev) do { if constexpr (NWV != 8) { int tl_ = tid; asm volatile("" : "+v"(tl_)); _Pragma("unroll") for (int i_ = 0; i_ < NWV / 2; ++i_) { const int c_ = tl_ + 512 * i_, row_ = c_ / (NWV * 4), cc_ = c_ % (NWV * 4); \
            *(u32x4*)(GO + (size_t)((chunk0 + (cprev)) * 64 + row_) * DM + h * GDV + dvbase + cc_ * 8) = *(const LAS u32x4*)(lds + C_O + row_ * (NWV * 64) + cc_ * 16); } } } while (0)
    for (int c = 0; c < nchunk; ++c) {
        GLC_LDS_BAR();
        if (c > 0) GLC_FLUSH(c - 1);
#pragma unroll
        for (int i = 0; i < 2; ++i) *(LAS u32x4*)(lds + C_QT + (qrow + 32 * i) * QROW + qcc * 16) = qst[i];
#pragma unroll
        for (int i = 0; i < 2; ++i) *(LAS u32x4*)(lds + C_KH + (krow + 64 * i) * KTROW + kcc * 16) = kst[i];
#pragma unroll
        for (int i = 0; i < VST; ++i) *(LAS u32x4*)(lds + C_V + (vrow0 + VRS * i) * VROW + vcc * 16) = vst[i];
        if (tid < 384) *(LAS u32x4*)(lds + C_AT + tid * 16) = ast;
        if (tid < 32) *(LAS u32x4*)(lds + C_DK + tid * 16) = dst;
        GLC_LDS_BAR();
        if (c + 1 < nchunk) GLC_LOAD(c + 1);
        if (active) {
        f32x16 o[2];
#pragma unroll
        for (int tb = 0; tb < 2; ++tb)
#pragma unroll
            for (int r = 0; r < 16; ++r) o[tb][r] = 0.f;
        const unsigned qa = (unsigned)(size_t)(lds + C_QT + ql * QROW + hh * 16), ka = (unsigned)(size_t)(lds + C_KH + kr * KTROW + hh * 16), ata = (unsigned)(size_t)(lds + C_AT + lane * 16);
        bf16x8 fa[4], fb[4];
#define GLC_QLD(f, kb) do { LDS_RD128(f[0], qa, (kb) * 64); LDS_RD128(f[1], qa, 32 * QROW + (kb) * 64); LDS_RD128(f[2], qa, (kb) * 64 + 32); LDS_RD128(f[3], qa, 32 * QROW + (kb) * 64 + 32); } while (0)
#define GLC_QMM(f, kb) do { const bf16x8 s0 = pack8(S[kb], 0), s1 = pack8(S[kb], 8); \
            o[0] = __builtin_amdgcn_mfma_f32_32x32x16_bf16(f[0], s0, o[0], 0, 0, 0); o[1] = __builtin_amdgcn_mfma_f32_32x32x16_bf16(f[1], s0, o[1], 0, 0, 0); \
            o[0] = __builtin_amdgcn_mfma_f32_32x32x16_bf16(f[2], s1, o[0], 0, 0, 0); o[1] = __builtin_amdgcn_mfma_f32_32x32x16_bf16(f[3], s1, o[1], 0, 0, 0); } while (0)
        GLC_QLD(fa, 0); GLC_QLD(fb, 1);
        LDS_WAIT4(fa, 4); GLC_QMM(fa, 0); GLC_QLD(fa, 2);
        LDS_WAIT4(fb, 4); GLC_QMM(fb, 1); GLC_QLD(fb, 3);
        LDS_WAIT4(fa, 4); GLC_QMM(fa, 2);
        LDS_RD128(fa[0], ata, 0 * 1024); LDS_RD128(fa[1], ata, 1 * 1024); LDS_RD128(fa[2], ata, 2 * 1024); LDS_RD128(fa[3], ata, 3 * 1024);
        LDS_WAIT4(fb, 4); GLC_QMM(fb, 3);
        LDS_RD128(fb[0], ata, 4 * 1024); LDS_RD128(fb[1], ata, 5 * 1024); LDS_RD128(fb[2], ka, 0); LDS_RD128(fb[3], ka, 32);
        bf16x8 vf[4];
#pragma unroll
        for (int ss = 0; ss < 4; ++ss) vf[ss] = tr_frag(lds + C_V + troff + ss * 16 * VROW);
        LDS_WAIT4(fa, 0); LDS_WAIT4(fb, 0);
        o[0] = __builtin_amdgcn_mfma_f32_32x32x16_bf16(fa[0], vf[0], o[0], 0, 0, 0);
        o[0] = __builtin_amdgcn_mfma_f32_32x32x16_bf16(fa[1], vf[1], o[0], 0, 0, 0);
        o[1] = __builtin_amdgcn_mfma_f32_32x32x16_bf16(fa[2], vf[0], o[1], 0, 0, 0);
        o[1] = __builtin_amdgcn_mfma_f32_32x32x16_bf16(fa[3], vf[1], o[1], 0, 0, 0);
        o[1] = __builtin_amdgcn_mfma_f32_32x32x16_bf16(fb[0], vf[2], o[1], 0, 0, 0);
        o[1] = __builtin_amdgcn_mfma_f32_32x32x16_bf16(fb[1], vf[3], o[1], 0, 0, 0);
#define GLC_KLD(f, kb) do { LDS_RD128(f[0], ka, (kb) * 32 * KTROW); LDS_RD128(f[1], ka, (kb) * 32 * KTROW + 32); LDS_RD128(f[2], ka, (kb) * 32 * KTROW + 64); LDS_RD128(f[3], ka, (kb) * 32 * KTROW + 96); } while (0)
#define GLC_SCALE(kb) do { _Pragma("unroll") for (int g = 0; g < 2; ++g) { const LAS f32x4* dp = (const LAS f32x4*)(lds + C_DK + (32 * (kb) + 16 * g + 8 * hh) * 4); const f32x4 d0 = dp[0], d1 = dp[1]; \
            S[kb][8 * g + 0] *= d0[0]; S[kb][8 * g + 1] *= d0[1]; S[kb][8 * g + 2] *= d0[2]; S[kb][8 * g + 3] *= d0[3]; \
            S[kb][8 * g + 4] *= d1[0]; S[kb][8 * g + 5] *= d1[1]; S[kb][8 * g + 6] *= d1[2]; S[kb][8 * g + 7] *= d1[3]; } } while (0)
#define GLC_KMM(f, kb) do { S[kb] = __builtin_amdgcn_mfma_f32_32x32x16_bf16(f[0], vf[0], S[kb], 0, 0, 0); S[kb] = __builtin_amdgcn_mfma_f32_32x32x16_bf16(f[1], vf[1], S[kb], 0, 0, 0); \
            S[kb] = __builtin_amdgcn_mfma_f32_32x32x16_bf16(f[2], vf[2], S[kb], 0, 0, 0); S[kb] = __builtin_amdgcn_mfma_f32_32x32x16_bf16(f[3], vf[3], S[kb], 0, 0, 0); } while (0)
        GLC_KLD(fa, 1);
        LDS_RD128(fb[0], ka, 64); LDS_RD128(fb[1], ka, 96);
        GLC_SCALE(0);
        LDS_WAIT4(fb, 0);
        S[0] = __builtin_amdgcn_mfma_f32_32x32x16_bf16(fb[2], vf[0], S[0], 0, 0, 0); S[0] = __builtin_amdgcn_mfma_f32_32x32x16_bf16(fb[3], vf[1], S[0], 0, 0, 0);
        S[0] = __builtin_amdgcn_mfma_f32_32x32x16_bf16(fb[0], vf[2], S[0], 0, 0, 0); S[0] = __builtin_amdgcn_mfma_f32_32x32x16_bf16(fb[1], vf[3], S[0], 0, 0, 0);
        GLC_KLD(fb, 2); GLC_SCALE(1);
        LDS_WAIT4(fa, 4); GLC_KMM(fa, 1); GLC_KLD(fa, 3); GLC_SCALE(2);
        LDS_WAIT4(fb, 4); GLC_KMM(fb, 2); GLC_SCALE(3);
        LDS_WAIT4(fa, 0); GLC_KMM(fa, 3);
#undef GLC_QLD
#undef GLC_QMM
#undef GLC_KLD
#undef GLC_SCALE
#undef GLC_KMM
        if constexpr (NWV != 8) {
            int qlx = ql, hhx = hh; asm volatile("" : "+v"(qlx), "+v"(hhx));
            LAS unsigned short* op_ = (LAS unsigned short*)(lds + C_O) + (4 * hhx) * (NWV * 32) + 32 * wave + qlx;
#pragma unroll
            for (int tb = 0; tb < 2; ++tb)
#pragma unroll
                for (int r = 0; r < 16; r += 2) { const unsigned w_ = cvt_pk_bf16(o[tb][r], o[tb][r + 1]);
                    const int t0_ = 32 * tb + (r & 3) + 8 * (r >> 2);
                    op_[t0_ * (NWV * 32)] = (unsigned short)(w_ & 0xffffu); op_[(t0_ + 1) * (NWV * 32)] = (unsigned short)(w_ >> 16); }
        } else {
          int qlx = ql, hhx = hh; asm volatile("" : "+v"(qlx), "+v"(hhx));
          bf16_t* gp = GO + (size_t)((chunk0 + c) * 64) * DM + h * GDV + dvbase + 32 * wave + qlx;
#pragma unroll
          for (int tb = 0; tb < 2; ++tb)
#pragma unroll
              for (int r = 0; r < 16; ++r) { const int t = 32 * tb + (r & 3) + 8 * (r >> 2) + 4 * hhx; if (t >= srow && t < srow + nrow) gp[(size_t)t * DM] = (bf16_t)(cvt_pk_bf16(o[tb][r], 0.f) & 0xffffu); } }
        }
    }
    if constexpr (NWV != 8) { GLC_LDS_BAR(); GLC_FLUSH(nchunk - 1); }
#undef GLC_FLUSH
#undef GLC_LOAD
#undef GLC_LDS_BAR
    if (active) { int qlx = ql, hhx = hh; asm volatile("" : "+v"(qlx), "+v"(hhx));
#pragma unroll
    for (int kb = 0; kb < 4; ++kb)
#pragma unroll
        for (int r = 0; r < 16; ++r) state_out[(size_t)(32 * kb + 16 * (r >> 3) + 8 * hhx + (r & 7)) * GDV + dvbase + 32 * wave + qlx] = S[kb][r]; }
    __syncthreads();
}
}

__global__ void __launch_bounds__(NWAVES * 64, 2) mk_fwd(Args args) {
    extern __shared__ __attribute__((aligned(16))) unsigned char lds_raw[];
    LAS unsigned char* lds = (LAS unsigned char*)lds_raw;
    volatile LAS unsigned* MISC = (volatile LAS unsigned*)(lds + MISC_OFF);
    const int wave = __builtin_amdgcn_readfirstlane(threadIdx.x >> 6);
    const int G = gridDim.x; const int bx = blockIdx.x; const int vcu = (G % 8 == 0) ? (bx % 8) * (G / 8) + bx / 8 : bx;
    const int gw = vcu * NWAVES + wave, NGW = G * NWAVES;
    unsigned char* ws = args.ws;
    unsigned* ctl = (unsigned*)(ws + WS_CTL);
    for (int u = wave * 64 + lane_now(); u < (LDS_BYTES - LDSCTL_OFF) / 4; u += NWAVES * 64) ((LAS unsigned*)(lds + LDSCTL_OFF))[u] = 0u;
    __syncthreads();
    XcdBarrier bar = xcd_barrier_post(ctl + 1024, MISC + 8, wave == 0 && lane_now() == 0);
#ifdef PROBE_A0
    unsigned long long* tsb = (unsigned long long*)(ws + WS_CTL + 32768);
    int n_ts = 0;
#define STAMP() do { if (bx == 0 && wave == 0 && lane_now() == 0) tsb[n_ts] = __builtin_amdgcn_s_memrealtime(); ++n_ts; } while (0)
#define GRID_BAR() do { xcd_barrier(bar, wave == 0 && lane_now() == 0); STAMP(); } while (0)
    STAMP();
#else
#define STAMP() do {} while (0)
#define GRID_BAR() xcd_barrier(bar, wave == 0 && lane_now() == 0)
#endif

    const float* x_prompt = (const float*)args.in[0]; const float* x_sample = (const float*)args.in[1];
    const float* cache_ckv = (const float*)args.in[2]; const float* cache_kpe = (const float*)args.in[3];
    const float* state_gla = (const float*)args.in[4]; const int* page_table = (const int*)args.in[5];
    const float* norm_g = (const float*)args.in[6]; const float* ffn_w_in = (const float*)args.in[7]; const float* ffn_w_out = (const float*)args.in[8];
    const float* mla_w_down = (const float*)args.in[9]; const float* mla_g_q = (const float*)args.in[10]; const float* mla_w_uq = (const float*)args.in[11];
    const float* mla_g_kv = (const float*)args.in[12]; const float* mla_w_uk = (const float*)args.in[13]; const float* mla_w_uv = (const float*)args.in[14];
    const float* mla_w_o = (const float*)args.in[15]; const float* gla_w_in = (const float*)args.in[16]; const float* gla_w_gk1 = (const float*)args.in[17];
    const float* gla_w_gk2 = (const float*)args.in[18]; const float* gla_b_gk = (const float*)args.in[19]; const float* gla_g_norm = (const float*)args.in[20];
    const float* gla_w_o = (const float*)args.in[21];
    float* out = args.out;
    float* ROPE_T = (float*)(ws + WS_ROPE);
    bf16_t* WIN = (bf16_t*)(ws + WS_WIN); bf16_t* WOUT = (bf16_t*)(ws + WS_WOUT); bf16_t* WDOWN = (bf16_t*)(ws + WS_WDOWN); bf16_t* WUQ = (bf16_t*)(ws + WS_WUQ);
    bf16_t* WUKT = (bf16_t*)(ws + WS_WUKT); bf16_t* WUK = (bf16_t*)(ws + WS_WUK); bf16_t* WUVT = (bf16_t*)(ws + WS_WUVT); bf16_t* WOT = (bf16_t*)(ws + WS_WOT);
    bf16_t* WGIN = (bf16_t*)(ws + WS_WGIN); bf16_t* WGO = (bf16_t*)(ws + WS_WGO);
    bf16_t* XN = (bf16_t*)(ws + WS_XN); bf16_t* HM = (bf16_t*)(ws + WS_HM); bf16_t* T = (bf16_t*)(ws + WS_T); float* RS = (float*)(ws + WS_H);     float* TP = (float*)(ws + WS_TP); bf16_t* D = (bf16_t*)(ws + WS_D);
    bf16_t* CQ = (bf16_t*)(ws + WS_CQ); bf16_t* CKV = (bf16_t*)(ws + WS_CKV); bf16_t* KPES = (bf16_t*)(ws + WS_KPES);
    bf16_t* KB = (bf16_t*)(ws + WS_KB); bf16_t* KPEP = (bf16_t*)(ws + WS_KPEP);
    float* Y = out + OUT_Y;
    const ConvPtrs cp{ffn_w_in, ffn_w_out, mla_w_down, mla_w_uq, mla_w_uk, mla_w_uv, mla_w_o, gla_w_in, gla_w_o, WIN, WOUT, WDOWN, WUQ, WUKT, WUVT, WOT, WGIN, WGO};

    {
        const int lane = lane_now(), tid = wave * 64 + lane; (void)tid;
        LAS float* scr = (LAS float*)(lds + wave * 16384);
        conv_segment<0>(cp, gw, NGW, scr, lane);
        const int gt = vcu * (NWAVES * 64) + tid, NGT = G * NWAVES * 64;
        for (int i = gt; i < KVL * NH * NOPE / 2; i += NGT) { const f32x2 v = ((const f32x2*)mla_w_uk)[i]; ((unsigned*)WUK)[i] = cvt_pk_bf16(v[0], v[1]); }
        for (int i = gt; i < (DDOWN_P - DDOWN) * DM / 2; i += NGT) ((unsigned*)(WDOWN + (size_t)DDOWN * DM))[i] = 0u;
        for (int i = gt; i < 128 * KVL / 2; i += NGT) ((unsigned*)(WUVT + (size_t)NH * VD * KVL))[i] = 0u;
        for (int i = gt; i < (GIN_P - GIN) * DM / 2; i += NGT) { const int row = (2 * i) / DM, k = (2 * i) % DM;
            unsigned w = 0u; if (row < GRANK) w = cvt_pk_bf16(gla_w_gk1[(size_t)k * GRANK + row], gla_w_gk1[(size_t)(k + 1) * GRANK + row]);
            ((unsigned*)(WGIN + (size_t)GIN * DM))[i] = w; }
        for (int i = gt; i < (SEQ + DECT) * 32; i += NGT) { const int p = i >> 5, fi = i & 31; const float pos = (float)(p < SEQ ? p : PAST + (p - SEQ));
            const float inv = (float)exp2(-(double)fi * (13.287712379549449 / 32.0));
            const float ang = pos * inv; double t = (double)ang * 0.15915494309189535; t -= rint(t); const float tf = (float)t;
            ((f32x2*)ROPE_T)[i] = (f32x2){__builtin_amdgcn_cosf(tf), __builtin_amdgcn_sinf(tf)}; }
        thin_phase<false, true, true, false>(gw, NGW, x_prompt, x_sample, nullptr, nullptr, 0, RS, nullptr, XN, nullptr, norm_g + 0 * DM, 1.f);
        GRID_BAR();
    }
    bf16_t* QKVG = (bf16_t*)(ws + WS_QKVG); float* T16 = (float*)(ws + WS_T16); bf16_t* GO = (bf16_t*)(ws + WS_GO);
    const int CONV_TAIL0 = ((M / 256) * (2 * DFF / 256)) % G;
#define FFN_GEMMS(slot) do { \
        { pg8::Gemm g{XN, WIN + (size_t)(slot) * 2 * DFF * DM, DM, DM, DM, 0, 0}; pg8::Order S{M / 256, 2 * DFF / 256, 1, G, bx}; \
          pg8::EpiSwiGLU E{HM, DFF}; \
          pg8::gemm_phase<pg8::EpiSwiGLU, true>(lds, wave, g, S, E); \
          if ((slot) < 3 && bx >= CONV_TAIL0) conv_segment<((slot) < 3 ? (slot) + 1 : 3)>(cp, (bx - CONV_TAIL0) * NWAVES + wave, (G - CONV_TAIL0) * NWAVES, (LAS float*)(lds + wave * 16384), lane_now()); \
          GRID_BAR(); } \
        { pg8::Gemm g{HM, WOUT + (size_t)(slot) * DM * DFF, DFF, DFF, DFF, 0, 0}; pg8::Order S{MP / 256, DM / 256, 1, G, bx};     \
          pg8::EpiBf16<0> E{T, DM, 0, 256, 1.f, 0}; \
          pg8::gemm_phase<pg8::EpiBf16<0>, true>(lds, wave, g, S, E); } \
        { pg8::Gemm g{HM + (size_t)MP * DFF, WOUT + (size_t)(slot) * DM * DFF, DFF, DFF, 256, 256, 256}; pg8::Order S{MS / 256, DM / 256, 11, G, bx};     \
          pg8::EpiBf16<0> E{(bf16_t*)TP, DM, (long)MS * DM, 256, 1.f, 0};     \
          pg8::gemm_phase<pg8::EpiBf16<0>, true>(lds, wave, g, S, E); \
          GRID_BAR(); } } while (0)
    { const float* ng = norm_g;
    FFN_GEMMS(0);
    thin_phase<true, true, false, false>(gw, NGW, nullptr, nullptr, T, TP, 11, RS, nullptr, XN, ng + 1 * DM, ng + 2 * DM, 0.5f, ng + 0 * DM); GRID_BAR();
        {
            pg8::Gemm g{XN, WDOWN, DM, DM, DM, 0, 0}; pg8::Order S{M / 256, DDOWN_P / 256, 1, G, bx};
            pg8::EpiBf16<0> E{D, DDOWN_P, 0, 256, 1.f, 0};
            pg8::gemm_phase<pg8::EpiBf16<0>, true>(lds, wave, g, S, E);
            GRID_BAR();
        }
        {
            const int lane = lane_now(), tid = wave * 64 + lane; (void)tid;
            f32x2 gq[3]; f32x4 gkv;
    #pragma unroll
            for (int j = 0; j < 3; ++j) gq[j] = *(const f32x2*)(mla_g_q + 2 * lane + 128 * j);
            gkv = *(const f32x4*)(mla_g_kv + 4 * lane);
            for (int r = gw; r < M; r += NGW) {
                const bf16_t* d = D + (size_t)r * DDOWN_P;
                f32x2 q[3];
    #pragma unroll
                for (int j = 0; j < 3; ++j) { const unsigned w = *(const unsigned*)(d + 2 * lane + 128 * j); q[j] = (f32x2){__uint_as_float(w << 16), __uint_as_float(w & 0xffff0000u)}; }
                const u32x2 kw = *(const u32x2*)(d + QL + 4 * lane);
                const f32x4 kv = (f32x4){__uint_as_float(kw.x << 16), __uint_as_float(kw.x & 0xffff0000u), __uint_as_float(kw.y << 16), __uint_as_float(kw.y & 0xffff0000u)};
                const float pe = bf2f(d[QL + KVL + lane]);
                float sq = 0.f;
    #pragma unroll
                for (int j = 0; j < 3; ++j) sq += q[j][0] * q[j][0] + q[j][1] * q[j][1];
                sq = wave_sum(sq);
                const float skv = wave_sum((kv[0] * kv[0] + kv[1] * kv[1]) + (kv[2] * kv[2] + kv[3] * kv[3]));
                const float rq = __builtin_amdgcn_rsqf(sq * (1.0f / QL) + EPS), rkv = __builtin_amdgcn_rsqf(skv * (1.0f / KVL) + EPS);
    #pragma unroll
                for (int j = 0; j < 3; ++j) *(unsigned*)(CQ + (size_t)r * QL + 2 * lane + 128 * j) = cvt_pk_bf16(q[j][0] * rq * gq[j][0], q[j][1] * rq * gq[j][1]);
                const f32x4 ckv = (kv * rkv) * gkv;
                float* ockv = r < MP ? out + OUT_CKV_P + (size_t)r * KVL : out + OUT_CKV_S + (size_t)(r - MP) * KVL;
                *(f32x4*)(ockv + 4 * lane) = ckv;
                u32x2 w; w.x = cvt_pk_bf16(ckv[0], ckv[1]); w.y = cvt_pk_bf16(ckv[2], ckv[3]);
                *(u32x2*)(CKV + (size_t)r * KVL + 4 * lane) = w;
                const float other = __shfl_xor(pe, 32);
                const f32x2 cs = ((const f32x2*)ROPE_T)[rope_pos_index(r) * 32 + (lane & 31)];
                const float ro = lane < 32 ? pe * cs[0] - other * cs[1] : pe * cs[0] + other * cs[1];
                float* okpe = r < MP ? out + OUT_KPE_P + (size_t)r * ROPE : out + OUT_KPE_S + (size_t)(r - MP) * ROPE;
                okpe[lane] = ro;
                const unsigned short rb = (unsigned short)(cvt_pk_bf16(ro, 0.f) & 0xffffu);
                if (r < MP) KPEP[(size_t)r * ROPE + lane] = rb; else KPES[(size_t)(r - MP) * ROPE + lane] = rb;
            }
            GRID_BAR();
        }

        bf16_t* Qb = (bf16_t*)(ws + WS_Q); bf16_t* VT = (bf16_t*)(ws + WS_VT); bf16_t* QLAT = (bf16_t*)(ws + WS_QLAT); bf16_t* Ob = (bf16_t*)(ws + WS_O);
        float* OPART = (float*)(ws + WS_OPART); float* OML = (float*)(ws + WS_OML); bf16_t* OLAT = (bf16_t*)(ws + WS_OLAT);
        const float QSCALE = 0.07216878364870322f * LOG2E;
        {
            pg8::Gemm g{CQ, WUQ, QL, QL, QL, 0, 0}; pg8::Order S{MP / 256, NH * QKD / 256, 1, G, bx};
            pg8::EpiQ E{Qb, ROPE_T, QSCALE};
            pg8::gemm_phase<pg8::EpiQ, true>(lds, wave, g, S, E);
            GRID_BAR();
        }
        {
            const int NQU = (MS / 256) * (NH * QKD / 256), NQP = NQU < G / 2 ? NQU : G / 2, NQC = 32 < G - NQP ? 32 : G - NQP;
            unsigned* qctr = ctl + 16 + 64 * 4;
            if (bx < NQP) {
                pg8::Gemm g{CQ, WUQ, QL, QL, QL, 0, 0}; pg8::OrderOff S{{MS / 256, NH * QKD / 256, 1, NQP, bx}, MP / 256};
                pg8::EpiQ E{Qb, ROPE_T, QSCALE};
                pg8::gemm_phase<pg8::EpiQ, true, pg8::OrderOff>(lds, wave, g, S, E);
                if (wave == 0 && lane_now() == 0) { __builtin_amdgcn_fence(__ATOMIC_RELEASE, "agent"); asm volatile("s_waitcnt vmcnt(0)" ::: "memory"); (void)xb_add(qctr, 1u); }
            }
            { pg8::Gemm g{CKV, WUKT, KVL, KVL, KVL, 0, 0}; pg8::Order S{MP / 256, NH * NOPE / 256, 1, G, bx};
              pg8::EpiBf16<0> E{KB, NH * NOPE, 0, 256, 1.f, 0};
              pg8::gemm_phase<pg8::EpiBf16<0>, true>(lds, wave, g, S, E); }
            { pg8::Gemm g{WUVT, CKV, KVL, KVL, KVL, 0, 0}; pg8::Order S{NH * VD / 256, MP / 256, 1, G, bx};
              pg8::EpiBf16<0> E{VT, MP, 0, 256, 1.f, 0};
              pg8::gemm_phase<pg8::EpiBf16<0>, true>(lds, wave, g, S, E); }
            if (bx >= G - NQC) {
                if (wave == 0 && lane_now() == 0) { XB_SPIN(xb_ld(qctr) < (unsigned)NQP, ctl + 1024); __builtin_amdgcn_fence(__ATOMIC_ACQUIRE, "agent"); asm volatile("s_waitcnt vmcnt(0)" ::: "memory"); }
                __syncthreads();
                { pg8::Gemm g{Qb + (size_t)MP * NH * QKD, WUK, NH * QKD, NH * NOPE, NOPE, QKD, NOPE}; pg8::Order S{MS / 256, 1, NH, NQC, bx - (G - NQC)};
                  pg8::EpiBf16<0> E{QLAT, NH * 320, 320, 256, 1.f, 0};
                  pg8::gemm_phase<pg8::EpiBf16<0>, true>(lds, wave, g, S, E); }
                const int lane = lane_now(), tid = wave * 64 + lane;
                for (int i = (bx - (G - NQC)) * (NWAVES * 64) + tid; i < MS * NH * 8; i += NQC * NWAVES * 64) { const int c = i & 7, th = i >> 3;
                    *(u32x4*)(QLAT + (size_t)th * 320 + 256 + c * 8) = *(const u32x4*)(Qb + (size_t)(MP + (th >> 3)) * (NH * QKD) + (th & 7) * QKD + NOPE + c * 8); }
            }
            GRID_BAR();
        }

        {
            for (int p = vcu; p < NB * NH * 4; p += G) { const int bh = p >> 2, x = p & 3;
                pat::unit(lds, wave, Qb, KB, KPEP, VT, Ob, bh >> 3, bh & 7, 7 - x);
                pat::unit(lds, wave, Qb, KB, KPEP, VT, Ob, bh >> 3, bh & 7, x); }
            STAMP();
            for (int u = bx; u < DECB * 2; u += G)
                sat::unit(lds, wave, QLAT, cache_ckv, cache_kpe, page_table, CKV + (size_t)MP * KVL, KPES, OPART, OML, u >> 1, u & 1);
            GRID_BAR();
        }
        {
            const int lane = lane_now(), tid = wave * 64 + lane; (void)tid;
            for (int r = gw; r < DECB * 64; r += NGW) { const int b = r >> 6, q = r & 63;
                const f32x2 ml0 = *(const f32x2*)(OML + ((size_t)(b * 2) * 64 + q) * 2), ml1 = *(const f32x2*)(OML + ((size_t)(b * 2 + 1) * 64 + q) * 2);
                const float mm = fmaxf(ml0[0], ml1[0]), w0 = __builtin_amdgcn_exp2f(ml0[0] - mm), w1 = __builtin_amdgcn_exp2f(ml1[0] - mm), inv = 1.0f / (ml0[1] * w0 + ml1[1] * w1);
                const f32x4 a = *(const f32x4*)(OPART + ((size_t)(b * 2) * 64 + q) * KVL + 4 * lane), c = *(const f32x4*)(OPART + ((size_t)(b * 2 + 1) * 64 + q) * KVL + 4 * lane);
                const f32x4 v = (a * w0 + c * w1) * inv;
                u32x2 w; w.x = cvt_pk_bf16(v[0], v[1]); w.y = cvt_pk_bf16(v[2], v[3]);
                *(u32x2*)(OLAT + (size_t)r * KVL + 4 * lane) = w; }
            GRID_BAR();
        }
        {
            pg8::Gemm g{OLAT, WUVT, NH * KVL, KVL, KVL, KVL, (long)VD * KVL}; pg8::Order S{MS / 256, 1, NH, G, bx};
            pg8::EpiBf16<0> E{Ob + (size_t)MP * DM, DM, VD, 128, 1.f, 0};
            pg8::gemm_phase<pg8::EpiBf16<0>, true>(lds, wave, g, S, E);
            GRID_BAR();
        }
        {
            { pg8::Gemm g{Ob, WOT, DM, DM, DM, 0, 0}; pg8::Order S{MP / 256, DM / 256, 1, G, bx};
              pg8::EpiBf16<0> E{T, DM, 0, 256, 1.f, 0};
              pg8::gemm_phase<pg8::EpiBf16<0>, true>(lds, wave, g, S, E); }
            { pg8::Gemm g{Ob + (size_t)MP * DM, WOT, DM, DM, 256, 256, 256}; pg8::Order S{MS / 256, DM / 256, 4, G, bx};
              pg8::EpiBf16<0> E{(bf16_t*)TP, DM, (long)MS * DM, 256, 1.f, 0};
              pg8::gemm_phase<pg8::EpiBf16<0>, true>(lds, wave, g, S, E); }
            GRID_BAR();
        }
        {
            thin_phase<true, true, false, false>(gw, NGW, nullptr, nullptr, T, TP, 4, RS, nullptr, XN, norm_g + 3 * DM, norm_g + 4 * DM, 1.0f, norm_g + 2 * DM);
            GRID_BAR();
        }


    FFN_GEMMS(1);
    thin_phase<true, true, false, false>(gw, NGW, nullptr, nullptr, T, TP, 11, RS, nullptr, XN, ng + 5 * DM, norm_g + 6 * DM, 0.5f, ng + 4 * DM); GRID_BAR();
    }
    { const float* ng = norm_g + 6 * DM;
    FFN_GEMMS(2);
    thin_phase<true, true, false, false>(gw, NGW, nullptr, nullptr, T, TP, 11, RS, nullptr, XN, ng + 1 * DM, ng + 2 * DM, 0.5f, ng + 0 * DM); GRID_BAR();
            { pg8::Gemm g{XN, WGIN, DM, DM, DM, 0, 0}; pg8::Order S{M / 256, GIN_P / 256, 1, G, bx};
              pg8::EpiGla E{QKVG, T16, 0.08838834764831845f};
              pg8::gemm_phase<pg8::EpiGla, true>(lds, wave, g, S, E);
              GRID_BAR(); }
            bf16_t* GQT = (bf16_t*)(ws + WS_GQT); bf16_t* GKH = (bf16_t*)(ws + WS_GKH); bf16_t* GAT = (bf16_t*)(ws + WS_GAT); float* GDK_ = (float*)(ws + WS_GDK);
            { for (int u = bx; u < (M / 64) * GH; u += G) { const int chunk = u >> 2, h = u & 3;
                  if (chunk < MP / 64) gla::prep<64>(lds, wave, QKVG, T16, gla_w_gk2, gla_b_gk, chunk, h, GQT, GKH, GAT, GDK_);
                  else gla::prep<8>(lds, wave, QKVG, T16, gla_w_gk2, gla_b_gk, chunk, h, GQT, GKH, GAT, GDK_); }
              GRID_BAR(); }
            { const int NPB = (G >= 2 * NB * GH * 2) ? NB * GH * 2 : 0;
              if (NPB == 0 || vcu < NPB) {
                  for (int u = vcu; u < NB * GH * 2; u += (NPB ? NPB : G)) { const int bh = u >> 1, q = u & 1, b = bh >> 2, h = bh & 3;
                      gla::chain<4>(lds, wave, GQT, GKH, GAT, GDK_, QKVG, h, b * (SEQ / 64), SEQ / 64, 0, 64, -1, 0, 128 * q, nullptr, out + OUT_ST_P + (size_t)bh * GDK * GDV, GO); } }
              if (NPB == 0 || vcu >= NPB) {
                  for (int u = (NPB ? vcu - NPB : vcu); u < DECB * GH; u += (NPB ? G - NPB : G)) { const int b = u >> 2, h = u & 3;
                      gla::chain<8>(lds, wave, GQT, GKH, GAT, GDK_, QKVG, h, MP / 64 + (b >> 3), 1, 8 * (b & 7), 8, b & 7, b & 7, 0, state_gla + (size_t)u * GDK * GDV, out + OUT_ST_S + (size_t)u * GDK * GDV, GO); } }
              GRID_BAR(); }
            bf16_t* GOUT = (bf16_t*)(ws + WS_O);
            { const int lane = lane_now(), tid = wave * 64 + lane; (void)tid; const f32x4 gn = *(const f32x4*)(gla_g_norm + 4 * lane);
              for (int r = gw; r < M; r += NGW) {
                  Row16 o = ld_row_bf16(GO + (size_t)r * DM, lane);
                  const u32x2* gp = (const u32x2*)(QKVG + (size_t)r * GIN + 2 * GH * GDK + GH * GDV) + lane;
#pragma unroll
                  for (int j = 0; j < 4; ++j) { const u32x2 gw2 = gp[64 * j];
                      const float ss = wave_sum((o.v[j][0] * o.v[j][0] + o.v[j][1] * o.v[j][1]) + (o.v[j][2] * o.v[j][2] + o.v[j][3] * o.v[j][3]));
                      const float rs = __builtin_amdgcn_rsqf(ss * (1.0f / GDV) + EPS);
                      const float g0 = __uint_as_float(gw2.x << 16), g1 = __uint_as_float(gw2.x & 0xffff0000u), g2 = __uint_as_float(gw2.y << 16), g3 = __uint_as_float(gw2.y & 0xffff0000u);
                      o.v[j][0] = o.v[j][0] * rs * gn[0] * pg8::silu_f(g0); o.v[j][1] = o.v[j][1] * rs * gn[1] * pg8::silu_f(g1);
                      o.v[j][2] = o.v[j][2] * rs * gn[2] * pg8::silu_f(g2); o.v[j][3] = o.v[j][3] * rs * gn[3] * pg8::silu_f(g3); }
                  st_row_bf16(GOUT + (size_t)r * DM, o, lane); }
              GRID_BAR(); }
            { { pg8::Gemm g{GOUT, WGO, DM, DM, DM, 0, 0}; pg8::Order S{MP / 256, DM / 256, 1, G, bx};
                pg8::EpiBf16<0> E{T, DM, 0, 256, 1.f, 0};
                pg8::gemm_phase<pg8::EpiBf16<0>, true>(lds, wave, g, S, E); }
              { pg8::Gemm g{GOUT + (size_t)MP * DM, WGO, DM, DM, 256, 256, 256}; pg8::Order S{MS / 256, DM / 256, 4, G, bx};
                pg8::EpiBf16<0> E{(bf16_t*)TP, DM, (long)MS * DM, 256, 1.f, 0};
                pg8::gemm_phase<pg8::EpiBf16<0>, true>(lds, wave, g, S, E); }
              GRID_BAR(); }
            { thin_phase<true, true, false, false>(gw, NGW, nullptr, nullptr, T, TP, 4, RS, nullptr, XN, ng + 3 * DM, ng + 4 * DM, 1.0f, ng + 2 * DM);
              GRID_BAR(); }

    FFN_GEMMS(3);
    thin_phase<true, false, false, true>(gw, NGW, nullptr, nullptr, T, TP, 11, RS, Y, XN, ng + 5 * DM, nullptr, 0.5f, ng + 4 * DM);
    }
#ifdef PROBE_A0
    GRID_BAR();
    {
        const int lane = lane_now(), tid = wave * 64 + lane;
        const float ta = (float)(tsb[PROBE_A1] - tsb[PROBE_A0]) * 0.01f, tb = (float)(tsb[PROBE_B1] - tsb[PROBE_B0]) * 0.01f;
        if (bx == 0 && tid == 0) out[0] += ta * 0.1f;
        const float f = 1.0f + tb * (1.0f / PROBE_BDIV);
        for (int i = bx * (NWAVES * 64) + tid; i < MS * ROPE; i += G * NWAVES * 64) out[OUT_KPE_S + i] *= f;
    }
#endif
#ifdef DBG_SCALE_MASK
    GRID_BAR();
    {
        const int lane = lane_now(), tid = wave * 64 + lane; (void)tid;
        const size_t offs[9] = {OUT_Y, OUT_Y + (size_t)MP * DM, OUT_CKV_P, OUT_KPE_P, OUT_CKV_S, OUT_KPE_S, OUT_ST_P, OUT_ST_S, OUT_END};
        for (int o = 0; o < 8; ++o) if ((DBG_SCALE_MASK >> o) & 1)
            for (size_t i = offs[o] / 4 + (size_t)vcu * (NWAVES * 64) + tid; i < offs[o + 1] / 4; i += (size_t)G * NWAVES * 64) ((f32x4*)out)[i] = ((f32x4*)out)[i] * 3.0f;
    }
#endif
#undef GRID_BAR
}

extern "C" void kernel_launch(void* const* d_in, const int* in_sizes, int n_in, void* d_out, int out_size, void* d_ws, size_t ws_size, hipStream_t stream) {
    static int grid = 0;
    if (grid == 0) {
        if (n_in != 22 || (size_t)out_size != OUT_END || ws_size < WS_END) { fprintf(stderr, "kernel_launch: unexpected shapes: n_in %d out %d ws %zu (need %zu)\n", n_in, out_size, ws_size, (size_t)WS_END); grid = -1; return; }
        int dev = 0, cus = 0, per_cu = 0;
        if (hipGetDevice(&dev) != hipSuccess || hipDeviceGetAttribute(&cus, hipDeviceAttributeMultiprocessorCount, dev) != hipSuccess) { grid = -1; return; }
        if (hipFuncSetAttribute((const void*)mk_fwd, hipFuncAttributeMaxDynamicSharedMemorySize, LDS_BYTES) != hipSuccess) { fprintf(stderr, "kernel_launch: hipFuncSetAttribute failed\n"); grid = -1; return; }
        if (hipOccupancyMaxActiveBlocksPerMultiprocessor(&per_cu, (const void*)mk_fwd, NWAVES * 64, LDS_BYTES) != hipSuccess || per_cu < 1) { fprintf(stderr, "kernel_launch: occupancy query says %d\n", per_cu); }
        (void)hipGetLastError();
        grid = cus;
    }
    if (grid < 0) return;
    if (hipMemsetAsync((char*)d_ws + WS_CTL, 0, CTL_ZERO_BYTES, stream) != hipSuccess) return;
    Args a{};
    for (int i = 0; i < 22; ++i) a.in[i] = d_in[i];
    a.out = (float*)d_out; a.ws = (unsigned char*)d_ws; a.ph_lo = 0; a.ph_hi = 100;
    hipLaunchKernelGGL(mk_fwd, dim3(grid), dim3(NWAVES * 64), LDS_BYTES, stream, a);
}
```

```cpp
#include <hip/hip_runtime.h>
#include <cstdio>
#include <cstdint>


#define GAS __attribute__((address_space(1)))
#define LAS __attribute__((address_space(3)))
typedef unsigned short bf16_t;
typedef short bf16x8 __attribute__((ext_vector_type(8)));
typedef float f32x4 __attribute__((ext_vector_type(4)));
typedef float f32x2 __attribute__((ext_vector_type(2)));
typedef float f32x16 __attribute__((ext_vector_type(16)));
typedef unsigned u32x4 __attribute__((ext_vector_type(4)));
typedef unsigned u32x2 __attribute__((ext_vector_type(2)));

constexpr int DM = 1024, NB = 16, SEQ = 2048, DECB = 128, DECT = 8, PAST = 8192, PAGE = 128, NPAGES = PAST / PAGE;
constexpr int MP = NB * SEQ, MS = DECB * DECT, M = MP + MS;
constexpr int DFF = 2816;
constexpr int QL = 384, KVL = 256, NOPE = 128, ROPE = 64, VD = 128, NH = 8, QKD = NOPE + ROPE;
constexpr int DDOWN = QL + KVL + ROPE, DDOWN_P = 768;
constexpr int GH = 4, GDK = 128, GDV = 256, GRANK = 16, GIN = 2 * GH * GDK + 2 * GH * GDV, GIN_P = GIN + 256;
constexpr float EPS = 1e-6f;
constexpr float LOG2E = 1.4426950408889634f;
constexpr int NPOOL = (DECB * NPAGES * 5) / 4;

constexpr size_t OUT_Y = 0;
constexpr size_t OUT_CKV_P = (size_t)M * DM;
constexpr size_t OUT_KPE_P = OUT_CKV_P + (size_t)MP * KVL;
constexpr size_t OUT_CKV_S = OUT_KPE_P + (size_t)MP * ROPE;
constexpr size_t OUT_KPE_S = OUT_CKV_S + (size_t)MS * KVL;
constexpr size_t OUT_ST_P = OUT_KPE_S + (size_t)MS * ROPE;
constexpr size_t OUT_ST_S = OUT_ST_P + (size_t)NB * GH * GDK * GDV;
constexpr size_t OUT_END = OUT_ST_S + (size_t)DECB * GH * GDK * GDV;

constexpr size_t MiB = 1u << 20;
constexpr size_t al(size_t x) { return (x + 4095) & ~(size_t)4095; }
constexpr size_t WS_CTL = 0, CTL_ZERO_BYTES = 64 * 1024;
constexpr size_t WS_ROPE = 1 * MiB;
constexpr size_t WS_WIN = 2 * MiB;
constexpr size_t SZ_WIN1 = (size_t)2 * DFF * DM * 2;
constexpr size_t WS_WOUT = WS_WIN + 4 * SZ_WIN1;
constexpr size_t SZ_WOUT1 = (size_t)DM * DFF * 2;
constexpr size_t WS_WDOWN = WS_WOUT + 4 * SZ_WOUT1;
constexpr size_t WS_WUQ = WS_WDOWN + (size_t)DDOWN_P * DM * 2;
constexpr size_t WS_WUKT = WS_WUQ + (size_t)NH * QKD * QL * 2;
constexpr size_t WS_WUK = WS_WUKT + (size_t)NH * NOPE * KVL * 2;
constexpr size_t WS_WUVT = WS_WUK + (size_t)NH * NOPE * KVL * 2;
constexpr size_t WS_WOT = WS_WUVT + (size_t)(NH * VD + 128) * KVL * 2;
constexpr size_t WS_WGIN = WS_WOT + (size_t)DM * DM * 2;
constexpr size_t WS_WGO = WS_WGIN + (size_t)GIN_P * DM * 2;
constexpr size_t WS_ACT = al(WS_WGO + (size_t)DM * DM * 2);
constexpr size_t WS_XN = WS_ACT;
constexpr size_t WS_HM = al(WS_XN + (size_t)M * DM * 2);
constexpr size_t WS_T = al(WS_HM + (size_t)M * DFF * 2);
constexpr size_t WS_D = al(WS_T + (size_t)M * DM * 4);
constexpr size_t WS_CQ = al(WS_D + (size_t)M * DDOWN_P * 4);
constexpr size_t WS_CKV = al(WS_CQ + (size_t)M * QL * 2);
constexpr size_t WS_KPES = al(WS_CKV + (size_t)M * KVL * 2);
constexpr size_t WS_Q = al(WS_KPES + (size_t)MS * ROPE * 2);
constexpr size_t WS_KB = al(WS_Q + (size_t)M * NH * QKD * 2);
constexpr size_t WS_KPEP = al(WS_KB + (size_t)MP * NH * NOPE * 2);
constexpr size_t WS_VT = al(WS_KPEP + (size_t)MP * ROPE * 2);
constexpr size_t WS_QLAT = al(WS_VT + (size_t)NH * VD * MP * 2);
constexpr size_t WS_O = al(WS_QLAT + (size_t)MS * NH * 320 * 2);
constexpr size_t WS_OPART = al(WS_O + (size_t)M * DM * 2);
constexpr size_t WS_OML = al(WS_OPART + (size_t)DECB * 2 * 64 * 256 * 4);
constexpr size_t WS_OLAT = al(WS_OML + (size_t)DECB * 2 * 64 * 2 * 4);
constexpr size_t WS_QKVG = al(WS_OLAT + (size_t)MS * NH * KVL * 2);
constexpr size_t WS_T16 = al(WS_QKVG + (size_t)M * GIN * 2);
constexpr size_t WS_GO = al(WS_T16 + (size_t)M * 16 * 4);
constexpr size_t WS_H = al(WS_GO + (size_t)M * DM * 4);
constexpr size_t WS_TP = al(WS_H + (size_t)M * DM * 2);
constexpr size_t WS_GQT = al(WS_TP + (size_t)11 * MS * DM * 4);
constexpr size_t WS_GKH = al(WS_GQT + (size_t)M * GH * GDK * 2);
constexpr size_t WS_GAT = al(WS_GKH + (size_t)(M / 64) * GH * 128 * 64 * 2);
constexpr size_t WS_GDK = al(WS_GAT + (size_t)(M / 64) * GH * 3072 * 2);
constexpr size_t WS_END = al(WS_GDK + (size_t)(M / 64) * GH * 1024 * 4);

constexpr int RING_BYTES = 131072;
constexpr int LDSCTL_OFF = RING_BYTES, MISC_OFF = LDSCTL_OFF + 320;
constexpr int LDS_BYTES = 147456;
constexpr int NWAVES = 8;

#define LDS_WAIT() asm volatile("s_waitcnt lgkmcnt(0)" ::: "memory")
#define VM_WAIT() asm volatile("s_waitcnt vmcnt(0)" ::: "memory")
#define RLX_AGENT __ATOMIC_RELAXED, __HIP_MEMORY_SCOPE_AGENT

typedef __bf16 bf16x2_t __attribute__((ext_vector_type(2)));
__device__ __forceinline__ unsigned cvt_pk_bf16(float lo, float hi) { const f32x2 v = {lo, hi}; const bf16x2_t b = __builtin_convertvector(v, bf16x2_t); return __builtin_bit_cast(unsigned, b); }
__device__ __forceinline__ int lane_now() { int l; asm volatile("v_mbcnt_lo_u32_b32 %0, -1, 0\n\tv_mbcnt_hi_u32_b32 %0, -1, %0" : "=v"(l)); return l; }
__device__ __forceinline__ float bf2f(unsigned short b) { return __uint_as_float((unsigned)b << 16); }
template <int CTRL> __device__ __forceinline__ float dpp_mov(float v) { return __builtin_bit_cast(float, __builtin_amdgcn_update_dpp(0, __builtin_bit_cast(int, v), CTRL, 0xF, 0xF, true)); }
__device__ __forceinline__ float wave_sum(float v) {
    v += dpp_mov<0xB1>(v);
    v += dpp_mov<0x4E>(v);
    v += dpp_mov<0x141>(v);
    v += dpp_mov<0x140>(v);
    const int iv = __builtin_bit_cast(int, v);
    const float a = __builtin_bit_cast(float, __builtin_amdgcn_readlane(iv, 0)), b = __builtin_bit_cast(float, __builtin_amdgcn_readlane(iv, 16));
    const float c = __builtin_bit_cast(float, __builtin_amdgcn_readlane(iv, 32)), d = __builtin_bit_cast(float, __builtin_amdgcn_readlane(iv, 48));
    return (a + b) + (c + d);
}

namespace pg8 {
constexpr int BM = 256, BK = 64, HALF = 128, HTB = HALF * BK * 2, STAGE_BYTES = 8 * HTB, NXCD = 8, WGM = 8;
__host__ __device__ __forceinline__ int lds_byte(int r, int c) { const int st = (r >> 4) * 2 + (c >> 5), rr = r & 15, cc = c & 31, ob = rr * 64 + cc * 2; return st * 1024 + (ob ^ (((ob >> 9) & 1) << 5)); }
__host__ __device__ __forceinline__ void stage_rc(int b, int& R, int& C) { const int st = b / 1024, sb = b % 1024, swz = sb ^ (((sb >> 9) & 1) << 5); R = (st >> 1) * 16 + swz / 64; C = (st & 1) * 32 + (swz % 64) / 2; }
__host__ __device__ __forceinline__ int perm32(int rho) { const int n = rho >> 4, i = rho & 15; return 8 * (i >> 2) + 4 * n + (i & 3); }

struct Unit { int pm, pn, z; };
struct Gemm { const bf16_t* A; const bf16_t* Bt; int lda, ldb, K; long sAz, sBz; };

struct Order {
    int nM, nN, nZ, G, c;
    __device__ __forceinline__ bool next(int i, Unit& u) const {
        const long L = (long)i * G + c; const int per = nM * nN; if (L >= (long)per * nZ) return false;
        const int z = (int)(L / per); int wgid = (int)(L - (long)z * per);
        { const int q = per / NXCD, r = per % NXCD, xcd = wgid % NXCD, off = wgid / NXCD; wgid = (xcd < r ? xcd * (q + 1) : r * (q + 1) + (xcd - r) * q) + off; }
        const int nig = WGM * nN, gid = wgid / nig, fm = gid * WGM, gsz = (nM - fm) < WGM ? (nM - fm) : WGM;
        u.pm = fm + ((wgid % nig) % gsz); u.pn = (wgid % nig) / gsz; u.z = z; return true;
    }
};

struct OrderOff {
    Order o; int m0;
    __device__ __forceinline__ bool next(int i, Unit& u) const { const bool ok = o.next(i, u); u.pm += m0; return ok; }
};

template <class Epi, bool ALIGN_EPI, class Ord = Order>
__device__ __forceinline__ void gemm_phase(LAS unsigned char* lds, const int wid, const Gemm g, const Ord& S, const Epi& E) {
    const int lane = lane_now(), tid = wid * 64 + lane;
    const int wr = wid >> 2, wc = wid & 3, fr = lane & 15, fq = lane >> 4;
    const int K = g.K, nt = K / BK;
    unsigned voffA, voffB;
    { int R, C; stage_rc(tid * 16, R, C); const int Rb = Epi::PERM ? ((R & ~31) + perm32(R & 31)) : R;
      voffA = (unsigned)(R * g.lda + C) * 2u; voffB = (unsigned)(Rb * g.ldb + C) * 2u; }
    const size_t qsA = (size_t)64 * g.lda * 2, qsB = (size_t)64 * g.ldb * 2;
    const size_t kstep = (size_t)(BK * 2);
    const size_t hsA = (size_t)HALF * g.lda * 2, hsB = (size_t)HALF * g.ldb * 2;
    const unsigned ldsw = (unsigned)wid * 1024u;
    const int aoff = lds_byte(wr * 64 + fr, fq * 8), boff = lds_byte(wc * 32 + fr, fq * 8);
#define PG8_SA(b, h) (((b) * 2 + (h)) * HTB)
#define PG8_SB(b, h) ((4 + (b) * 2 + (h)) * HTB)
#define PG8_STAGE(bufoff, gbase, voff) do { _Pragma("unroll") for (int _i = 0; _i < 2; ++_i) \
        __builtin_amdgcn_global_load_lds((const unsigned*)((const char*)(gbase) + _i * PG8_QS_##voff + (voff)), (LAS unsigned*)(lds + (bufoff) + ldsw + _i * 8192), 16, 0, 0); } while (0)
#define PG8_QS_voffA qsA
#define PG8_QS_voffB qsB
#define PG8_LDA(dst, b, h) do { _Pragma("unroll") for (int m = 0; m < 4; ++m) _Pragma("unroll") for (int k = 0; k < 2; ++k) dst[m][k] = *(const LAS bf16x8*)(lds + PG8_SA(b, h) + aoff + m * 2048 + k * 1024); } while (0)
#define PG8_LDB(dst, b, h) do { _Pragma("unroll") for (int n = 0; n < 2; ++n) _Pragma("unroll") for (int k = 0; k < 2; ++k) dst[n][k] = *(const LAS bf16x8*)(lds + PG8_SB(b, h) + boff + n * 2048 + k * 1024); } while (0)
#define PG8_MMA(ai, bj, At, Bt) do { __builtin_amdgcn_s_setprio(1); _Pragma("unroll") for (int m = 0; m < 4; ++m) _Pragma("unroll") for (int n = 0; n < 2; ++n) _Pragma("unroll") for (int k = 0; k < 2; ++k) \
        acc[ai][bj][m][n] = __builtin_amdgcn_mfma_f32_16x16x32_bf16(Bt[n][k], At[m][k], acc[ai][bj][m][n], 0, 0, 0); __builtin_amdgcn_s_setprio(0); } while (0)
#define PG8_WAIT_V(n) asm volatile("s_waitcnt vmcnt(" #n ")" ::: "memory")
#define PG8_WAIT_L(n) asm volatile("s_waitcnt lgkmcnt(" #n ")" ::: "memory")
#define PG8_BAR __builtin_amdgcn_s_barrier()
#define PG8_SCHED __builtin_amdgcn_sched_barrier(0)
#define PG8_APTR(u) ((const char*)g.A + ((size_t)(u).z * g.sAz + (size_t)(u).pm * BM * g.lda) * 2)
#define PG8_BPTR(u) ((const char*)g.Bt + ((size_t)(u).z * g.sBz + (size_t)(u).pn * BM * g.ldb) * 2)
    Unit cur, nxt; int ui = 0;
    if (!S.next(0, cur)) return;
    f32x4 acc[2][2][4][2];
#pragma unroll
    for (int a = 0; a < 2; ++a)
#pragma unroll
        for (int b = 0; b < 2; ++b)
#pragma unroll
            for (int m = 0; m < 4; ++m)
#pragma unroll
                for (int n = 0; n < 2; ++n) acc[a][b][m][n] = (f32x4){0.f, 0.f, 0.f, 0.f};
    bf16x8 At[4][2], B0[2][2], B1[2][2];
    const char* cA = PG8_APTR(cur); const char* cB = PG8_BPTR(cur);
    PG8_STAGE(PG8_SB(0, 0), cB, voffB); PG8_STAGE(PG8_SB(0, 1), cB + hsB, voffB); PG8_STAGE(PG8_SA(0, 0), cA, voffA); PG8_STAGE(PG8_SA(0, 1), cA + hsA, voffA);
    if (wr == 1) PG8_BAR;
    PG8_WAIT_V(2); PG8_BAR;
    PG8_STAGE(PG8_SB(1, 0), cB + kstep, voffB); PG8_STAGE(PG8_SA(1, 0), cA + kstep, voffA); PG8_STAGE(PG8_SB(1, 1), cB + hsB + kstep, voffB);
    PG8_WAIT_V(6); PG8_BAR;
    for (;;) {
        const bool has_next = S.next(ui + 1, nxt);
        const char* nA = has_next ? PG8_APTR(nxt) : cA; const char* nB = has_next ? PG8_BPTR(nxt) : cB;
#pragma unroll 1
        for (int t = 0; t < nt; t += 2) {
            const bool last = (t == nt - 2);
            const char* a1 = cA + (size_t)(t + 1) * kstep;
            const char* a2 = last ? nA : cA + (size_t)(t + 2) * kstep; const char* b2 = last ? nB : cB + (size_t)(t + 2) * kstep;
            const char* a3 = a2 + kstep; const char* b3 = b2 + kstep;
            PG8_LDB(B0, 0, 0); PG8_LDB(B1, 0, 1); PG8_SCHED; PG8_LDA(At, 0, 0); PG8_STAGE(PG8_SA(1, 1), a1 + hsA, voffA);
            PG8_WAIT_V(8); PG8_WAIT_L(0); PG8_BAR; PG8_MMA(0, 0, At, B0); PG8_MMA(0, 1, At, B1); PG8_BAR; PG8_SCHED;
            PG8_LDA(At, 0, 1); PG8_STAGE(PG8_SB(0, 0), b2, voffB); PG8_STAGE(PG8_SB(0, 1), b2 + hsB, voffB); PG8_STAGE(PG8_SA(0, 0), a2, voffA);
            PG8_WAIT_V(8); PG8_WAIT_L(0); PG8_BAR; PG8_MMA(1, 0, At, B0); PG8_MMA(1, 1, At, B1); PG8_BAR; PG8_SCHED;
            PG8_LDB(B0, 1, 0); PG8_LDB(B1, 1, 1); PG8_SCHED; PG8_LDA(At, 1, 0); PG8_STAGE(PG8_SA(0, 1), a2 + hsA, voffA);
            PG8_WAIT_V(8); PG8_WAIT_L(0); PG8_BAR; PG8_MMA(0, 0, At, B0); PG8_MMA(0, 1, At, B1); PG8_BAR; PG8_SCHED;
            PG8_LDA(At, 1, 1); PG8_STAGE(PG8_SB(1, 0), b3, voffB); PG8_STAGE(PG8_SB(1, 1), b3 + hsB, voffB); PG8_STAGE(PG8_SA(1, 0), a3, voffA);
            PG8_WAIT_V(8); PG8_WAIT_L(0); PG8_BAR; PG8_MMA(1, 0, At, B0); PG8_MMA(1, 1, At, B1); PG8_BAR; PG8_SCHED;
        }
        if constexpr (ALIGN_EPI) { if (wr == 0) PG8_BAR; }
        { int fr2 = fr, fq2 = fq; asm volatile("" : "+v"(fr2), "+v"(fq2)); E(acc, cur, wr, wc, fr2, fq2); }
        if (!has_next) break;
#pragma unroll
        for (int a = 0; a < 2; ++a)
#pragma unroll
            for (int b = 0; b < 2; ++b)
#pragma unroll
                for (int m = 0; m < 4; ++m)
#pragma unroll
                    for (int n = 0; n < 2; ++n) acc[a][b][m][n] = (f32x4){0.f, 0.f, 0.f, 0.f};
        cur = nxt; cA = nA; cB = nB; ++ui;
        if constexpr (ALIGN_EPI) { if (wr == 1) PG8_BAR; }
    }
    PG8_WAIT_V(0);
    if constexpr (!ALIGN_EPI) { if (wr == 0) PG8_BAR; }
    PG8_BAR;
#undef PG8_SA
#undef PG8_SB
#undef PG8_STAGE
#undef PG8_QS_voffA
#undef PG8_QS_voffB
#undef PG8_LDA
#undef PG8_LDB
#undef PG8_MMA
#undef PG8_WAIT_V
#undef PG8_WAIT_L
#undef PG8_BAR
#undef PG8_SCHED
#undef PG8_APTR
#undef PG8_BPTR
}

__device__ __forceinline__ float silu_f(float g) { return g * __builtin_amdgcn_rcpf(1.0f + __builtin_amdgcn_exp2f(-g * LOG2E)); }
__device__ __forceinline__ float swiglu_f(float g, float u) { return (g * u) * __builtin_amdgcn_rcpf(1.0f + __builtin_amdgcn_exp2f(-g)); }

struct EpiSwiGLU {
    static constexpr bool PERM = true;
    bf16_t* O; int ldc;
    __device__ __forceinline__ void operator()(const f32x4 (&acc)[2][2][4][2], const Unit& u, int wr, int wc, int fr, int fq) const {
        const int row0 = u.pm * BM + wr * 64 + fr, col0 = u.pn * HALF + wc * 32 + 8 * fq;
#pragma unroll
        for (int ai = 0; ai < 2; ++ai)
#pragma unroll
            for (int m = 0; m < 4; ++m) {
                bf16_t* rowp = O + (size_t)(row0 + ai * HALF + m * 16) * ldc + col0;
                const f32x4 g0 = acc[ai][0][m][0], g1 = acc[ai][0][m][1], u0 = acc[ai][1][m][0], u1 = acc[ai][1][m][1];
                u32x4 w;
                w.x = cvt_pk_bf16(swiglu_f(g0[0], u0[0]), swiglu_f(g0[1], u0[1])); w.y = cvt_pk_bf16(swiglu_f(g0[2], u0[2]), swiglu_f(g0[3], u0[3]));
                w.z = cvt_pk_bf16(swiglu_f(g1[0], u1[0]), swiglu_f(g1[1], u1[1])); w.w = cvt_pk_bf16(swiglu_f(g1[2], u1[2]), swiglu_f(g1[3], u1[3]));
                *(u32x4*)rowp = w;
            }
    }
};
struct EpiF32 {
    static constexpr bool PERM = false;
    float* O; int ldc; long sOz;
    __device__ __forceinline__ void operator()(const f32x4 (&acc)[2][2][4][2], const Unit& u, int wr, int wc, int fr, int fq) const {
        const int row0 = u.pm * BM + wr * 64 + fr, col0 = u.pn * BM + wc * 32 + 4 * fq;
#pragma unroll
        for (int ai = 0; ai < 2; ++ai)
#pragma unroll
            for (int m = 0; m < 4; ++m) {
                float* rowp = O + (size_t)u.z * sOz + (size_t)(row0 + ai * HALF + m * 16) * ldc + col0;
#pragma unroll
                for (int bj = 0; bj < 2; ++bj)
#pragma unroll
                    for (int n = 0; n < 2; ++n) *(f32x4*)(rowp + bj * HALF + n * 16) = acc[ai][bj][m][n];
            }
    }
};

template <int CMAP> struct EpiBf16 {
    static constexpr bool PERM = true;
    bf16_t* O; int ldc; long sOz; int ncol; float scale; int scale_cols;
    __device__ __forceinline__ void operator()(const f32x4 (&acc)[2][2][4][2], const Unit& u, int wr, int wc, int fr, int fq) const {
        const int row0 = u.pm * BM + wr * 64 + fr;
#pragma unroll
        for (int bj = 0; bj < 2; ++bj) {
            const int ct = bj * HALF + wc * 32 + 8 * fq; if (ct >= ncol) continue;
            const int c0 = u.pn * BM + ct; const int oc = CMAP == 1 ? (c0 >> 7) * 192 + (c0 & 127) : c0;
            const float sc = c0 < scale_cols ? scale : 1.f;
            bf16_t* base = O + (size_t)u.z * sOz + oc;
#pragma unroll
            for (int ai = 0; ai < 2; ++ai)
#pragma unroll
                for (int m = 0; m < 4; ++m) { const f32x4 v0 = acc[ai][bj][m][0] * sc, v1 = acc[ai][bj][m][1] * sc;
                    u32x4 w; w.x = cvt_pk_bf16(v0[0], v0[1]); w.y = cvt_pk_bf16(v0[2], v0[3]); w.z = cvt_pk_bf16(v1[0], v1[1]); w.w = cvt_pk_bf16(v1[2], v1[3]);
                    *(u32x4*)(base + (size_t)(row0 + ai * HALF + m * 16) * ldc) = w; }
        }
    }
};
struct EpiQ {
    static constexpr bool PERM = true;
    bf16_t* O; const float* rope_t; float scale;
    __device__ __forceinline__ void operator()(const f32x4 (&acc)[2][2][4][2], const Unit& u, int wr, int wc, int fr, int fq) const {
        const int row0 = u.pm * BM + wr * 64 + fr;
#pragma unroll
        for (int bj = 0; bj < 2; ++bj) {
            const int c0 = u.pn * BM + bj * HALF + wc * 32 + 8 * fq; const int h = c0 / 192, f0 = c0 - h * 192;
            if (f0 < 128) {
#pragma unroll
                for (int ai = 0; ai < 2; ++ai)
#pragma unroll
                    for (int m = 0; m < 4; ++m) { const f32x4 v0 = acc[ai][bj][m][0] * scale, v1 = acc[ai][bj][m][1] * scale;
                        u32x4 w; w.x = cvt_pk_bf16(v0[0], v0[1]); w.y = cvt_pk_bf16(v0[2], v0[3]); w.z = cvt_pk_bf16(v1[0], v1[1]); w.w = cvt_pk_bf16(v1[2], v1[3]);
                        *(u32x4*)(O + (size_t)(row0 + ai * HALF + m * 16) * 1536 + c0) = w; }
            } else {
                const int a4 = ((f0 - 128) >> 3) * 4;
#pragma unroll
                for (int ai = 0; ai < 2; ++ai)
#pragma unroll
                    for (int m = 0; m < 4; ++m) { const int r = row0 + ai * HALF + m * 16; const int pidx = r < MP ? (r & (SEQ - 1)) : SEQ + ((r - MP) & (DECT - 1));
                        const f32x4 cs0 = *(const f32x4*)(rope_t + (size_t)(pidx * 32 + a4) * 2), cs1 = *(const f32x4*)(rope_t + (size_t)(pidx * 32 + a4) * 2 + 4);
                        const f32x4 x1 = acc[ai][bj][m][0] * scale, x2 = acc[ai][bj][m][1] * scale;
                        const float y10 = x1[0] * cs0[0] - x2[0] * cs0[1], y11 = x1[1] * cs0[2] - x2[1] * cs0[3], y12 = x1[2] * cs1[0] - x2[2] * cs1[1], y13 = x1[3] * cs1[2] - x2[3] * cs1[3];
                        const float y20 = x2[0] * cs0[0] + x1[0] * cs0[1], y21 = x2[1] * cs0[2] + x1[1] * cs0[3], y22 = x2[2] * cs1[0] + x1[2] * cs1[1], y23 = x2[3] * cs1[2] + x1[3] * cs1[3];
                        bf16_t* rowp = O + (size_t)r * 1536 + h * 192 + 128 + a4;
                        u32x2 w1, w2; w1.x = cvt_pk_bf16(y10, y11); w1.y = cvt_pk_bf16(y12, y13); w2.x = cvt_pk_bf16(y20, y21); w2.y = cvt_pk_bf16(y22, y23);
                        *(u32x2*)rowp = w1; *(u32x2*)(rowp + 32) = w2; asm volatile("" ::: "memory"); }
            }
        }
    }
};

struct EpiGla {
    static constexpr bool PERM = true;
    bf16_t* O; float* T16; float qscale;
    __device__ __forceinline__ void operator()(const f32x4 (&acc)[2][2][4][2], const Unit& u, int wr, int wc, int fr, int fq) const {
        const int row0 = u.pm * BM + wr * 64 + fr;
        if (u.pn < 12) {
#pragma unroll
            for (int bj = 0; bj < 2; ++bj) {
                const int c0 = u.pn * BM + bj * HALF + wc * 32 + 8 * fq; const float sc = c0 < 512 ? qscale : 1.f;
#pragma unroll
                for (int ai = 0; ai < 2; ++ai)
#pragma unroll
                    for (int m = 0; m < 4; ++m) { const f32x4 v0 = acc[ai][bj][m][0] * sc, v1 = acc[ai][bj][m][1] * sc;
                        u32x4 w; w.x = cvt_pk_bf16(v0[0], v0[1]); w.y = cvt_pk_bf16(v0[2], v0[3]); w.z = cvt_pk_bf16(v1[0], v1[1]); w.w = cvt_pk_bf16(v1[2], v1[3]);
                        *(u32x4*)(O + (size_t)(row0 + ai * HALF + m * 16) * GIN + c0) = w; }
            }
        } else if (wc == 0 && fq < 2) {
#pragma unroll
            for (int ai = 0; ai < 2; ++ai)
#pragma unroll
                for (int m = 0; m < 4; ++m) { float* tp = T16 + (size_t)(row0 + ai * HALF + m * 16) * 16 + 8 * fq;
                    *(f32x4*)tp = acc[ai][0][m][0]; *(f32x4*)(tp + 4) = acc[ai][0][m][1]; }
        }
    }
};
}

#define XB_TMO      128
#define XB_XCNT(j)  (256  + 64 * (j))
#define XB_XSUB(j)  (1280 + 64 * (j))
#define XB_XGEN(j)  (2304 + 64 * (j))
#define XB_TOP      3328
#define XB_TOPGEN   3392
#define XCD_BAR_WORDS 3456
#define XB_SPIN_CAP (1u << 18)

__device__ __forceinline__ unsigned xb_ld(unsigned* p)              { return __hip_atomic_load(p, __ATOMIC_RELAXED, __HIP_MEMORY_SCOPE_AGENT); }
__device__ __forceinline__ unsigned xb_add(unsigned* p, unsigned v) { return __hip_atomic_fetch_add(p, v, __ATOMIC_RELAXED, __HIP_MEMORY_SCOPE_AGENT); }
__device__ __forceinline__ unsigned xb_xcc_id() { return (unsigned)__builtin_amdgcn_s_getreg((3 << 11) | 20) & 0xFu; }
#define XB_SPIN(cond, bar) do { unsigned _sp = 0; while (cond) { __builtin_amdgcn_s_sleep(1); \
    if ((++_sp & 255u) == 0u) { if (xb_ld(&(bar)[XB_TMO])) break; if (_sp > XB_SPIN_CAP) { atomicAdd(&(bar)[XB_TMO], 1u); break; } } } } while (0)

struct XcdBarrier { unsigned* bar; unsigned x; volatile LAS unsigned* st; };

__device__ __forceinline__ XcdBarrier xcd_barrier_post(unsigned* bar, volatile LAS unsigned* st, bool t0) {
    XcdBarrier b; b.bar = bar; b.x = xb_xcc_id(); b.st = st;
    if (t0) (void)xb_add(&bar[XB_XCNT(b.x)], 1u);
    return b;
}
__device__ __forceinline__ void xcd_barrier_complete(unsigned* bar, unsigned x, unsigned& nloc, unsigned& nx) {
    const unsigned G = gridDim.x * gridDim.y * gridDim.z;
    unsigned sum, cnt, mine, sp = 0u;
    for (;;) {
        sum = 0u; cnt = 0u; mine = 0u;
#pragma unroll
        for (unsigned j = 0; j < 16; ++j) { const unsigned c = xb_ld(&bar[XB_XCNT(j)]); sum += c; cnt += (c > 0u) ? 1u : 0u; mine = (j == x) ? c : mine; }
        if (sum == G) break;
        __builtin_amdgcn_s_sleep(1);
        if ((++sp & 255u) == 0u) { if (xb_ld(&bar[XB_TMO])) break; if (sp > XB_SPIN_CAP) { atomicAdd(&bar[XB_TMO], 1u); break; } }
    }
    nloc = mine > 0u ? mine : 1u; nx = cnt > 0u ? cnt : 1u;
}
__device__ __forceinline__ void xcd_barrier(const XcdBarrier& b, bool t0) {
    asm volatile("s_waitcnt vmcnt(0)" ::: "memory");
    __syncthreads();
    if (t0) {
        unsigned* bar = b.bar;
        __builtin_amdgcn_s_waitcnt(0);
        unsigned nloc = b.st[0], nx = b.st[1];
        if (nloc == 0u) { xcd_barrier_complete(bar, b.x, nloc, nx); b.st[0] = nloc; b.st[1] = nx; }
        const unsigned old = xb_add(&bar[XB_XSUB(b.x)], 1u);
        const unsigned gen = old / nloc;
        if (old + 1u == (gen + 1u) * nloc) {
            __builtin_amdgcn_fence(__ATOMIC_RELEASE, "agent");
            asm volatile("s_waitcnt vmcnt(0)" ::: "memory");
            const unsigned og = xb_add(&bar[XB_TOP], 1u);
            const unsigned tg = og / nx;
            if (og + 1u == (tg + 1u) * nx) xb_add(&bar[XB_TOPGEN], 1u);
            else XB_SPIN(xb_ld(&bar[XB_TOPGEN]) == tg, bar);
            __builtin_amdgcn_fence(__ATOMIC_ACQUIRE, "agent");
            xb_add(&bar[XB_XGEN(b.x)], 1u);
            asm volatile("s_waitcnt vmcnt(0)" ::: "memory");
        } else {
            XB_SPIN(xb_ld(&bar[XB_XGEN(b.x)]) == gen, bar);
            __builtin_amdgcn_fence(__ATOMIC_ACQUIRE, "agent");
            asm volatile("s_waitcnt vmcnt(0)" ::: "memory");
        }
    }
    __syncthreads();
}

struct Args { const void* in[22]; float* out; unsigned char* ws; int ph_lo, ph_hi; };

struct Frame {
    LAS unsigned char* lds;
    int tid, lane, wave, vcu, G;
    const float* const* dummy;
};

__device__ __forceinline__ void transpose_item(const float* W, int N, int k0, int n0, bf16_t* WT, int KT, int drow0, int interleave, LAS float* scr, int lane, float sc = 1.0f) {
    f32x4 v[8];
    const float* src = W + (size_t)(k0 + (lane >> 3)) * N + n0 + 4 * (lane & 7);
#pragma unroll
    for (int i = 0; i < 8; ++i) v[i] = *(const f32x4*)(src + (size_t)(8 * i) * N);
#pragma unroll
    for (int i = 0; i < 8; ++i) { LAS float* d = scr + (8 * i + (lane >> 3)) * 33 + 4 * (lane & 7); d[0] = v[i][0]; d[1] = v[i][1]; d[2] = v[i][2]; d[3] = v[i][3]; }
    LDS_WAIT(); asm volatile("" ::: "memory");
    const int c = lane & 7;
#pragma unroll
    for (int j = 0; j < 4; ++j) { const int n = (lane >> 3) + 8 * j; const LAS float* s = scr + (8 * c) * 33 + n;
        u32x4 o; o.x = cvt_pk_bf16(s[0 * 33] * sc, s[1 * 33] * sc); o.y = cvt_pk_bf16(s[2 * 33] * sc, s[3 * 33] * sc); o.z = cvt_pk_bf16(s[4 * 33] * sc, s[5 * 33] * sc); o.w = cvt_pk_bf16(s[6 * 33] * sc, s[7 * 33] * sc);
        const int drow = interleave ? (drow0 + 8 * (n >> 2) + (n & 3)) : (drow0 + n);
        *(u32x4*)(WT + (size_t)drow * KT + k0 + 8 * c) = o; }
    LDS_WAIT(); asm volatile("" ::: "memory");
}

struct ConvPtrs { const float *w_in, *w_out, *w_down, *w_uq, *w_uk, *w_uv, *w_o, *g_in, *g_o; bf16_t *WIN, *WOUT, *WDOWN, *WUQ, *WUKT, *WUVT, *WOT, *WGIN, *WGO; };
constexpr int I_WIN = (DM / 64) * (2 * DFF / 32);
constexpr int I_WOUT = (DFF / 64) * (DM / 32);
constexpr int I_DOWN = (DM / 64) * (DDOWN / 32);
constexpr int I_UQ = (QL / 64) * (NH * QKD / 32);
constexpr int I_UK = (KVL / 64) * (NH * NOPE / 32);
constexpr int I_UV = I_UK;
constexpr int I_O = (DM / 64) * (DM / 32);
constexpr int I_GIN = (DM / 64) * (GIN / 32);
constexpr int I_GO = I_O;
template <int SEG> __device__ __forceinline__ void conv_segment(const ConvPtrs& P, int widx, int nw, LAS float* scr, int lane) {
    constexpr int mi = SEG;
    constexpr int NIT = I_WIN + I_WOUT + (SEG == 1 ? I_DOWN + I_UQ + I_UK + I_UV + I_O : SEG == 2 ? I_GIN + I_GO : 0);
    for (int it = widx; it < NIT; it += nw) {
        int r = it;
        if (r < I_WIN) { const int nblk = 2 * DFF / 32, kb = r / nblk, nb = r % nblk, n0 = nb * 32;
            const int drow0 = n0 < DFF ? 256 * (n0 / 128) + (n0 % 128) : 256 * ((n0 - DFF) / 128) + 128 + ((n0 - DFF) % 128);
            transpose_item(P.w_in + (size_t)mi * DM * 2 * DFF, 2 * DFF, kb * 64, n0, P.WIN + (size_t)mi * 2 * DFF * DM, DM, drow0, 0, scr, lane, n0 < DFF ? LOG2E : 1.0f / LOG2E); continue; } r -= I_WIN;
        if (r < I_WOUT) { const int nblk = DM / 32, kb = r / nblk, nb = r % nblk;
            transpose_item(P.w_out + (size_t)mi * DFF * DM, DM, kb * 64, nb * 32, P.WOUT + (size_t)mi * DM * DFF, DFF, nb * 32, 0, scr, lane); continue; } r -= I_WOUT;
        if constexpr (SEG == 1) {
            if (r < I_DOWN) { const int nblk = DDOWN / 32, kb = r / nblk, nb = r % nblk;
                transpose_item(P.w_down, DDOWN, kb * 64, nb * 32, P.WDOWN, DM, nb * 32, 0, scr, lane); continue; } r -= I_DOWN;
            if (r < I_UQ) { const int nblk = NH * QKD / 32, kb = r / nblk, nb = r % nblk, n0 = nb * 32, h = n0 / QKD, f = n0 % QKD;
                if (f < NOPE) transpose_item(P.w_uq, NH * QKD, kb * 64, n0, P.WUQ, QL, n0, 0, scr, lane);
                else transpose_item(P.w_uq, NH * QKD, kb * 64, n0, P.WUQ, QL, h * QKD + NOPE + (f == NOPE ? 0 : 4), 1, scr, lane);
                continue; } r -= I_UQ;
            if (r < I_UK) { const int nblk = NH * NOPE / 32, kb = r / nblk, nb = r % nblk;
                transpose_item(P.w_uk, NH * NOPE, kb * 64, nb * 32, P.WUKT, KVL, nb * 32, 0, scr, lane); continue; } r -= I_UK;
            if (r < I_UV) { const int nblk = NH * VD / 32, kb = r / nblk, nb = r % nblk;
                transpose_item(P.w_uv, NH * VD, kb * 64, nb * 32, P.WUVT, KVL, nb * 32, 0, scr, lane); continue; } r -= I_UV;
            { const int nblk = DM / 32, kb = r / nblk, nb = r % nblk;
                transpose_item(P.w_o, DM, kb * 64, nb * 32, P.WOT, DM, nb * 32, 0, scr, lane); }
        }
        if constexpr (SEG == 2) {
            if (r < I_GIN) { const int nblk = GIN / 32, kb = r / nblk, nb = r % nblk;
                transpose_item(P.g_in, GIN, kb * 64, nb * 32, P.WGIN, DM, nb * 32, 0, scr, lane); continue; } r -= I_GIN;
            { const int nblk = DM / 32, kb = r / nblk, nb = r % nblk;
                transpose_item(P.g_o, DM, kb * 64, nb * 32, P.WGO, DM, nb * 32, 0, scr, lane); }
        }
    }
}

struct Row16 { f32x4 v[4]; };
__device__ __forceinline__ Row16 ld_row(const float* p, int lane) { Row16 r; const f32x4* q = (const f32x4*)p + lane;
#pragma unroll
    for (int j = 0; j < 4; ++j) r.v[j] = q[64 * j]; return r; }
__device__ __forceinline__ Row16 ld_row_bf16(const bf16_t* p, int lane) { Row16 r; const u32x2* q = (const u32x2*)p + lane;
#pragma unroll
    for (int j = 0; j < 4; ++j) { const u32x2 w = q[64 * j]; r.v[j][0] = __uint_as_float(w.x << 16); r.v[j][1] = __uint_as_float(w.x & 0xffff0000u); r.v[j][2] = __uint_as_float(w.y << 16); r.v[j][3] = __uint_as_float(w.y & 0xffff0000u); } return r; }
__device__ __forceinline__ float row_ss(const Row16& r) { float s = 0.f;
#pragma unroll
    for (int j = 0; j < 4; ++j) s += (r.v[j][0] * r.v[j][0] + r.v[j][1] * r.v[j][1]) + (r.v[j][2] * r.v[j][2] + r.v[j][3] * r.v[j][3]); return wave_sum(s); }
__device__ __forceinline__ void st_row_bf16(bf16_t* p, const Row16& r, int lane) { u32x2* q = (u32x2*)p + lane;
#pragma unroll
    for (int j = 0; j < 4; ++j) { u32x2 w; w.x = cvt_pk_bf16(r.v[j][0], r.v[j][1]); w.y = cvt_pk_bf16(r.v[j][2], r.v[j][3]); q[64 * j] = w; } }
__device__ __forceinline__ void st_row_f32(float* p, const Row16& r, int lane) { f32x4* q = (f32x4*)p + lane;
#pragma unroll
    for (int j = 0; j < 4; ++j) q[64 * j] = r.v[j]; }

template <bool HAS_T, bool HAS_PRE, bool SRC_X, bool FINAL>
__device__ __forceinline__ void thin_phase(int gw, int NGW, const float* xp, const float* xs, const bf16_t* T, const float* TP, int nsplit, float* RS, float* Yout, bf16_t* XN, const float* gpost, const float* gpre, float scale, const float* gold = nullptr) {
    const int lane = lane_now();
    Row16 gp, gq;
    if (HAS_T) gp = ld_row(gpost, lane);
    if (HAS_PRE) gq = ld_row(gpre, lane);
    Row16 gi;
    if (!SRC_X) { gi = ld_row(gold, lane);
#pragma unroll
        for (int j = 0; j < 4; ++j) { gi.v[j][0] = 1.0f / gi.v[j][0]; gi.v[j][1] = 1.0f / gi.v[j][1]; gi.v[j][2] = 1.0f / gi.v[j][2]; gi.v[j][3] = 1.0f / gi.v[j][3]; } }
    const bool bal = HAS_T && NGW == 2 * MS && MP % NGW == 0;
    const int N1 = bal ? MP / NGW - (nsplit > 4 ? 2 : 1) : 0;
    for (int i = 0;; ++i) {
        int r;
        if (!bal) { r = gw + i * NGW; if (r >= M) break; }
        else if (i < N1) r = gw + i * NGW;
        else if (gw < MS) { if (i > N1) break; r = MP + gw; }
        else { r = N1 * NGW + (gw - MS) + (i - N1) * (NGW - MS); if (r >= MP) break; }
        Row16 h;
        if constexpr (SRC_X) h = ld_row(r < MP ? xp + (size_t)r * DM : xs + (size_t)(r - MP) * DM, lane);
        else { h = ld_row_bf16(XN + (size_t)r * DM, lane); const float irs = __hip_atomic_load(RS + r, __ATOMIC_RELAXED, __HIP_MEMORY_SCOPE_WORKGROUP);
#pragma unroll
            for (int j = 0; j < 4; ++j) h.v[j] = (h.v[j] * irs) * gi.v[j]; }
        if (HAS_T) {
            Row16 t;
            if (r < MP) t = ld_row_bf16(T + (size_t)r * DM, lane);
            else { const bf16_t* TPb = (const bf16_t*)TP; t = ld_row_bf16(TPb + (size_t)(r - MP) * DM, lane);
                int z = 1;
#pragma unroll 1
                for (; z + 1 < nsplit; z += 2) { const Row16 u0 = ld_row_bf16(TPb + ((size_t)z * MS + (r - MP)) * DM, lane), u1 = ld_row_bf16(TPb + ((size_t)(z + 1) * MS + (r - MP)) * DM, lane);
#pragma unroll
                    for (int j = 0; j < 4; ++j) t.v[j] = (t.v[j] + u0.v[j]) + u1.v[j]; }
                if (z < nsplit) { const Row16 u = ld_row_bf16(TPb + ((size_t)z * MS + (r - MP)) * DM, lane);
#pragma unroll
                    for (int j = 0; j < 4; ++j) t.v[j] = t.v[j] + u.v[j]; } }
            const float rs = scale * __builtin_amdgcn_rsqf(row_ss(t) * (1.0f / DM) + EPS);
#pragma unroll
            for (int j = 0; j < 4; ++j) h.v[j] = h.v[j] + (t.v[j] * rs) * gp.v[j];
            if constexpr (FINAL) st_row_f32(Yout + (size_t)r * DM, h, lane);
        }
        if (HAS_PRE) {
            const float ms = row_ss(h) * (1.0f / DM) + EPS, rs = __builtin_amdgcn_rsqf(ms);
#pragma unroll
            for (int j = 0; j < 4; ++j) h.v[j] = (h.v[j] * rs) * gq.v[j];
            st_row_bf16(XN + (size_t)r * DM, h, lane);
            if (lane == 0) RS[r] = ms * rs;
        }
    }
}

__device__ __forceinline__ int rope_pos_index(int r) { return r < MP ? (r & (SEQ - 1)) : SEQ + ((r - MP) & (DECT - 1)); }


typedef short s16x4 __attribute__((ext_vector_type(4)));
__device__ __forceinline__ int swap23(int x) { return (x & ~12) | ((x & 4) << 1) | ((x & 8) >> 1); }
__device__ __forceinline__ float half_max(float v) { auto rr = __builtin_amdgcn_permlane32_swap(__float_as_uint(v), __float_as_uint(v), false, false); return fmaxf(__uint_as_float(rr[0]), __uint_as_float(rr[1])); }
__device__ __forceinline__ float half_sum(float v) { auto rr = __builtin_amdgcn_permlane32_swap(__float_as_uint(v), __float_as_uint(v), false, false); return __uint_as_float(rr[0]) + __uint_as_float(rr[1]); }
__device__ __forceinline__ bf16x8 pack8(const f32x16& p, int o) {
    u32x4 w; w.x = cvt_pk_bf16(p[o + 0], p[o + 1]); w.y = cvt_pk_bf16(p[o + 2], p[o + 3]); w.z = cvt_pk_bf16(p[o + 4], p[o + 5]); w.w = cvt_pk_bf16(p[o + 6], p[o + 7]);
    return __builtin_bit_cast(bf16x8, w);
}
template <int NO>
__device__ __forceinline__ void softmax_step(f32x16& p0, f32x16& p1, float& m, float& lh, f32x16 (&o)[NO], bf16x8 (&pf)[4]) {
    float pm = fmaxf(p0[0], p1[0]);
#pragma unroll
    for (int r = 1; r < 16; ++r) pm = fmaxf(pm, fmaxf(p0[r], p1[r]));
    pm = half_max(pm);
    const float mn = fmaxf(m, pm), alpha = __builtin_amdgcn_exp2f(m - mn); m = mn;
    float rs = 0.f;
#pragma unroll
    for (int r = 0; r < 16; ++r) { p0[r] = __builtin_amdgcn_exp2f(p0[r] - mn); p1[r] = __builtin_amdgcn_exp2f(p1[r] - mn); rs += p0[r] + p1[r]; }
    lh = lh * alpha + rs;
    if (!__all(alpha == 1.0f)) {
#pragma unroll
        for (int d = 0; d < NO; ++d) o[d] = o[d] * alpha;
    }
    pf[0] = pack8(p0, 0); pf[1] = pack8(p0, 8); pf[2] = pack8(p1, 0); pf[3] = pack8(p1, 8);
}

template <int NO>
__device__ __forceinline__ void softmax_step1(f32x16& p0, float& m, float& lh, f32x16 (&o)[NO], bf16x8 (&pf)[2]) {
    float pm = p0[0];
#pragma unroll
    for (int r = 1; r < 16; ++r) pm = fmaxf(pm, p0[r]);
    pm = half_max(pm);
    const float mn = fmaxf(m, pm), alpha = __builtin_amdgcn_exp2f(m - mn); m = mn;
    float rs = 0.f;
#pragma unroll
    for (int r = 0; r < 16; ++r) { p0[r] = __builtin_amdgcn_exp2f(p0[r] - mn); rs += p0[r]; }
    lh = lh * alpha + rs;
    if (!__all(alpha == 1.0f)) {
#pragma unroll
        for (int d = 0; d < NO; ++d) o[d] = o[d] * alpha;
    }
    pf[0] = pack8(p0, 0); pf[1] = pack8(p0, 8);
}

namespace pat {
constexpr int KROW = 400, VROW = 144, KTILE = 64 * KROW, VTILE = 128 * VROW;
__device__ __forceinline__ void unit(LAS unsigned char* lds, const int wave, const bf16_t* Q, const bf16_t* KB, const bf16_t* KPE, const bf16_t* VT, bf16_t* O, int b, int h, int qb) {
    const int lane = lane_now(), tid = wave * 64 + lane, ql = lane & 31, hh = lane >> 5;
    const int q0 = b * SEQ + qb * 256 + 32 * wave;
    bf16x8 qf[12];
    { const bf16_t* qp = Q + (size_t)(q0 + ql) * (NH * QKD) + h * QKD + hh * 8;
#pragma unroll
      for (int ks = 0; ks < 12; ++ks) qf[ks] = *(const bf16x8*)(qp + ks * 16); }
    f32x16 o[4];
#pragma unroll
    for (int d = 0; d < 4; ++d)
#pragma unroll
        for (int r = 0; r < 16; ++r) o[d][r] = 0.f;
    float m = -1e30f, lh = 0.f;
    const int ntiles = 4 * (qb + 1);
    int krow[3], kcc[3]; unsigned koff[3];
#pragma unroll
    for (int i = 0; i < 3; ++i) { const int c = tid + 512 * i; krow[i] = c / 24; kcc[i] = c % 24; koff[i] = (unsigned)(krow[i] * KROW + kcc[i] * 16); }
    const bf16_t* kg = KB + (size_t)(b * SEQ) * (NH * NOPE) + h * NOPE;
    const bf16_t* kpg = KPE + (size_t)(b * SEQ) * ROPE;
    const bf16_t* vg = VT + (size_t)(h * VD) * MP + b * SEQ;
    const int vrow0 = tid >> 3, vcc = tid & 7;
    u32x4 kst[3], vst[2];
#define PAT_LOAD(j) do { _Pragma("unroll") for (int i = 0; i < 3; ++i) kst[i] = kcc[i] < 16 ? *(const u32x4*)(kg + (size_t)((j) * 64 + krow[i]) * (NH * NOPE) + kcc[i] * 8) : *(const u32x4*)(kpg + (size_t)((j) * 64 + krow[i]) * ROPE + (kcc[i] - 16) * 8); \
        _Pragma("unroll") for (int i = 0; i < 2; ++i) vst[i] = *(const u32x4*)(vg + (size_t)(vrow0 + 64 * i) * MP + (j) * 64 + vcc * 8); } while (0)
#define PAT_STORE(buf) do { _Pragma("unroll") for (int i = 0; i < 3; ++i) *(LAS u32x4*)(lds + (buf) * KTILE + koff[i]) = kst[i]; \
        _Pragma("unroll") for (int i = 0; i < 2; ++i) *(LAS u32x4*)(lds + 2 * KTILE + (buf) * VTILE + (vrow0 + 64 * i) * VROW + vcc * 16) = vst[i]; } while (0)
    PAT_LOAD(0); PAT_STORE(0);
    __syncthreads();
    const int kr = swap23(ql);
    for (int j = 0; j < ntiles; ++j) {
        const int buf = j & 1;
        if (j + 1 < ntiles) PAT_LOAD(j + 1);
        const int jd = j - 4 * qb;
        if (jd <= (wave >> 1)) {
            f32x16 p0, p1;
#pragma unroll
            for (int r = 0; r < 16; ++r) { p0[r] = 0.f; p1[r] = 0.f; }
            const LAS unsigned char* kb0 = lds + buf * KTILE + kr * KROW + hh * 16;
            __builtin_amdgcn_s_setprio(1);
#pragma unroll
            for (int ks = 0; ks < 12; ++ks) {
                const bf16x8 a0 = *(const LAS bf16x8*)(kb0 + ks * 32), a1 = *(const LAS bf16x8*)(kb0 + 32 * KROW + ks * 32);
                p0 = __builtin_amdgcn_mfma_f32_32x32x16_bf16(a0, qf[ks], p0, 0, 0, 0);
                p1 = __builtin_amdgcn_mfma_f32_32x32x16_bf16(a1, qf[ks], p1, 0, 0, 0);
            }
            __builtin_amdgcn_s_setprio(0);
            if (jd >= 0) {
                const int qrel = 32 * wave + ql - 64 * jd - 8 * hh;
#pragma unroll
                for (int r = 0; r < 16; ++r) { const int kk = 16 * (r >> 3) + (r & 7);
                    if (kk > qrel) p0[r] = -__builtin_inff();
                    if (kk + 32 > qrel) p1[r] = -__builtin_inff(); }
            }
            bf16x8 pf[4];
            softmax_step<4>(p0, p1, m, lh, o, pf);
            const LAS unsigned char* vb0 = lds + 2 * KTILE + buf * VTILE + ql * VROW + hh * 16;
#pragma unroll
            for (int d = 0; d < 4; ++d)
#pragma unroll
                for (int ss = 0; ss < 4; ++ss) {
                    const bf16x8 a = *(const LAS bf16x8*)(vb0 + d * 32 * VROW + ss * 32);
                    o[d] = __builtin_amdgcn_mfma_f32_32x32x16_bf16(a, pf[ss], o[d], 0, 0, 0);
                }
        }
        if (j + 1 < ntiles) PAT_STORE(buf ^ 1);
        __syncthreads();
    }
#undef PAT_LOAD
#undef PAT_STORE
    const float inv = 1.0f / half_sum(lh);
    bf16_t* op = O + (size_t)(q0 + ql) * DM + h * VD + 4 * hh;
#pragma unroll
    for (int d = 0; d < 4; ++d)
#pragma unroll
        for (int g = 0; g < 4; ++g) { u32x2 w; w.x = cvt_pk_bf16(o[d][4 * g] * inv, o[d][4 * g + 1] * inv); w.y = cvt_pk_bf16(o[d][4 * g + 2] * inv, o[d][4 * g + 3] * inv);
            *(u32x2*)(op + 32 * d + 8 * g) = w; }
}
}

namespace sat {
constexpr int KROW = 656, KTILE = 64 * KROW;
__device__ __forceinline__ bf16x8 tr_frag(const LAS unsigned char* p) {
    typedef short v4i16_t __attribute__((ext_vector_type(4)));
    const s16x4 a = __builtin_bit_cast(s16x4, __builtin_amdgcn_ds_read_tr16_b64_v4i16((LAS v4i16_t*)p));
    const s16x4 b = __builtin_bit_cast(s16x4, __builtin_amdgcn_ds_read_tr16_b64_v4i16((LAS v4i16_t*)(p + 4 * KROW)));
    bf16x8 r; r[0] = a[0]; r[1] = a[1]; r[2] = a[2]; r[3] = a[3]; r[4] = b[0]; r[5] = b[1]; r[6] = b[2]; r[7] = b[3]; return r;
}
__device__ __forceinline__ void unit(LAS unsigned char* lds, const int wave, const bf16_t* QLAT, const float* cache_ckv, const float* cache_kpe, const int* page_table, const bf16_t* CKVS  , const bf16_t* KPES,
                                     float* OPART, float* OML, int b, int split) {
    const int lane = lane_now(), tid = wave * 64 + lane, ql = lane & 31, hh = lane >> 5;
    const int qblk = wave & 1, kb = (wave >> 1) & 1, dvh = wave >> 2;
#pragma unroll
    for (int i = 0; i < 5; ++i) { const int c = tid + 512 * i, row = c / 40, cc = c % 40;
        *(LAS u32x4*)(lds + 2 * KTILE + row * KROW + cc * 16) = *(const u32x4*)(QLAT + (size_t)(b * 64 + row) * 320 + cc * 8); }
    f32x16 o[4];
#pragma unroll
    for (int d = 0; d < 4; ++d)
#pragma unroll
        for (int r = 0; r < 16; ++r) o[d][r] = 0.f;
    float m = -1e30f, lh = 0.f;
    const int npg = NPAGES / 2, ntiles = 2 * npg + (split == 1 ? 1 : 0);
    const int* pt = page_table + b * NPAGES + split * npg;
    const int crow0 = tid >> 6, ccol = tid & 63;
    const int prow0 = tid >> 4, pcol = tid & 15;
    f32x4 cst[8], pst[2];
#define SAT_LOAD(j) do { const int pg = pt[(j) >> 1]; const size_t r0 = (size_t)pg * PAGE + ((j) & 1) * 64; \
        _Pragma("unroll") for (int i = 0; i < 8; ++i) cst[i] = __builtin_nontemporal_load((const f32x4*)(cache_ckv + (r0 + crow0 + 8 * i) * KVL) + ccol); \
        _Pragma("unroll") for (int i = 0; i < 2; ++i) pst[i] = __builtin_nontemporal_load((const f32x4*)(cache_kpe + (r0 + prow0 + 32 * i) * ROPE) + pcol); } while (0)
#define SAT_STORE(buf) do { _Pragma("unroll") for (int i = 0; i < 8; ++i) { u32x2 w; w.x = cvt_pk_bf16(cst[i][0], cst[i][1]); w.y = cvt_pk_bf16(cst[i][2], cst[i][3]); \
            *(LAS u32x2*)(lds + (buf) * KTILE + (crow0 + 8 * i) * KROW + ccol * 8) = w; } \
        _Pragma("unroll") for (int i = 0; i < 2; ++i) { u32x2 w; w.x = cvt_pk_bf16(pst[i][0], pst[i][1]); w.y = cvt_pk_bf16(pst[i][2], pst[i][3]); \
            *(LAS u32x2*)(lds + (buf) * KTILE + (prow0 + 32 * i) * KROW + 512 + pcol * 8) = w; } } while (0)
#define SAT_NEW(buf) do { _Pragma("unroll") for (int i = 0; i < 5; ++i) { const int c = tid + 512 * i, row = c / 40, cc = c % 40; u32x4 v = (u32x4){0u, 0u, 0u, 0u}; \
            if (row < DECT) v = cc < 32 ? *(const u32x4*)(CKVS + (size_t)(b * DECT + row) * KVL + cc * 8) : *(const u32x4*)(KPES + (size_t)(b * DECT + row) * ROPE + (cc - 32) * 8); \
            *(LAS u32x4*)(lds + (buf) * KTILE + row * KROW + cc * 16) = v; } } while (0)
    SAT_LOAD(0); SAT_STORE(0);
    __syncthreads();
    const int kr = 32 * kb + swap23(ql);
    const int g16 = lane >> 4, i16 = lane & 15;
    const int troff = (32 * kb + 8 * (g16 >> 1) + (i16 >> 2)) * KROW + (128 * dvh + 16 * (g16 & 1) + 4 * (i16 & 3)) * 2;
    for (int j = 0; j < ntiles; ++j) {
        const int buf = j & 1;
        const bool nxt_page = (j + 1 < 2 * npg), nxt_new = (j + 1 == 2 * npg) && (split == 1);
        if (nxt_page) SAT_LOAD(j + 1);
        f32x16 p0;
#pragma unroll
        for (int r = 0; r < 16; ++r) p0[r] = 0.f;
        const LAS unsigned char* kb0 = lds + buf * KTILE + kr * KROW + hh * 16;
        const LAS unsigned char* qb0 = lds + 2 * KTILE + (32 * qblk + ql) * KROW + hh * 16;
        __builtin_amdgcn_s_setprio(1);
#pragma unroll
        for (int ks = 0; ks < 20; ++ks) p0 = __builtin_amdgcn_mfma_f32_32x32x16_bf16(*(const LAS bf16x8*)(kb0 + ks * 32), *(const LAS bf16x8*)(qb0 + ks * 32), p0, 0, 0, 0);
        __builtin_amdgcn_s_setprio(0);
        if (j == 2 * npg) {
            const int tq = (32 * qblk + ql) >> 3;
#pragma unroll
            for (int r = 0; r < 16; ++r) { const int kk = 32 * kb + 16 * (r >> 3) + 8 * hh + (r & 7); if (kk > tq) p0[r] = -__builtin_inff(); }
        }
        bf16x8 pf[2];
        softmax_step1<4>(p0, m, lh, o, pf);
        const LAS unsigned char* vb0 = lds + buf * KTILE + troff;
#pragma unroll
        for (int d = 0; d < 4; ++d)
#pragma unroll
            for (int ss = 0; ss < 2; ++ss) {
                const bf16x8 a = tr_frag(vb0 + d * 64 + ss * 16 * KROW);
                o[d] = __builtin_amdgcn_mfma_f32_32x32x16_bf16(a, pf[ss], o[d], 0, 0, 0);
            }
        if (nxt_page) SAT_STORE(buf ^ 1);
        if (nxt_new) SAT_NEW(buf ^ 1);
        __syncthreads();
    }
#undef SAT_LOAD
#undef SAT_STORE
#undef SAT_NEW
    float lt = half_sum(lh);
    const int pair = dvh * 2 + qblk;
    LAS float* xb = (LAS float*)(lds + pair * 17408);
    if (kb == 1) {
#pragma unroll
        for (int d = 0; d < 4; ++d)
#pragma unroll
            for (int r = 0; r < 16; ++r) xb[(d * 16 + r) * 64 + lane] = o[d][r];
        xb[64 * 64 + lane] = m; xb[65 * 64 + lane] = lt;
    }
    __syncthreads();
    if (kb == 0) {
        const float m1 = xb[64 * 64 + lane], l1 = xb[65 * 64 + lane];
        const float mm = fmaxf(m, m1), w0 = __builtin_amdgcn_exp2f(m - mm), w1 = __builtin_amdgcn_exp2f(m1 - mm);
#pragma unroll
        for (int d = 0; d < 4; ++d)
#pragma unroll
            for (int r = 0; r < 16; ++r) o[d][r] = o[d][r] * w0 + xb[(d * 16 + r) * 64 + lane] * w1;
        lt = lt * w0 + l1 * w1;
        const int q = 32 * qblk + ql;
        float* op = OPART + ((size_t)(b * 2 + split) * 64 + q) * KVL + 128 * dvh + 4 * hh;
#pragma unroll
        for (int d = 0; d < 4; ++d)
#pragma unroll
            for (int g = 0; g < 4; ++g) *(f32x4*)(op + 32 * d + 8 * g) = (f32x4){o[d][4 * g], o[d][4 * g + 1], o[d][4 * g + 2], o[d][4 * g + 3]};
        if (dvh == 0 && hh == 0) *(f32x2*)(OML + ((size_t)(b * 2 + split) * 64 + q) * 2) = (f32x2){mm, lt};
    }
    __syncthreads();
}
}


#define LDS_RD128(dst, addr, off) asm volatile("ds_read_b128 %0, %1 offset:%2" : "=v"(dst) : "v"(addr), "n"(off))
#define LDS_WAIT4(f, N) asm volatile("s_waitcnt lgkmcnt(" #N ")" : "+v"(f[0]), "+v"(f[1]), "+v"(f[2]), "+v"(f[3]))
namespace gla {
constexpr int QROW = 272, KTROW = 144, VROW = 528;
constexpr int P_T16 = 0, P_TOT = 4096, P_QT = 8192, P_KT = P_QT + 64 * QROW;
constexpr int C_DK = 0, C_QT = 1024, C_KH = C_QT + 64 * QROW, C_V = C_KH + 128 * KTROW, C_AT = C_V + 64 * VROW, C_O = C_AT + 6144;
static_assert(C_O + 64 * 8 * 64 <= RING_BYTES, "gla chain LDS");
static_assert(C_AT + 6144 <= RING_BYTES, "gla LDS");
__device__ __forceinline__ bf16x8 tr_frag(const LAS unsigned char* p) {
    typedef short v4i16_t __attribute__((ext_vector_type(4)));
    const s16x4 a = __builtin_bit_cast(s16x4, __builtin_amdgcn_ds_read_tr16_b64_v4i16((LAS v4i16_t*)p));
    const s16x4 b = __builtin_bit_cast(s16x4, __builtin_amdgcn_ds_read_tr16_b64_v4i16((LAS v4i16_t*)(p + 4 * VROW)));
    bf16x8 r; r[0] = a[0]; r[1] = a[1]; r[2] = a[2]; r[3] = a[3]; r[4] = b[0]; r[5] = b[1]; r[6] = b[2]; r[7] = b[3]; return r;
}
template <int SEG>
__device__ __forceinline__ void prep(LAS unsigned char* lds, const int wave, const bf16_t* QKVG, const float* T16, const float* w_gk2, const float* b_gk, int chunk, int h,
                                     bf16_t* QTg, bf16_t* KHg, bf16_t* ATg, float* DKg) {
    const int lane = lane_now(), tid = wave * 64 + lane, ql = lane & 31, hh = lane >> 5;
    const int kk = tid & 127, tq = tid >> 7, cu = chunk * 4 + h, row0 = chunk * 64;
    float w2[16];
#pragma unroll
    for (int j = 0; j < 16; ++j) w2[j] = w_gk2[j * (GH * GDK) + h * GDK + kk];
    const float bias = b_gk[h * GDK + kk];
    unsigned short qraw[16], kraw[16];
    { const bf16_t* qg = QKVG + (size_t)(row0 + tq * 16) * GIN + h * GDK + kk;
#pragma unroll
      for (int i = 0; i < 16; ++i) { qraw[i] = qg[(size_t)i * GIN]; kraw[i] = qg[(size_t)i * GIN + GH * GDK]; } }
    __syncthreads();
    if (tid < 256) *(LAS f32x4*)(lds + P_T16 + tid * 16) = *(const f32x4*)(T16 + (size_t)row0 * 16 + tid * 4);
    __syncthreads();
    float Gl[16];
    { float run = 0.f;
#pragma unroll
      for (int i = 0; i < 16; ++i) { const int t = tq * 16 + i; const LAS f32x4* tp = (const LAS f32x4*)(lds + P_T16 + t * 64);
          const f32x4 a0 = tp[0], a1 = tp[1], a2 = tp[2], a3 = tp[3];
          float z = bias;
          z += a0[0] * w2[0] + a0[1] * w2[1] + a0[2] * w2[2] + a0[3] * w2[3];
          z += a1[0] * w2[4] + a1[1] * w2[5] + a1[2] * w2[6] + a1[3] * w2[7];
          z += a2[0] * w2[8] + a2[1] * w2[9] + a2[2] * w2[10] + a2[3] * w2[11];
          z += a3[0] * w2[12] + a3[1] * w2[13] + a3[2] * w2[14] + a3[3] * w2[15];
          const float ls = fminf(z, 0.f) - 0.6931471805599453f * __builtin_amdgcn_logf(1.0f + __builtin_amdgcn_exp2f(-fabsf(z) * LOG2E));
          if (SEG == 8 && i == 8) run = 0.f;
          run += ls * (1.0f / 16.0f); Gl[i] = run; }
      if (SEG == 64) *(LAS float*)(lds + P_TOT + (tq * 128 + kk) * 4) = run; }
    float prefix = 0.f, total = 0.f;
    if (SEG == 64) {
        __syncthreads();
#pragma unroll
        for (int q = 0; q < 4; ++q) { const float v = *(const LAS float*)(lds + P_TOT + (q * 128 + kk) * 4); total += v; if (q < tq) prefix += v; }
    }
    { unsigned kh[8];
#pragma unroll
      for (int i = 0; i < 16; i += 2) {
          const float G0 = (Gl[i] + prefix) * LOG2E, G1 = (Gl[i + 1] + prefix) * LOG2E;
          const float TL = (SEG == 64 ? total : Gl[i | 7]) * LOG2E;
          const float q0 = bf2f(qraw[i]), q1 = bf2f(qraw[i + 1]), k0 = bf2f(kraw[i]), k1 = bf2f(kraw[i + 1]);
          const unsigned qq = cvt_pk_bf16(q0 * __builtin_amdgcn_exp2f(G0), q1 * __builtin_amdgcn_exp2f(G1));
          const unsigned kt = cvt_pk_bf16(k0 * __builtin_amdgcn_exp2f(-G0), k1 * __builtin_amdgcn_exp2f(-G1));
          kh[i >> 1] = cvt_pk_bf16(k0 * __builtin_amdgcn_exp2f(TL - G0), k1 * __builtin_amdgcn_exp2f(TL - G1));
          const int t = tq * 16 + i;
          *(LAS unsigned short*)(lds + P_QT + t * QROW + kk * 2) = (unsigned short)(qq & 0xffffu); *(LAS unsigned short*)(lds + P_QT + (t + 1) * QROW + kk * 2) = (unsigned short)(qq >> 16);
          *(LAS unsigned short*)(lds + P_KT + t * QROW + kk * 2) = (unsigned short)(kt & 0xffffu); *(LAS unsigned short*)(lds + P_KT + (t + 1) * QROW + kk * 2) = (unsigned short)(kt >> 16);
      }
      bf16_t* khp = KHg + ((size_t)cu * 128 + kk) * 64 + tq * 16;
      *(u32x4*)khp = (u32x4){kh[0], kh[1], kh[2], kh[3]}; *(u32x4*)(khp + 8) = (u32x4){kh[4], kh[5], kh[6], kh[7]};
      if (SEG == 64) { if (tq == 0) DKg[(size_t)cu * 1024 + kk] = __builtin_amdgcn_exp2f(total * LOG2E); }
      else { DKg[(size_t)cu * 1024 + (tq * 2) * 128 + kk] = __builtin_amdgcn_exp2f(Gl[7] * LOG2E); DKg[(size_t)cu * 1024 + (tq * 2 + 1) * 128 + kk] = __builtin_amdgcn_exp2f(Gl[15] * LOG2E); } }
    __syncthreads();
    if (wave < 3) {
        const int sb = wave >> 1, tb = (wave + 1) >> 1, kr = swap23(ql);
        f32x16 x;
#pragma unroll
        for (int r = 0; r < 16; ++r) x[r] = 0.f;
        const LAS unsigned char* ap = lds + P_KT + (32 * sb + kr) * QROW + hh * 16;
        const LAS unsigned char* bp = lds + P_QT + (32 * tb + ql) * QROW + hh * 16;
#pragma unroll
        for (int ks = 0; ks < 8; ++ks) x = __builtin_amdgcn_mfma_f32_32x32x16_bf16(*(const LAS bf16x8*)(ap + ks * 32), *(const LAS bf16x8*)(bp + ks * 32), x, 0, 0, 0);
        const int tt = 32 * tb + ql;
#pragma unroll
        for (int r = 0; r < 16; ++r) { const int sr = 32 * sb + 16 * (r >> 3) + 8 * hh + (r & 7); if (sr > tt || (SEG == 8 && (sr >> 3) != (tt >> 3))) x[r] = 0.f; }
        bf16_t* atp = ATg + (size_t)cu * 3072 + (wave * 2) * 512 + lane * 8;
        *(bf16x8*)atp = pack8(x, 0); *(bf16x8*)(atp + 512) = pack8(x, 8);
    }
#pragma unroll
    for (int i = 0; i < 2; ++i) { const int c = tid + 512 * i, row = c >> 4, cc = c & 15;
        *(u32x4*)(QTg + (size_t)(row0 + row) * (GH * GDK) + h * GDK + cc * 8) = *(const LAS u32x4*)(lds + P_QT + row * QROW + cc * 16); }
}

template <int NWV>
__device__ __forceinline__ void chain(LAS unsigned char* lds, const int wave, const bf16_t* QTg, const bf16_t* KHg, const bf16_t* ATg, const float* DKg, const bf16_t* QKVG, int h, int chunk0, int nchunk,
                                      int srow, int nrow, int sseg, int dseg, int dvbase, const float* state_in, float* state_out, bf16_t* GO) {
    constexpr int VPR = NWV * 4  , VST = NWV / 2  , VRS = 512 / VPR  ;
    const bool active = wave < NWV;
    const int lane = lane_now(), tid = wave * 64 + lane, ql = lane & 31, hh = lane >> 5;
    f32x16 S[4];
#pragma unroll
    for (int kb = 0; kb < 4; ++kb)
#pragma unroll
        for (int r = 0; r < 16; ++r) S[kb][r] = (state_in && active) ? state_in[(size_t)(32 * kb + 16 * (r >> 3) + 8 * hh + (r & 7)) * GDV + dvbase + 32 * wave + ql] : 0.f;
    const int qrow = tid >> 4, qcc = tid & 15;
    const int krow = tid >> 3, kcc = tid & 7;
    const int vrow0 = tid / VPR, vcc = tid % VPR;
    u32x4 qst[2], kst[2], vst[VST], ast, dst;
#define GLC_LOAD(c) do { const int ch = chunk0 + (c); const size_t cu = (size_t)ch * 4 + h; \
        _Pragma("unroll") for (int i = 0; i < 2; ++i) qst[i] = *(const u32x4*)(QTg + (size_t)(ch * 64 + qrow + 32 * i) * (GH * GDK) + h * GDK + qcc * 8); \
        _Pragma("unroll") for (int i = 0; i < 2; ++i) kst[i] = (sseg < 0 || kcc == sseg) ? *(const u32x4*)(KHg + (cu * 128 + krow + 64 * i) * 64 + kcc * 8) : (u32x4){0u, 0u, 0u, 0u}; \
        _Pragma("unroll") for (int i = 0; i < VST; ++i) { const int r = vrow0 + VRS * i; \
            vst[i] = (r >= srow && r < srow + nrow) ? *(const u32x4*)(QKVG + (size_t)(ch * 64 + r) * GIN + 2 * GH * GDK + h * GDV + dvbase + vcc * 8) : (u32x4){0u, 0u, 0u, 0u}; } \
        if (tid < 384) ast = *(const u32x4*)(ATg + cu * 3072 + tid * 8); \
        if (tid < 32) dst = *(const u32x4*)(DKg + cu * 1024 + dseg * 128 + tid * 4); } while (0)
    GLC_LOAD(0);
    const int g16 = lane >> 4, i16 = lane & 15;
    const int troff = (8 * (g16 >> 1) + (i16 >> 2)) * VROW + (32 * wave + 16 * (g16 & 1) + 4 * (i16 & 3)) * 2;
    const int kr = swap23(ql);
#define GLC_LDS_BAR() do { asm volatile("s_waitcnt lgkmcnt(0)" ::: "memory"); __builtin_amdgcn_s_barrier(); asm volatile("" ::: "memory"); } while (0)
#define GLC_FLUSH(cprev) do { if constexpr (NWV != 8) { int tl_ = tid; asm volatile("" : "+v"(tl_)); _Pragma("unroll") for (int i_ = 0; i_ < NWV / 2; ++i_) { const int c_ = tl_ + 512 * i_, row_ = c_ / (NWV * 4), cc_ = c_ % (NWV * 4); \
            *(u32x4*)(GO + (size_t)((chunk0 + (cprev)) * 64 + row_) * DM + h * GDV + dvbase + cc_ * 8) = *(const LAS u32x4*)(lds + C_O + row_ * (NWV * 64) + cc_ * 16); } } } while (0)
    for (int c = 0; c < nchunk; ++c) {
        GLC_LDS_BAR();
        if (c > 0) GLC_FLUSH(c - 1);
#pragma unroll
        for (int i = 0; i < 2; ++i) *(LAS u32x4*)(lds + C_QT + (qrow + 32 * i) * QROW + qcc * 16) = qst[i];
#pragma unroll
        for (int i = 0; i < 2; ++i) *(LAS u32x4*)(lds + C_KH + (krow + 64 * i) * KTROW + kcc * 16) = kst[i];
#pragma unroll
        for (int i = 0; i < VST; ++i) *(LAS u32x4*)(lds + C_V + (vrow0 + VRS * i) * VROW + vcc * 16) = vst[i];
        if (tid < 384) *(LAS u32x4*)(lds + C_AT + tid * 16) = ast;
        if (tid < 32) *(LAS u32x4*)(lds + C_DK + tid * 16) = dst;
        GLC_LDS_BAR();
        if (c + 1 < nchunk) GLC_LOAD(c + 1);
        if (active) {
        f32x16 o[2];
#pragma unroll
        for (int tb = 0; tb < 2; ++tb)
#pragma unroll
            for (int r = 0; r < 16; ++r) o[tb][r] = 0.f;
        const unsigned qa = (unsigned)(size_t)(lds + C_QT + ql * QROW + hh * 16), ka = (unsigned)(size_t)(lds + C_KH + kr * KTROW + hh * 16), ata = (unsigned)(size_t)(lds + C_AT + lane * 16);
        bf16x8 fa[4], fb[4];
#define GLC_QLD(f, kb) do { LDS_RD128(f[0], qa, (kb) * 64); LDS_RD128(f[1], qa, 32 * QROW + (kb) * 64); LDS_RD128(f[2], qa, (kb) * 64 + 32); LDS_RD128(f[3], qa, 32 * QROW + (kb) * 64 + 32); } while (0)
#define GLC_QMM(f, kb) do { const bf16x8 s0 = pack8(S[kb], 0), s1 = pack8(S[kb], 8); \
            o[0] = __builtin_amdgcn_mfma_f32_32x32x16_bf16(f[0], s0, o[0], 0, 0, 0); o[1] = __builtin_amdgcn_mfma_f32_32x32x16_bf16(f[1], s0, o[1], 0, 0, 0); \
            o[0] = __builtin_amdgcn_mfma_f32_32x32x16_bf16(f[2], s1, o[0], 0, 0, 0); o[1] = __builtin_amdgcn_mfma_f32_32x32x16_bf16(f[3], s1, o[1], 0, 0, 0); } while (0)
        GLC_QLD(fa, 0); GLC_QLD(fb, 1);
        LDS_WAIT4(fa, 4); GLC_QMM(fa, 0); GLC_QLD(fa, 2);
        LDS_WAIT4(fb, 4); GLC_QMM(fb, 1); GLC_QLD(fb, 3);
        LDS_WAIT4(fa, 4); GLC_QMM(fa, 2);
        LDS_RD128(fa[0], ata, 0 * 1024); LDS_RD128(fa[1], ata, 1 * 1024); LDS_RD128(fa[2], ata, 2 * 1024); LDS_RD128(fa[3], ata, 3 * 1024);
        LDS_WAIT4(fb, 4); GLC_QMM(fb, 3);
        LDS_RD128(fb[0], ata, 4 * 1024); LDS_RD128(fb[1], ata, 5 * 1024); LDS_RD128(fb[2], ka, 0); LDS_RD128(fb[3], ka, 32);
        bf16x8 vf[4];
#pragma unroll
        for (int ss = 0; ss < 4; ++ss) vf[ss] = tr_frag(lds + C_V + troff + ss * 16 * VROW);
        LDS_WAIT4(fa, 0); LDS_WAIT4(fb, 0);
        o[0] = __builtin_amdgcn_mfma_f32_32x32x16_bf16(fa[0], vf[0], o[0], 0, 0, 0);
        o[0] = __builtin_amdgcn_mfma_f32_32x32x16_bf16(fa[1], vf[1], o[0], 0, 0, 0);
        o[1] = __builtin_amdgcn_mfma_f32_32x32x16_bf16(fa[2], vf[0], o[1], 0, 0, 0);
        o[1] = __builtin_amdgcn_mfma_f32_32x32x16_bf16(fa[3], vf[1], o[1], 0, 0, 0);
        o[1] = __builtin_amdgcn_mfma_f32_32x32x16_bf16(fb[0], vf[2], o[1], 0, 0, 0);
        o[1] = __builtin_amdgcn_mfma_f32_32x32x16_bf16(fb[1], vf[3], o[1], 0, 0, 0);
#define GLC_KLD(f, kb) do { LDS_RD128(f[0], ka, (kb) * 32 * KTROW); LDS_RD128(f[1], ka, (kb) * 32 * KTROW + 32); LDS_RD128(f[2], ka, (kb) * 32 * KTROW + 64); LDS_RD128(f[3], ka, (kb) * 32 * KTROW + 96); } while (0)
#define GLC_SCALE(kb) do { _Pragma("unroll") for (int g = 0; g < 2; ++g) { const LAS f32x4* dp = (const LAS f32x4*)(lds + C_DK + (32 * (kb) + 16 * g + 8 * hh) * 4); const f32x4 d0 = dp[0], d1 = dp[1]; \
            S[kb][8 * g + 0] *= d0[0]; S[kb][8 * g + 1] *= d0[1]; S[kb][8 * g + 2] *= d0[2]; S[kb][8 * g + 3] *= d0[3]; \
            S[kb][8 * g + 4] *= d1[0]; S[kb][8 * g + 5] *= d1[1]; S[kb][8 * g + 6] *= d1[2]; S[kb][8 * g + 7] *= d1[3]; } } while (0)
#define GLC_KMM(f, kb) do { S[kb] = __builtin_amdgcn_mfma_f32_32x32x16_bf16(f[0], vf[0], S[kb], 0, 0, 0); S[kb] = __builtin_amdgcn_mfma_f32_32x32x16_bf16(f[1], vf[1], S[kb], 0, 0, 0); \
            S[kb] = __builtin_amdgcn_mfma_f32_32x32x16_bf16(f[2], vf[2], S[kb], 0, 0, 0); S[kb] = __builtin_amdgcn_mfma_f32_32x32x16_bf16(f[3], vf[3], S[kb], 0, 0, 0); } while (0)
        GLC_KLD(fa, 1);
        LDS_RD128(fb[0], ka, 64); LDS_RD128(fb[1], ka, 96);
        GLC_SCALE(0);
        LDS_WAIT4(fb, 0);
        S[0] = __builtin_amdgcn_mfma_f32_32x32x16_bf16(fb[2], vf[0], S[0], 0, 0, 0); S[0] = __builtin_amdgcn_mfma_f32_32x32x16_bf16(fb[3], vf[1], S[0], 0, 0, 0);
        S[0] = __builtin_amdgcn_mfma_f32_32x32x16_bf16(fb[0], vf[2], S[0], 0, 0, 0); S[0] = __builtin_amdgcn_mfma_f32_32x32x16_bf16(fb[1], vf[3], S[0], 0, 0, 0);
        GLC_KLD(fb, 2); GLC_SCALE(1);
        LDS_WAIT4(fa, 4); GLC_KMM(fa, 1); GLC_KLD(fa, 3); GLC_SCALE(2);
        LDS_WAIT4(fb, 4); GLC_KMM(fb, 2); GLC_SCALE(3);
        LDS_WAIT4(fa, 0); GLC_KMM(fa, 3);
#undef GLC_QLD
#undef GLC_QMM
#undef GLC_KLD
#undef GLC_SCALE
#undef GLC_KMM
        if constexpr (NWV != 8) {
            int qlx = ql, hhx = hh; asm volatile("" : "+v"(qlx), "+v"(hhx));
            LAS unsigned short* op_ = (LAS unsigned short*)(lds + C_O) + (4 * hhx) * (NWV * 32) + 32 * wave + qlx;
#pragma unroll
            for (int tb = 0; tb < 2; ++tb)
#pragma unroll
                for (int r = 0; r < 16; r += 2) { const unsigned w_ = cvt_pk_bf16(o[tb][r], o[tb][r + 1]);
                    const int t0_ = 32 * tb + (r & 3) + 8 * (r >> 2);
                    op_[t0_ * (NWV * 32)] = (unsigned short)(w_ & 0xffffu); op_[(t0_ + 1) * (NWV * 32)] = (unsigned short)(w_ >> 16); }
        } else {
          int qlx = ql, hhx = hh; asm volatile("" : "+v"(qlx), "+v"(hhx));
          bf16_t* gp = GO + (size_t)((chunk0 + c) * 64) * DM + h * GDV + dvbase + 32 * wave + qlx;
#pragma unroll
          for (int tb = 0; tb < 2; ++tb)
#pragma unroll
              for (int r = 0; r < 16; ++r) { const int t = 32 * tb + (r & 3) + 8 * (r >> 2) + 4 * hhx; if (t >= srow && t < srow + nrow) gp[(size_t)t * DM] = (bf16_t)(cvt_pk_bf16(o[tb][r], 0.f) & 0xffffu); } }
        }
    }
    if constexpr (NWV != 8) { GLC_LDS_BAR(); GLC_FLUSH(nchunk - 1); }
#undef GLC_FLUSH
#undef GLC_LOAD
#undef GLC_LDS_BAR
    if (active) { int qlx = ql, hhx = hh; asm volatile("" : "+v"(qlx), "+v"(hhx));
#pragma unroll
    for (int kb = 0; kb < 4; ++kb)
#pragma unroll
        for (int r = 0; r < 16; ++r) state_out[(size_t)(32 * kb + 16 * (r >> 3) + 8 * hhx + (r & 7)) * GDV + dvbase + 32 * wave + qlx] = S[kb][r]; }
    __syncthreads();
}
}

__global__ void __launch_bounds__(NWAVES * 64, 2) mk_fwd(Args args) {
    extern __shared__ __attribute__((aligned(16))) unsigned char lds_raw[];
    LAS unsigned char* lds = (LAS unsigned char*)lds_raw;
    volatile LAS unsigned* MISC = (volatile LAS unsigned*)(lds + MISC_OFF);
    const int wave = __builtin_amdgcn_readfirstlane(threadIdx.x >> 6);
    const int G = gridDim.x; const int bx = blockIdx.x; const int vcu = (G % 8 == 0) ? (bx % 8) * (G / 8) + bx / 8 : bx;
    const int gw = vcu * NWAVES + wave, NGW = G * NWAVES;
    unsigned char* ws = args.ws;
    unsigned* ctl = (unsigned*)(ws + WS_CTL);
    for (int u = wave * 64 + lane_now(); u < (LDS_BYTES - LDSCTL_OFF) / 4; u += NWAVES * 64) ((LAS unsigned*)(lds + LDSCTL_OFF))[u] = 0u;
    __syncthreads();
    XcdBarrier bar = xcd_barrier_post(ctl + 1024, MISC + 8, wave == 0 && lane_now() == 0);
#ifdef PROBE_A0
    unsigned long long* tsb = (unsigned long long*)(ws + WS_CTL + 32768);
    int n_ts = 0;
#define STAMP() do { if (bx == 0 && wave == 0 && lane_now() == 0) tsb[n_ts] = __builtin_amdgcn_s_memrealtime(); ++n_ts; } while (0)
#define GRID_BAR() do { xcd_barrier(bar, wave == 0 && lane_now() == 0); STAMP(); } while (0)
    STAMP();
#else
#define STAMP() do {} while (0)
#define GRID_BAR() xcd_barrier(bar, wave == 0 && lane_now() == 0)
#endif

    const float* x_prompt = (const float*)args.in[0]; const float* x_sample = (const float*)args.in[1];
    const float* cache_ckv = (const float*)args.in[2]; const float* cache_kpe = (const float*)args.in[3];
    const float* state_gla = (const float*)args.in[4]; const int* page_table = (const int*)args.in[5];
    const float* norm_g = (const float*)args.in[6]; const float* ffn_w_in = (const float*)args.in[7]; const float* ffn_w_out = (const float*)args.in[8];
    const float* mla_w_down = (const float*)args.in[9]; const float* mla_g_q = (const float*)args.in[10]; const float* mla_w_uq = (const float*)args.in[11];
    const float* mla_g_kv = (const float*)args.in[12]; const float* mla_w_uk = (const float*)args.in[13]; const float* mla_w_uv = (const float*)args.in[14];
    const float* mla_w_o = (const float*)args.in[15]; const float* gla_w_in = (const float*)args.in[16]; const float* gla_w_gk1 = (const float*)args.in[17];
    const float* gla_w_gk2 = (const float*)args.in[18]; const float* gla_b_gk = (const float*)args.in[19]; const float* gla_g_norm = (const float*)args.in[20];
    const float* gla_w_o = (const float*)args.in[21];
    float* out = args.out;
    float* ROPE_T = (float*)(ws + WS_ROPE);
    bf16_t* WIN = (bf16_t*)(ws + WS_WIN); bf16_t* WOUT = (bf16_t*)(ws + WS_WOUT); bf16_t* WDOWN = (bf16_t*)(ws + WS_WDOWN); bf16_t* WUQ = (bf16_t*)(ws + WS_WUQ);
    bf16_t* WUKT = (bf16_t*)(ws + WS_WUKT); bf16_t* WUK = (bf16_t*)(ws + WS_WUK); bf16_t* WUVT = (bf16_t*)(ws + WS_WUVT); bf16_t* WOT = (bf16_t*)(ws + WS_WOT);
    bf16_t* WGIN = (bf16_t*)(ws + WS_WGIN); bf16_t* WGO = (bf16_t*)(ws + WS_WGO);
    bf16_t* XN = (bf16_t*)(ws + WS_XN); bf16_t* HM = (bf16_t*)(ws + WS_HM); bf16_t* T = (bf16_t*)(ws + WS_T); float* RS = (float*)(ws + WS_H);     float* TP = (float*)(ws + WS_TP); bf16_t* D = (bf16_t*)(ws + WS_D);
    bf16_t* CQ = (bf16_t*)(ws + WS_CQ); bf16_t* CKV = (bf16_t*)(ws + WS_CKV); bf16_t* KPES = (bf16_t*)(ws + WS_KPES);
    bf16_t* KB = (bf16_t*)(ws + WS_KB); bf16_t* KPEP = (bf16_t*)(ws + WS_KPEP);
    float* Y = out + OUT_Y;
    const ConvPtrs cp{ffn_w_in, ffn_w_out, mla_w_down, mla_w_uq, mla_w_uk, mla_w_uv, mla_w_o, gla_w_in, gla_w_o, WIN, WOUT, WDOWN, WUQ, WUKT, WUVT, WOT, WGIN, WGO};

    {
        const int lane = lane_now(), tid = wave * 64 + lane; (void)tid;
        LAS float* scr = (LAS float*)(lds + wave * 16384);
        conv_segment<0>(cp, gw, NGW, scr, lane);
        const int gt = vcu * (NWAVES * 64) + tid, NGT = G * NWAVES * 64;
        for (int i = gt; i < KVL * NH * NOPE / 2; i += NGT) { const f32x2 v = ((const f32x2*)mla_w_uk)[i]; ((unsigned*)WUK)[i] = cvt_pk_bf16(v[0], v[1]); }
        for (int i = gt; i < (DDOWN_P - DDOWN) * DM / 2; i += NGT) ((unsigned*)(WDOWN + (size_t)DDOWN * DM))[i] = 0u;
        for (int i = gt; i < 128 * KVL / 2; i += NGT) ((unsigned*)(WUVT + (size_t)NH * VD * KVL))[i] = 0u;
        for (int i = gt; i < (GIN_P - GIN) * DM / 2; i += NGT) { const int row = (2 * i) / DM, k = (2 * i) % DM;
            unsigned w = 0u; if (row < GRANK) w = cvt_pk_bf16(gla_w_gk1[(size_t)k * GRANK + row], gla_w_gk1[(size_t)(k + 1) * GRANK + row]);
            ((unsigned*)(WGIN + (size_t)GIN * DM))[i] = w; }
        for (int i = gt; i < (SEQ + DECT) * 32; i += NGT) { const int p = i >> 5, fi = i & 31; const float pos = (float)(p < SEQ ? p : PAST + (p - SEQ));
            const float inv = (float)exp2(-(double)fi * (13.287712379549449 / 32.0));
            const float ang = pos * inv; double t = (double)ang * 0.15915494309189535; t -= rint(t); const float tf = (float)t;
            ((f32x2*)ROPE_T)[i] = (f32x2){__builtin_amdgcn_cosf(tf), __builtin_amdgcn_sinf(tf)}; }
        thin_phase<false, true, true, false>(gw, NGW, x_prompt, x_sample, nullptr, nullptr, 0, RS, nullptr, XN, nullptr, norm_g + 0 * DM, 1.f);
        GRID_BAR();
    }
    bf16_t* QKVG = (bf16_t*)(ws + WS_QKVG); float* T16 = (float*)(ws + WS_T16); bf16_t* GO = (bf16_t*)(ws + WS_GO);
    const int CONV_TAIL0 = ((M / 256) * (2 * DFF / 256)) % G;
#define FFN_GEMMS(slot) do { \
        { pg8::Gemm g{XN, WIN + (size_t)(slot) * 2 * DFF * DM, DM, DM, DM, 0, 0}; pg8::Order S{M / 256, 2 * DFF / 256, 1, G, bx}; \
          pg8::EpiSwiGLU E{HM, DFF}; \
          pg8::gemm_phase<pg8::EpiSwiGLU, true>(lds, wave, g, S, E); \
          if ((slot) < 3 && bx >= CONV_TAIL0) conv_segment<((slot) < 3 ? (slot) + 1 : 3)>(cp, (bx - CONV_TAIL0) * NWAVES + wave, (G - CONV_TAIL0) * NWAVES, (LAS float*)(lds + wave * 16384), lane_now()); \
          GRID_BAR(); } \
        { pg8::Gemm g{HM, WOUT + (size_t)(slot) * DM * DFF, DFF, DFF, DFF, 0, 0}; pg8::Order S{MP / 256, DM / 256, 1, G, bx};     \
          pg8::EpiBf16<0> E{T, DM, 0, 256, 1.f, 0}; \
          pg8::gemm_phase<pg8::EpiBf16<0>, true>(lds, wave, g, S, E); } \
        { pg8::Gemm g{HM + (size_t)MP * DFF, WOUT + (size_t)(slot) * DM * DFF, DFF, DFF, 256, 256, 256}; pg8::Order S{MS / 256, DM / 256, 11, G, bx};     \
          pg8::EpiBf16<0> E{(bf16_t*)TP, DM, (long)MS * DM, 256, 1.f, 0};     \
          pg8::gemm_phase<pg8::EpiBf16<0>, true>(lds, wave, g, S, E); \
          GRID_BAR(); } } while (0)
    { const float* ng = norm_g;
    FFN_GEMMS(0);
    thin_phase<true, true, false, false>(gw, NGW, nullptr, nullptr, T, TP, 11, RS, nullptr, XN, ng + 1 * DM, ng + 2 * DM, 0.5f, ng + 0 * DM); GRID_BAR();
        {
            pg8::Gemm g{XN, WDOWN, DM, DM, DM, 0, 0}; pg8::Order S{M / 256, DDOWN_P / 256, 1, G, bx};
            pg8::EpiBf16<0> E{D, DDOWN_P, 0, 256, 1.f, 0};
            pg8::gemm_phase<pg8::EpiBf16<0>, true>(lds, wave, g, S, E);
            GRID_BAR();
        }
        {
            const int lane = lane_now(), tid = wave * 64 + lane; (void)tid;
            f32x2 gq[3]; f32x4 gkv;
    #pragma unroll
            for (int j = 0; j < 3; ++j) gq[j] = *(const f32x2*)(mla_g_q + 2 * lane + 128 * j);
            gkv = *(const f32x4*)(mla_g_kv + 4 * lane);
            for (int r = gw; r < M; r += NGW) {
                const bf16_t* d = D + (size_t)r * DDOWN_P;
                f32x2 q[3];
    #pragma unroll
                for (int j = 0; j < 3; ++j) { const unsigned w = *(const unsigned*)(d + 2 * lane + 128 * j); q[j] = (f32x2){__uint_as_float(w << 16), __uint_as_float(w & 0xffff0000u)}; }
                const u32x2 kw = *(const u32x2*)(d + QL + 4 * lane);
                const f32x4 kv = (f32x4){__uint_as_float(kw.x << 16), __uint_as_float(kw.x & 0xffff0000u), __uint_as_float(kw.y << 16), __uint_as_float(kw.y & 0xffff0000u)};
                const float pe = bf2f(d[QL + KVL + lane]);
                float sq = 0.f;
    #pragma unroll
                for (int j = 0; j < 3; ++j) sq += q[j][0] * q[j][0] + q[j][1] * q[j][1];
                sq = wave_sum(sq);
                const float skv = wave_sum((kv[0] * kv[0] + kv[1] * kv[1]) + (kv[2] * kv[2] + kv[3] * kv[3]));
                const float rq = __builtin_amdgcn_rsqf(sq * (1.0f / QL) + EPS), rkv = __builtin_amdgcn_rsqf(skv * (1.0f / KVL) + EPS);
    #pragma unroll
                for (int j = 0; j < 3; ++j) *(unsigned*)(CQ + (size_t)r * QL + 2 * lane + 128 * j) = cvt_pk_bf16(q[j][0] * rq * gq[j][0], q[j][1] * rq * gq[j][1]);
                const f32x4 ckv = (kv * rkv) * gkv;
                float* ockv = r < MP ? out + OUT_CKV_P + (size_t)r * KVL : out + OUT_CKV_S + (size_t)(r - MP) * KVL;
                *(f32x4*)(ockv + 4 * lane) = ckv;
                u32x2 w; w.x = cvt_pk_bf16(ckv[0], ckv[1]); w.y = cvt_pk_bf16(ckv[2], ckv[3]);
                *(u32x2*)(CKV + (size_t)r * KVL + 4 * lane) = w;
                const float other = __shfl_xor(pe, 32);
                const f32x2 cs = ((const f32x2*)ROPE_T)[rope_pos_index(r) * 32 + (lane & 31)];
                const float ro = lane < 32 ? pe * cs[0] - other * cs[1] : pe * cs[0] + other * cs[1];
                float* okpe = r < MP ? out + OUT_KPE_P + (size_t)r * ROPE : out + OUT_KPE_S + (size_t)(r - MP) * ROPE;
                okpe[lane] = ro;
                const unsigned short rb = (unsigned short)(cvt_pk_bf16(ro, 0.f) & 0xffffu);
                if (r < MP) KPEP[(size_t)r * ROPE + lane] = rb; else KPES[(size_t)(r - MP) * ROPE + lane] = rb;
            }
            GRID_BAR();
        }

        bf16_t* Qb = (bf16_t*)(ws + WS_Q); bf16_t* VT = (bf16_t*)(ws + WS_VT); bf16_t* QLAT = (bf16_t*)(ws + WS_QLAT); bf16_t* Ob = (bf16_t*)(ws + WS_O);
        float* OPART = (float*)(ws + WS_OPART); float* OML = (float*)(ws + WS_OML); bf16_t* OLAT = (bf16_t*)(ws + WS_OLAT);
        const float QSCALE = 0.07216878364870322f * LOG2E;
        {
            pg8::Gemm g{CQ, WUQ, QL, QL, QL, 0, 0}; pg8::Order S{MP / 256, NH * QKD / 256, 1, G, bx};
            pg8::EpiQ E{Qb, ROPE_T, QSCALE};
            pg8::gemm_phase<pg8::EpiQ, true>(lds, wave, g, S, E);
            GRID_BAR();
        }
        {
            const int NQU = (MS / 256) * (NH * QKD / 256), NQP = NQU < G / 2 ? NQU : G / 2, NQC = 32 < G - NQP ? 32 : G - NQP;
            unsigned* qctr = ctl + 16 + 64 * 4;
            if (bx < NQP) {
                pg8::Gemm g{CQ, WUQ, QL, QL, QL, 0, 0}; pg8::OrderOff S{{MS / 256, NH * QKD / 256, 1, NQP, bx}, MP / 256};
                pg8::EpiQ E{Qb, ROPE_T, QSCALE};
                pg8::gemm_phase<pg8::EpiQ, true, pg8::OrderOff>(lds, wave, g, S, E);
                if (wave == 0 && lane_now() == 0) { __builtin_amdgcn_fence(__ATOMIC_RELEASE, "agent"); asm volatile("s_waitcnt vmcnt(0)" ::: "memory"); (void)xb_add(qctr, 1u); }
            }
            { pg8::Gemm g{CKV, WUKT, KVL, KVL, KVL, 0, 0}; pg8::Order S{MP / 256, NH * NOPE / 256, 1, G, bx};
              pg8::EpiBf16<0> E{KB, NH * NOPE, 0, 256, 1.f, 0};
              pg8::gemm_phase<pg8::EpiBf16<0>, true>(lds, wave, g, S, E); }
            { pg8::Gemm g{WUVT, CKV, KVL, KVL, KVL, 0, 0}; pg8::Order S{NH * VD / 256, MP / 256, 1, G, bx};
              pg8::EpiBf16<0> E{VT, MP, 0, 256, 1.f, 0};
              pg8::gemm_phase<pg8::EpiBf16<0>, true>(lds, wave, g, S, E); }
            if (bx >= G - NQC) {
                if (wave == 0 && lane_now() == 0) { XB_SPIN(xb_ld(qctr) < (unsigned)NQP, ctl + 1024); __builtin_amdgcn_fence(__ATOMIC_ACQUIRE, "agent"); asm volatile("s_waitcnt vmcnt(0)" ::: "memory"); }
                __syncthreads();
                { pg8::Gemm g{Qb + (size_t)MP * NH * QKD, WUK, NH * QKD, NH * NOPE, NOPE, QKD, NOPE}; pg8::Order S{MS / 256, 1, NH, NQC, bx - (G - NQC)};
                  pg8::EpiBf16<0> E{QLAT, NH * 320, 320, 256, 1.f, 0};
                  pg8::gemm_phase<pg8::EpiBf16<0>, true>(lds, wave, g, S, E); }
                const int lane = lane_now(), tid = wave * 64 + lane;
                for (int i = (bx - (G - NQC)) * (NWAVES * 64) + tid; i < MS * NH * 8; i += NQC * NWAVES * 64) { const int c = i & 7, th = i >> 3;
                    *(u32x4*)(QLAT + (size_t)th * 320 + 256 + c * 8) = *(const u32x4*)(Qb + (size_t)(MP + (th >> 3)) * (NH * QKD) + (th & 7) * QKD + NOPE + c * 8); }
            }
            GRID_BAR();
        }

        {
            for (int p = vcu; p < NB * NH * 4; p += G) { const int bh = p >> 2, x = p & 3;
                pat::unit(lds, wave, Qb, KB, KPEP, VT, Ob, bh >> 3, bh & 7, 7 - x);
                pat::unit(lds, wave, Qb, KB, KPEP, VT, Ob, bh >> 3, bh & 7, x); }
            STAMP();
            for (int u = bx; u < DECB * 2; u += G)
                sat::unit(lds, wave, QLAT, cache_ckv, cache_kpe, page_table, CKV + (size_t)MP * KVL, KPES, OPART, OML, u >> 1, u & 1);
            GRID_BAR();
        }
        {
            const int lane = lane_now(), tid = wave * 64 + lane; (void)tid;
            for (int r = gw; r < DECB * 64; r += NGW) { const int b = r >> 6, q = r & 63;
                const f32x2 ml0 = *(const f32x2*)(OML + ((size_t)(b * 2) * 64 + q) * 2), ml1 = *(const f32x2*)(OML + ((size_t)(b * 2 + 1) * 64 + q) * 2);
                const float mm = fmaxf(ml0[0], ml1[0]), w0 = __builtin_amdgcn_exp2f(ml0[0] - mm), w1 = __builtin_amdgcn_exp2f(ml1[0] - mm), inv = 1.0f / (ml0[1] * w0 + ml1[1] * w1);
                const f32x4 a = *(const f32x4*)(OPART + ((size_t)(b * 2) * 64 + q) * KVL + 4 * lane), c = *(const f32x4*)(OPART + ((size_t)(b * 2 + 1) * 64 + q) * KVL + 4 * lane);
                const f32x4 v = (a * w0 + c * w1) * inv;
                u32x2 w; w.x = cvt_pk_bf16(v[0], v[1]); w.y = cvt_pk_bf16(v[2], v[3]);
                *(u32x2*)(OLAT + (size_t)r * KVL + 4 * lane) = w; }
            GRID_BAR();
        }
        {
            pg8::Gemm g{OLAT, WUVT, NH * KVL, KVL, KVL, KVL, (long)VD * KVL}; pg8::Order S{MS / 256, 1, NH, G, bx};
            pg8::EpiBf16<0> E{Ob + (size_t)MP * DM, DM, VD, 128, 1.f, 0};
            pg8::gemm_phase<pg8::EpiBf16<0>, true>(lds, wave, g, S, E);
            GRID_BAR();
        }
        {
            { pg8::Gemm g{Ob, WOT, DM, DM, DM, 0, 0}; pg8::Order S{MP / 256, DM / 256, 1, G, bx};
              pg8::EpiBf16<0> E{T, DM, 0, 256, 1.f, 0};
              pg8::gemm_phase<pg8::EpiBf16<0>, true>(lds, wave, g, S, E); }
            { pg8::Gemm g{Ob + (size_t)MP * DM, WOT, DM, DM, 256, 256, 256}; pg8::Order S{MS / 256, DM / 256, 4, G, bx};
              pg8::EpiBf16<0> E{(bf16_t*)TP, DM, (long)MS * DM, 256, 1.f, 0};
              pg8::gemm_phase<pg8::EpiBf16<0>, true>(lds, wave, g, S, E); }
            GRID_BAR();
        }
        {
            thin_phase<true, true, false, false>(gw, NGW, nullptr, nullptr, T, TP, 4, RS, nullptr, XN, norm_g + 3 * DM, norm_g + 4 * DM, 1.0f, norm_g + 2 * DM);
            GRID_BAR();
        }


    FFN_GEMMS(1);
    thin_phase<true, true, false, false>(gw, NGW, nullptr, nullptr, T, TP, 11, RS, nullptr, XN, ng + 5 * DM, norm_g + 6 * DM, 0.5f, ng + 4 * DM); GRID_BAR();
    }
    { const float* ng = norm_g + 6 * DM;
    FFN_GEMMS(2);
    thin_phase<true, true, false, false>(gw, NGW, nullptr, nullptr, T, TP, 11, RS, nullptr, XN, ng + 1 * DM, ng + 2 * DM, 0.5f, ng + 0 * DM); GRID_BAR();
            { pg8::Gemm g{XN, WGIN, DM, DM, DM, 0, 0}; pg8::Order S{M / 256, GIN_P / 256, 1, G, bx};
              pg8::EpiGla E{QKVG, T16, 0.08838834764831845f};
              pg8::gemm_phase<pg8::EpiGla, true>(lds, wave, g, S, E);
              GRID_BAR(); }
            bf16_t* GQT = (bf16_t*)(ws + WS_GQT); bf16_t* GKH = (bf16_t*)(ws + WS_GKH); bf16_t* GAT = (bf16_t*)(ws + WS_GAT); float* GDK_ = (float*)(ws + WS_GDK);
            { for (int u = bx; u < (M / 64) * GH; u += G) { const int chunk = u >> 2, h = u & 3;
                  if (chunk < MP / 64) gla::prep<64>(lds, wave, QKVG, T16, gla_w_gk2, gla_b_gk, chunk, h, GQT, GKH, GAT, GDK_);
                  else gla::prep<8>(lds, wave, QKVG, T16, gla_w_gk2, gla_b_gk, chunk, h, GQT, GKH, GAT, GDK_); }
              GRID_BAR(); }
            { const int NPB = (G >= 2 * NB * GH * 2) ? NB * GH * 2 : 0;
              if (NPB == 0 || vcu < NPB) {
                  for (int u = vcu; u < NB * GH * 2; u += (NPB ? NPB : G)) { const int bh = u >> 1, q = u & 1, b = bh >> 2, h = bh & 3;
                      gla::chain<4>(lds, wave, GQT, GKH, GAT, GDK_, QKVG, h, b * (SEQ / 64), SEQ / 64, 0, 64, -1, 0, 128 * q, nullptr, out + OUT_ST_P + (size_t)bh * GDK * GDV, GO); } }
              if (NPB == 0 || vcu >= NPB) {
                  for (int u = (NPB ? vcu - NPB : vcu); u < DECB * GH; u += (NPB ? G - NPB : G)) { const int b = u >> 2, h = u & 3;
                      gla::chain<8>(lds, wave, GQT, GKH, GAT, GDK_, QKVG, h, MP / 64 + (b >> 3), 1, 8 * (b & 7), 8, b & 7, b & 7, 0, state_gla + (size_t)u * GDK * GDV, out + OUT_ST_S + (size_t)u * GDK * GDV, GO); } }
              GRID_BAR(); }
            bf16_t* GOUT = (bf16_t*)(ws + WS_O);
            { const int lane = lane_now(), tid = wave * 64 + lane; (void)tid; const f32x4 gn = *(const f32x4*)(gla_g_norm + 4 * lane);
              for (int r = gw; r < M; r += NGW) {
                  Row16 o = ld_row_bf16(GO + (size_t)r * DM, lane);
                  const u32x2* gp = (const u32x2*)(QKVG + (size_t)r * GIN + 2 * GH * GDK + GH * GDV) + lane;
#pragma unroll
                  for (int j = 0; j < 4; ++j) { const u32x2 gw2 = gp[64 * j];
                      const float ss = wave_sum((o.v[j][0] * o.v[j][0] + o.v[j][1] * o.v[j][1]) + (o.v[j][2] * o.v[j][2] + o.v[j][3] * o.v[j][3]));
                      const float rs = __builtin_amdgcn_rsqf(ss * (1.0f / GDV) + EPS);
                      const float g0 = __uint_as_float(gw2.x << 16), g1 = __uint_as_float(gw2.x & 0xffff0000u), g2 = __uint_as_float(gw2.y << 16), g3 = __uint_as_float(gw2.y & 0xffff0000u);
                      o.v[j][0] = o.v[j][0] * rs * gn[0] * pg8::silu_f(g0); o.v[j][1] = o.v[j][1] * rs * gn[1] * pg8::silu_f(g1);
                      o.v[j][2] = o.v[j][2] * rs * gn[2] * pg8::silu_f(g2); o.v[j][3] = o.v[j][3] * rs * gn[3] * pg8::silu_f(g3); }
                  st_row_bf16(GOUT + (size_t)r * DM, o, lane); }
              GRID_BAR(); }
            { { pg8::Gemm g{GOUT, WGO, DM, DM, DM, 0, 0}; pg8::Order S{MP / 256, DM / 256, 1, G, bx};
                pg8::EpiBf16<0> E{T, DM, 0, 256, 1.f, 0};
                pg8::gemm_phase<pg8::EpiBf16<0>, true>(lds, wave, g, S, E); }
              { pg8::Gemm g{GOUT + (size_t)MP * DM, WGO, DM, DM, 256, 256, 256}; pg8::Order S{MS / 256, DM / 256, 4, G, bx};
                pg8::EpiBf16<0> E{(bf16_t*)TP, DM, (long)MS * DM, 256, 1.f, 0};
                pg8::gemm_phase<pg8::EpiBf16<0>, true>(lds, wave, g, S, E); }
              GRID_BAR(); }
            { thin_phase<true, true, false, false>(gw, NGW, nullptr, nullptr, T, TP, 4, RS, nullptr, XN, ng + 3 * DM, ng + 4 * DM, 1.0f, ng + 2 * DM);
              GRID_BAR(); }

    FFN_GEMMS(3);
    thin_phase<true, false, false, true>(gw, NGW, nullptr, nullptr, T, TP, 11, RS, Y, XN, ng + 5 * DM, nullptr, 0.5f, ng + 4 * DM);
    }
#ifdef PROBE_A0
    GRID_BAR();
    {
        const int lane = lane_now(), tid = wave * 64 + lane;
        const float ta = (float)(tsb[PROBE_A1] - tsb[PROBE_A0]) * 0.01f, tb = (float)(tsb[PROBE_B1] - tsb[PROBE_B0]) * 0.01f;
        if (bx == 0 && tid == 0) out[0] += ta * 0.1f;
        const float f = 1.0f + tb * (1.0f / PROBE_BDIV);
        for (int i = bx * (NWAVES * 64) + tid; i < MS * ROPE; i += G * NWAVES * 64) out[OUT_KPE_S + i] *= f;
    }
#endif
#ifdef DBG_SCALE_MASK
    GRID_BAR();
    {
        const int lane = lane_now(), tid = wave * 64 + lane; (void)tid;
        const size_t offs[9] = {OUT_Y, OUT_Y + (size_t)MP * DM, OUT_CKV_P, OUT_KPE_P, OUT_CKV_S, OUT_KPE_S, OUT_ST_P, OUT_ST_S, OUT_END};
        for (int o = 0; o < 8; ++o) if ((DBG_SCALE_MASK >> o) & 1)
            for (size_t i = offs[o] / 4 + (size_t)vcu * (NWAVES * 64) + tid; i < offs[o + 1] / 4; i += (size_t)G * NWAVES * 64) ((f32x4*)out)[i] = ((f32x4*)out)[i] * 3.0f;
    }
#endif
#undef GRID_BAR
}

extern "C" void kernel_launch(void* const* d_in, const int* in_sizes, int n_in, void* d_out, int out_size, void* d_ws, size_t ws_size, hipStream_t stream) {
    static int grid = 0;
    if (grid == 0) {
        if (n_in != 22 || (size_t)out_size != OUT_END || ws_size < WS_END) { fprintf(stderr, "kernel_launch: unexpected shapes: n_in %d out %d ws %zu (need %zu)\n", n_in, out_size, ws_size, (size_t)WS_END); grid = -1; return; }
        int dev = 0, cus = 0, per_cu = 0;
        if (hipGetDevice(&dev) != hipSuccess || hipDeviceGetAttribute(&cus, hipDeviceAttributeMultiprocessorCount, dev) != hipSuccess) { grid = -1; return; }
        if (hipFuncSetAttribute((const void*)mk_fwd, hipFuncAttributeMaxDynamicSharedMemorySize, LDS_BYTES) != hipSuccess) { fprintf(stderr, "kernel_launch: hipFuncSetAttribute failed\n"); grid = -1; return; }
        if (hipOccupancyMaxActiveBlocksPerMultiprocessor(&per_cu, (const void*)mk_fwd, NWAVES * 64, LDS_BYTES) != hipSuccess || per_cu < 1) { fprintf(stderr, "kernel_launch: occupancy query says %d\n", per_cu); }
        (void)hipGetLastError();
        grid = cus;
    }
    if (grid < 0) return;
    if (hipMemsetAsync((char*)d_ws + WS_CTL, 0, CTL_ZERO_BYTES, stream) != hipSuccess) return;
    Args a{};
    for (int i = 0; i < 22; ++i) a.in[i] = d_in[i];
    a.out = (float*)d_out; a.ws = (unsigned char*)d_ws; a.ph_lo = 0; a.ph_hi = 100;
    hipLaunchKernelGGL(mk_fwd, dim3(grid), dim3(NWAVES * 64), LDS_BYTES, stream, a);
}
```
